# Optimizing an MI355X kernel written in HIP

```python
import math
import jax
import jax.numpy as jnp
from jax import lax
import numpy as np

D_MODEL = 1024
BATCH = 8
SEQ = 8192
DEPTH = 2

GRID_W = 64
CTX_LEN = 256
N_BRANCH = 3
MLA_HEADS = 8
MLA_Q_RANK = 384
MLA_KV_RANK = 256
MLA_NOPE = 64
MLA_ROPE = 32
MLA_V = 64
DIFF_HEADS = 4
DIFF_QK = 64
DIFF_V = 128
RET_HEADS = 4
RET_K = 64
RET_V = 128
RET_CHUNK = 128
BRANCH_W = 512
D_FF = 2816
N_MOD = 9
ROPE_BASE = 10000.0
Q_BLOCK = 128
EPS = 1e-6
PROJ_SIZES = (MLA_Q_RANK, MLA_KV_RANK, MLA_ROPE,
              DIFF_HEADS * 2 * DIFF_QK, DIFF_HEADS * 2 * DIFF_QK, DIFF_HEADS * DIFF_V,
              RET_HEADS * RET_K, RET_HEADS * RET_K, RET_HEADS * RET_V, RET_HEADS * RET_V,
              N_BRANCH * D_MODEL)
PROJ_DIM = sum(PROJ_SIZES)

kernel_name = 'hybrid_mla_diff_retention_trunk'


def _rmsnorm(x, gain):
    xf = x.astype(jnp.float32)
    xf = xf * lax.rsqrt(jnp.mean(xf * xf, axis=-1, keepdims=True) + EPS)
    return (xf * gain.astype(jnp.float32)).astype(x.dtype)


def _modulate(x, gain, shift, scale):
    return _rmsnorm(x, gain) * (1.0 + scale) + shift


def _swiglu(h, w1, w3, w2):
    return (jax.nn.silu(h @ w1) * (h @ w3)) @ w2


def _rope_1d(x, pos):
    d = x.shape[-1]
    inv = ROPE_BASE ** (-jnp.arange(0, d, 2, dtype=jnp.float32) / d)
    ang = pos.astype(jnp.float32)[:, None] * inv[None, :]
    cos, sin = jnp.cos(ang).astype(x.dtype), jnp.sin(ang).astype(x.dtype)
    x1, x2 = x[..., : d // 2], x[..., d // 2:]
    return jnp.concatenate([x1 * cos - x2 * sin, x1 * sin + x2 * cos], axis=-1)


def _rope_2d(x, row, col):
    h = x.shape[-1] // 2
    return jnp.concatenate([_rope_1d(x[..., :h], row), _rope_1d(x[..., h:], col)], axis=-1)


def _heads(z, n_heads):
    b, s, _ = z.shape
    return z.reshape(b, s, n_heads, -1).transpose(0, 2, 1, 3)


def _merge_heads(z):
    b, h, s, d = z.shape
    return z.transpose(0, 2, 1, 3).reshape(b, s, h * d)


def _sweep_queries(fn, *qs):
    b, h, n, _ = qs[0].shape
    nb = n // Q_BLOCK
    blocks = tuple(jnp.moveaxis(q.reshape(b, h, nb, Q_BLOCK, q.shape[-1]), 2, 0) for q in qs)
    out = lax.map(lambda a: fn(*a), blocks)
    return jnp.moveaxis(out, 0, 2).reshape(b, h, n, out.shape[-1])


def _mla_attend(q_nope, q_rope, k_nope, k_rope, v):
    s = jnp.einsum('bhqd,bhkd->bhqk', q_nope, k_nope) + jnp.einsum('bhqr,bkr->bhqk', q_rope, k_rope)
    p = jax.nn.softmax(s.astype(jnp.float32), axis=-1).astype(v.dtype)
    return jnp.einsum('bhqk,bhkv->bhqv', p, v)


def _diff_attend(q1, q2, k1, k2, v, lam):
    s1 = jnp.einsum('bhqd,bhkd->bhqk', q1, k1).astype(jnp.float32)
    s2 = jnp.einsum('bhqd,bhkd->bhqk', q2, k2).astype(jnp.float32)
    a = jax.nn.softmax(s1, axis=-1) - lam * jax.nn.softmax(s2, axis=-1)
    return jnp.einsum('bhqk,bhkv->bhqv', a.astype(v.dtype), v)


def _retention(q, k, v, log_gamma, state0):
    b, h, s, _ = q.shape
    dv = v.shape[-1]
    nc = s // RET_CHUNK
    idx = jnp.arange(RET_CHUNK, dtype=jnp.float32)
    lg = log_gamma.astype(jnp.float32)[:, None]
    rel = idx[:, None] - idx[None, :]
    intra = jnp.where(rel >= 0, jnp.exp(lg[:, :, None] * jnp.maximum(rel, 0.0)), 0.0)
    q_dec = jnp.exp(lg * (idx + 1.0))[:, :, None]
    k_dec = jnp.exp(lg * (RET_CHUNK - 1.0 - idx))[:, :, None]
    c_dec = jnp.exp(lg * RET_CHUNK)[:, :, None]

    def chunks(z):
        return jnp.moveaxis(z.reshape(b, h, nc, RET_CHUNK, z.shape[-1]), 2, 0)

    def step(state, inp):
        qi, ki, vi = inp
        a = jnp.einsum('bhqd,bhkd->bhqk', qi, ki) * intra
        o = jnp.einsum('bhqk,bhkv->bhqv', a, vi) + jnp.einsum('bhqd,bhdv->bhqv', qi * q_dec, state)
        state = state * c_dec + jnp.einsum('bhkd,bhkv->bhdv', ki * k_dec, vi)
        return state, o

    state, out = lax.scan(step, state0, (chunks(q), chunks(k), chunks(v)))
    return jnp.moveaxis(out, 0, 2).reshape(b, h, s, dv), state


def _token_mixer(hx, hc, row, col, t, w_in, mla_q_norm, mla_w_qb, mla_kv_norm, mla_w_kvb,
                 diff_lambda, diff_norm, lambda_init, ret_decay, ret_norm, w_branch, w_out, ctx_out):
    f32 = jnp.float32
    splits = np.cumsum(PROJ_SIZES)[:-1].tolist()
    px = jnp.split(hx @ w_in, splits, axis=-1)
    pc = jnp.split(hc @ w_in, splits, axis=-1)
    rope_grid = lambda z: _rope_2d(z, row, col)
    rope_seq = lambda z: _rope_1d(z, t)

    def mla_proj(p, rope):
        q = _heads(_rmsnorm(p[0], mla_q_norm) @ mla_w_qb, MLA_HEADS) * (MLA_NOPE + MLA_ROPE) ** -0.5
        kv = _heads(_rmsnorm(p[1], mla_kv_norm) @ mla_w_kvb, MLA_HEADS)
        q_nope, q_rope = q[..., :MLA_NOPE], q[..., MLA_NOPE:]
        k_nope, v = kv[..., :MLA_NOPE], kv[..., MLA_NOPE:]
        k_rope = p[2]
        if rope is not None:
            q_rope, k_rope = rope(q_rope), rope(k_rope)
        return q_nope, q_rope, k_nope, k_rope, v

    xqn, xqr, xkn, xkr, xv = mla_proj(px, rope_grid)
    cqn, cqr, ckn, ckr, cv = mla_proj(pc, None)
    kn_all = jnp.concatenate([xkn, ckn], axis=2)
    kr_all = jnp.concatenate([xkr, ckr], axis=1)
    mv_all = jnp.concatenate([xv, cv], axis=2)
    mla_x = _merge_heads(_sweep_queries(
        lambda qn, qr: _mla_attend(qn, qr, kn_all, kr_all, mv_all), xqn, xqr))

    dl = diff_lambda.astype(f32)
    lam = jnp.exp(jnp.sum(dl[0] * dl[1])) - jnp.exp(jnp.sum(dl[2] * dl[3])) + lambda_init

    def diff_proj(p, rope):
        b, s, _ = p[3].shape
        q = p[3].reshape(b, s, DIFF_HEADS, 2, DIFF_QK).transpose(3, 0, 2, 1, 4) * DIFF_QK ** -0.5
        k = p[4].reshape(b, s, DIFF_HEADS, 2, DIFF_QK).transpose(3, 0, 2, 1, 4)
        v = _heads(p[5], DIFF_HEADS)
        if rope is not None:
            q, k = rope(q), rope(k)
        return q[0], q[1], k[0], k[1], v

    def diff_post(o):
        return _merge_heads(_rmsnorm(o, diff_norm) * (1.0 - lambda_init))

    xq1, xq2, xk1, xk2, xdv = diff_proj(px, rope_grid)
    cq1, cq2, ck1, ck2, cdv = diff_proj(pc, None)
    k1_all = jnp.concatenate([xk1, ck1], axis=2)
    k2_all = jnp.concatenate([xk2, ck2], axis=2)
    dv_all = jnp.concatenate([xdv, cdv], axis=2)
    diff_x = diff_post(_sweep_queries(
        lambda a1, a2: _diff_attend(a1, a2, k1_all, k2_all, dv_all, lam), xq1, xq2))

    log_gamma = -jnp.exp(ret_decay.astype(f32))

    def ret_proj(p, rope):
        q = _heads(p[6], RET_HEADS)
        k = _heads(p[7], RET_HEADS) * RET_K ** -0.5
        v = _heads(p[8], RET_HEADS)
        if rope is not None:
            q, k = rope(q), rope(k)
        return q, k, v

    def ret_post(o, g):
        return _merge_heads(_rmsnorm(o.astype(g.dtype), ret_norm)) * jax.nn.silu(g)

    flip = lambda z: jnp.flip(z, axis=2)
    rq_c, rk_c, rv_c = ret_proj(pc, None)
    rq_x, rk_x, rv_x = ret_proj(px, rope_seq)
    zero = jnp.zeros((hx.shape[0], RET_HEADS, RET_K, RET_V), f32)
    oc_f, st_f = _retention(rq_c, rk_c, rv_c, log_gamma[0], zero)
    oc_b, st_b = _retention(flip(rq_c), flip(rk_c), flip(rv_c), log_gamma[1], zero)
    ox_f, _ = _retention(rq_x, rk_x, rv_x, log_gamma[0], st_f)
    ox_b, _ = _retention(flip(rq_x), flip(rk_x), flip(rv_x), log_gamma[1], st_b)
    ret_x = ret_post(ox_f + flip(ox_b), px[9])

    def merge(y_mla, y_diff, y_ret, gate_logits):
        b, s, _ = gate_logits.shape
        g = jax.nn.sigmoid(gate_logits).reshape(b, s, N_BRANCH, D_MODEL)
        y = (g[:, :, 0] * (y_mla @ w_branch[0]) + g[:, :, 1] * (y_diff @ w_branch[1])
             + g[:, :, 2] * (y_ret @ w_branch[2]))
        return y @ w_out

    y_x = merge(mla_x, diff_x, ret_x, px[10])
    y_c = None
    if ctx_out:
        mla_c = _merge_heads(_mla_attend(cqn, cqr, ckn, ckr, cv))
        diff_c = diff_post(_diff_attend(cq1, cq2, ck1, ck2, cdv, lam))
        ret_c = ret_post(oc_f + flip(oc_b), pc[9])
        y_c = merge(mla_c, diff_c, ret_c, pc[10])
    return y_x, y_c


def setup_inputs(seed: int = 0) -> dict:
    key = jax.random.key(seed)
    ks = jax.random.split(key, 26)
    f32 = jnp.float32
    d, nl = D_MODEL, DEPTH

    def nrm(i, shape, scale):
        return jax.random.normal(ks[i], shape, f32) * scale

    def gain(i, shape):
        return 1.0 + 0.02 * jax.random.normal(ks[i], shape, f32)

    base_decay = jnp.log(-jnp.log1p(-jnp.exp2(-5.0 - jnp.arange(RET_HEADS, dtype=f32))))
    return {
        'x': nrm(0, (BATCH, SEQ, d), 1.0),
        'c': nrm(1, (BATCH, d), 1.0),
        'ctx': nrm(2, (BATCH, CTX_LEN, d), 1.0),
        'c_ctx': nrm(3, (d,), 1.0),
        'ada_w': nrm(4, (nl, d, N_MOD * d), 0.5 * d ** -0.5),
        'ada_b': nrm(5, (nl, N_MOD * d), 0.02),
        'norm_gain': gain(6, (nl, 3, d)),
        'ffn1_w1': nrm(7, (nl, d, D_FF), d ** -0.5),
        'ffn1_w3': nrm(8, (nl, d, D_FF), d ** -0.5),
        'ffn1_w2': nrm(9, (nl, D_FF, d), D_FF ** -0.5),
        'ffn2_w1': nrm(10, (nl, d, D_FF), d ** -0.5),
        'ffn2_w3': nrm(11, (nl, d, D_FF), d ** -0.5),
        'ffn2_w2': nrm(12, (nl, D_FF, d), D_FF ** -0.5),
        'w_in': nrm(13, (nl, d, PROJ_DIM), d ** -0.5),
        'mla_q_norm': gain(14, (nl, MLA_Q_RANK)),
        'mla_w_qb': nrm(15, (nl, MLA_Q_RANK, MLA_HEADS * (MLA_NOPE + MLA_ROPE)), MLA_Q_RANK ** -0.5),
        'mla_kv_norm': gain(16, (nl, MLA_KV_RANK)),
        'mla_w_kvb': nrm(17, (nl, MLA_KV_RANK, MLA_HEADS * (MLA_NOPE + MLA_V)), MLA_KV_RANK ** -0.5),
        'diff_lambda': nrm(18, (nl, 4, DIFF_QK), 0.1),
        'diff_norm': gain(19, (nl, DIFF_V)),
        'ret_decay': base_decay + 0.05 * jax.random.normal(ks[20], (nl, 2, RET_HEADS), f32),
        'ret_norm': gain(21, (nl, RET_V)),
        'w_branch': nrm(22, (nl, N_BRANCH, BRANCH_W, d), BRANCH_W ** -0.5),
        'w_out': nrm(23, (nl, d, d), d ** -0.5),
        'final_norm': gain(24, (d,)),
    }


def reference(x, c, ctx, c_ctx, ada_w, ada_b, norm_gain, ffn1_w1, ffn1_w3, ffn1_w2,
              ffn2_w1, ffn2_w3, ffn2_w2, w_in, mla_q_norm, mla_w_qb, mla_kv_norm, mla_w_kvb,
              diff_lambda, diff_norm, ret_decay, ret_norm, w_branch, w_out, final_norm):
    n = x.shape[1]
    rows = n // GRID_W
    t = jnp.arange(n)
    row = jnp.repeat(jnp.arange(rows), GRID_W)
    col = t - row * GRID_W
    sc_x = jax.nn.silu(c)
    sc_c = jax.nn.silu(c_ctx)
    xc = ctx
    for l in range(DEPTH):
        lambda_init = 0.8 - 0.6 * math.exp(-0.3 * l)
        ctx_out = l < DEPTH - 1
        mx = jnp.split((sc_x @ ada_w[l] + ada_b[l])[:, None, :], N_MOD, axis=-1)
        mc = jnp.split(sc_c @ ada_w[l] + ada_b[l], N_MOD, axis=-1)
        x = x + mx[2] * 0.5 * _swiglu(_modulate(x, norm_gain[l, 0], mx[0], mx[1]),
                                      ffn1_w1[l], ffn1_w3[l], ffn1_w2[l])
        xc = xc + mc[2] * 0.5 * _swiglu(_modulate(xc, norm_gain[l, 0], mc[0], mc[1]),
                                        ffn1_w1[l], ffn1_w3[l], ffn1_w2[l])
        y_x, y_c = _token_mixer(
            _modulate(x, norm_gain[l, 1], mx[3], mx[4]), _modulate(xc, norm_gain[l, 1], mc[3], mc[4]),
            row, col, t, w_in[l], mla_q_norm[l], mla_w_qb[l], mla_kv_norm[l], mla_w_kvb[l],
            diff_lambda[l], diff_norm[l], lambda_init, ret_decay[l], ret_norm[l], w_branch[l], w_out[l],
            ctx_out)
        x = x + mx[5] * y_x
        x = x + mx[8] * 0.5 * _swiglu(_modulate(x, norm_gain[l, 2], mx[6], mx[7]),
                                      ffn2_w1[l], ffn2_w3[l], ffn2_w2[l])
        if ctx_out:
            xc = xc + mc[5] * y_c
            xc = xc + mc[8] * 0.5 * _swiglu(_modulate(xc, norm_gain[l, 2], mc[6], mc[7]),
                                            ffn2_w1[l], ffn2_w3[l], ffn2_w2[l])
    return _rmsnorm(x, final_norm)
```

```cpp
#include <hip/hip_runtime.h>
#include <hip/hip_cooperative_groups.h>
#include <cstdio>
#include <cstdint>
namespace cg = cooperative_groups;

#ifndef PMASK
#define PMASK 0xffffffff
#endif
#if defined(DIAG)
#if DIAG >= 3
#define DIAG_STOP 7
#else
#define DIAG_STOP 8
#endif
#endif
#ifndef PER_PHASE_LAUNCH
#define PER_PHASE_LAUNCH 0
#endif

typedef unsigned short bf16_t;
typedef short bf16x8 __attribute__((ext_vector_type(8)));
typedef short s16x4 __attribute__((ext_vector_type(4)));
typedef float f32x4 __attribute__((ext_vector_type(4)));
typedef float f32x8 __attribute__((ext_vector_type(8)));
typedef float f32x16 __attribute__((ext_vector_type(16)));
typedef unsigned u32x4 __attribute__((ext_vector_type(4)));
typedef unsigned u32x2 __attribute__((ext_vector_type(2)));

constexpr int DM = 1024, NB = 8, SEQ = 8192, CTXL = 256, TL = NB * SEQ, TC = NB * CTXL, T = TL + TC, SK = SEQ + CTXL;
constexpr int DFF = 2816, PROJ = 6816;
constexpr int NPM = T / 256;
constexpr float EPS = 1e-6f;

constexpr size_t al256(size_t x) { return (x + 255) / 256 * 256; }
constexpr size_t O_MOD = 0;
constexpr size_t O_LAM = al256(O_MOD + (size_t)2 * 9 * 9216 * 4);
constexpr size_t O_R1C = O_LAM + 256;
constexpr size_t O_R1S = O_R1C + (size_t)8192 * 32 * 4;
constexpr size_t O_RDC = O_R1S + (size_t)8192 * 32 * 4;
constexpr size_t O_RDS = O_RDC + 128 * 16 * 4;
constexpr size_t O_RMC = O_RDS + 128 * 16 * 4;
constexpr size_t O_RMS = O_RMC + 128 * 8 * 4;
constexpr size_t O_W = al256(O_RMS + 128 * 8 * 4);
constexpr size_t O_WUP = O_W;
constexpr size_t O_WDN = O_WUP + (size_t)5632 * 1024 * 2;
constexpr size_t O_WIN = O_W;
constexpr size_t O_WG = O_WIN + (size_t)3840 * 1024 * 2;
constexpr size_t O_WQB = O_WG + (size_t)3072 * 1024 * 2;
constexpr size_t O_WKVB = O_WQB + (size_t)768 * 384 * 2;
constexpr size_t O_WBR = O_WKVB + (size_t)1024 * 256 * 2;
constexpr size_t O_WOUT = O_WBR + (size_t)3 * 1024 * 512 * 2;
constexpr size_t O_WEND = O_WOUT + (size_t)1024 * 1024 * 2;
constexpr size_t O_XC = al256(O_WEND);
constexpr size_t O_H = O_XC + (size_t)TC * DM * 4;
constexpr size_t O_M = O_H + (size_t)T * DM * 2;
constexpr size_t O_G = O_M;
constexpr size_t TB = (size_t)T;
constexpr size_t O_QLAT = O_M;
constexpr size_t O_KVLAT = O_QLAT + TB * 768;
constexpr size_t O_KNOPE = O_KVLAT + TB * 512;
constexpr size_t O_KROPE = O_KNOPE + TB * 1024;
constexpr size_t O_QD = O_KROPE + TB * 64;
constexpr size_t O_KD = O_QD + TB * 1024;
constexpr size_t O_VD = O_KD + TB * 1024;
constexpr size_t O_RQ = O_VD + TB * 1024;
constexpr size_t O_RK = O_RQ + TB * 512;
constexpr size_t O_RV = O_RK + TB * 512;
constexpr size_t O_YRET = O_RV + TB * 1024;
constexpr size_t O_QMLA = O_YRET + TB * 1024;
constexpr size_t O_VMLA = O_QMLA + TB * 1536;
constexpr size_t O_RETO = O_VMLA + TB * 1024;
constexpr size_t O_END = O_RETO + TB * 2048;
constexpr size_t O_YMLA = O_RQ;
constexpr size_t O_YDIFF = O_RV;
constexpr size_t O_O1S = O_QLAT;
constexpr size_t O_G6S = O_QMLA;
constexpr size_t O_YBR = O_RETO;
static_assert(O_G + TB * 2816 * 2 <= O_END, "ffn g fits");
constexpr size_t WS_NEED = O_END;

constexpr int LDS_BYTES = 131072 + 4096;

struct Params { const float* in[25]; float* out; unsigned char* ws; int ph_lo, ph_hi; };

extern __shared__ __attribute__((aligned(16))) unsigned char g_lds[];

#define MEMFENCE() asm volatile("" ::: "memory")
__device__ __forceinline__ int launder_tid() { int t = __builtin_amdgcn_workitem_id_x(); asm volatile("" : "+v"(t)); return t; }
typedef __bf16 bf16v2_t __attribute__((ext_vector_type(2)));
typedef float f32v2_t __attribute__((ext_vector_type(2)));
__device__ __forceinline__ unsigned cvtpk(float lo, float hi) { const f32v2_t v = {lo, hi}; const bf16v2_t b = __builtin_convertvector(v, bf16v2_t); return __builtin_bit_cast(unsigned, b); }
__device__ __forceinline__ float bf2f(unsigned short b) { return __uint_as_float(((unsigned)b) << 16); }
__device__ __forceinline__ float silu_f(float v) { return v / (1.f + __expf(-v)); }
__device__ __forceinline__ float sigm_f(float v) { return 1.f / (1.f + __expf(-v)); }
__device__ __forceinline__ void store4bf(bf16_t* p, f32x4 v) { u32x2 w; w.x = cvtpk(v[0], v[1]); w.y = cvtpk(v[2], v[3]); *(u32x2*)p = w; }
__device__ __forceinline__ int logical_wg() { const int g = gridDim.x, w = blockIdx.x; return (g % 8 == 0) ? (w % 8) * (g / 8) + w / 8 : w; }

constexpr int BK = 64, HALF = 128, HTB = HALF * BK * 2;
__device__ __forceinline__ int lds_byte(int r, int c) { int st = (r >> 4) * 2 + (c >> 5), rr = r & 15, cc = c & 31, ob = rr * 64 + cc * 2; return st * 1024 + (ob ^ (((ob >> 9) & 1) << 5)); }
__device__ __forceinline__ void stage_rc(int b, int& R, int& C) { int st = b / 1024, sb = b % 1024, swz = sb ^ (((sb >> 9) & 1) << 5); R = (st >> 1) * 16 + swz / 64; C = (st & 1) * 32 + (swz % 64) / 2; }

#define LAS __attribute__((address_space(3)))
#define WAIT_V(n) asm volatile("s_waitcnt vmcnt(" #n ")" ::: "memory")
#define WAIT_L(n) asm volatile("s_waitcnt lgkmcnt(" #n ")" ::: "memory")
#define BAR __builtin_amdgcn_s_barrier()
#define SCHED __builtin_amdgcn_sched_barrier(0)

__device__ __forceinline__ void gemm_core(f32x4 (&acc)[2][2][4][2], const bf16_t* __restrict__ A, int lda, const bf16_t* __restrict__ B, int ldb, int K) {
  LAS unsigned char* lds = (LAS unsigned char*)g_lds;
  const int tid = launder_tid();
  const int wid = __builtin_amdgcn_readfirstlane(tid >> 6), lane = tid & 63, wr = wid >> 2, wc = wid & 3, fr = lane & 15, fq = lane >> 4;
  unsigned voffA[2], voffB[2];
#pragma unroll
  for (int i = 0; i < 2; ++i) { int R, C; stage_rc(tid * 16 + i * 8192, R, C); voffA[i] = (unsigned)(R * lda + C) * 2u; voffB[i] = (unsigned)(R * ldb + C) * 2u; }
  const size_t kstep = (size_t)(BK * 2), hstepA = (size_t)HALF * lda * 2, hstepB = (size_t)HALF * ldb * 2;
  const unsigned ldsw = (unsigned)wid * 1024u;
  const int aoff = lds_byte(wr * 64 + fr, fq * 8), boff = lds_byte(wc * 32 + fr, fq * 8);
  const char* cA = (const char*)A; const char* cB = (const char*)B;
#define G_SA(b, h) (((b) * 2 + (h)) * HTB)
#define G_SB(b, h) ((4 + (b) * 2 + (h)) * HTB)
#define STAGE(bufoff, gbase, voff) do { _Pragma("unroll") for (int _i = 0; _i < 2; ++_i) \
    __builtin_amdgcn_global_load_lds((const unsigned*)((const char*)(gbase) + (voff)[_i]), (LAS unsigned*)(lds + (bufoff) + ldsw + _i * 8192), 16, 0, 0); } while (0)
#define LDA(dst, b, h) do { _Pragma("unroll") for (int m = 0; m < 4; ++m) _Pragma("unroll") for (int k = 0; k < 2; ++k) dst[m][k] = *(const LAS bf16x8*)(lds + G_SA(b, h) + aoff + m * 2048 + k * 1024); } while (0)
#define LDB(dst, b, h) do { _Pragma("unroll") for (int n = 0; n < 2; ++n) _Pragma("unroll") for (int k = 0; k < 2; ++k) dst[n][k] = *(const LAS bf16x8*)(lds + G_SB(b, h) + boff + n * 2048 + k * 1024); } while (0)
#define MMA(ai, bj, At_, Bt_) do { __builtin_amdgcn_s_setprio(1); \
    _Pragma("unroll") for (int m = 0; m < 4; ++m) _Pragma("unroll") for (int n = 0; n < 2; ++n) _Pragma("unroll") for (int k = 0; k < 2; ++k) \
      acc[ai][bj][m][n] = __builtin_amdgcn_mfma_f32_16x16x32_bf16(At_[m][k], Bt_[n][k], acc[ai][bj][m][n], 0, 0, 0); \
    __builtin_amdgcn_s_setprio(0); } while (0)
#pragma unroll
  for (int a = 0; a < 2; ++a)
#pragma unroll
    for (int b = 0; b < 2; ++b)
#pragma unroll
      for (int m = 0; m < 4; ++m)
#pragma unroll
        for (int n = 0; n < 2; ++n) acc[a][b][m][n] = (f32x4){0.f, 0.f, 0.f, 0.f};
  bf16x8 At[4][2], B0[2][2], B1[2][2];
  const int nt = K / BK;
  STAGE(G_SB(0, 0), cB, voffB); STAGE(G_SA(0, 0), cA, voffA); STAGE(G_SB(0, 1), cB + hstepB, voffB); STAGE(G_SA(0, 1), cA + hstepA, voffA);
  if (wr == 1) BAR;
  WAIT_V(4); BAR;
  STAGE(G_SB(1, 0), cB + kstep, voffB); STAGE(G_SA(1, 0), cA + kstep, voffA); STAGE(G_SB(1, 1), cB + hstepB + kstep, voffB);
  WAIT_V(6); BAR;
  for (int t = 0; t < nt - 2; t += 2) {
    const char* a1 = cA + (size_t)(t + 1) * kstep; const char* a2 = cA + (size_t)(t + 2) * kstep; const char* b2 = cB + (size_t)(t + 2) * kstep;
    const char* a3 = a2 + kstep; const char* b3 = b2 + kstep;
    LDB(B0, 0, 0); SCHED; LDA(At, 0, 0); STAGE(G_SA(1, 1), a1 + hstepA, voffA);
    WAIT_L(8); BAR; WAIT_L(0); MMA(0, 0, At, B0); BAR; SCHED;
    LDB(B1, 0, 1); STAGE(G_SB(0, 0), b2, voffB);
    BAR; WAIT_L(0); MMA(0, 1, At, B1); BAR;
    LDA(At, 0, 1); STAGE(G_SA(0, 0), a2, voffA);
    BAR; WAIT_L(0); MMA(1, 0, At, B0); BAR; SCHED;
    STAGE(G_SB(0, 1), b2 + hstepB, voffB);
    WAIT_V(6); BAR; MMA(1, 1, At, B1); BAR;
    LDB(B0, 1, 0); SCHED; LDA(At, 1, 0); STAGE(G_SA(0, 1), a2 + hstepA, voffA);
    WAIT_L(8); BAR; WAIT_L(0); MMA(0, 0, At, B0); BAR; SCHED;
    LDB(B1, 1, 1); STAGE(G_SB(1, 0), b3, voffB);
    BAR; WAIT_L(0); MMA(0, 1, At, B1); BAR;
    LDA(At, 1, 1); STAGE(G_SA(1, 0), a3, voffA);
    BAR; WAIT_L(0); MMA(1, 0, At, B0); BAR; SCHED;
    STAGE(G_SB(1, 1), b3 + hstepB, voffB);
    WAIT_V(6); BAR; MMA(1, 1, At, B1); BAR;
  }
  { const char* a1 = cA + (size_t)(nt - 1) * kstep;
    LDB(B0, 0, 0); LDA(At, 0, 0); STAGE(G_SA(1, 1), a1 + hstepA, voffA);
    BAR; WAIT_L(0); MMA(0, 0, At, B0); BAR;
    LDB(B1, 0, 1); BAR; WAIT_L(0); MMA(0, 1, At, B1); BAR;
    LDA(At, 0, 1); WAIT_V(4); BAR; WAIT_L(0); MMA(1, 0, At, B0); MMA(1, 1, At, B1); BAR; }
  { LDB(B0, 1, 0); LDA(At, 1, 0); WAIT_V(2); BAR; WAIT_L(0); MMA(0, 0, At, B0); BAR;
    LDB(B1, 1, 1); WAIT_V(0); BAR; WAIT_L(0); MMA(0, 1, At, B1); BAR;
    LDA(At, 1, 1); BAR; WAIT_L(0); MMA(1, 0, At, B0); MMA(1, 1, At, B1); BAR; }
  if (wr == 0) BAR;
#undef G_SA
#undef G_SB
#undef STAGE
#undef LDA
#undef LDB
#undef MMA
}

__device__ __forceinline__ void unit_decode(int U, int NPN, int SBN, int& pm, int& pn) {
  const int per = 8 * SBN, blk = U / per, within = U % per, npng = NPN / SBN;
  const int pmg = blk / npng, png = blk % npng;
  pm = pmg * 8 + (within & 7); pn = png * SBN + (within >> 3);
}
struct TI { int b, bb, arow0; };
__device__ __forceinline__ TI tile_info(int pm) { TI t; if (pm < 256) { t.b = pm >> 5; t.bb = t.b; t.arow0 = (pm & 31) * 256; } else { t.b = pm - 256; t.bb = 8; t.arow0 = 8192; } return t; }

#define LANE_IDS const int tid = launder_tid(), wid = __builtin_amdgcn_readfirstlane(tid >> 6), lane = tid & 63, wr = wid >> 2, wc = wid & 3, fr = lane & 15, fq = lane >> 4; (void)tid; (void)wr; (void)wc; (void)fr; (void)fq; (void)lane; (void)wid;

enum { CM_PLAIN = 0, CM_UP, CM_WIN, CM_QB, CM_KVB };
__device__ __forceinline__ int colmap(int kind, int n, int base, int& which) {
  which = 0;
  switch (kind) {
    case CM_PLAIN: return base + n;
    case CM_UP: { const int tile = n >> 8, c = n & 255, ai = c >> 7, wrr = (c >> 6) & 1, m = (c >> 4) & 3, q = c & 15; which = m & 1; return tile * 128 + ai * 64 + wrr * 32 + (m >> 1) * 16 + q; }
    case CM_WIN: {
      if (n < 384) return n;
      if (n < 416) { const int cc = n - 384, part = (cc >> 4) & 1, half = (cc >> 3) & 1, idx = cc & 7; return 640 + half * 16 + part * 8 + idx; }
      if (n < 512) return -1;
      if (n < 768) return 384 + (n - 512);
      return 672 + (n - 768);
    }
    case CM_QB: {
      if (n < 512) return (n >> 6) * 96 + (n & 63);
      const int c = n - 512, h = c >> 5, cc = c & 31, part = (cc >> 4) & 1, half = (cc >> 3) & 1, idx = cc & 7; return h * 96 + 64 + half * 16 + part * 8 + idx;
    }
    case CM_KVB: {
      if (n < 512) return (n >> 6) * 128 + (n & 63);
      const int c = n - 512; return (c >> 6) * 128 + 64 + (c & 63);
    }
  }
  return -1;
}
__device__ __forceinline__ void conv_tile(int kind, bf16_t* dst, int K, const float* src0, const float* src1, int ld, int base, const float* scale, int n0, int k0) {
  float* tl = (float*)g_lds;
  const int tid = launder_tid();
  { const int nn = tid & 63, kk = tid >> 6; int which; const int col = colmap(kind, n0 + nn, base, which); const float* s = which ? src1 : src0;
#pragma unroll
    for (int i = 0; i < 8; ++i) { const int k = kk + 8 * i; float v = 0.f; if (col >= 0) { v = s[(long)(k0 + k) * ld + col]; if (scale) v *= scale[k0 + k]; } tl[k * 65 + nn] = v; } }
  __syncthreads();
  { const int nr = tid >> 3, kc = (tid & 7) * 8; float v[8];
#pragma unroll
    for (int e = 0; e < 8; ++e) v[e] = tl[(kc + e) * 65 + nr];
    u32x4 w; w.x = cvtpk(v[0], v[1]); w.y = cvtpk(v[2], v[3]); w.z = cvtpk(v[4], v[5]); w.w = cvtpk(v[6], v[7]);
    *(u32x4*)(dst + (long)(n0 + nr) * K + k0 + kc) = w; }
  __syncthreads();
}
struct ConvJob { int kind; size_t dst; int N, K; const float* s0; const float* s1; int ld, base; const float* scale; };
__device__ __forceinline__ ConvJob conv_job(const Params& p, int l, int grp, int j) {
  ConvJob J; J.s1 = nullptr; J.scale = nullptr; J.base = 0;
  if (grp != 1) {
    const float* w1 = p.in[grp == 0 ? 7 : 10] + (size_t)l * DM * DFF; const float* w3 = p.in[grp == 0 ? 8 : 11] + (size_t)l * DM * DFF; const float* w2 = p.in[grp == 0 ? 9 : 12] + (size_t)l * DFF * DM;
    if (j == 0) { J.kind = CM_UP; J.dst = O_WUP; J.N = 5632; J.K = 1024; J.s0 = w1; J.s1 = w3; J.ld = DFF; }
    else { J.kind = CM_PLAIN; J.dst = O_WDN; J.N = 1024; J.K = 2816; J.s0 = w2; J.s1 = w2; J.ld = DM; }
  } else {
    const float* win = p.in[13] + (size_t)l * DM * PROJ; const float* wb = p.in[22] + (size_t)l * 3 * 512 * 1024;
    switch (j) {
      case 0: J.kind = CM_WIN; J.dst = O_WIN; J.N = 3840; J.K = 1024; J.s0 = win; J.ld = PROJ; break;
      case 1: J.kind = CM_PLAIN; J.dst = O_WG; J.N = 3072; J.K = 1024; J.s0 = win; J.ld = PROJ; J.base = 3744; break;
      case 2: J.kind = CM_QB; J.dst = O_WQB; J.N = 768; J.K = 384; J.s0 = p.in[15] + (size_t)l * 384 * 768; J.ld = 768; J.scale = p.in[14] + l * 384; break;
      case 3: J.kind = CM_KVB; J.dst = O_WKVB; J.N = 1024; J.K = 256; J.s0 = p.in[17] + (size_t)l * 256 * 1024; J.ld = 1024; J.scale = p.in[16] + l * 256; break;
      case 4: J.kind = CM_PLAIN; J.dst = O_WBR; J.N = 3072; J.K = 512; J.s0 = wb; J.ld = 1024; break;
      default: J.kind = CM_PLAIN; J.dst = O_WOUT; J.N = 1024; J.K = 1024; J.s0 = p.in[23] + (size_t)l * DM * DM; J.ld = DM; break;
    }
    J.s1 = J.s0;
  }
  return J;
}
__device__ __forceinline__ void conv_group(const Params& p, int l, int grp) {
  const int nj = (grp == 1) ? 6 : 2;
  int tot = 0; for (int j = 0; j < nj; ++j) { const ConvJob J = conv_job(p, l, grp, j); tot += (J.N / 64) * (J.K / 64); }
  for (int u = blockIdx.x; u < tot; u += gridDim.x) {
    int v = u, j = 0; ConvJob J = conv_job(p, l, grp, 0);
    for (;;) { const int c = (J.N / 64) * (J.K / 64); if (v < c) break; v -= c; ++j; J = conv_job(p, l, grp, j); }
    const int nk = J.K / 64; const int nt_ = v / nk, kt_ = v % nk;
    int n0 = nt_ * 64; const float* s0 = J.s0; bf16_t* dst = (bf16_t*)(p.ws + J.dst);
    if (grp == 1 && j == 4) { const int i = n0 >> 10; s0 += (size_t)i * 512 * 1024; dst += (size_t)i * 1024 * 512; n0 &= 1023; }
    conv_tile(J.kind, dst, J.K, s0, J.s1, J.ld, J.base, J.scale, n0, kt_ * 64);
  }
}

__device__ __forceinline__ void phase_p0(const Params& p) {
  const int tid = launder_tid();
  float* sl = (float*)g_lds;
  float* red = sl + 9 * 1024;
  for (int i = tid; i < 9 * 1024; i += 512) { const int bb = i >> 10, k = i & 1023; const float v = bb < 8 ? p.in[1][bb * 1024 + k] : p.in[3][k]; sl[i] = v / (1.f + expf(-v)); }
  __syncthreads();
  float* modp = (float*)(p.ws + O_MOD);
  for (int u = blockIdx.x; u < 144; u += gridDim.x) {
    const int l = u / 72, c0 = (u % 72) * 128, col = c0 + (tid & 127), ks = tid >> 7;
    const float* w = p.in[4] + (size_t)l * 1024 * 9216 + col;
    float a[9];
#pragma unroll
    for (int bb = 0; bb < 9; ++bb) a[bb] = 0.f;
    for (int k = ks * 256; k < ks * 256 + 256; ++k) { const float wv = w[(size_t)k * 9216];
#pragma unroll
      for (int bb = 0; bb < 9; ++bb) a[bb] += sl[bb * 1024 + k] * wv; }
#pragma unroll
    for (int bb = 0; bb < 9; ++bb) red[(ks * 9 + bb) * 128 + (tid & 127)] = a[bb];
    __syncthreads();
    for (int i = tid; i < 9 * 128; i += 512) { const int bb = i >> 7, cc = i & 127;
      const float s = red[(0 * 9 + bb) * 128 + cc] + red[(1 * 9 + bb) * 128 + cc] + red[(2 * 9 + bb) * 128 + cc] + red[(3 * 9 + bb) * 128 + cc];
      modp[((size_t)l * 9 + bb) * 9216 + c0 + cc] = s + p.in[5][l * 9216 + c0 + cc]; }
    __syncthreads();
  }
  const long gt = (long)blockIdx.x * 512 + tid, gs = (long)gridDim.x * 512;
  float* r1c = (float*)(p.ws + O_R1C); float* r1s = (float*)(p.ws + O_R1S);
  for (long i = gt; i < 8192 * 32; i += gs) { const int pos = (int)(i >> 5), f = (int)(i & 31); const float inv = (float)pow(10000.0, -(double)(2 * f) / 64.0); const float ang = (float)pos * inv; r1c[i] = (float)cos((double)ang); r1s[i] = (float)sin((double)ang); }
  float* rdc = (float*)(p.ws + O_RDC); float* rds = (float*)(p.ws + O_RDS);
  for (long i = gt; i < 128 * 16; i += gs) { const int pos = (int)(i >> 4), f = (int)(i & 15); const float inv = (float)pow(10000.0, -(double)(2 * f) / 32.0); const float ang = (float)pos * inv; rdc[i] = (float)cos((double)ang); rds[i] = (float)sin((double)ang); }
  float* rmc = (float*)(p.ws + O_RMC); float* rms = (float*)(p.ws + O_RMS);
  for (long i = gt; i < 128 * 8; i += gs) { const int pos = (int)(i >> 3), f = (int)(i & 7); const float inv = (float)pow(10000.0, -(double)(2 * f) / 16.0); const float ang = (float)pos * inv; rmc[i] = (float)cos((double)ang); rms[i] = (float)sin((double)ang); }
  if (blockIdx.x == 0 && tid == 200) { ((float*)(p.ws + O_LAM))[16] = 0.f; ((float*)(p.ws + O_LAM))[17] = 0.f; }
  if (blockIdx.x == 0 && tid < 128) {
    const int l = tid >> 6, ln = tid & 63; const float* dl = p.in[18] + l * 256;
    float s1 = dl[ln] * dl[64 + ln], s2 = dl[128 + ln] * dl[192 + ln];
#pragma unroll
    for (int o = 32; o > 0; o >>= 1) { s1 += __shfl_xor(s1, o); s2 += __shfl_xor(s2, o); }
    const float li = 0.8f - 0.6f * expf(-0.3f * (float)l);
    if (ln == 0) ((float*)(p.ws + O_LAM))[l] = expf(s1) - expf(s2) + li;
  }
}

__device__ __forceinline__ const float* xsrc_row(const Params& p, long row, bool from_input) {
  if (row < TL) return (from_input ? p.in[0] : p.out) + row * DM;
  return (from_input ? p.in[2] : (const float*)(p.ws + O_XC)) + (row - TL) * DM;
}
__device__ __forceinline__ float* xdst_row(const Params& p, long row) { return row < TL ? p.out + row * DM : (float*)(p.ws + O_XC) + (row - TL) * DM; }

__device__ __forceinline__ void phase_norm(const Params& p, int l, int which, bool from_input) {
  const int tid = launder_tid(), wid = tid >> 6, lane = tid & 63;
  bf16_t* H = (bf16_t*)(p.ws + O_H);
  const float* gain = p.in[6] + (l * 3 + which) * DM;
  for (long row = (long)blockIdx.x * 8 + wid; row < T; row += (long)gridDim.x * 8) {
    const float* src = xsrc_row(p, row, from_input);
    f32x4 v[4]; float ss = 0.f;
#pragma unroll
    for (int i = 0; i < 4; ++i) { v[i] = *(const f32x4*)(src + (lane + 64 * i) * 4); ss += v[i][0] * v[i][0] + v[i][1] * v[i][1] + v[i][2] * v[i][2] + v[i][3] * v[i][3]; }
#pragma unroll
    for (int o = 32; o > 0; o >>= 1) ss += __shfl_xor(ss, o);
    const float rstd = rsqrtf(ss * (1.f / 1024.f) + EPS);
    const int bb = row < TL ? (int)(row >> 13) : 8;
    const float* md = (const float*)(p.ws + O_MOD) + ((size_t)l * 9 + bb) * 9216;
#pragma unroll
    for (int i = 0; i < 4; ++i) { const int c = (lane + 64 * i) * 4;
      const f32x4 g = *(const f32x4*)(gain + c), sh = *(const f32x4*)(md + which * 3 * 1024 + c), sc = *(const f32x4*)(md + (which * 3 + 1) * 1024 + c);
      f32x4 o;
#pragma unroll
      for (int e = 0; e < 4; ++e) o[e] = v[i][e] * rstd * g[e] * (1.f + sc[e]) + sh[e];
      store4bf(H + row * DM + c, o); }
  }
}
__device__ __forceinline__ void phase_final(const Params& p) {
  const int tid = launder_tid(), wid = tid >> 6, lane = tid & 63;
  const float* gain = p.in[24];
  for (long row = (long)blockIdx.x * 8 + wid; row < TL; row += (long)gridDim.x * 8) {
    float* src = p.out + row * DM;
    f32x4 v[4]; float ss = 0.f;
#pragma unroll
    for (int i = 0; i < 4; ++i) { v[i] = *(const f32x4*)(src + (lane + 64 * i) * 4); ss += v[i][0] * v[i][0] + v[i][1] * v[i][1] + v[i][2] * v[i][2] + v[i][3] * v[i][3]; }
#pragma unroll
    for (int o = 32; o > 0; o >>= 1) ss += __shfl_xor(ss, o);
    const float rstd = rsqrtf(ss * (1.f / 1024.f) + EPS);
#pragma unroll
    for (int i = 0; i < 4; ++i) { const int c = (lane + 64 * i) * 4; const f32x4 g = *(const f32x4*)(gain + c); f32x4 o;
#pragma unroll
      for (int e = 0; e < 4; ++e) o[e] = v[i][e] * rstd * g[e];
      *(f32x4*)(src + c) = o; }
  }
}

__device__ __forceinline__ void phase_ffn_up(const Params& p) {
  const bf16_t* W = (const bf16_t*)(p.ws + O_WUP); const bf16_t* H = (const bf16_t*)(p.ws + O_H); bf16_t* G = (bf16_t*)(p.ws + O_G);
  const int q = logical_wg();
  for (int U = q; U < NPM * 22; U += gridDim.x) {
    int pm, pn; unit_decode(U, 22, 2, pm, pn);
    f32x4 acc[2][2][4][2];
    gemm_core(acc, W + (size_t)pn * 256 * 1024, 1024, H + (size_t)pm * 256 * 1024, 1024, 1024);
    LANE_IDS
#pragma unroll
    for (int ai = 0; ai < 2; ++ai)
#pragma unroll
      for (int bj = 0; bj < 2; ++bj)
#pragma unroll
        for (int n = 0; n < 2; ++n)
#pragma unroll
          for (int mp = 0; mp < 2; ++mp) {
            const long tok = (long)pm * 256 + bj * 128 + wc * 32 + n * 16 + fr; const int gc = pn * 128 + ai * 64 + wr * 32 + mp * 16 + fq * 4;
            const f32x4 a = acc[ai][bj][2 * mp][n], b = acc[ai][bj][2 * mp + 1][n]; f32x4 o;
#pragma unroll
            for (int e = 0; e < 4; ++e) o[e] = silu_f(a[e]) * b[e];
            store4bf(G + tok * DFF + gc, o);
          }
  }
}
__device__ __forceinline__ void epi_res(const Params& p, const f32x4 (&acc)[2][2][4][2], int l, int pm, int pn, int gate_idx, float scale, bool from_input) {
  LANE_IDS
  const TI ti = tile_info(pm);
  const float* md = (const float*)(p.ws + O_MOD) + ((size_t)l * 9 + ti.bb) * 9216 + gate_idx * 1024;
#pragma unroll
  for (int bj = 0; bj < 2; ++bj)
#pragma unroll
    for (int n = 0; n < 2; ++n) {
      const long row = (long)pm * 256 + bj * 128 + wc * 32 + n * 16 + fr;
      const float* src = xsrc_row(p, row, from_input); float* dst = xdst_row(p, row);
#pragma unroll
      for (int ai = 0; ai < 2; ++ai)
#pragma unroll
        for (int m = 0; m < 4; ++m) {
          const int col = pn * 256 + ai * 128 + wr * 64 + m * 16 + fq * 4;
          const f32x4 xv = *(const f32x4*)(src + col), g = *(const f32x4*)(md + col); f32x4 o;
#pragma unroll
          for (int e = 0; e < 4; ++e) o[e] = xv[e] + g[e] * scale * acc[ai][bj][m][n][e];
          *(f32x4*)(dst + col) = o;
          if (m & 1) MEMFENCE();
        }
    }
}
__device__ __forceinline__ void phase_ffn_down(const Params& p, int l, int gate_idx, bool from_input) {
  const bf16_t* W = (const bf16_t*)(p.ws + O_WDN); const bf16_t* G = (const bf16_t*)(p.ws + O_G);
  const int q = logical_wg();
  for (int U = q; U < NPM * 4; U += gridDim.x) {
    int pm, pn; unit_decode(U, 4, 4, pm, pn);
    f32x4 acc[2][2][4][2];
    gemm_core(acc, W + (size_t)pn * 256 * DFF, DFF, G + (size_t)pm * 256 * DFF, DFF, DFF);
    epi_res(p, acc, l, pm, pn, gate_idx, 0.5f, from_input);
  }
}
__device__ __forceinline__ void phase_wout(const Params& p, int l) {
  const bf16_t* W = (const bf16_t*)(p.ws + O_WOUT); const bf16_t* Y = (const bf16_t*)(p.ws + O_YBR);
  const int q = logical_wg();
  for (int U = q; U < NPM * 4; U += gridDim.x) {
    int pm, pn; unit_decode(U, 4, 4, pm, pn);
    f32x4 acc[2][2][4][2];
    gemm_core(acc, W + (size_t)pn * 256 * 1024, 1024, Y + (size_t)pm * 256 * 1024, 1024, 1024);
    epi_res(p, acc, l, pm, pn, 5, 1.0f, false);
  }
}

__device__ __forceinline__ void rope4(f32x4 x1, f32x4 x2, f32x4 c, f32x4 s, f32x4& o1, f32x4& o2) {
#pragma unroll
  for (int e = 0; e < 4; ++e) { o1[e] = x1[e] * c[e] - x2[e] * s[e]; o2[e] = x1[e] * s[e] + x2[e] * c[e]; }
}
__device__ __forceinline__ void phase_win(const Params& p) {
  const bf16_t* W = (const bf16_t*)(p.ws + O_WIN); const bf16_t* H = (const bf16_t*)(p.ws + O_H);
  bf16_t* QLAT = (bf16_t*)(p.ws + O_QLAT); bf16_t* KVLAT = (bf16_t*)(p.ws + O_KVLAT); bf16_t* KROPE = (bf16_t*)(p.ws + O_KROPE);
  bf16_t* QD = (bf16_t*)(p.ws + O_QD); bf16_t* KD = (bf16_t*)(p.ws + O_KD); bf16_t* VD = (bf16_t*)(p.ws + O_VD);
  bf16_t* RQ = (bf16_t*)(p.ws + O_RQ); bf16_t* RK = (bf16_t*)(p.ws + O_RK); bf16_t* RV = (bf16_t*)(p.ws + O_RV); bf16_t* YRET = (bf16_t*)(p.ws + O_YRET);
  const float* r1c = (const float*)(p.ws + O_R1C); const float* r1s = (const float*)(p.ws + O_R1S);
  const float* rdc = (const float*)(p.ws + O_RDC); const float* rds = (const float*)(p.ws + O_RDS);
  const float* rmc = (const float*)(p.ws + O_RMC); const float* rms = (const float*)(p.ws + O_RMS);
  const int q = logical_wg();
  for (int U = q; U < NPM * 15; U += gridDim.x) {
    int pm, pn; unit_decode(U, 15, 3, pm, pn);
    f32x4 acc[2][2][4][2];
    gemm_core(acc, W + (size_t)pn * 256 * 1024, 1024, H + (size_t)pm * 256 * 1024, 1024, 1024);
    LANE_IDS
    const TI ti = tile_info(pm); const bool lat = ti.bb < 8;
#pragma unroll
    for (int bj = 0; bj < 2; ++bj)
#pragma unroll
      for (int n = 0; n < 2; ++n) {
        const int tl = bj * 128 + wc * 32 + n * 16 + fr; const long tok = (long)pm * 256 + tl; const int ar = ti.arow0 + tl;
        const int prow = ar >> 6, pcol = ar & 63;
        if (pn == 0 || pn == 2 || pn == 13 || pn == 14) {
#pragma unroll
          for (int ai = 0; ai < 2; ++ai)
#pragma unroll
            for (int m = 0; m < 4; ++m) { const int c = ai * 128 + wr * 64 + m * 16 + fq * 4; const f32x4 v = acc[ai][bj][m][n];
              if (pn == 0) store4bf(QLAT + tok * 384 + c, v);
              else if (pn == 2) store4bf(KVLAT + tok * 256 + c, v);
              else { f32x4 o;
#pragma unroll
                for (int e = 0; e < 4; ++e) o[e] = silu_f(v[e]);
                store4bf(YRET + tok * 512 + (pn - 13) * 256 + c, o); } }
        } else if (pn == 1) {
#pragma unroll
          for (int m = 0; m < 4; ++m) store4bf(QLAT + tok * 384 + 256 + wr * 64 + m * 16 + fq * 4, acc[0][bj][m][n]);
          if (wr == 0) {
            const int half = fq >> 1, idx = (fq & 1) * 4; f32x4 o1 = acc[1][bj][0][n], o2 = acc[1][bj][1][n];
            if (lat) { const int pos = half ? pcol : prow; const f32x4 c = *(const f32x4*)(rmc + pos * 8 + idx), s = *(const f32x4*)(rms + pos * 8 + idx); rope4(acc[1][bj][0][n], acc[1][bj][1][n], c, s, o1, o2); }
            bf16_t* d = KROPE + ((long)ti.b * SK + ar) * 32 + half * 16 + idx; store4bf(d, o1); store4bf(d + 8, o2);
          }
        } else if (pn >= 3 && pn <= 6) {
          bf16_t* D = (pn < 5) ? QD : KD; const int hb = ((pn - 3) & 1) * 2;
#pragma unroll
          for (int ai = 0; ai < 2; ++ai) {
            bf16_t* d = D + (((long)ti.b * 8 + (hb + ai) * 2 + wr) * SK + ar) * 64 + fq * 4;
            f32x4 a0 = acc[ai][bj][0][n], a1 = acc[ai][bj][1][n], a2 = acc[ai][bj][2][n], a3 = acc[ai][bj][3][n];
            if (lat) { const f32x4 cr = *(const f32x4*)(rdc + prow * 16 + fq * 4), sr = *(const f32x4*)(rds + prow * 16 + fq * 4), cc = *(const f32x4*)(rdc + pcol * 16 + fq * 4), sc = *(const f32x4*)(rds + pcol * 16 + fq * 4);
              rope4(acc[ai][bj][0][n], acc[ai][bj][1][n], cr, sr, a0, a1); rope4(acc[ai][bj][2][n], acc[ai][bj][3][n], cc, sc, a2, a3); }
            store4bf(d, a0); store4bf(d + 16, a1); store4bf(d + 32, a2); store4bf(d + 48, a3);
          }
        } else if (pn == 7 || pn == 8 || pn == 11 || pn == 12) {
          bf16_t* D = (pn < 9) ? VD : RV; const int hb = (pn < 9 ? pn - 7 : pn - 11) * 2;
#pragma unroll
          for (int ai = 0; ai < 2; ++ai)
#pragma unroll
            for (int m = 0; m < 4; ++m) store4bf(D + (((long)ti.b * 4 + hb + ai) * SK + ar) * 128 + wr * 64 + m * 16 + fq * 4, acc[ai][bj][m][n]);
        } else {
          bf16_t* D = (pn == 9) ? RQ : RK; const float sc = (pn == 9) ? 1.f : 0.125f;
#pragma unroll
          for (int ai = 0; ai < 2; ++ai) {
            bf16_t* d = D + (((long)ti.b * 4 + ai * 2 + wr) * SK + ar) * 64 + fq * 4;
            f32x4 a0 = acc[ai][bj][0][n], a1 = acc[ai][bj][1][n], a2 = acc[ai][bj][2][n], a3 = acc[ai][bj][3][n];
            if (lat) { const f32x4 c0 = *(const f32x4*)(r1c + ar * 32 + fq * 4), s0 = *(const f32x4*)(r1s + ar * 32 + fq * 4), c1 = *(const f32x4*)(r1c + ar * 32 + 16 + fq * 4), s1 = *(const f32x4*)(r1s + ar * 32 + 16 + fq * 4);
              rope4(acc[ai][bj][0][n], acc[ai][bj][2][n], c0, s0, a0, a2); rope4(acc[ai][bj][1][n], acc[ai][bj][3][n], c1, s1, a1, a3); }
            store4bf(d, a0 * sc); store4bf(d + 16, a1 * sc); store4bf(d + 32, a2 * sc); store4bf(d + 48, a3 * sc);
          }
        }
      }
  }
}

__device__ __forceinline__ int crow(int r, int hi) { return (r & 3) + 8 * (r >> 2) + 4 * hi; }
__device__ __forceinline__ void ret_unit(const Params& p, int l, int u) {
  const int tid = launder_tid(), wid = tid >> 6, lane = tid & 63, r32 = lane & 31, hi = lane >> 5;
  const int b = u & 7, h = (u >> 3) & 3, dir = (u >> 5) & 1, s = u >> 6;
  constexpr int QS = 0, KS = 18432, KT = 36864, VT = 54272, VTS = 62976, SC = 71680, SBF = 106496, PW = 115712;
  unsigned char* L = g_lds; float* pw = (float*)(L + PW);
  const float lg = -expf(p.in[20][l * 8 + dir * 4 + h]);
  __syncthreads();
  if (tid <= 128) pw[tid] = expf(lg * (float)tid);
  for (int i = tid; i < 576; i += 512) *(u32x4*)(L + SBF + i * 16) = (u32x4){0u, 0u, 0u, 0u};
  const bf16_t* RQ = (const bf16_t*)(p.ws + O_RQ) + ((long)b * 4 + h) * SK * 64;
  const bf16_t* RK = (const bf16_t*)(p.ws + O_RK) + ((long)b * 4 + h) * SK * 64;
  const bf16_t* RV = (const bf16_t*)(p.ws + O_RV) + ((long)b * 4 + h) * SK * 128 + s * 32;
  bf16_t* RO = (bf16_t*)(p.ws + O_RETO) + (size_t)dir * T * 512 + h * 128 + s * 32;
  f32x16 sacc = {};
  u32x4 rq0, rq1, rk0, rk1, rv0;
  const int qrow0 = tid >> 3, qcc = tid & 7, vrow = tid >> 2, vcc = tid & 3;
  auto chunk_arow = [&](int n) -> int { if (n < 2) return 8192 + 128 * (dir ? 1 - n : n); return 128 * (dir ? 65 - n : n - 2); };
#define RLOAD(n) do { const int ar_ = chunk_arow(n); \
    rq0 = *(const u32x4*)(RQ + (long)(ar_ + qrow0) * 64 + qcc * 8); rq1 = *(const u32x4*)(RQ + (long)(ar_ + 64 + qrow0) * 64 + qcc * 8); \
    rk0 = *(const u32x4*)(RK + (long)(ar_ + qrow0) * 64 + qcc * 8); rk1 = *(const u32x4*)(RK + (long)(ar_ + 64 + qrow0) * 64 + qcc * 8); \
    rv0 = *(const u32x4*)(RV + (long)(ar_ + vrow) * 128 + vcc * 8); } while (0)
  RLOAD(0);
  int cur = 0;
  for (int n = 0; n < 66; ++n) {
    __syncthreads();
    *(u32x4*)(L + QS + qrow0 * 144 + qcc * 16) = rq0; *(u32x4*)(L + QS + (64 + qrow0) * 144 + qcc * 16) = rq1;
    *(u32x4*)(L + KS + qrow0 * 144 + qcc * 16) = rk0; *(u32x4*)(L + KS + (64 + qrow0) * 144 + qcc * 16) = rk1;
    { const unsigned short* e0 = (const unsigned short*)&rk0; const unsigned short* e1 = (const unsigned short*)&rk1;
#pragma unroll
      for (int e = 0; e < 8; ++e) { *(unsigned short*)(L + KT + (qcc * 8 + e) * 272 + qrow0 * 2) = e0[e]; *(unsigned short*)(L + KT + (qcc * 8 + e) * 272 + (64 + qrow0) * 2) = e1[e]; }
      const unsigned short* ev = (const unsigned short*)&rv0; const float kd = pw[dir ? vrow : 127 - vrow];
#pragma unroll
      for (int e = 0; e < 8; ++e) { *(unsigned short*)(L + VT + (vcc * 8 + e) * 272 + vrow * 2) = ev[e];
        const unsigned pk = cvtpk(bf2f(ev[e]) * kd, 0.f); *(unsigned short*)(L + VTS + (vcc * 8 + e) * 272 + vrow * 2) = (unsigned short)(pk & 0xffff); } }
    __syncthreads();
    if (n + 1 < 66) RLOAD(n + 1);
    { const int I = wid >> 1;
#pragma unroll
      for (int jj = 0; jj < 2; ++jj) { const int J = (wid & 1) * 2 + jj; f32x16 sc = {};
#pragma unroll
        for (int kk = 0; kk < 4; ++kk) { const bf16x8 ka = *(const bf16x8*)(L + KS + (32 * I + r32) * 144 + (kk * 16 + hi * 8) * 2), qb = *(const bf16x8*)(L + QS + (32 * J + r32) * 144 + (kk * 16 + hi * 8) * 2);
          sc = __builtin_amdgcn_mfma_f32_32x32x16_bf16(ka, qb, sc, 0, 0, 0); }
        const int a = 32 * J + r32;
#pragma unroll
        for (int q4 = 0; q4 < 4; ++q4) { f32x4 o;
#pragma unroll
          for (int e = 0; e < 4; ++e) { const int ap = 32 * I + 8 * q4 + 4 * hi + e; const int dd = dir ? ap - a : a - ap; o[e] = dd >= 0 ? sc[q4 * 4 + e] * pw[dd >= 0 ? dd : 0] : 0.f; }
          store4bf((bf16_t*)(L + SC + a * 272 + (32 * I + 8 * q4 + 4 * hi) * 2), o); } } }
    __syncthreads();
    if (wid < 4) {
      f32x16 a1 = {}, a2 = {};
#pragma unroll
      for (int kk = 0; kk < 8; ++kk) { const bf16x8 sa = *(const bf16x8*)(L + SC + (32 * wid + r32) * 272 + (kk * 16 + hi * 8) * 2), vb = *(const bf16x8*)(L + VT + r32 * 272 + (kk * 16 + hi * 8) * 2);
        a1 = __builtin_amdgcn_mfma_f32_32x32x16_bf16(sa, vb, a1, 0, 0, 0); }
#pragma unroll
      for (int kk = 0; kk < 4; ++kk) { const bf16x8 qa = *(const bf16x8*)(L + QS + (32 * wid + r32) * 144 + (kk * 16 + hi * 8) * 2), sb = *(const bf16x8*)(L + SBF + cur * 4608 + r32 * 144 + (kk * 16 + hi * 8) * 2);
        a2 = __builtin_amdgcn_mfma_f32_32x32x16_bf16(qa, sb, a2, 0, 0, 0); }
      const int ar = chunk_arow(n); const long tokbase = (ar >= 8192) ? (long)TL + b * 256 + (ar - 8192) : (long)b * 8192 + ar;
#pragma unroll
      for (int r = 0; r < 16; ++r) { const int a = 32 * wid + crow(r, hi); const float qd = pw[dir ? 128 - a : a + 1];

#if defined(DIAG) && DIAG == 4
        const unsigned pk = cvtpk(a1[r], 0.f);
#elif defined(DIAG) && DIAG == 5
        const unsigned pk = cvtpk(qd * a2[r], 0.f);
#else
        const unsigned pk = cvtpk(a1[r] + qd * a2[r], 0.f);
#endif
        RO[(tokbase + a) * 512 + r32] = (unsigned short)(pk & 0xffff); }
    } else if (wid < 6) {
      const int db = wid - 4; const float cd = pw[128];
#pragma unroll
      for (int r = 0; r < 16; ++r) sacc[r] *= cd;
#pragma unroll
      for (int kk = 0; kk < 8; ++kk) { const bf16x8 ka = *(const bf16x8*)(L + KT + (32 * db + r32) * 272 + (kk * 16 + hi * 8) * 2), vb = *(const bf16x8*)(L + VTS + r32 * 272 + (kk * 16 + hi * 8) * 2);
        sacc = __builtin_amdgcn_mfma_f32_32x32x16_bf16(ka, vb, sacc, 0, 0, 0); }
#pragma unroll
      for (int q4 = 0; q4 < 4; ++q4) { f32x4 o = {sacc[q4 * 4], sacc[q4 * 4 + 1], sacc[q4 * 4 + 2], sacc[q4 * 4 + 3]};
        store4bf((bf16_t*)(L + SBF + (cur ^ 1) * 4608 + r32 * 144 + (32 * db + 8 * q4 + 4 * hi) * 2), o); }
    }
    cur ^= 1;
  }
  __syncthreads();
#undef RLOAD
}

__device__ __forceinline__ void row_rstd(const bf16_t* src, int Kd) {
  const int tid = launder_tid(), row = tid >> 1, hf = tid & 1; float* rs = (float*)(g_lds + 131072);
  const bf16_t* s = src + (long)row * Kd + hf * (Kd / 2); float ss = 0.f;
  for (int c = 0; c < Kd / 16; ++c) { const u32x4 w = *(const u32x4*)(s + c * 8);
#pragma unroll
    for (int e = 0; e < 4; ++e) { const float lo = __uint_as_float(w[e] << 16), hi_ = __uint_as_float(w[e] & 0xffff0000u); ss += lo * lo + hi_ * hi_; } }
  ss += __shfl_xor(ss, 1);
  if (hf == 0) rs[row] = rsqrtf(ss / (float)Kd + EPS);
  __syncthreads();
}
__device__ __forceinline__ void phase_g4(const Params& p, int l) {
  if (PMASK & 0x80000) for (int u = blockIdx.x; u < 256; u += gridDim.x) ret_unit(p, l, u);
  const bf16_t* WQB = (const bf16_t*)(p.ws + O_WQB); const bf16_t* WKVB = (const bf16_t*)(p.ws + O_WKVB);
  const bf16_t* QLAT = (const bf16_t*)(p.ws + O_QLAT); const bf16_t* KVLAT = (const bf16_t*)(p.ws + O_KVLAT);
  bf16_t* QMLA = (bf16_t*)(p.ws + O_QMLA); bf16_t* KNOPE = (bf16_t*)(p.ws + O_KNOPE); bf16_t* VMLA = (bf16_t*)(p.ws + O_VMLA);
  const float* rmc = (const float*)(p.ws + O_RMC); const float* rms = (const float*)(p.ws + O_RMS);
  const float* rs = (const float*)(g_lds + 131072);
  const int q = logical_wg();
  if (PMASK & 0x100000) for (int U = q; U < NPM * 7; U += gridDim.x) {
    const bool isq = U < NPM * 3; int pm, pn;
    if (isq) unit_decode(U, 3, 3, pm, pn); else unit_decode(U - NPM * 3, 4, 4, pm, pn);
    f32x4 acc[2][2][4][2];
    __syncthreads();
    if (isq) { row_rstd(QLAT + (size_t)pm * 256 * 384, 384); gemm_core(acc, WQB + (size_t)pn * 256 * 384, 384, QLAT + (size_t)pm * 256 * 384, 384, 384); }
    else { row_rstd(KVLAT + (size_t)pm * 256 * 256, 256); gemm_core(acc, WKVB + (size_t)pn * 256 * 256, 256, KVLAT + (size_t)pm * 256 * 256, 256, 256); }
    LANE_IDS
    const TI ti = tile_info(pm); const bool lat = ti.bb < 8;
#pragma unroll
    for (int bj = 0; bj < 2; ++bj)
#pragma unroll
      for (int n = 0; n < 2; ++n) {
        const int tl = bj * 128 + wc * 32 + n * 16 + fr; const int ar = ti.arow0 + tl; const float rr = rs[tl]; const int prow = ar >> 6, pcol = ar & 63;
        if (isq && pn == 2) {
          const int half = fq >> 1, idx = (fq & 1) * 4; const int pos = half ? pcol : prow;
          f32x4 c = {1.f, 1.f, 1.f, 1.f}, s = {0.f, 0.f, 0.f, 0.f};
          if (lat) { c = *(const f32x4*)(rmc + pos * 8 + idx); s = *(const f32x4*)(rms + pos * 8 + idx); }
#pragma unroll
          for (int ai = 0; ai < 2; ++ai)
#pragma unroll
            for (int mp = 0; mp < 2; ++mp) { const int hd = ai * 4 + wr * 2 + mp; f32x4 o1, o2; rope4(acc[ai][bj][2 * mp][n] * rr, acc[ai][bj][2 * mp + 1][n] * rr, c, s, o1, o2);
              bf16_t* d = QMLA + (((long)ti.b * 8 + hd) * SK + ar) * 96 + 64 + half * 16 + idx; store4bf(d, o1); store4bf(d + 8, o2); }
        } else {
#pragma unroll
          for (int ai = 0; ai < 2; ++ai)
#pragma unroll
            for (int m = 0; m < 4; ++m) { const int cfull = (pn & 1) * 256 + ai * 128 + wr * 64 + m * 16 + fq * 4; const int hd = cfull >> 6, d = cfull & 63; const f32x4 v = acc[ai][bj][m][n] * rr;
              if (isq) store4bf(QMLA + (((long)ti.b * 8 + hd) * SK + ar) * 96 + d, v);
              else if (pn < 2) store4bf(KNOPE + (((long)ti.b * 8 + hd) * SK + ar) * 64 + d, v);
              else store4bf(VMLA + (((long)ti.b * 8 + hd) * SK + ar) * 64 + d, v); }
        }
      }
  }
}

#define SBAR() __builtin_amdgcn_sched_barrier(0)
template <int DQK> __device__ __forceinline__ int kswz(int row, int colB) { if (DQK == 96) return row * 256 + (colB ^ ((row & 7) << 4)); return row * 128 + (colB ^ (((row >> 1) & 7) << 4)); }
#ifndef EXP_THR
#define EXP_THR 8.f
#endif
constexpr float ATHR = EXP_THR;
template <int DQK> __device__ __forceinline__ void partialSM(f32x16& p0, f32x16& p1, float& m_reg, float& mn, float& alpha) {
  constexpr float SCALE = (DQK == 96) ? 0.10206207261596575f : 0.125f; constexpr float C = SCALE * 1.4426950408889634f;
  float pmax = p0[0];
#pragma unroll
  for (int r = 1; r < 16; ++r) pmax = fmaxf(pmax, p0[r]);
#pragma unroll
  for (int r = 0; r < 16; ++r) pmax = fmaxf(pmax, p1[r]);
  { auto rr = __builtin_amdgcn_permlane32_swap(__float_as_uint(pmax), __float_as_uint(pmax), false, false); pmax = fmaxf(__uint_as_float(rr[0]), __uint_as_float(rr[1])); }
  if (__builtin_expect(__all(pmax - m_reg <= ATHR / SCALE), 1)) { mn = m_reg; alpha = 1.f; }
  else { mn = fmaxf(m_reg, pmax); alpha = __builtin_amdgcn_exp2f((m_reg - mn) * C); m_reg = mn; }
  const float mnC = -mn * C;
#pragma unroll
  for (int r = 0; r < 16; ++r) p0[r] = fmaf(p0[r], C, mnC);
#pragma unroll
  for (int r = 0; r < 16; ++r) p1[r] = fmaf(p1[r], C, mnC);
#pragma unroll
  for (int r = 0; r < 16; ++r) p0[r] = __builtin_amdgcn_exp2f(p0[r]);
}
__device__ __forceinline__ void finishSM(f32x16& p0, f32x16& p1, float alpha, float& l_reg, bf16x8& pa0, bf16x8& pa1, bf16x8& pa2, bf16x8& pa3) {
#pragma unroll
  for (int r = 0; r < 16; ++r) p1[r] = __builtin_amdgcn_exp2f(p1[r]);
  float ps = 0;
#pragma unroll
  for (int r = 0; r < 16; ++r) ps += p0[r];
#pragma unroll
  for (int r = 0; r < 16; ++r) ps += p1[r];
  { auto rr = __builtin_amdgcn_permlane32_swap(__float_as_uint(ps), __float_as_uint(ps), false, false); ps = __uint_as_float(rr[0]) + __uint_as_float(rr[1]); }
  l_reg = l_reg * alpha + ps;
#define PK4(P, BASE, OUT) do { unsigned a0 = cvtpk(P[BASE + 0], P[BASE + 1]), a1 = cvtpk(P[BASE + 2], P[BASE + 3]); \
    unsigned b0 = cvtpk(P[BASE + 4], P[BASE + 5]), b1 = cvtpk(P[BASE + 6], P[BASE + 7]); \
    auto r0 = __builtin_amdgcn_permlane32_swap(a0, b0, false, false); auto r1 = __builtin_amdgcn_permlane32_swap(a1, b1, false, false); \
    u32x4 w = {r0[0], r1[0], r0[1], r1[1]}; OUT = *reinterpret_cast<bf16x8*>(&w); } while (0)
  PK4(p0, 0, pa0); PK4(p0, 8, pa1); PK4(p1, 0, pa2); PK4(p1, 8, pa3);
#undef PK4
}
template <int DQK> __device__ __forceinline__ void qkt(f32x16& p0, f32x16& p1, const unsigned char* Ks, const bf16x8* qr, int r32, int hi) {
  p0 = f32x16{}; p1 = f32x16{};
#pragma unroll
  for (int d0 = 0; d0 < DQK / 16; ++d0) { const int cb = (d0 * 16 + hi * 8) * 2;
    const bf16x8 b0 = *reinterpret_cast<const bf16x8*>(Ks + kswz<DQK>(r32, cb));
    const bf16x8 b1 = *reinterpret_cast<const bf16x8*>(Ks + kswz<DQK>(32 + r32, cb));
    p0 = __builtin_amdgcn_mfma_f32_32x32x16_bf16(b0, qr[d0], p0, 0, 0, 0);
    p1 = __builtin_amdgcn_mfma_f32_32x32x16_bf16(b1, qr[d0], p1, 0, 0, 0); }
}
template <int DV> __device__ __forceinline__ int v_st(int k, int c) { const int kk = (k & ~0xC) | ((k & 4) << 1) | ((k & 8) >> 1); return ((kk >> 3) * (DV / 32) + (c >> 5)) * 512 + ((kk & 7) * 32 + (c & 31)) * 2; }
__device__ __forceinline__ int v_rd_base(int lane) { return ((lane & 3) << 3) | (((lane >> 2) & 3) << 6) | (((lane >> 4) & 1) << 5) | (((lane >> 5) & 1) << 8); }
template <int OFF> __device__ __forceinline__ s16x4 tr_read(int vb) { s16x4 r; asm volatile("ds_read_b64_tr_b16 %0, %1 offset:%2" : "=&v"(r) : "v"(vb), "i"(OFF) : "memory"); return r; }
template <int DV, int D0> __device__ __forceinline__ void pv_one(f32x16& od, int vb, bf16x8 pa0, bf16x8 pa1, bf16x8 pa2, bf16x8 pa3) {
  constexpr int NS = DV / 32;
#define VOFF(ks, half) (D0 * 512 + (ks) * (2 * NS * 512) + (half) * (NS * 512))
  const s16x4 l0 = tr_read<VOFF(0, 0)>(vb), h0 = tr_read<VOFF(0, 1)>(vb), l1 = tr_read<VOFF(1, 0)>(vb), h1 = tr_read<VOFF(1, 1)>(vb);
  const s16x4 l2 = tr_read<VOFF(2, 0)>(vb), h2 = tr_read<VOFF(2, 1)>(vb), l3 = tr_read<VOFF(3, 0)>(vb), h3 = tr_read<VOFF(3, 1)>(vb);
#undef VOFF
  asm volatile("s_waitcnt lgkmcnt(0)" ::: "memory"); SBAR();
#define PK(L_, H_) (bf16x8){L_[0], L_[1], L_[2], L_[3], H_[0], H_[1], H_[2], H_[3]}
  od = __builtin_amdgcn_mfma_f32_32x32x16_bf16(pa0, PK(l0, h0), od, 0, 0, 0);
  od = __builtin_amdgcn_mfma_f32_32x32x16_bf16(pa1, PK(l1, h1), od, 0, 0, 0);
  od = __builtin_amdgcn_mfma_f32_32x32x16_bf16(pa2, PK(l2, h2), od, 0, 0, 0);
  od = __builtin_amdgcn_mfma_f32_32x32x16_bf16(pa3, PK(l3, h3), od, 0, 0, 0);
#undef PK
}
template <int DV> __device__ __forceinline__ void pv_all(f32x16* o, int vb, bf16x8 pa0, bf16x8 pa1, bf16x8 pa2, bf16x8 pa3) {
  pv_one<DV, 0>(o[0], vb, pa0, pa1, pa2, pa3); pv_one<DV, 1>(o[1], vb, pa0, pa1, pa2, pa3);
  if constexpr (DV == 128) { pv_one<DV, 2>(o[2], vb, pa0, pa1, pa2, pa3); pv_one<DV, 3>(o[3], vb, pa0, pa1, pa2, pa3); }
}
template <int DQK, int DV>
__device__ __forceinline__ void attn_body(const bf16_t* __restrict__ Qb, const bf16_t* kp0, int kst0, const bf16_t* kp1, int kst1, bool k1valid,
                                          const bf16_t* vp0, const bf16_t* vp1, int nkeys, f32x16 (&o)[DV / 32]) {
  constexpr int KSTR = (DQK == 96) ? 256 : 128, SHM_K = 64 * KSTR, SHM_V = 64 * DV * 2, CK = DQK / 8, CV = DV / 8, ND = DV / 32;
  constexpr bool K2 = (64 * CK > 512), V2 = (64 * CV > 512);
  const int tid = launder_tid(), wid = tid >> 6, lane = tid & 63, r32 = lane & 31, hi = lane >> 5;
  unsigned char* V_lds = g_lds; unsigned char* K_lds = g_lds + 2 * SHM_V;
  float* ws = (float*)(g_lds + 2 * SHM_V + 2 * SHM_K) + wid * 64; float* li_l = ws; float* al_l = ws + 32;
  float m_reg = -1e30f, l_reg = 0;
#pragma unroll
  for (int d = 0; d < ND; ++d) o[d] = f32x16{};
  bf16x8 qr[DQK / 16];
  const bf16_t* Qw = Qb + (long)(wid * 32 + r32) * DQK + hi * 8;
#pragma unroll
  for (int d0 = 0; d0 < DQK / 16; ++d0) qr[d0] = *reinterpret_cast<const bf16x8*>(Qw + d0 * 16);
  const int kq0 = tid, kq1 = tid + 512;
  const int kd0 = kswz<DQK>(kq0 / CK, (kq0 % CK) * 16), kd1 = kswz<DQK>((kq1 / CK) & 63, (kq1 % CK) * 16);
  const int vq0 = tid, vq1 = tid + 512;
  const int vd0 = v_st<DV>(vq0 / CV, (vq0 % CV) * 8), vd1 = v_st<DV>((vq1 / CV) & 63, (vq1 % CV) * 8);
  const int vb0 = (int)(uintptr_t)(__attribute__((address_space(3))) unsigned char*)V_lds + v_rd_base(lane);
  struct St { bf16x8 k0, k1, v0, v1; } sr_[2];
#define SLOAD(i, key0) do { sr_[i].k0 = *reinterpret_cast<const bf16x8*>(kp0 + (long)(key0) * kst0); \
    if (K2) { if (k1valid) sr_[i].k1 = *reinterpret_cast<const bf16x8*>(kp1 + (long)(key0) * kst1); } \
    sr_[i].v0 = *reinterpret_cast<const bf16x8*>(vp0 + (long)(key0) * DV); \
    if (V2) sr_[i].v1 = *reinterpret_cast<const bf16x8*>(vp1 + (long)(key0) * DV); } while (0)
#define SWRITE(b, i) do { *(bf16x8*)(K_lds + (b) * SHM_K + kd0) = sr_[i].k0; \
    if (K2) { if (k1valid) *(bf16x8*)(K_lds + (b) * SHM_K + kd1) = sr_[i].k1; } \
    *(bf16x8*)(V_lds + (b) * SHM_V + vd0) = sr_[i].v0; \
    if (V2) *(bf16x8*)(V_lds + (b) * SHM_V + vd1) = sr_[i].v1; } while (0)
#define RESC(a) do { if (__any((a) < 1.f)) { if (hi == 0) al_l[r32] = (a); asm volatile("s_waitcnt lgkmcnt(0)" ::: "memory"); \
    _Pragma("unroll") for (int d = 0; d < ND; ++d) _Pragma("unroll") for (int r = 0; r < 16; ++r) o[d][r] *= al_l[crow(r, hi)]; } } while (0)
  f32x16 pA0, pA1, pB0, pB1; float mnA, mnB, alA, alB; bf16x8 pa0, pa1, pa2, pa3; const int NT = nkeys / 64;
  __syncthreads();
  SLOAD(0, 0); asm volatile("s_waitcnt vmcnt(0)" ::: "memory"); SWRITE(0, 0); __syncthreads();
  qkt<DQK>(pA0, pA1, K_lds, qr, r32, hi); partialSM<DQK>(pA0, pA1, m_reg, mnA, alA);
  SLOAD(1, 64); if (2 < NT) SLOAD(0, 128);
  SWRITE(1, 1); __syncthreads();
  for (int j = 1; j + 1 < NT; j += 2) {
    SBAR(); qkt<DQK>(pB0, pB1, K_lds + SHM_K, qr, r32, hi);
    finishSM(pA0, pA1, alA, l_reg, pa0, pa1, pa2, pa3); SBAR();
    SLOAD(1, (j + 2) * 64); SBAR();
    pv_all<DV>(o, vb0, pa0, pa1, pa2, pa3); partialSM<DQK>(pB0, pB1, m_reg, mnB, alB);
    __syncthreads(); SWRITE(0, 0);
    RESC(alB); __syncthreads();
    SBAR(); qkt<DQK>(pA0, pA1, K_lds, qr, r32, hi);
    finishSM(pB0, pB1, alB, l_reg, pa0, pa1, pa2, pa3); SBAR();
    if (j + 3 < NT) SLOAD(0, (j + 3) * 64); SBAR();
    pv_all<DV>(o, vb0 + SHM_V, pa0, pa1, pa2, pa3); partialSM<DQK>(pA0, pA1, m_reg, mnA, alA);
    __syncthreads(); SWRITE(1, 1);
    RESC(alA); __syncthreads();
  }
  SBAR(); qkt<DQK>(pB0, pB1, K_lds + SHM_K, qr, r32, hi);
  finishSM(pA0, pA1, alA, l_reg, pa0, pa1, pa2, pa3); SBAR();
  pv_all<DV>(o, vb0, pa0, pa1, pa2, pa3); partialSM<DQK>(pB0, pB1, m_reg, mnB, alB);
  __syncthreads(); RESC(alB);
  finishSM(pB0, pB1, alB, l_reg, pa0, pa1, pa2, pa3); SBAR();
  pv_all<DV>(o, vb0 + SHM_V, pa0, pa1, pa2, pa3);
  if (hi == 0) li_l[r32] = l_reg; asm volatile("s_waitcnt lgkmcnt(0)" ::: "memory");
#pragma unroll
  for (int r = 0; r < 16; ++r) { const float rl = __builtin_amdgcn_rcpf(li_l[crow(r, hi)]);
#pragma unroll
    for (int d = 0; d < ND; ++d) o[d][r] *= rl; }
  __syncthreads();
#undef SLOAD
#undef SWRITE
#undef RESC
}

__device__ __forceinline__ void mla_unit(const Params& p, int b, int h, int qrow0, int key0, int nkeys, long tok0) {
  const int tid = launder_tid(), wid = tid >> 6, lane = tid & 63, r32 = lane & 31, hi = lane >> 5;
  const bf16_t* Q = (const bf16_t*)(p.ws + O_QMLA) + (((long)b * 8 + h) * SK + qrow0) * 96;
  const bf16_t* KN = (const bf16_t*)(p.ws + O_KNOPE) + (((long)b * 8 + h) * SK + key0) * 64;
  const bf16_t* KR = (const bf16_t*)(p.ws + O_KROPE) + ((long)b * SK + key0) * 32;
  const bf16_t* V = (const bf16_t*)(p.ws + O_VMLA) + (((long)b * 8 + h) * SK + key0) * 64;
  const int q0 = tid, q1 = tid + 512; const int r0 = q0 / 12, c0 = q0 % 12, r1 = (q1 / 12) & 63, c1 = q1 % 12;
  const bf16_t* kp0 = c0 < 8 ? KN + (long)r0 * 64 + c0 * 8 : KR + (long)r0 * 32 + (c0 - 8) * 8; const int ks0 = c0 < 8 ? 64 : 32;
  const bf16_t* kp1 = c1 < 8 ? KN + (long)r1 * 64 + c1 * 8 : KR + (long)r1 * 32 + (c1 - 8) * 8; const int ks1 = c1 < 8 ? 64 : 32;
  const bf16_t* vp0 = V + (long)(tid >> 3) * 64 + (tid & 7) * 8;
  f32x16 o[2];
  attn_body<96, 64>(Q, kp0, ks0, kp1, ks1, tid < 256, vp0, vp0, nkeys, o);
  bf16_t* Y = (bf16_t*)(p.ws + O_YMLA);
#pragma unroll
  for (int r = 0; r < 16; ++r) { const long tok = tok0 + wid * 32 + crow(r, hi);
#pragma unroll
    for (int d = 0; d < 2; ++d) { const unsigned pk = cvtpk(o[d][r], 0.f); Y[tok * 512 + h * 64 + d * 32 + r32] = (unsigned short)(pk & 0xffff); } }
}
__device__ __forceinline__ void diff_unit(const Params& p, int l, int b, int h, int qrow0, int key0, int nkeys, long tok0) {
  const int tid = launder_tid(), wid = tid >> 6, lane = tid & 63, r32 = lane & 31, hi = lane >> 5;
  float* scr = (float*)(p.ws + O_O1S) + (size_t)blockIdx.x * 32768; float* scrt = scr + (size_t)tid * 64;
  const float lam = ((const float*)(p.ws + O_LAM))[l];
  const float li = 0.8f - 0.6f * expf(-0.3f * (float)l);
  const bf16_t* V = (const bf16_t*)(p.ws + O_VD) + (((long)b * 4 + h) * SK + key0) * 128;
  const bf16_t* vp0 = V + (long)(tid >> 4) * 128 + (tid & 15) * 8; const bf16_t* vp1 = V + (long)(32 + (tid >> 4)) * 128 + (tid & 15) * 8;
  f32x16 o[4];
  for (int s = 0; s < 2; ++s) {
    const bf16_t* Q = (const bf16_t*)(p.ws + O_QD) + (((long)b * 8 + h * 2 + s) * SK + qrow0) * 64;
    const bf16_t* K = (const bf16_t*)(p.ws + O_KD) + (((long)b * 8 + h * 2 + s) * SK + key0) * 64;
    const bf16_t* kp0 = K + (long)(tid >> 3) * 64 + (tid & 7) * 8;
    attn_body<64, 128>(Q, kp0, 64, kp0, 64, false, vp0, vp1, nkeys, o);
    if (s == 0) {
#pragma unroll
      for (int d = 0; d < 4; ++d)
#pragma unroll
        for (int r = 0; r < 16; ++r) scrt[d * 16 + r] = o[d][r];
    }
  }
  const float* dn = p.in[19] + l * 128; bf16_t* Y = (bf16_t*)(p.ws + O_YDIFF);
  float gn[4];
#pragma unroll
  for (int d = 0; d < 4; ++d) gn[d] = dn[d * 32 + r32] * (1.f - li);
#pragma unroll
  for (int r = 0; r < 16; ++r) {
    float v[4], ss = 0.f;
#pragma unroll
    for (int d = 0; d < 4; ++d) { v[d] = scrt[d * 16 + r] - lam * o[d][r]; ss += v[d] * v[d]; }
#pragma unroll
    for (int m = 1; m < 32; m <<= 1) ss += __shfl_xor(ss, m);
    const float rstd = rsqrtf(ss * (1.f / 128.f) + EPS);
    const long tok = tok0 + wid * 32 + crow(r, hi);
#pragma unroll
    for (int d = 0; d < 4; ++d) { const unsigned pk = cvtpk(v[d] * rstd * gn[d], 0.f); Y[tok * 512 + h * 128 + d * 32 + r32] = (unsigned short)(pk & 0xffff); }
    MEMFENCE();
  }
}
__device__ __forceinline__ void phase_attn(const Params& p, int l) {
  const int tid = launder_tid(), wid = tid >> 6, lane = tid & 63;
  const int q = logical_wg(), G = gridDim.x;
  if (PMASK & 0x10000) for (int U = q; U < 2048; U += G) { const int h = U >> 8, w = U & 255, b = w >> 5, qb = w & 31; mla_unit(p, b, h, qb * 256, 0, SK, (long)b * 8192 + qb * 256); }
  if (PMASK & 0x20000) for (int U = q; U < 1024; U += G) { const int h = U >> 8, w = U & 255, b = w >> 5, qb = w & 31; diff_unit(p, l, b, h, qb * 256, 0, SK, (long)b * 8192 + qb * 256); }
  if (PMASK & 0x10000) for (int U = q; U < 64; U += G) { const int b = U >> 3, h = U & 7; mla_unit(p, b, h, 8192, 8192, 256, (long)TL + b * 256); }
  if (PMASK & 0x20000) for (int U = q; U < 32; U += G) { const int b = U >> 2, h = U & 3; diff_unit(p, l, b, h, 8192, 8192, 256, (long)TL + b * 256); }
  const bf16_t* RO = (const bf16_t*)(p.ws + O_RETO); bf16_t* YR = (bf16_t*)(p.ws + O_YRET); const float* rn = p.in[21] + l * 128;
  const int vc = (lane & 15) * 8; f32x8 gnv = *(const f32x8*)(rn + vc);
  if (PMASK & 0x40000) for (long row = (long)blockIdx.x * 8 + wid; row < T; row += (long)gridDim.x * 8) {
    const u32x4 a = *(const u32x4*)(RO + row * 512 + lane * 8), bq = *(const u32x4*)(RO + (size_t)T * 512 + row * 512 + lane * 8), g = *(const u32x4*)(YR + row * 512 + lane * 8);
    float v[8], ss = 0.f;
#pragma unroll
    for (int e = 0; e < 4; ++e) { v[2 * e] = __uint_as_float(a[e] << 16) + __uint_as_float(bq[e] << 16); v[2 * e + 1] = __uint_as_float(a[e] & 0xffff0000u) + __uint_as_float(bq[e] & 0xffff0000u); }
#pragma unroll
    for (int e = 0; e < 8; ++e) ss += v[e] * v[e];
#pragma unroll
    for (int m = 1; m < 16; m <<= 1) ss += __shfl_xor(ss, m);
    const float rstd = rsqrtf(ss * (1.f / 128.f) + EPS);
    u32x4 w;
#pragma unroll
    for (int e = 0; e < 4; ++e) { const float g0 = __uint_as_float(g[e] << 16), g1 = __uint_as_float(g[e] & 0xffff0000u); w[e] = cvtpk(v[2 * e] * rstd * gnv[2 * e] * g0, v[2 * e + 1] * rstd * gnv[2 * e + 1] * g1); }
    *(u32x4*)(YR + row * 512 + lane * 8) = w;
  }
}

template <int MODE>
__device__ __forceinline__ void branch_epi(const f32x4 (&acc)[2][2][4][2], const u32x2* sg, f32x4* sa, bf16_t* YBR, int pm, int pn, int tid, int wr, int wc, int fr, int fq) {
  const u32x2* sgt = sg + (size_t)tid * 32; f32x4* sat = sa + (size_t)tid * 32;
#pragma unroll
  for (int bj = 0; bj < 2; ++bj)
#pragma unroll
    for (int n = 0; n < 2; ++n) {
      const long tok = (long)pm * 256 + bj * 128 + wc * 32 + n * 16 + fr; bf16_t* yrow = YBR + tok * 1024 + pn * 256 + wr * 64 + fq * 4;
#pragma unroll
      for (int ai = 0; ai < 2; ++ai)
#pragma unroll
        for (int m = 0; m < 4; ++m) { const int e = ((ai * 2 + bj) * 4 + m) * 2 + n; const u32x2 w = sgt[e]; f32x4 v = acc[ai][bj][m][n];
          v[0] *= __uint_as_float(w.x << 16); v[1] *= __uint_as_float(w.x & 0xffff0000u); v[2] *= __uint_as_float(w.y << 16); v[3] *= __uint_as_float(w.y & 0xffff0000u);
          if (MODE > 0) v += sat[e];
          if (MODE < 2) sat[e] = v; else store4bf(yrow + ai * 128 + m * 16, v);
          if (m & 1) MEMFENCE(); }
    }
}
__device__ __forceinline__ void phase_branch(const Params& p) {
  const bf16_t* WG = (const bf16_t*)(p.ws + O_WG); const bf16_t* WBR = (const bf16_t*)(p.ws + O_WBR); const bf16_t* H = (const bf16_t*)(p.ws + O_H);
  bf16_t* YBR = (bf16_t*)(p.ws + O_YBR);
  unsigned char* scr = p.ws + O_G6S + (size_t)blockIdx.x * 393216; u32x2* sg = (u32x2*)scr; f32x4* sa = (f32x4*)(scr + 131072);
  const int q = logical_wg();
  for (int U = q; U < NPM * 4; U += gridDim.x) {
    int pm, pn; unit_decode(U, 4, 4, pm, pn);
    for (int i = 0; i < 3; ++i) {
      const bf16_t* Y = (const bf16_t*)(p.ws + (i == 0 ? O_YMLA : (i == 1 ? O_YDIFF : O_YRET)));
      f32x4 acc[2][2][4][2];
      gemm_core(acc, WG + ((size_t)i * 1024 + pn * 256) * 1024, 1024, H + (size_t)pm * 256 * 1024, 1024, 1024);
      { const int tid = launder_tid(); u32x2* sgt = sg + (size_t)tid * 32;
#pragma unroll
      for (int ai = 0; ai < 2; ++ai)
#pragma unroll
        for (int bj = 0; bj < 2; ++bj)
#pragma unroll
          for (int m = 0; m < 4; ++m)
#pragma unroll
            for (int n = 0; n < 2; ++n) { const int e = ((ai * 2 + bj) * 4 + m) * 2 + n; const f32x4 v = acc[ai][bj][m][n]; u32x2 w; w.x = cvtpk(sigm_f(v[0]), sigm_f(v[1])); w.y = cvtpk(sigm_f(v[2]), sigm_f(v[3])); sgt[e] = w; if (n == 1) MEMFENCE(); } }
      gemm_core(acc, WBR + ((size_t)i * 1024 + pn * 256) * 512, 512, Y + (size_t)pm * 256 * 512, 512, 512);
      LANE_IDS
      if (i == 0) branch_epi<0>(acc, sg, sa, YBR, pm, pn, tid, wr, wc, fr, fq);
      else if (i == 1) branch_epi<1>(acc, sg, sa, YBR, pm, pn, tid, wr, wc, fr, fq);
      else branch_epi<2>(acc, sg, sa, YBR, pm, pn, tid, wr, wc, fr, fq);
    }
  }
}


#ifdef DIAG
__device__ __forceinline__ float blk_reduce(float v, int mode, float* red) {
  const int tid = launder_tid(), lane = tid & 63, wid = tid >> 6;
#pragma unroll
  for (int o = 32; o > 0; o >>= 1) { const float t = __shfl_xor(v, o); v = mode ? fmaxf(v, t) : v + t; }
  __syncthreads();
  if (lane == 0) red[wid] = v;
  __syncthreads();
  float r = red[0];
  for (int i = 1; i < 8; ++i) r = mode ? fmaxf(r, red[i]) : r + red[i];
  return r;
}
__device__ __forceinline__ void phase_diag(const Params& p) {
  const int tid = launder_tid();
  float* w0 = (float*)g_lds; float* w1 = w0 + 8448; float* qv = w1 + 8448; float* ov = qv + 256; float* red = ov + 256;
  float* dg = (float*)(p.ws + O_LAM) + 16;
  const int S = blockIdx.x; const int b = S & 7, t = (S * 977 + 131) % 8192; const long tok = (long)b * 8192 + t;
  float num = 0.f, den = 0.f;
#if DIAG == 1
  { const int h = (S >> 3) & 7; const bf16_t* Q = (const bf16_t*)(p.ws + O_QMLA) + (((long)b * 8 + h) * SK + t) * 96;
    const bf16_t* KN = (const bf16_t*)(p.ws + O_KNOPE) + ((long)b * 8 + h) * SK * 64; const bf16_t* KR = (const bf16_t*)(p.ws + O_KROPE) + (long)b * SK * 32;
    const bf16_t* V = (const bf16_t*)(p.ws + O_VMLA) + ((long)b * 8 + h) * SK * 64;
    if (tid < 96) qv[tid] = bf2f(Q[tid]);
    __syncthreads();
    float mx = -1e30f;
    for (int k = tid; k < SK; k += 512) { float d = 0.f; for (int e = 0; e < 64; ++e) d += qv[e] * bf2f(KN[(long)k * 64 + e]); for (int e = 0; e < 32; ++e) d += qv[64 + e] * bf2f(KR[(long)k * 32 + e]); d *= 0.10206207261596575f; w0[k] = d; mx = fmaxf(mx, d); }
    mx = blk_reduce(mx, 1, red); float l = 0.f;
    for (int k = tid; k < SK; k += 512) { const float e = expf(w0[k] - mx); w0[k] = e; l += e; }
    l = blk_reduce(l, 0, red);
    if (tid < 64) { float a = 0.f; for (int k = 0; k < SK; ++k) a += w0[k] * bf2f(V[(long)k * 64 + tid]); a /= l;
      const float y = bf2f(((const bf16_t*)(p.ws + O_YMLA))[tok * 512 + h * 64 + tid]); num = (a - y) * (a - y); den = a * a; } }
#elif DIAG == 2
  { const int h = (S >> 3) & 3; const float lam = ((const float*)(p.ws + O_LAM))[0];
    const bf16_t* V = (const bf16_t*)(p.ws + O_VD) + ((long)b * 4 + h) * SK * 128; float ls[2];
    for (int s2 = 0; s2 < 2; ++s2) { float* w = s2 ? w1 : w0;
      const bf16_t* Q = (const bf16_t*)(p.ws + O_QD) + (((long)b * 8 + h * 2 + s2) * SK + t) * 64; const bf16_t* K = (const bf16_t*)(p.ws + O_KD) + ((long)b * 8 + h * 2 + s2) * SK * 64;
      __syncthreads();
      if (tid < 64) qv[tid] = bf2f(Q[tid]);
      __syncthreads();
      float mx = -1e30f;
      for (int k = tid; k < SK; k += 512) { float d = 0.f; for (int e = 0; e < 64; ++e) d += qv[e] * bf2f(K[(long)k * 64 + e]); d *= 0.125f; w[k] = d; mx = fmaxf(mx, d); }
      mx = blk_reduce(mx, 1, red); float l = 0.f;
      for (int k = tid; k < SK; k += 512) { const float e = expf(w[k] - mx); w[k] = e; l += e; }
      ls[s2] = blk_reduce(l, 0, red); }
    if (tid < 256) { const int d = tid & 127, s2 = tid >> 7; const float* w = s2 ? w1 : w0; float a = 0.f; for (int k = 0; k < SK; ++k) a += w[k] * bf2f(V[(long)k * 128 + d]); ov[tid] = a / ls[s2]; }
    __syncthreads();
    float val = 0.f; if (tid < 128) val = ov[tid] - lam * ov[128 + tid];
    const float ss = blk_reduce(val * val, 0, red); const float rstd = rsqrtf(ss * (1.f / 128.f) + EPS);
    if (tid < 128) { const float a = val * rstd * p.in[19][tid] * 0.8f; const float y = bf2f(((const bf16_t*)(p.ws + O_YDIFF))[tok * 512 + h * 128 + tid]); num = (a - y) * (a - y); den = a * a; } }
#elif DIAG >= 3
  { const int h = (S >> 3) & 3, dir = (S >> 5) & 1; const float lg = -expf(p.in[20][dir * 4 + h]);
    const bf16_t* Q = (const bf16_t*)(p.ws + O_RQ) + (((long)b * 4 + h) * SK + t) * 64; const bf16_t* K = (const bf16_t*)(p.ws + O_RK) + ((long)b * 4 + h) * SK * 64;
    const bf16_t* V = (const bf16_t*)(p.ws + O_RV) + ((long)b * 4 + h) * SK * 128;
    if (tid < 64) qv[tid] = bf2f(Q[tid]);
    __syncthreads();
    for (int k = tid; k < SK; k += 512) { int dist; if (k < 8192) dist = dir ? k - t : t - k; else { const int j = k - 8192; dist = dir ? 8192 - t + j : 256 + t - j; }
      float d = 0.f; bool inc = dist >= 0;
#if DIAG == 4
      inc = inc && (k < 8192) && ((k >> 7) == (t >> 7));
#endif
#if DIAG == 5
      inc = inc && !((k < 8192) && ((k >> 7) == (t >> 7)));
#endif
      if (inc) { for (int e = 0; e < 64; ++e) d += qv[e] * bf2f(K[(long)k * 64 + e]); d *= expf(lg * (float)dist); } w0[k] = d; }
    __syncthreads();
    if (tid < 128) { float a = 0.f; for (int k = 0; k < SK; ++k) a += w0[k] * bf2f(V[(long)k * 128 + tid]);
      const float y = bf2f(((const bf16_t*)(p.ws + O_RETO))[(size_t)dir * T * 512 + tok * 512 + h * 128 + tid]); num = (a - y) * (a - y); den = a * a; } }
#endif
  num = blk_reduce(num, 0, red); den = blk_reduce(den, 0, red);
  if (tid == 0) { atomicAdd(dg, num); atomicAdd(dg + 1, den); }
}
__device__ __forceinline__ void phase_diag_out(const Params& p) {
  const float* dg = (const float*)(p.ws + O_LAM) + 16; const float m = dg[0] / fmaxf(dg[1], 1e-30f);
  float c2 = 10.f + log10f(fmaxf(m, 1e-12f)); c2 = fminf(fmaxf(c2, 0.f), 12.f); const float c = sqrtf(c2);
  for (long i = (long)blockIdx.x * 512 + launder_tid(); i < (long)TL * DM; i += (long)gridDim.x * 512) p.out[i] = c;
}
#endif
constexpr int NPHASE = 26;
__device__ __forceinline__ void run_phase(const Params& p0_, int ph) {
  Params p = p0_; asm volatile("" : "+s"(p.ws), "+s"(p.out));
  if (ph == 0) { if (PMASK & 0x1000) phase_p0(p); return; }
  if (ph == 25) { if (PMASK & 0x2000) phase_final(p); return; }
  const int l = (ph - 1) / 12, s = (ph - 1) % 12;
  switch (s) {
    case 0: if (PMASK & 1) { phase_norm(p, l, 0, l == 0); conv_group(p, l, 0); } break;
    case 1: if (PMASK & 2) phase_ffn_up(p); break;
    case 2: if (PMASK & 4) phase_ffn_down(p, l, 2, l == 0); break;
    case 3: if (PMASK & 1) { phase_norm(p, l, 1, false); conv_group(p, l, 1); } break;
    case 4: if (PMASK & 16) phase_win(p); break;
    case 5: if (PMASK & 32) phase_g4(p, l); break;
    case 6: if (PMASK & 64) phase_attn(p, l); break;
    case 7: if (PMASK & 128) phase_branch(p); break;
    case 8: if (PMASK & 256) phase_wout(p, l); break;
    case 9: if (PMASK & 1) { phase_norm(p, l, 2, false); conv_group(p, l, 2); } break;
    case 10: if (PMASK & 2) phase_ffn_up(p); break;
    case 11: if (PMASK & 4) phase_ffn_down(p, l, 8, false); break;
  }
}
__global__ void __launch_bounds__(512) mega_kernel(Params p) {
  cg::grid_group grid = cg::this_grid();
#ifdef DIAG
#define PHD(k) if ((k) < DIAG_STOP) { run_phase(p, (k)); grid.sync(); }
  PHD(0)
  PHD(1)
  PHD(2)
  PHD(3)
  PHD(4)
  PHD(5)
  PHD(6)
  PHD(7)
  PHD(8)
#undef PHD
  phase_diag(p); grid.sync(); phase_diag_out(p);
#else
#define PH(k) if ((k) >= p.ph_lo && (k) < p.ph_hi) { run_phase(p, (k)); if ((k) + 1 < p.ph_hi) grid.sync(); }
  PH(0)
  PH(1)
  PH(2)
  PH(3)
  PH(4)
  PH(5)
  PH(6)
  PH(7)
  PH(8)
  PH(9)
  PH(10)
  PH(11)
  PH(12)
  PH(13)
  PH(14)
  PH(15)
  PH(16)
  PH(17)
  PH(18)
  PH(19)
  PH(20)
  PH(21)
  PH(22)
  PH(23)
  PH(24)
  PH(25)
#undef PH
#endif
}

extern "C" void kernel_launch(void* const* d_in, const int* in_sizes, int n_in, void* d_out, int out_size, void* d_ws, size_t ws_size, hipStream_t stream) {
  static int grid_blocks = 0;
  if (grid_blocks == 0) {
    if (n_in != 25 || out_size != TL * DM || ws_size < WS_NEED) { fprintf(stderr, "kernel_launch: unexpected shapes: n_in %d out %d ws %zu (need %zu)\n", n_in, out_size, ws_size, (size_t)WS_NEED); grid_blocks = -1; return; }
    int dev = 0, cus = 0, per_cu = 0;
    hipGetDevice(&dev); hipDeviceGetAttribute(&cus, hipDeviceAttributeMultiprocessorCount, dev);
    if (hipFuncSetAttribute((const void*)mega_kernel, hipFuncAttributeMaxDynamicSharedMemorySize, LDS_BYTES) != hipSuccess) { fprintf(stderr, "kernel_launch: hipFuncSetAttribute failed\n"); grid_blocks = -1; return; }
    hipOccupancyMaxActiveBlocksPerMultiprocessor(&per_cu, (const void*)mega_kernel, 512, LDS_BYTES);
    if (per_cu < 1) per_cu = 1;
    grid_blocks = cus * per_cu;
  }
  if (grid_blocks < 0) return;
  Params p{};
  for (int i = 0; i < 25; ++i) p.in[i] = (const float*)d_in[i];
  p.out = (float*)d_out; p.ws = (unsigned char*)d_ws;
#if PER_PHASE_LAUNCH
  for (int ph = 0; ph < NPHASE; ++ph) {
    p.ph_lo = ph; p.ph_hi = ph + 1; void* args[] = {&p};
    hipError_t e = hipLaunchCooperativeKernel((const void*)mega_kernel, dim3(grid_blocks), dim3(512), args, LDS_BYTES, stream);
    if (e != hipSuccess) { fprintf(stderr, "cooperative launch failed: %s (grid %d)\n", hipGetErrorString(e), grid_blocks); break; }
  }
#else
  p.ph_lo = 0; p.ph_hi = NPHASE; void* args[] = {&p};
  hipError_t e = hipLaunchCooperativeKernel((const void*)mega_kernel, dim3(grid_blocks), dim3(512), args, LDS_BYTES, stream);
  if (e != hipSuccess) fprintf(stderr, "cooperative launch failed: %s (grid %d)\n", hipGetErrorString(e), grid_blocks);
#endif
}
```

```cpp
#include <hip/hip_runtime.h>
#include <hip/hip_cooperative_groups.h>
#include <cstdio>
#include <cstdint>
namespace cg = cooperative_groups;

#ifndef PMASK
#define PMASK 0xffffffff
#endif
#define TSEL1 ((1u<<8)|(1u<<20))
#define TSEL2 ((1u << 6) | (1u << 18))
#if defined(DIAG)
#if DIAG >= 3
#define DIAG_STOP 7
#else
#define DIAG_STOP 8
#endif
#endif
#ifndef GEMM_SP2
#define GEMM_SP2 1
#endif
#ifndef PER_PHASE_LAUNCH
#define PER_PHASE_LAUNCH 0
#endif

typedef unsigned short bf16_t;
typedef short bf16x8 __attribute__((ext_vector_type(8)));
typedef short s16x4 __attribute__((ext_vector_type(4)));
typedef float f32x4 __attribute__((ext_vector_type(4)));
typedef float f32x8 __attribute__((ext_vector_type(8)));
typedef float f32x16 __attribute__((ext_vector_type(16)));
typedef unsigned u32x4 __attribute__((ext_vector_type(4)));
typedef unsigned u32x2 __attribute__((ext_vector_type(2)));

constexpr int DM = 1024, NB = 8, SEQ = 8192, CTXL = 256, TL = NB * SEQ, TC = NB * CTXL, T = TL + TC, SK = SEQ + CTXL;
constexpr int DFF = 2816, PROJ = 6816;
constexpr int NPM = T / 256;
constexpr float EPS = 1e-6f;
constexpr float CQ_MLA = 0.10206207261596575f * 1.4426950408889634f;
constexpr float CQ_DIFF = 0.125f * 1.4426950408889634f;

constexpr size_t al256(size_t x) { return (x + 255) / 256 * 256; }
constexpr size_t O_MOD = 0;
constexpr size_t O_LAM = al256(O_MOD + (size_t)2 * 9 * 9216 * 4);
constexpr size_t O_R1C = O_LAM + 256;
constexpr size_t O_R1S = O_R1C + (size_t)8192 * 32 * 4;
constexpr size_t O_RDC = O_R1S + (size_t)8192 * 32 * 4;
constexpr size_t O_RDS = O_RDC + 128 * 16 * 4;
constexpr size_t O_RMC = O_RDS + 128 * 16 * 4;
constexpr size_t O_RMS = O_RMC + 128 * 8 * 4;
constexpr size_t O_W = al256(O_RMS + 128 * 8 * 4);
constexpr size_t O_WUP = O_W;
constexpr size_t O_WDN = O_WUP + (size_t)5632 * 1024 * 2;
constexpr size_t O_WIN = O_W;
constexpr size_t O_WG = O_WIN + (size_t)3840 * 1024 * 2;
constexpr size_t O_WQB = O_WG + (size_t)3072 * 1024 * 2;
constexpr size_t O_WKVB = O_WQB + (size_t)768 * 384 * 2;
constexpr size_t O_WBR = O_WKVB + (size_t)1024 * 256 * 2;
constexpr size_t O_WOUT = O_WBR + (size_t)3 * 1024 * 512 * 2;
constexpr size_t O_WEND = O_WOUT + (size_t)1024 * 1024 * 2;
constexpr size_t O_XC = al256(O_WEND);
constexpr size_t O_H = O_XC + (size_t)TC * DM * 4;
constexpr size_t O_M = O_H + (size_t)T * DM * 2;
constexpr size_t O_G = O_M;
constexpr size_t TB = (size_t)T;
constexpr size_t O_QLAT = O_M;
constexpr size_t O_KVLAT = O_QLAT + TB * 768;
constexpr size_t O_KNOPE = O_KVLAT + TB * 512;
constexpr size_t O_KROPE = O_KNOPE + TB * 1024;
constexpr size_t O_QD = O_KROPE + TB * 64;
constexpr size_t O_KD = O_QD + TB * 1024;
constexpr size_t O_VD = O_KD + TB * 1024;
constexpr size_t O_RQ = O_VD + TB * 1024;
constexpr size_t O_RK = O_RQ + TB * 512;
constexpr size_t O_RV = O_RK + TB * 512;
constexpr size_t O_YRET = O_RV + TB * 1024;
constexpr size_t O_QMLA = O_YRET + TB * 1024;
constexpr size_t O_VMLA = O_QMLA + TB * 1536;
constexpr size_t O_RETO = O_VMLA + TB * 1024;
constexpr size_t O_END = O_RETO + TB * 2048;
constexpr size_t O_YMLA = O_RQ;
constexpr size_t O_YDIFF = O_RV;
constexpr size_t O_O1S = O_QLAT;
constexpr size_t O_G6S = O_QMLA;
constexpr size_t O_YBR = O_RETO;
static_assert(O_G + TB * 2816 * 2 <= O_END, "ffn g fits");
constexpr size_t O_TS = O_END;
constexpr size_t O_CNT = O_TS + 512;
constexpr size_t O_PART = al256(O_CNT + 26 * 264 * 4);
constexpr size_t WS_NEED = O_PART + (size_t)6 * 264 * 4 * 256 * 4;

constexpr int LDS_BYTES = 131072 + 4096;

struct Params { const float* in[25]; float* out; unsigned char* ws; int ph_lo, ph_hi; };

extern __shared__ __attribute__((aligned(16))) unsigned char g_lds[];

#define MK_RSRC(ptr) __builtin_amdgcn_make_buffer_rsrc((void*)(ptr), 0, 0x7fffffff, 0x00020000)
#define MEMFENCE() asm volatile("" ::: "memory")
__device__ __forceinline__ int launder_tid() { int t = __builtin_amdgcn_workitem_id_x(); asm volatile("" : "+v"(t)); return t; }
typedef __bf16 bf16v2_t __attribute__((ext_vector_type(2)));
typedef float f32v2_t __attribute__((ext_vector_type(2)));
__device__ __forceinline__ unsigned cvtpk(float lo, float hi) { const f32v2_t v = {lo, hi}; const bf16v2_t b = __builtin_convertvector(v, bf16v2_t); return __builtin_bit_cast(unsigned, b); }
__device__ __forceinline__ float bf2f(unsigned short b) { return __uint_as_float(((unsigned)b) << 16); }
__device__ __forceinline__ float silu_f(float v) { return v * __builtin_amdgcn_rcpf(1.f + __expf(-v)); }
__device__ __forceinline__ float sigm_f(float v) { return __builtin_amdgcn_rcpf(1.f + __expf(-v)); }
__device__ __forceinline__ void store4bf(bf16_t* p, f32x4 v) { u32x2 w; w.x = cvtpk(v[0], v[1]); w.y = cvtpk(v[2], v[3]); *(u32x2*)p = w; }
__device__ __forceinline__ int logical_wg() { const int g = gridDim.x, w = blockIdx.x; return (g % 8 == 0) ? (w % 8) * (g / 8) + w / 8 : w; }

constexpr int BK = 64, HALF = 128, HTB = HALF * BK * 2;
__device__ __forceinline__ int lds_byte(int r, int c) { int st = (r >> 4) * 2 + (c >> 5), rr = r & 15, cc = c & 31, ob = rr * 64 + cc * 2; return st * 1024 + (ob ^ (((ob >> 9) & 1) << 5)); }
__device__ __forceinline__ void stage_rc(int b, int& R, int& C) { int st = b / 1024, sb = b % 1024, swz = sb ^ (((sb >> 9) & 1) << 5); R = (st >> 1) * 16 + swz / 64; C = (st & 1) * 32 + (swz % 64) / 2; }

#define LAS __attribute__((address_space(3)))
#define WAIT_V(n) asm volatile("s_waitcnt vmcnt(" #n ")" ::: "memory")
#define WAIT_L(n) asm volatile("s_waitcnt lgkmcnt(" #n ")" ::: "memory")
#define BAR __builtin_amdgcn_s_barrier()
#define SCHED __builtin_amdgcn_sched_barrier(0)

struct GOp { const char* A; const char* B; unsigned lda2, ldb2; int nt; };
template <class GetOp, class Epi>
__device__ __forceinline__ void gemm_stream(GetOp get, Epi epi) {
  LAS unsigned char* lds = (LAS unsigned char*)g_lds;
  GOp cur, nxt;
  if (!get(0, cur)) return;
  const int tid = launder_tid();
  const int wid = __builtin_amdgcn_readfirstlane(tid >> 6), lane = tid & 63, wr = wid >> 2, wc = wid & 3, fr = lane & 15, fq = lane >> 4;
  int R0, C0, R1, C1; stage_rc(tid * 16, R0, C0); stage_rc(tid * 16 + 8192, R1, C1);
  const unsigned ldsw = (unsigned)wid * 1024u;
  const int aoff = lds_byte(wr * 64 + fr, fq * 8), boff = lds_byte(wc * 32 + fr, fq * 8);
  unsigned cvA[2], cvB[2], nvA[2], nvB[2];
  cvA[0] = R0 * cur.lda2 + C0 * 2; cvA[1] = R1 * cur.lda2 + C1 * 2; cvB[0] = R0 * cur.ldb2 + C0 * 2; cvB[1] = R1 * cur.ldb2 + C1 * 2;
#define G_SA(b, h) (((b) * 2 + (h)) * HTB)
#define G_SB(b, h) ((4 + (b) * 2 + (h)) * HTB)
#define STAGE(bufoff, gbase, voff) do { _Pragma("unroll") for (int _i = 0; _i < 2; ++_i) \
    __builtin_amdgcn_global_load_lds((const unsigned*)((const char*)(gbase) + (voff)[_i]), (LAS unsigned*)(lds + (bufoff) + ldsw + _i * 8192), 16, 0, 0); } while (0)
#define LDA(dst, b, h) do { _Pragma("unroll") for (int m = 0; m < 4; ++m) _Pragma("unroll") for (int k = 0; k < 2; ++k) dst[m][k] = *(const LAS bf16x8*)(lds + G_SA(b, h) + aoff + m * 2048 + k * 1024); } while (0)
#define LDB(dst, b, h) do { _Pragma("unroll") for (int n = 0; n < 2; ++n) _Pragma("unroll") for (int k = 0; k < 2; ++k) dst[n][k] = *(const LAS bf16x8*)(lds + G_SB(b, h) + boff + n * 2048 + k * 1024); } while (0)
#define MMA(ai, bj, At_, Bt_) do { __builtin_amdgcn_s_setprio(1); \
    _Pragma("unroll") for (int m = 0; m < 4; ++m) _Pragma("unroll") for (int n = 0; n < 2; ++n) _Pragma("unroll") for (int k = 0; k < 2; ++k) \
      acc[ai][bj][m][n] = __builtin_amdgcn_mfma_f32_16x16x32_bf16(At_[m][k], Bt_[n][k], acc[ai][bj][m][n], 0, 0, 0); \
    __builtin_amdgcn_s_setprio(0); } while (0)
  { const size_t hA = (size_t)HALF * cur.lda2, hB = (size_t)HALF * cur.ldb2;
#if GEMM_SP2
    STAGE(G_SB(0, 0), cur.B, cvB); STAGE(G_SB(0, 1), cur.B + hB, cvB); STAGE(G_SA(0, 0), cur.A, cvA); STAGE(G_SA(0, 1), cur.A + hA, cvA);
    if (wr == 1) BAR;
    WAIT_V(2); BAR;
#else
    STAGE(G_SB(0, 0), cur.B, cvB); STAGE(G_SA(0, 0), cur.A, cvA); STAGE(G_SB(0, 1), cur.B + hB, cvB); STAGE(G_SA(0, 1), cur.A + hA, cvA);
    if (wr == 1) BAR;
    WAIT_V(4); BAR;
#endif
    STAGE(G_SB(1, 0), cur.B + 128, cvB); STAGE(G_SA(1, 0), cur.A + 128, cvA); STAGE(G_SB(1, 1), cur.B + hB + 128, cvB);
    WAIT_V(6); BAR; }
  f32x4 acc[2][2][4][2];
  bf16x8 At[4][2], B0[2][2], B1[2][2];
  for (int idx = 0;; ++idx) {
    const bool has_next = get(idx + 1, nxt);
    if (!has_next) nxt = cur;
    nvA[0] = R0 * nxt.lda2 + C0 * 2; nvA[1] = R1 * nxt.lda2 + C1 * 2; nvB[0] = R0 * nxt.ldb2 + C0 * 2; nvB[1] = R1 * nxt.ldb2 + C1 * 2;
    if (idx > 0) { if (wr == 1) BAR; }
#pragma unroll
    for (int a = 0; a < 2; ++a)
#pragma unroll
      for (int b = 0; b < 2; ++b)
#pragma unroll
        for (int m = 0; m < 4; ++m)
#pragma unroll
          for (int n = 0; n < 2; ++n) acc[a][b][m][n] = (f32x4){0.f, 0.f, 0.f, 0.f};
    const size_t hA = (size_t)HALF * cur.lda2, hB = (size_t)HALF * cur.ldb2, nhA = (size_t)HALF * nxt.lda2, nhB = (size_t)HALF * nxt.ldb2;
    const int nt = cur.nt;
    for (int t = 0; t < nt; t += 2) {
      const bool last = (t == nt - 2);
      const char* a1 = cur.A + (size_t)(t + 1) * 128;
      const char* a2 = last ? nxt.A : cur.A + (size_t)(t + 2) * 128; const char* b2 = last ? nxt.B : cur.B + (size_t)(t + 2) * 128;
      const char* a3 = a2 + 128; const char* b3 = b2 + 128;
      const size_t hA2 = last ? nhA : hA, hB2 = last ? nhB : hB;
      unsigned vA2[2], vB2[2]; vA2[0] = last ? nvA[0] : cvA[0]; vA2[1] = last ? nvA[1] : cvA[1]; vB2[0] = last ? nvB[0] : cvB[0]; vB2[1] = last ? nvB[1] : cvB[1];
#if GEMM_SP2
      LDB(B0, 0, 0); LDB(B1, 0, 1); SCHED; LDA(At, 0, 0); STAGE(G_SA(1, 1), a1 + hA, cvA);
      WAIT_V(8); WAIT_L(0); BAR; MMA(0, 0, At, B0); MMA(0, 1, At, B1); BAR; SCHED;
      LDA(At, 0, 1); STAGE(G_SB(0, 0), b2, vB2); STAGE(G_SB(0, 1), b2 + hB2, vB2); STAGE(G_SA(0, 0), a2, vA2);
      WAIT_V(8); WAIT_L(0); BAR; MMA(1, 0, At, B0); MMA(1, 1, At, B1); BAR; SCHED;
      LDB(B0, 1, 0); LDB(B1, 1, 1); SCHED; LDA(At, 1, 0); STAGE(G_SA(0, 1), a2 + hA2, vA2);
      WAIT_V(8); WAIT_L(0); BAR; MMA(0, 0, At, B0); MMA(0, 1, At, B1); BAR; SCHED;
      LDA(At, 1, 1); STAGE(G_SB(1, 0), b3, vB2); STAGE(G_SB(1, 1), b3 + hB2, vB2); STAGE(G_SA(1, 0), a3, vA2);
      WAIT_V(8); WAIT_L(0); BAR; MMA(1, 0, At, B0); MMA(1, 1, At, B1); BAR; SCHED;
#else
      LDB(B0, 0, 0); SCHED; LDA(At, 0, 0); STAGE(G_SA(1, 1), a1 + hA, cvA);
      WAIT_L(8); BAR; WAIT_L(0); MMA(0, 0, At, B0); BAR; SCHED;
      LDB(B1, 0, 1); STAGE(G_SB(0, 0), b2, vB2);
      BAR; WAIT_L(0); MMA(0, 1, At, B1); BAR;
      LDA(At, 0, 1); STAGE(G_SA(0, 0), a2, vA2);
      BAR; WAIT_L(0); MMA(1, 0, At, B0); BAR; SCHED;
      STAGE(G_SB(0, 1), b2 + hB2, vB2);
      WAIT_V(6); BAR; MMA(1, 1, At, B1); BAR;
      LDB(B0, 1, 0); SCHED; LDA(At, 1, 0); STAGE(G_SA(0, 1), a2 + hA2, vA2);
      WAIT_L(8); BAR; WAIT_L(0); MMA(0, 0, At, B0); BAR; SCHED;
      LDB(B1, 1, 1); STAGE(G_SB(1, 0), b3, vB2);
      BAR; WAIT_L(0); MMA(0, 1, At, B1); BAR;
      LDA(At, 1, 1); STAGE(G_SA(1, 0), a3, vA2);
      BAR; WAIT_L(0); MMA(1, 0, At, B0); BAR; SCHED;
      STAGE(G_SB(1, 1), b3 + hB2, vB2);
      WAIT_V(6); BAR; MMA(1, 1, At, B1); BAR;
#endif
    }
    if (wr == 0) BAR;
    epi(idx, acc);
    if (!has_next) break;
    cur = nxt; cvA[0] = nvA[0]; cvA[1] = nvA[1]; cvB[0] = nvB[0]; cvB[1] = nvB[1];
  }
  WAIT_V(0); BAR;
#undef G_SA
#undef G_SB
#undef STAGE
#undef LDA
#undef LDB
#undef MMA
}

__device__ __forceinline__ void unit_decode(int U, int NPN, int SBN, int& pm, int& pn) {
  const int per = 8 * SBN, blk = U / per, within = U % per, npng = NPN / SBN;
  const int pmg = blk / npng, png = blk % npng;
  pm = pmg * 8 + (within & 7); pn = png * SBN + (within >> 3);
}
struct TI { int b, bb, arow0; };
__device__ __forceinline__ TI tile_info(int pm) { TI t; if (pm < 256) { t.b = pm >> 5; t.bb = t.b; t.arow0 = (pm & 31) * 256; } else { t.b = pm - 256; t.bb = 8; t.arow0 = 8192; } return t; }

#define LANE_IDS const int tid = launder_tid(), wid = __builtin_amdgcn_readfirstlane(tid >> 6), lane = tid & 63, wr = wid >> 2, wc = wid & 3, fr = lane & 15, fq = lane >> 4; (void)tid; (void)wr; (void)wc; (void)fr; (void)fq; (void)lane; (void)wid;

enum { CM_PLAIN = 0, CM_UP, CM_WIN, CM_QB, CM_KVB };
__device__ __forceinline__ int colmap(int kind, int n, int base, int& which) {
  which = 0;
  switch (kind) {
    case CM_PLAIN: return base + n;
    case CM_UP: { const int tile = n >> 8, c = n & 255, ai = c >> 7, wrr = (c >> 6) & 1, m = (c >> 4) & 3, q = c & 15; which = m & 1; return tile * 128 + ai * 64 + wrr * 32 + (m >> 1) * 16 + q; }
    case CM_WIN: {
      if (n < 384) return n;
      if (n < 416) { const int cc = n - 384, part = (cc >> 4) & 1, half = (cc >> 3) & 1, idx = cc & 7; return 640 + half * 16 + part * 8 + idx; }
      if (n < 512) return -1;
      if (n < 768) return 384 + (n - 512);
      return 672 + (n - 768);
    }
    case CM_QB: {
      if (n < 512) return (n >> 6) * 96 + (n & 63);
      const int c = n - 512, h = c >> 5, cc = c & 31, part = (cc >> 4) & 1, half = (cc >> 3) & 1, idx = cc & 7; return h * 96 + 64 + half * 16 + part * 8 + idx;
    }
    case CM_KVB: {
      if (n < 512) return (n >> 6) * 128 + (n & 63);
      const int c = n - 512; return (c >> 6) * 128 + 64 + (c & 63);
    }
  }
  return -1;
}
__device__ __forceinline__ void conv_load(float (&v)[8], int kind, const float* src0, const float* src1, int ld, int base, const float* scale, int n0, int k0) {
  const int tid = launder_tid(); const int nn = tid & 63, kk = tid >> 6; int which; const int col = colmap(kind, n0 + nn, base, which); const float* s = which ? src1 : src0;
#pragma unroll
  for (int i = 0; i < 8; ++i) { const int k = kk + 8 * i; float x = 0.f; if (col >= 0) { x = s[(long)(k0 + k) * ld + col]; if (scale) x *= scale[k0 + k]; } v[i] = x; }
}
__device__ __forceinline__ void conv_store(const float (&vin)[8], bf16_t* dst, int K, int n0, int k0) {
  float* tl = (float*)g_lds;
  const int tid = launder_tid();
  { const int nn = tid & 63, kk = tid >> 6;
#pragma unroll
    for (int i = 0; i < 8; ++i) tl[(kk + 8 * i) * 65 + nn] = vin[i]; }
  __syncthreads();
  { const int nr = tid >> 3, kc = (tid & 7) * 8; float v[8];
#pragma unroll
    for (int e = 0; e < 8; ++e) v[e] = tl[(kc + e) * 65 + nr];
    u32x4 w; w.x = cvtpk(v[0], v[1]); w.y = cvtpk(v[2], v[3]); w.z = cvtpk(v[4], v[5]); w.w = cvtpk(v[6], v[7]);
    *(u32x4*)(dst + (long)(n0 + nr) * K + k0 + kc) = w; }
  __syncthreads();
}
struct ConvJob { int kind; size_t dst; int N, K; const float* s0; const float* s1; int ld, base; const float* scale; };
__device__ __forceinline__ ConvJob conv_job(const Params& p, int l, int grp, int j) {
  ConvJob J; J.s1 = nullptr; J.scale = nullptr; J.base = 0;
  if (grp != 1) {
    const float* w1 = p.in[grp == 0 ? 7 : 10] + (size_t)l * DM * DFF; const float* w3 = p.in[grp == 0 ? 8 : 11] + (size_t)l * DM * DFF; const float* w2 = p.in[grp == 0 ? 9 : 12] + (size_t)l * DFF * DM;
    if (j == 0) { J.kind = CM_UP; J.dst = O_WUP; J.N = 5632; J.K = 1024; J.s0 = w1; J.s1 = w3; J.ld = DFF; }
    else { J.kind = CM_PLAIN; J.dst = O_WDN; J.N = 1024; J.K = 2816; J.s0 = w2; J.s1 = w2; J.ld = DM; }
  } else {
    const float* win = p.in[13] + (size_t)l * DM * PROJ; const float* wb = p.in[22] + (size_t)l * 3 * 512 * 1024;
    switch (j) {
      case 0: J.kind = CM_WIN; J.dst = O_WIN; J.N = 3840; J.K = 1024; J.s0 = win; J.ld = PROJ; break;
      case 1: J.kind = CM_PLAIN; J.dst = O_WG; J.N = 3072; J.K = 1024; J.s0 = win; J.ld = PROJ; J.base = 3744; break;
      case 2: J.kind = CM_QB; J.dst = O_WQB; J.N = 768; J.K = 384; J.s0 = p.in[15] + (size_t)l * 384 * 768; J.ld = 768; J.scale = p.in[14] + l * 384; break;
      case 3: J.kind = CM_KVB; J.dst = O_WKVB; J.N = 1024; J.K = 256; J.s0 = p.in[17] + (size_t)l * 256 * 1024; J.ld = 1024; J.scale = p.in[16] + l * 256; break;
      case 4: J.kind = CM_PLAIN; J.dst = O_WBR; J.N = 3072; J.K = 512; J.s0 = wb; J.ld = 1024; break;
      default: J.kind = CM_PLAIN; J.dst = O_WOUT; J.N = 1024; J.K = 1024; J.s0 = p.in[23] + (size_t)l * DM * DM; J.ld = DM; break;
    }
    J.s1 = J.s0;
  }
  return J;
}
struct ConvTile { int kind; bf16_t* dst; int K; const float* s0; const float* s1; int ld, base; const float* scale; int n0, k0; };
__device__ __forceinline__ ConvTile conv_decode(const Params& p, int l, int grp, int u) {
  int v = u, j = 0; ConvJob J = conv_job(p, l, grp, 0);
  for (;;) { const int c = (J.N / 64) * (J.K / 64); if (v < c) break; v -= c; ++j; J = conv_job(p, l, grp, j); }
  const int nk = J.K / 64; const int nt_ = v / nk, kt_ = v % nk;
  ConvTile t; t.kind = J.kind; t.K = J.K; t.s0 = J.s0; t.s1 = J.s1; t.ld = J.ld; t.base = J.base; t.scale = J.scale; t.n0 = nt_ * 64; t.k0 = kt_ * 64; t.dst = (bf16_t*)(p.ws + J.dst);
  if (grp == 1 && j == 4) { const int i = t.n0 >> 10; t.s0 += (size_t)i * 512 * 1024; t.dst += (size_t)i * 1024 * 512; t.n0 &= 1023; }
  return t;
}
__device__ __forceinline__ void conv_group(const Params& p, int l, int grp) {
  const int nj = (grp == 1) ? 6 : 2;
  int tot = 0; for (int j = 0; j < nj; ++j) { const ConvJob J = conv_job(p, l, grp, j); tot += (J.N / 64) * (J.K / 64); }
  int u = blockIdx.x; if (u >= tot) return;
  ConvTile t = conv_decode(p, l, grp, u); float v[8];
  conv_load(v, t.kind, t.s0, t.s1, t.ld, t.base, t.scale, t.n0, t.k0);
  for (;;) {
    const int un = u + gridDim.x; const bool more = un < tot; ConvTile tn = t; float vn[8];
    if (more) { tn = conv_decode(p, l, grp, un); conv_load(vn, tn.kind, tn.s0, tn.s1, tn.ld, tn.base, tn.scale, tn.n0, tn.k0); }
    conv_store(v, t.dst, t.K, t.n0, t.k0);
    if (!more) break;
    u = un; t = tn;
#pragma unroll
    for (int i = 0; i < 8; ++i) v[i] = vn[i];
  }
}

__device__ __forceinline__ void phase_p0(const Params& p) {
  const int tid = launder_tid();
  float* sl = (float*)g_lds;
  float* red = sl + 9 * 1024;
  for (int i = tid; i < 9 * 1024; i += 512) { const int bb = i >> 10, k = i & 1023; const float v = bb < 8 ? p.in[1][bb * 1024 + k] : p.in[3][k]; sl[i] = v / (1.f + expf(-v)); }
  __syncthreads();
  float* modp = (float*)(p.ws + O_MOD);
  for (int u = blockIdx.x; u < 144; u += gridDim.x) {
    const int l = u / 72, c0 = (u % 72) * 128, col = c0 + (tid & 127), ks = tid >> 7;
    const float* w = p.in[4] + (size_t)l * 1024 * 9216 + col;
    float a[9];
#pragma unroll
    for (int bb = 0; bb < 9; ++bb) a[bb] = 0.f;
    for (int k = ks * 256; k < ks * 256 + 256; ++k) { const float wv = w[(size_t)k * 9216];
#pragma unroll
      for (int bb = 0; bb < 9; ++bb) a[bb] += sl[bb * 1024 + k] * wv; }
#pragma unroll
    for (int bb = 0; bb < 9; ++bb) red[(ks * 9 + bb) * 128 + (tid & 127)] = a[bb];
    __syncthreads();
    for (int i = tid; i < 9 * 128; i += 512) { const int bb = i >> 7, cc = i & 127;
      const float s = red[(0 * 9 + bb) * 128 + cc] + red[(1 * 9 + bb) * 128 + cc] + red[(2 * 9 + bb) * 128 + cc] + red[(3 * 9 + bb) * 128 + cc];
      modp[((size_t)l * 9 + bb) * 9216 + c0 + cc] = s + p.in[5][l * 9216 + c0 + cc]; }
    __syncthreads();
  }
  const long gt = (long)blockIdx.x * 512 + tid, gs = (long)gridDim.x * 512;
  for (long i = gt; i < (long)6 * 264 * 1024; i += gs) ((float*)(p.ws + O_PART))[i] = -1.f;
  float* r1c = (float*)(p.ws + O_R1C); float* r1s = (float*)(p.ws + O_R1S);
  for (long i = gt; i < 8192 * 32; i += gs) { const int pos = (int)(i >> 5), f = (int)(i & 31); const float inv = (float)pow(10000.0, -(double)(2 * f) / 64.0); const float ang = (float)pos * inv; r1c[i] = (float)cos((double)ang); r1s[i] = (float)sin((double)ang); }
  float* rdc = (float*)(p.ws + O_RDC); float* rds = (float*)(p.ws + O_RDS);
  for (long i = gt; i < 128 * 16; i += gs) { const int pos = (int)(i >> 4), f = (int)(i & 15); const float inv = (float)pow(10000.0, -(double)(2 * f) / 32.0); const float ang = (float)pos * inv; rdc[i] = (float)cos((double)ang); rds[i] = (float)sin((double)ang); }
  float* rmc = (float*)(p.ws + O_RMC); float* rms = (float*)(p.ws + O_RMS);
  for (long i = gt; i < 128 * 8; i += gs) { const int pos = (int)(i >> 3), f = (int)(i & 7); const float inv = (float)pow(10000.0, -(double)(2 * f) / 16.0); const float ang = (float)pos * inv; rmc[i] = (float)cos((double)ang); rms[i] = (float)sin((double)ang); }
  if (blockIdx.x == 0 && tid == 200) { ((float*)(p.ws + O_LAM))[16] = 0.f; ((float*)(p.ws + O_LAM))[17] = 0.f; }
  if (blockIdx.x == 0 && tid < 128) {
    const int l = tid >> 6, ln = tid & 63; const float* dl = p.in[18] + l * 256;
    float s1 = dl[ln] * dl[64 + ln], s2 = dl[128 + ln] * dl[192 + ln];
#pragma unroll
    for (int o = 32; o > 0; o >>= 1) { s1 += __shfl_xor(s1, o); s2 += __shfl_xor(s2, o); }
    const float li = 0.8f - 0.6f * expf(-0.3f * (float)l);
    if (ln == 0) ((float*)(p.ws + O_LAM))[l] = expf(s1) - expf(s2) + li;
  }
}

__device__ __forceinline__ const float* xsrc_row(const Params& p, long row, bool from_input) {
  if (row < TL) return (from_input ? p.in[0] : p.out) + row * DM;
  return (from_input ? p.in[2] : (const float*)(p.ws + O_XC)) + (row - TL) * DM;
}
__device__ __forceinline__ float* xdst_row(const Params& p, long row) { return row < TL ? p.out + row * DM : (float*)(p.ws + O_XC) + (row - TL) * DM; }

__device__ __forceinline__ void phase_norm(const Params& p, int l, int which, bool from_input) {
  const int tid = launder_tid(), wid = tid >> 6, lane = tid & 63;
  bf16_t* H = (bf16_t*)(p.ws + O_H);
  const float* gain = p.in[6] + (l * 3 + which) * DM;
  const long nwaves = (long)gridDim.x * 8, w0 = (long)blockIdx.x * 8 + wid;
  for (long rb = w0; rb < T; rb += nwaves * 4) {
    f32x4 v[4][4]; float ss[4];
#pragma unroll
    for (int j = 0; j < 4; ++j) { const long row = rb + j * nwaves; ss[j] = 0.f;
      if (row < T) { const float* src = xsrc_row(p, row, from_input);
#pragma unroll
        for (int i = 0; i < 4; ++i) v[j][i] = *(const f32x4*)(src + (lane + 64 * i) * 4); } }
#pragma unroll
    for (int j = 0; j < 4; ++j) { const long row = rb + j * nwaves;
      if (row < T) {
#pragma unroll
        for (int i = 0; i < 4; ++i) ss[j] += v[j][i][0] * v[j][i][0] + v[j][i][1] * v[j][i][1] + v[j][i][2] * v[j][i][2] + v[j][i][3] * v[j][i][3];
#pragma unroll
        for (int o = 32; o > 0; o >>= 1) ss[j] += __shfl_xor(ss[j], o);
        const float rstd = rsqrtf(ss[j] * (1.f / 1024.f) + EPS);
        const int bb = row < TL ? (int)(row >> 13) : 8;
        const float* md = (const float*)(p.ws + O_MOD) + ((size_t)l * 9 + bb) * 9216;
#pragma unroll
        for (int i = 0; i < 4; ++i) { const int c = (lane + 64 * i) * 4;
          const f32x4 g = *(const f32x4*)(gain + c), sh = *(const f32x4*)(md + which * 3 * 1024 + c), sc = *(const f32x4*)(md + (which * 3 + 1) * 1024 + c);
          f32x4 o;
#pragma unroll
          for (int e = 0; e < 4; ++e) o[e] = v[j][i][e] * rstd * g[e] * (1.f + sc[e]) + sh[e];
          store4bf(H + row * DM + c, o); } } }
  }
}
__device__ __forceinline__ void phase_final(const Params& p) {
  const int tid = launder_tid(), wid = tid >> 6, lane = tid & 63;
  const float* gain = p.in[24];
  const long nwaves = (long)gridDim.x * 8, w0 = (long)blockIdx.x * 8 + wid;
  for (long rb = w0; rb < TL; rb += nwaves * 4) {
    f32x4 v[4][4];
#pragma unroll
    for (int j = 0; j < 4; ++j) { const long row = rb + j * nwaves;
      if (row < TL) { const float* src = p.out + row * DM;
#pragma unroll
        for (int i = 0; i < 4; ++i) v[j][i] = *(const f32x4*)(src + (lane + 64 * i) * 4); } }
#pragma unroll
    for (int j = 0; j < 4; ++j) { const long row = rb + j * nwaves;
      if (row < TL) { float ss = 0.f; float* dst = p.out + row * DM;
#pragma unroll
        for (int i = 0; i < 4; ++i) ss += v[j][i][0] * v[j][i][0] + v[j][i][1] * v[j][i][1] + v[j][i][2] * v[j][i][2] + v[j][i][3] * v[j][i][3];
#pragma unroll
        for (int o = 32; o > 0; o >>= 1) ss += __shfl_xor(ss, o);
        const float rstd = rsqrtf(ss * (1.f / 1024.f) + EPS);
#pragma unroll
        for (int i = 0; i < 4; ++i) { const int c = (lane + 64 * i) * 4; const f32x4 g = *(const f32x4*)(gain + c); f32x4 o;
#pragma unroll
          for (int e = 0; e < 4; ++e) o[e] = v[j][i][e] * rstd * g[e];
          *(f32x4*)(dst + c) = o; } } }
  }
}

__device__ __forceinline__ void phase_ffn_up(const Params& p, int npm) {
  const char* W = (const char*)(p.ws + O_WUP); const char* H = (const char*)(p.ws + O_H); bf16_t* G = (bf16_t*)(p.ws + O_G);
  const int q = logical_wg(), Gd = gridDim.x, tot = npm * 22;
  auto get = [&](int idx, GOp& o) __attribute__((always_inline)) -> bool { const int U = q + idx * Gd; if (U >= tot) return false; int pm, pn; unit_decode(U, 22, 2, pm, pn);
    o.A = W + (size_t)pn * 256 * 2048; o.B = H + (size_t)pm * 256 * 2048; o.lda2 = 2048; o.ldb2 = 2048; o.nt = 16; return true; };
  auto epi = [&](int idx, const f32x4 (&acc)[2][2][4][2]) __attribute__((always_inline)) {
    const int U = q + idx * Gd; int pm, pn; unit_decode(U, 22, 2, pm, pn);
    LANE_IDS
#pragma unroll
    for (int ai = 0; ai < 2; ++ai)
#pragma unroll
      for (int bj = 0; bj < 2; ++bj)
#pragma unroll
        for (int n = 0; n < 2; ++n)
#pragma unroll
          for (int mp = 0; mp < 2; ++mp) {
            const long tok = (long)pm * 256 + bj * 128 + wc * 32 + n * 16 + fr; const int gc = pn * 128 + ai * 64 + wr * 32 + mp * 16 + fq * 4;
            const f32x4 a = acc[ai][bj][2 * mp][n], b = acc[ai][bj][2 * mp + 1][n]; f32x4 o;
#pragma unroll
            for (int e = 0; e < 4; ++e) o[e] = silu_f(a[e]) * b[e];
            store4bf(G + tok * DFF + gc, o);
          }
  };
  gemm_stream(get, epi);
}
__device__ __forceinline__ void epi_res(const Params& p, const f32x4 (&acc)[2][2][4][2], int l, int pm, int pn, int gate_idx, float scale, bool from_input) {
  LANE_IDS
  const TI ti = tile_info(pm);
  const float* md = (const float*)(p.ws + O_MOD) + ((size_t)l * 9 + ti.bb) * 9216 + gate_idx * 1024;
#pragma unroll
  for (int bj = 0; bj < 2; ++bj)
#pragma unroll
    for (int n = 0; n < 2; ++n) {
      const long row = (long)pm * 256 + bj * 128 + wc * 32 + n * 16 + fr;
      const float* src = xsrc_row(p, row, from_input); float* dst = xdst_row(p, row);
#pragma unroll
      for (int ai = 0; ai < 2; ++ai)
#pragma unroll
        for (int m = 0; m < 4; ++m) {
          const int col = pn * 256 + ai * 128 + wr * 64 + m * 16 + fq * 4;
          const f32x4 xv = *(const f32x4*)(src + col), g = *(const f32x4*)(md + col); f32x4 o;
#pragma unroll
          for (int e = 0; e < 4; ++e) o[e] = xv[e] + g[e] * scale * acc[ai][bj][m][n][e];
          *(f32x4*)(dst + col) = o;
          if (m & 1) MEMFENCE();
        }
    }
}
struct NormFuse { int nl, which, pslot, cslot; bool fin; };
__device__ __forceinline__ void epi_res_norm(const Params& p, f32x4 (&acc)[2][2][4][2], int l, int pm, int pn, int gate_idx, float scale, bool from_input, const NormFuse nf) {
  LANE_IDS
  const TI ti = tile_info(pm);
  const float* md = (const float*)(p.ws + O_MOD) + ((size_t)l * 9 + ti.bb) * 9216 + gate_idx * 1024;
  float ssr[2][2];
#pragma unroll
  for (int bj = 0; bj < 2; ++bj)
#pragma unroll
    for (int n = 0; n < 2; ++n) {
      const long row = (long)pm * 256 + bj * 128 + wc * 32 + n * 16 + fr;
      const float* src = xsrc_row(p, row, from_input); float* dst = xdst_row(p, row); float ss = 0.f;
#pragma unroll
      for (int ai = 0; ai < 2; ++ai)
#pragma unroll
        for (int m = 0; m < 4; ++m) {
          const int col = pn * 256 + ai * 128 + wr * 64 + m * 16 + fq * 4;
          const f32x4 xv = *(const f32x4*)(src + col), g = *(const f32x4*)(md + col); f32x4 o;
#pragma unroll
          for (int e = 0; e < 4; ++e) { o[e] = xv[e] + g[e] * scale * acc[ai][bj][m][n][e]; ss += o[e] * o[e]; }
          if (!nf.fin) *(f32x4*)(dst + col) = o;
          acc[ai][bj][m][n] = o;
          if (m & 1) MEMFENCE();
        }
      ss += __shfl_xor(ss, 16); ss += __shfl_xor(ss, 32); ssr[bj][n] = ss;
    }
  float* ssl = (float*)(g_lds + 131072);
  __syncthreads();
  if (fq == 0) {
#pragma unroll
    for (int bj = 0; bj < 2; ++bj)
#pragma unroll
      for (int n = 0; n < 2; ++n) ssl[wr * 256 + bj * 128 + wc * 32 + n * 16 + fr] = ssr[bj][n]; }
  __syncthreads();
  unsigned* part = (unsigned*)(p.ws + O_PART) + ((size_t)nf.pslot * 264 + pm) * 1024;
  if (tid < 256) {
    __hip_atomic_store(part + pn * 256 + tid, __float_as_uint(ssl[tid] + ssl[256 + tid]), __ATOMIC_RELAXED, __HIP_MEMORY_SCOPE_AGENT);
    float t = 0.f; int spins = 0;
    for (;;) { float v0 = __uint_as_float(__hip_atomic_load(part + tid, __ATOMIC_RELAXED, __HIP_MEMORY_SCOPE_AGENT)), v1 = __uint_as_float(__hip_atomic_load(part + 256 + tid, __ATOMIC_RELAXED, __HIP_MEMORY_SCOPE_AGENT)),
        v2 = __uint_as_float(__hip_atomic_load(part + 512 + tid, __ATOMIC_RELAXED, __HIP_MEMORY_SCOPE_AGENT)), v3 = __uint_as_float(__hip_atomic_load(part + 768 + tid, __ATOMIC_RELAXED, __HIP_MEMORY_SCOPE_AGENT));
      t = v0 + v1 + v2 + v3;
      if ((v0 >= 0.f && v1 >= 0.f && v2 >= 0.f && v3 >= 0.f) || ++spins > (1 << 18)) break;
      __builtin_amdgcn_s_sleep(4); }
    ssl[512 + tid] = rsqrtf(t * (1.f / 1024.f) + EPS); }
  __syncthreads();
  const float* gain = nf.fin ? p.in[24] : p.in[6] + (nf.nl * 3 + nf.which) * DM;
  const float* mdn = (const float*)(p.ws + O_MOD) + ((size_t)nf.nl * 9 + ti.bb) * 9216;
  bf16_t* H = (bf16_t*)(p.ws + O_H);
#pragma unroll
  for (int bj = 0; bj < 2; ++bj)
#pragma unroll
    for (int n = 0; n < 2; ++n) {
      const int tl = bj * 128 + wc * 32 + n * 16 + fr; const long row = (long)pm * 256 + tl; const float r = ssl[512 + tl];
#pragma unroll
      for (int ai = 0; ai < 2; ++ai)
#pragma unroll
        for (int m = 0; m < 4; ++m) {
          const int col = pn * 256 + ai * 128 + wr * 64 + m * 16 + fq * 4; const f32x4 o = acc[ai][bj][m][n], g = *(const f32x4*)(gain + col); f32x4 h;
          if (nf.fin) {
#pragma unroll
            for (int e = 0; e < 4; ++e) h[e] = o[e] * r * g[e];
            *(f32x4*)(p.out + row * DM + col) = h;
          } else { const f32x4 sh = *(const f32x4*)(mdn + nf.which * 3 * 1024 + col), sc = *(const f32x4*)(mdn + (nf.which * 3 + 1) * 1024 + col);
#pragma unroll
            for (int e = 0; e < 4; ++e) h[e] = o[e] * r * g[e] * (1.f + sc[e]) + sh[e];
            store4bf(H + row * DM + col, h); }
          if (m & 1) MEMFENCE();
        }
    }
}
__device__ __forceinline__ void phase_ffn_down(const Params& p, int l, int gate_idx, bool from_input, int npm, const NormFuse nf) {
  const char* W = (const char*)(p.ws + O_WDN); const char* G = (const char*)(p.ws + O_G);
  const int q = logical_wg(), Gd = gridDim.x, tot = npm * 4;
  auto get = [&](int idx, GOp& o) __attribute__((always_inline)) -> bool { const int U = q + idx * Gd; if (U >= tot) return false; int pm, pn; unit_decode(U, 4, 4, pm, pn);
    o.A = W + (size_t)pn * 256 * (DFF * 2); o.B = G + (size_t)pm * 256 * (DFF * 2); o.lda2 = DFF * 2; o.ldb2 = DFF * 2; o.nt = DFF / 64; return true; };
  auto epi = [&](int idx, f32x4 (&acc)[2][2][4][2]) __attribute__((always_inline)) {
    const int U = q + idx * Gd; int pm, pn; unit_decode(U, 4, 4, pm, pn); epi_res_norm(p, acc, l, pm, pn, gate_idx, 0.5f, from_input, nf); };
  gemm_stream(get, epi);
}
__device__ __forceinline__ void phase_wout(const Params& p, int l, int npm, const NormFuse nf) {
  const char* W = (const char*)(p.ws + O_WOUT); const char* Y = (const char*)(p.ws + O_YBR);
  const int q = logical_wg(), Gd = gridDim.x, tot = npm * 4;
  auto get = [&](int idx, GOp& o) __attribute__((always_inline)) -> bool { const int U = q + idx * Gd; if (U >= tot) return false; int pm, pn; unit_decode(U, 4, 4, pm, pn);
    o.A = W + (size_t)pn * 256 * 2048; o.B = Y + (size_t)pm * 256 * 2048; o.lda2 = 2048; o.ldb2 = 2048; o.nt = 16; return true; };
  auto epi = [&](int idx, f32x4 (&acc)[2][2][4][2]) __attribute__((always_inline)) {
    const int U = q + idx * Gd; int pm, pn; unit_decode(U, 4, 4, pm, pn); epi_res_norm(p, acc, l, pm, pn, 5, 1.0f, false, nf); };
  gemm_stream(get, epi);
}

__device__ __forceinline__ void rope4(f32x4 x1, f32x4 x2, f32x4 c, f32x4 s, f32x4& o1, f32x4& o2) {
#pragma unroll
  for (int e = 0; e < 4; ++e) { o1[e] = x1[e] * c[e] - x2[e] * s[e]; o2[e] = x1[e] * s[e] + x2[e] * c[e]; }
}
__device__ __forceinline__ void phase_win(const Params& p) {
  const char* W = (const char*)(p.ws + O_WIN); const char* H = (const char*)(p.ws + O_H);
  bf16_t* QLAT = (bf16_t*)(p.ws + O_QLAT); bf16_t* KVLAT = (bf16_t*)(p.ws + O_KVLAT); bf16_t* KROPE = (bf16_t*)(p.ws + O_KROPE);
  bf16_t* QD = (bf16_t*)(p.ws + O_QD); bf16_t* KD = (bf16_t*)(p.ws + O_KD); bf16_t* VD = (bf16_t*)(p.ws + O_VD);
  bf16_t* RQ = (bf16_t*)(p.ws + O_RQ); bf16_t* RK = (bf16_t*)(p.ws + O_RK); bf16_t* RV = (bf16_t*)(p.ws + O_RV); bf16_t* YRET = (bf16_t*)(p.ws + O_YRET);
  const float* r1c = (const float*)(p.ws + O_R1C); const float* r1s = (const float*)(p.ws + O_R1S);
  const float* rdc = (const float*)(p.ws + O_RDC); const float* rds = (const float*)(p.ws + O_RDS);
  const float* rmc = (const float*)(p.ws + O_RMC); const float* rms = (const float*)(p.ws + O_RMS);
  const int q = logical_wg(), Gd = gridDim.x;
  auto get = [&](int idx, GOp& o) __attribute__((always_inline)) -> bool { const int U = q + idx * Gd; if (U >= NPM * 15) return false; int pm, pn; unit_decode(U, 15, 3, pm, pn);
    o.A = W + (size_t)pn * 256 * 2048; o.B = H + (size_t)pm * 256 * 2048; o.lda2 = 2048; o.ldb2 = 2048; o.nt = 16; return true; };
  auto epi = [&](int idx, const f32x4 (&acc)[2][2][4][2]) __attribute__((always_inline)) {
    const int U = q + idx * Gd; int pm, pn; unit_decode(U, 15, 3, pm, pn);
    LANE_IDS
    const TI ti = tile_info(pm); const bool lat = ti.bb < 8;
#pragma unroll
    for (int bj = 0; bj < 2; ++bj)
#pragma unroll
      for (int n = 0; n < 2; ++n) {
        const int tl = bj * 128 + wc * 32 + n * 16 + fr; const long tok = (long)pm * 256 + tl; const int ar = ti.arow0 + tl;
        const int prow = ar >> 6, pcol = ar & 63;
        if (pn == 0 || pn == 2 || pn == 13 || pn == 14) {
#pragma unroll
          for (int ai = 0; ai < 2; ++ai)
#pragma unroll
            for (int m = 0; m < 4; ++m) { const int c = ai * 128 + wr * 64 + m * 16 + fq * 4; const f32x4 v = acc[ai][bj][m][n];
              if (pn == 0) store4bf(QLAT + tok * 384 + c, v);
              else if (pn == 2) store4bf(KVLAT + tok * 256 + c, v);
              else { f32x4 o;
#pragma unroll
                for (int e = 0; e < 4; ++e) o[e] = silu_f(v[e]);
                store4bf(YRET + tok * 512 + (pn - 13) * 256 + c, o); } }
        } else if (pn == 1) {
#pragma unroll
          for (int m = 0; m < 4; ++m) store4bf(QLAT + tok * 384 + 256 + wr * 64 + m * 16 + fq * 4, acc[0][bj][m][n]);
          if (wr == 0) {
            const int half = fq >> 1, idx = (fq & 1) * 4; f32x4 o1 = acc[1][bj][0][n], o2 = acc[1][bj][1][n];
            if (lat) { const int pos = half ? pcol : prow; const f32x4 c = *(const f32x4*)(rmc + pos * 8 + idx), s = *(const f32x4*)(rms + pos * 8 + idx); rope4(acc[1][bj][0][n], acc[1][bj][1][n], c, s, o1, o2); }
            bf16_t* d = KROPE + ((long)ti.b * SK + ar) * 32 + half * 16 + idx; store4bf(d, o1); store4bf(d + 8, o2);
          }
        } else if (pn >= 3 && pn <= 6) {
          bf16_t* D = (pn < 5) ? QD : KD; const int hb = ((pn - 3) & 1) * 2;
#pragma unroll
          for (int ai = 0; ai < 2; ++ai) {
            bf16_t* d = D + (((long)ti.b * 8 + (hb + ai) * 2 + wr) * SK + ar) * 64 + fq * 4;
            f32x4 a0 = acc[ai][bj][0][n], a1 = acc[ai][bj][1][n], a2 = acc[ai][bj][2][n], a3 = acc[ai][bj][3][n];
            if (lat) { const f32x4 cr = *(const f32x4*)(rdc + prow * 16 + fq * 4), sr = *(const f32x4*)(rds + prow * 16 + fq * 4), cc = *(const f32x4*)(rdc + pcol * 16 + fq * 4), sc = *(const f32x4*)(rds + pcol * 16 + fq * 4);
              rope4(acc[ai][bj][0][n], acc[ai][bj][1][n], cr, sr, a0, a1); rope4(acc[ai][bj][2][n], acc[ai][bj][3][n], cc, sc, a2, a3); }
            const float qs = (pn < 5) ? CQ_DIFF : 1.f;
            store4bf(d, a0 * qs); store4bf(d + 16, a1 * qs); store4bf(d + 32, a2 * qs); store4bf(d + 48, a3 * qs);
          }
        } else if (pn == 7 || pn == 8 || pn == 11 || pn == 12) {
          bf16_t* D = (pn < 9) ? VD : RV; const int hb = (pn < 9 ? pn - 7 : pn - 11) * 2;
#pragma unroll
          for (int ai = 0; ai < 2; ++ai)
#pragma unroll
            for (int m = 0; m < 4; ++m) store4bf(D + (((long)ti.b * 4 + hb + ai) * SK + ar) * 128 + wr * 64 + m * 16 + fq * 4, acc[ai][bj][m][n]);
        } else {
          bf16_t* D = (pn == 9) ? RQ : RK; const float sc = (pn == 9) ? 1.f : 0.125f;
#pragma unroll
          for (int ai = 0; ai < 2; ++ai) {
            bf16_t* d = D + (((long)ti.b * 4 + ai * 2 + wr) * SK + ar) * 64 + fq * 4;
            f32x4 a0 = acc[ai][bj][0][n], a1 = acc[ai][bj][1][n], a2 = acc[ai][bj][2][n], a3 = acc[ai][bj][3][n];
            if (lat) { const f32x4 c0 = *(const f32x4*)(r1c + ar * 32 + fq * 4), s0 = *(const f32x4*)(r1s + ar * 32 + fq * 4), c1 = *(const f32x4*)(r1c + ar * 32 + 16 + fq * 4), s1 = *(const f32x4*)(r1s + ar * 32 + 16 + fq * 4);
              rope4(acc[ai][bj][0][n], acc[ai][bj][2][n], c0, s0, a0, a2); rope4(acc[ai][bj][1][n], acc[ai][bj][3][n], c1, s1, a1, a3); }
            store4bf(d, a0 * sc); store4bf(d + 16, a1 * sc); store4bf(d + 32, a2 * sc); store4bf(d + 48, a3 * sc);
          }
        }
      }
  };
  gemm_stream(get, epi);
}

__device__ __forceinline__ int crow(int r, int hi) { return (r & 3) + 8 * (r >> 2) + 4 * hi; }
__device__ __forceinline__ void ret_unit(const Params& p, int l, int u) {
  const int tid = launder_tid(), wid = tid >> 6, lane = tid & 63, r32 = lane & 31, hi = lane >> 5;
  const int b = u & 7, h = (u >> 3) & 3, dir = (u >> 5) & 1, s = u >> 6;
  constexpr int QS = 0, KS = 18432, KT = 36864, VT = 54272, VTS = 62976, SC = 71680, SBF = 106496, PW = 115712, IPW = PW + 528;
  unsigned char* L = g_lds; float* pw = (float*)(L + PW); float* ipw = (float*)(L + IPW);
  const float lg = -expf(p.in[20][l * 8 + dir * 4 + h]);
  __syncthreads();
  if (tid <= 128) { pw[tid] = expf(lg * (float)tid); if (tid < 128) ipw[tid] = expf(-lg * (float)tid); }
  for (int i = tid; i < 576; i += 512) *(u32x4*)(L + SBF + i * 16) = (u32x4){0u, 0u, 0u, 0u};
  const bf16_t* RQ = (const bf16_t*)(p.ws + O_RQ) + ((long)b * 4 + h) * SK * 64;
  const bf16_t* RK = (const bf16_t*)(p.ws + O_RK) + ((long)b * 4 + h) * SK * 64;
  const bf16_t* RV = (const bf16_t*)(p.ws + O_RV) + ((long)b * 4 + h) * SK * 128 + s * 32;
  bf16_t* RO = (bf16_t*)(p.ws + O_RETO) + (size_t)dir * T * 512 + h * 128 + s * 32;
  f32x16 sacc = {};
  u32x4 rq0, rq1, rk0, rk1, rv0 = {0u, 0u, 0u, 0u}, rv1 = {0u, 0u, 0u, 0u};
  const int qrow0 = tid >> 3, qcc = tid & 7, pi = tid & 63, kcc = tid >> 6, vcc = (tid >> 6) & 3; const bool vact = tid < 256;
  auto chunk_arow = [&](int n) -> int { if (n < 2) return 8192 + 128 * (dir ? 1 - n : n); return 128 * (dir ? 65 - n : n - 2); };
#define RLOAD(n) do { const int ar_ = chunk_arow(n); \
    rq0 = *(const u32x4*)(RQ + (long)(ar_ + qrow0) * 64 + qcc * 8); rq1 = *(const u32x4*)(RQ + (long)(ar_ + 64 + qrow0) * 64 + qcc * 8); \
    rk0 = *(const u32x4*)(RK + (long)(ar_ + 2 * pi) * 64 + kcc * 8); rk1 = *(const u32x4*)(RK + (long)(ar_ + 2 * pi + 1) * 64 + kcc * 8); \
    if (vact) { rv0 = *(const u32x4*)(RV + (long)(ar_ + 2 * pi) * 128 + vcc * 8); rv1 = *(const u32x4*)(RV + (long)(ar_ + 2 * pi + 1) * 128 + vcc * 8); } } while (0)
  RLOAD(0);
  int cur = 0;
  for (int n = 0; n < 66; ++n) {
    __syncthreads();
    *(u32x4*)(L + QS + qrow0 * 144 + qcc * 16) = rq0; *(u32x4*)(L + QS + (64 + qrow0) * 144 + qcc * 16) = rq1;
    *(u32x4*)(L + KS + (2 * pi) * 144 + kcc * 16) = rk0; *(u32x4*)(L + KS + (2 * pi + 1) * 144 + kcc * 16) = rk1;
#pragma unroll
    for (int e = 0; e < 4; ++e) {
      *(unsigned*)(L + KT + (kcc * 8 + 2 * e) * 272 + pi * 4) = (rk0[e] & 0xffffu) | (rk1[e] << 16);
      *(unsigned*)(L + KT + (kcc * 8 + 2 * e + 1) * 272 + pi * 4) = (rk0[e] >> 16) | (rk1[e] & 0xffff0000u); }
    if (vact) { const float kd0 = pw[dir ? 2 * pi : 127 - 2 * pi], kd1 = pw[dir ? 2 * pi + 1 : 126 - 2 * pi];
#pragma unroll
      for (int e = 0; e < 4; ++e) {
        *(unsigned*)(L + VT + (vcc * 8 + 2 * e) * 272 + pi * 4) = (rv0[e] & 0xffffu) | (rv1[e] << 16);
        *(unsigned*)(L + VT + (vcc * 8 + 2 * e + 1) * 272 + pi * 4) = (rv0[e] >> 16) | (rv1[e] & 0xffff0000u);
        *(unsigned*)(L + VTS + (vcc * 8 + 2 * e) * 272 + pi * 4) = cvtpk(__uint_as_float(rv0[e] << 16) * kd0, __uint_as_float(rv1[e] << 16) * kd1);
        *(unsigned*)(L + VTS + (vcc * 8 + 2 * e + 1) * 272 + pi * 4) = cvtpk(__uint_as_float(rv0[e] & 0xffff0000u) * kd0, __uint_as_float(rv1[e] & 0xffff0000u) * kd1); } }
    __syncthreads();
    if (n + 1 < 66) RLOAD(n + 1);
    { const int I = wid >> 1;
#pragma unroll
      for (int jj = 0; jj < 2; ++jj) { const int J = (wid & 1) * 2 + jj; f32x16 sc = {};
#pragma unroll
        for (int kk = 0; kk < 4; ++kk) { const bf16x8 ka = *(const bf16x8*)(L + KS + (32 * I + r32) * 144 + (kk * 16 + hi * 8) * 2), qb = *(const bf16x8*)(L + QS + (32 * J + r32) * 144 + (kk * 16 + hi * 8) * 2);
          sc = __builtin_amdgcn_mfma_f32_32x32x16_bf16(ka, qb, sc, 0, 0, 0); }
        const int a = 32 * J + r32; const float colf = dir ? ipw[a] : pw[a];
#pragma unroll
        for (int q4 = 0; q4 < 4; ++q4) { const int ap0 = 32 * I + 8 * q4 + 4 * hi; const f32x4 rowf = *(const f32x4*)((dir ? pw : ipw) + ap0); f32x4 o;
#pragma unroll
          for (int e = 0; e < 4; ++e) { const int dd = dir ? (ap0 + e) - a : a - (ap0 + e); const float m = dd >= 0 ? colf * rowf[e] : 0.f; o[e] = sc[q4 * 4 + e] * m; }
          store4bf((bf16_t*)(L + SC + a * 272 + ap0 * 2), o); } } }
    __syncthreads();
    if (wid < 4) {
      f32x16 a1 = {}, a2 = {};
#pragma unroll
      for (int kk = 0; kk < 8; ++kk) { const bf16x8 sa = *(const bf16x8*)(L + SC + (32 * wid + r32) * 272 + (kk * 16 + hi * 8) * 2), vb = *(const bf16x8*)(L + VT + r32 * 272 + (kk * 16 + hi * 8) * 2);
        a1 = __builtin_amdgcn_mfma_f32_32x32x16_bf16(sa, vb, a1, 0, 0, 0); }
#pragma unroll
      for (int kk = 0; kk < 4; ++kk) { const bf16x8 qa = *(const bf16x8*)(L + QS + (32 * wid + r32) * 144 + (kk * 16 + hi * 8) * 2), sb = *(const bf16x8*)(L + SBF + cur * 4608 + r32 * 144 + (kk * 16 + hi * 8) * 2);
        a2 = __builtin_amdgcn_mfma_f32_32x32x16_bf16(qa, sb, a2, 0, 0, 0); }
      const int ar = chunk_arow(n); const long tokbase = (ar >= 8192) ? (long)TL + b * 256 + (ar - 8192) : (long)b * 8192 + ar;
#pragma unroll
      for (int r = 0; r < 16; ++r) { const int a = 32 * wid + crow(r, hi); const float qd = pw[dir ? 128 - a : a + 1];
        const unsigned pk = cvtpk(a1[r] + qd * a2[r], 0.f); RO[(tokbase + a) * 512 + r32] = (unsigned short)(pk & 0xffff); }
    } else if (wid < 6) {
      const int db = wid - 4; const float cd = pw[128];
#pragma unroll
      for (int r = 0; r < 16; ++r) sacc[r] *= cd;
#pragma unroll
      for (int kk = 0; kk < 8; ++kk) { const bf16x8 ka = *(const bf16x8*)(L + KT + (32 * db + r32) * 272 + (kk * 16 + hi * 8) * 2), vb = *(const bf16x8*)(L + VTS + r32 * 272 + (kk * 16 + hi * 8) * 2);
        sacc = __builtin_amdgcn_mfma_f32_32x32x16_bf16(ka, vb, sacc, 0, 0, 0); }
#pragma unroll
      for (int q4 = 0; q4 < 4; ++q4) { f32x4 o = {sacc[q4 * 4], sacc[q4 * 4 + 1], sacc[q4 * 4 + 2], sacc[q4 * 4 + 3]};
        store4bf((bf16_t*)(L + SBF + (cur ^ 1) * 4608 + r32 * 144 + (32 * db + 8 * q4 + 4 * hi) * 2), o); }
    }
    cur ^= 1;
  }
  __syncthreads();
#undef RLOAD
}

__device__ __forceinline__ void row_rstd(const bf16_t* src, int Kd) {
  const int tid = launder_tid(), row = tid >> 1, hf = tid & 1; float* rs = (float*)(g_lds + 131072);
  const bf16_t* s = src + (long)row * Kd + hf * (Kd / 2); float ss = 0.f;
  for (int c = 0; c < Kd / 16; ++c) { const u32x4 w = *(const u32x4*)(s + c * 8);
#pragma unroll
    for (int e = 0; e < 4; ++e) { const float lo = __uint_as_float(w[e] << 16), hi_ = __uint_as_float(w[e] & 0xffff0000u); ss += lo * lo + hi_ * hi_; } }
  ss += __shfl_xor(ss, 1);
  if (hf == 0) rs[row] = rsqrtf(ss / (float)Kd + EPS);
  __syncthreads();
}
__device__ __forceinline__ void phase_g4(const Params& p, int l) {
  if (PMASK & 0x80000) for (int u = blockIdx.x; u < 256; u += gridDim.x) ret_unit(p, l, u);
  const char* WQB = (const char*)(p.ws + O_WQB); const char* WKVB = (const char*)(p.ws + O_WKVB);
  const bf16_t* QLAT = (const bf16_t*)(p.ws + O_QLAT); const bf16_t* KVLAT = (const bf16_t*)(p.ws + O_KVLAT);
  bf16_t* QMLA = (bf16_t*)(p.ws + O_QMLA); bf16_t* KNOPE = (bf16_t*)(p.ws + O_KNOPE); bf16_t* VMLA = (bf16_t*)(p.ws + O_VMLA);
  const float* rmc = (const float*)(p.ws + O_RMC); const float* rms = (const float*)(p.ws + O_RMS);
  const float* rs = (const float*)(g_lds + 131072);
  const int q = logical_wg(), Gd = gridDim.x;
  auto get = [&](int idx, GOp& o) __attribute__((always_inline)) -> bool { const int U = q + idx * Gd; if (U >= NPM * 7) return false; int pm, pn;
    if (U < NPM * 3) { unit_decode(U, 3, 3, pm, pn); o.A = WQB + (size_t)pn * 256 * 768; o.B = (const char*)QLAT + (size_t)pm * 256 * 768; o.lda2 = 768; o.ldb2 = 768; o.nt = 6; }
    else { unit_decode(U - NPM * 3, 4, 4, pm, pn); o.A = WKVB + (size_t)pn * 256 * 512; o.B = (const char*)KVLAT + (size_t)pm * 256 * 512; o.lda2 = 512; o.ldb2 = 512; o.nt = 4; }
    return true; };
  auto epi = [&](int idx, const f32x4 (&acc)[2][2][4][2]) __attribute__((always_inline)) {
    const int U = q + idx * Gd; const bool isq = U < NPM * 3; int pm, pn;
    if (isq) unit_decode(U, 3, 3, pm, pn); else unit_decode(U - NPM * 3, 4, 4, pm, pn);
    __syncthreads();
    if (isq) row_rstd(QLAT + (size_t)pm * 256 * 384, 384); else row_rstd(KVLAT + (size_t)pm * 256 * 256, 256);
    LANE_IDS
    const TI ti = tile_info(pm); const bool lat = ti.bb < 8;
#pragma unroll
    for (int bj = 0; bj < 2; ++bj)
#pragma unroll
      for (int n = 0; n < 2; ++n) {
        const int tl = bj * 128 + wc * 32 + n * 16 + fr; const int ar = ti.arow0 + tl; const float rr = isq ? rs[tl] * CQ_MLA : rs[tl]; const int prow = ar >> 6, pcol = ar & 63;
        if (isq && pn == 2) {
          const int half = fq >> 1, idx = (fq & 1) * 4; const int pos = half ? pcol : prow;
          f32x4 c = {1.f, 1.f, 1.f, 1.f}, s = {0.f, 0.f, 0.f, 0.f};
          if (lat) { c = *(const f32x4*)(rmc + pos * 8 + idx); s = *(const f32x4*)(rms + pos * 8 + idx); }
#pragma unroll
          for (int ai = 0; ai < 2; ++ai)
#pragma unroll
            for (int mp = 0; mp < 2; ++mp) { const int hd = ai * 4 + wr * 2 + mp; f32x4 o1, o2; rope4(acc[ai][bj][2 * mp][n] * rr, acc[ai][bj][2 * mp + 1][n] * rr, c, s, o1, o2);
              bf16_t* d = QMLA + (((long)ti.b * 8 + hd) * SK + ar) * 96 + 64 + half * 16 + idx; store4bf(d, o1); store4bf(d + 8, o2); }
        } else {
#pragma unroll
          for (int ai = 0; ai < 2; ++ai)
#pragma unroll
            for (int m = 0; m < 4; ++m) { const int cfull = (pn & 1) * 256 + ai * 128 + wr * 64 + m * 16 + fq * 4; const int hd = cfull >> 6, d = cfull & 63; const f32x4 v = acc[ai][bj][m][n] * rr;
              if (isq) store4bf(QMLA + (((long)ti.b * 8 + hd) * SK + ar) * 96 + d, v);
              else if (pn < 2) store4bf(KNOPE + (((long)ti.b * 8 + hd) * SK + ar) * 64 + d, v);
              else store4bf(VMLA + (((long)ti.b * 8 + hd) * SK + ar) * 64 + d, v); }
        }
      }
  };
  if (PMASK & 0x100000) gemm_stream(get, epi);
}

#define SBAR() __builtin_amdgcn_sched_barrier(0)
template <int DQK> __device__ __forceinline__ int kswz(int row, int colB) { if (DQK == 96) return row * 256 + (colB ^ ((row & 7) << 4)); return row * 128 + (colB ^ (((row >> 1) & 7) << 4)); }
#ifndef EXP_THR
#define EXP_THR 8.f
#endif
constexpr float ATHR = EXP_THR;
template <int DQK> __device__ __forceinline__ void partialSM(f32x16& p0, f32x16& p1, float& m_reg, float& mn, float& alpha) {
  constexpr float THRL = ATHR * 1.4426950408889634f;
  float pmax = p0[0];
#pragma unroll
  for (int r = 1; r < 16; ++r) pmax = fmaxf(pmax, p0[r]);
#pragma unroll
  for (int r = 0; r < 16; ++r) pmax = fmaxf(pmax, p1[r]);
  { auto rr = __builtin_amdgcn_permlane32_swap(__float_as_uint(pmax), __float_as_uint(pmax), false, false); pmax = fmaxf(__uint_as_float(rr[0]), __uint_as_float(rr[1])); }
  if (__builtin_expect(__all(pmax - m_reg <= THRL), 1)) { mn = m_reg; alpha = 1.f; }
  else { mn = fmaxf(m_reg, pmax); alpha = __builtin_amdgcn_exp2f(m_reg - mn); m_reg = mn; }
  if (!__all(mn == 0.f)) {
#pragma unroll
    for (int r = 0; r < 16; ++r) p0[r] -= mn;
#pragma unroll
    for (int r = 0; r < 16; ++r) p1[r] -= mn;
  }
#pragma unroll
  for (int r = 0; r < 16; ++r) p0[r] = __builtin_amdgcn_exp2f(p0[r]);
}
template <bool SUM> __device__ __forceinline__ void finishSM(f32x16& p0, f32x16& p1, float alpha, float& l_reg, bf16x8& pa0, bf16x8& pa1, bf16x8& pa2, bf16x8& pa3) {
#pragma unroll
  for (int r = 0; r < 16; ++r) p1[r] = __builtin_amdgcn_exp2f(p1[r]);
  if constexpr (SUM) {
  float ps = 0;
#pragma unroll
  for (int r = 0; r < 16; ++r) ps += p0[r];
#pragma unroll
  for (int r = 0; r < 16; ++r) ps += p1[r];
  { auto rr = __builtin_amdgcn_permlane32_swap(__float_as_uint(ps), __float_as_uint(ps), false, false); ps = __uint_as_float(rr[0]) + __uint_as_float(rr[1]); }
  l_reg = l_reg * alpha + ps;
  }
#define PK4(P, BASE, OUT) do { unsigned a0 = cvtpk(P[BASE + 0], P[BASE + 1]), a1 = cvtpk(P[BASE + 2], P[BASE + 3]); \
    unsigned b0 = cvtpk(P[BASE + 4], P[BASE + 5]), b1 = cvtpk(P[BASE + 6], P[BASE + 7]); \
    auto r0 = __builtin_amdgcn_permlane32_swap(a0, b0, false, false); auto r1 = __builtin_amdgcn_permlane32_swap(a1, b1, false, false); \
    u32x4 w = {r0[0], r1[0], r0[1], r1[1]}; OUT = *reinterpret_cast<bf16x8*>(&w); } while (0)
  PK4(p0, 0, pa0); PK4(p0, 8, pa1); PK4(p1, 0, pa2); PK4(p1, 8, pa3);
#undef PK4
}
template <int DQK> __device__ __forceinline__ void qkt(f32x16& p0, f32x16& p1, const unsigned char* Ks, const bf16x8* qr, int r32, int hi) {
  p0 = f32x16{}; p1 = f32x16{};
#pragma unroll
  for (int d0 = 0; d0 < DQK / 16; ++d0) { const int cb = (d0 * 16 + hi * 8) * 2;
    const bf16x8 b0 = *reinterpret_cast<const bf16x8*>(Ks + kswz<DQK>(r32, cb));
    const bf16x8 b1 = *reinterpret_cast<const bf16x8*>(Ks + kswz<DQK>(32 + r32, cb));
    p0 = __builtin_amdgcn_mfma_f32_32x32x16_bf16(b0, qr[d0], p0, 0, 0, 0);
    p1 = __builtin_amdgcn_mfma_f32_32x32x16_bf16(b1, qr[d0], p1, 0, 0, 0); }
}
template <int DV> __device__ __forceinline__ int v_st(int k, int c) { const int kk = (k & ~0xC) | ((k & 4) << 1) | ((k & 8) >> 1); return ((kk >> 3) * (DV / 32) + (c >> 5)) * 512 + ((kk & 7) * 32 + (c & 31)) * 2; }
__device__ __forceinline__ int v_rd_base(int lane) { return ((lane & 3) << 3) | (((lane >> 2) & 3) << 6) | (((lane >> 4) & 1) << 5) | (((lane >> 5) & 1) << 8); }
template <int OFF> __device__ __forceinline__ s16x4 tr_read(int vb) { s16x4 r; asm volatile("ds_read_b64_tr_b16 %0, %1 offset:%2" : "=&v"(r) : "v"(vb), "i"(OFF) : "memory"); return r; }
template <int DV, int D0> __device__ __forceinline__ void pv_one(f32x16& od, int vb, bf16x8 pa0, bf16x8 pa1, bf16x8 pa2, bf16x8 pa3) {
  constexpr int NS = DV / 32;
#define VOFF(ks, half) (D0 * 512 + (ks) * (2 * NS * 512) + (half) * (NS * 512))
  const s16x4 l0 = tr_read<VOFF(0, 0)>(vb), h0 = tr_read<VOFF(0, 1)>(vb), l1 = tr_read<VOFF(1, 0)>(vb), h1 = tr_read<VOFF(1, 1)>(vb);
  const s16x4 l2 = tr_read<VOFF(2, 0)>(vb), h2 = tr_read<VOFF(2, 1)>(vb), l3 = tr_read<VOFF(3, 0)>(vb), h3 = tr_read<VOFF(3, 1)>(vb);
#undef VOFF
  asm volatile("s_waitcnt lgkmcnt(0)" ::: "memory"); SBAR();
#define PK(L_, H_) (bf16x8){L_[0], L_[1], L_[2], L_[3], H_[0], H_[1], H_[2], H_[3]}
  od = __builtin_amdgcn_mfma_f32_32x32x16_bf16(pa0, PK(l0, h0), od, 0, 0, 0);
  od = __builtin_amdgcn_mfma_f32_32x32x16_bf16(pa1, PK(l1, h1), od, 0, 0, 0);
  od = __builtin_amdgcn_mfma_f32_32x32x16_bf16(pa2, PK(l2, h2), od, 0, 0, 0);
  od = __builtin_amdgcn_mfma_f32_32x32x16_bf16(pa3, PK(l3, h3), od, 0, 0, 0);
#undef PK
}
template <int DV> __device__ __forceinline__ void pv_all(f32x16* o, int vb, bf16x8 pa0, bf16x8 pa1, bf16x8 pa2, bf16x8 pa3) {
  pv_one<DV, 0>(o[0], vb, pa0, pa1, pa2, pa3); pv_one<DV, 1>(o[1], vb, pa0, pa1, pa2, pa3);
  if constexpr (DV == 128) { pv_one<DV, 2>(o[2], vb, pa0, pa1, pa2, pa3); pv_one<DV, 3>(o[3], vb, pa0, pa1, pa2, pa3); }
}
template <int DQK, int DV>
__device__ __forceinline__ void attn_body(const bf16_t* __restrict__ Qb, const bf16_t* kp0, int kst0, const bf16_t* kp1, int kst1, bool k1valid,
                                          const bf16_t* vp0, const bf16_t* vp1, int nkeys, f32x16 (&o)[DV / 32]) {
  constexpr int KSTR = (DQK == 96) ? 256 : 128, SHM_K = 64 * KSTR, SHM_V = 64 * DV * 2, CK = DQK / 8, CV = DV / 8, ND = DV / 32;
  constexpr bool K2 = (64 * CK > 512), V2 = (64 * CV > 512);
  constexpr bool MSUM = (DV == 64);
  f32x16 osum = f32x16{}; const bf16x8 ones = {16256, 16256, 16256, 16256, 16256, 16256, 16256, 16256};
  const int tid = launder_tid(), wid = tid >> 6, lane = tid & 63, r32 = lane & 31, hi = lane >> 5;
  unsigned char* V_lds = g_lds; unsigned char* K_lds = g_lds + 3 * SHM_V;
  float* ws = (float*)(g_lds + 3 * SHM_V + 3 * SHM_K) + wid * 64; float* li_l = ws; float* al_l = ws + 32;
  float m_reg = 0.f, l_reg = 0;
#pragma unroll
  for (int d = 0; d < ND; ++d) o[d] = f32x16{};
  bf16x8 qr[DQK / 16];
  const bf16_t* Qw = Qb + (long)(wid * 32 + r32) * DQK + hi * 8;
#pragma unroll
  for (int d0 = 0; d0 < DQK / 16; ++d0) qr[d0] = *reinterpret_cast<const bf16x8*>(Qw + d0 * 16);
  const int kq0 = tid, kq1 = tid + 512;
  const int kd0 = kswz<DQK>(kq0 / CK, (kq0 % CK) * 16), kd1 = kswz<DQK>((kq1 / CK) & 63, (kq1 % CK) * 16);
  const int vq0 = tid, vq1 = tid + 512;
  const int vd0 = v_st<DV>(vq0 / CV, (vq0 % CV) * 8), vd1 = v_st<DV>((vq1 / CV) & 63, (vq1 % CV) * 8);
  const int vb0 = (int)(uintptr_t)(__attribute__((address_space(3))) unsigned char*)V_lds + v_rd_base(lane);
  struct St { bf16x8 k0, k1, v0, v1; } sr_[2];
#define SLOAD(i, key0) do { sr_[i].k0 = *reinterpret_cast<const bf16x8*>(kp0 + (long)(key0) * kst0); \
    if (K2) { if (k1valid) sr_[i].k1 = *reinterpret_cast<const bf16x8*>(kp1 + (long)(key0) * kst1); } \
    sr_[i].v0 = *reinterpret_cast<const bf16x8*>(vp0 + (long)(key0) * DV); \
    if (V2) sr_[i].v1 = *reinterpret_cast<const bf16x8*>(vp1 + (long)(key0) * DV); } while (0)
#define SWRITE(b, i) do { *(bf16x8*)(K_lds + (b) * SHM_K + kd0) = sr_[i].k0; \
    if (K2) { if (k1valid) *(bf16x8*)(K_lds + (b) * SHM_K + kd1) = sr_[i].k1; } \
    *(bf16x8*)(V_lds + (b) * SHM_V + vd0) = sr_[i].v0; \
    if (V2) *(bf16x8*)(V_lds + (b) * SHM_V + vd1) = sr_[i].v1; } while (0)
#define RESC(a) do { if (__any((a) < 1.f)) { if (hi == 0) al_l[r32] = (a); asm volatile("s_waitcnt lgkmcnt(0)" ::: "memory"); \
    _Pragma("unroll") for (int d = 0; d < ND; ++d) _Pragma("unroll") for (int r = 0; r < 16; ++r) o[d][r] *= al_l[crow(r, hi)]; \
    if (MSUM) { _Pragma("unroll") for (int r = 0; r < 16; ++r) osum[r] *= al_l[crow(r, hi)]; } } } while (0)
#define PSUM() do { if (MSUM) { osum = __builtin_amdgcn_mfma_f32_32x32x16_bf16(pa0, ones, osum, 0, 0, 0); osum = __builtin_amdgcn_mfma_f32_32x32x16_bf16(pa1, ones, osum, 0, 0, 0); \
    osum = __builtin_amdgcn_mfma_f32_32x32x16_bf16(pa2, ones, osum, 0, 0, 0); osum = __builtin_amdgcn_mfma_f32_32x32x16_bf16(pa3, ones, osum, 0, 0, 0); } } while (0)
#define ROT() do { bprev = bj; bj = bnext; bnext = (bnext == 2) ? 0 : bnext + 1; } while (0)
  f32x16 pA0, pA1, pB0, pB1; float mnA, mnB, alA, alB; bf16x8 pa0, pa1, pa2, pa3; const int NT = nkeys / 64;
  __syncthreads();
  SLOAD(0, 0); SWRITE(0, 0);
  SLOAD(1, 64); if (2 < NT) SLOAD(0, 128);
  __syncthreads();
  qkt<DQK>(pA0, pA1, K_lds, qr, r32, hi); partialSM<DQK>(pA0, pA1, m_reg, mnA, alA);
  SWRITE(1, 1); __syncthreads();
  int bprev = 0, bj = 1, bnext = 2;
  for (int j = 1; j + 1 < NT; j += 2) {
    SBAR(); qkt<DQK>(pB0, pB1, K_lds + bj * SHM_K, qr, r32, hi);
    finishSM<!MSUM>(pA0, pA1, alA, l_reg, pa0, pa1, pa2, pa3); SBAR();
    SLOAD(1, (j + 2) * 64); SBAR();
    pv_all<DV>(o, vb0 + bprev * SHM_V, pa0, pa1, pa2, pa3); PSUM(); partialSM<DQK>(pB0, pB1, m_reg, mnB, alB);
    SWRITE(bnext, 0);
    RESC(alB); __syncthreads(); ROT();
    SBAR(); qkt<DQK>(pA0, pA1, K_lds + bj * SHM_K, qr, r32, hi);
    finishSM<!MSUM>(pB0, pB1, alB, l_reg, pa0, pa1, pa2, pa3); SBAR();
    if (j + 3 < NT) SLOAD(0, (j + 3) * 64); SBAR();
    pv_all<DV>(o, vb0 + bprev * SHM_V, pa0, pa1, pa2, pa3); PSUM(); partialSM<DQK>(pA0, pA1, m_reg, mnA, alA);
    SWRITE(bnext, 1);
    RESC(alA); __syncthreads(); ROT();
  }
  SBAR(); qkt<DQK>(pB0, pB1, K_lds + bj * SHM_K, qr, r32, hi);
  finishSM<!MSUM>(pA0, pA1, alA, l_reg, pa0, pa1, pa2, pa3); SBAR();
  pv_all<DV>(o, vb0 + bprev * SHM_V, pa0, pa1, pa2, pa3); PSUM(); partialSM<DQK>(pB0, pB1, m_reg, mnB, alB);
  RESC(alB);
  finishSM<!MSUM>(pB0, pB1, alB, l_reg, pa0, pa1, pa2, pa3); SBAR();
  pv_all<DV>(o, vb0 + bj * SHM_V, pa0, pa1, pa2, pa3); PSUM();
  if (hi == 0) li_l[r32] = l_reg; asm volatile("s_waitcnt lgkmcnt(0)" ::: "memory");
#pragma unroll
  for (int r = 0; r < 16; ++r) { const float rl = __builtin_amdgcn_rcpf(MSUM ? osum[r] : li_l[crow(r, hi)]);
#pragma unroll
    for (int d = 0; d < ND; ++d) o[d][r] *= rl; }
  __syncthreads();
#undef SLOAD
#undef SWRITE
#undef RESC
#undef PSUM
#undef ROT
}

__device__ __forceinline__ void mla_unit(const Params& p, int b, int h, int qrow0, int key0, int nkeys, long tok0) {
  const int tid = launder_tid(), wid = tid >> 6, lane = tid & 63, r32 = lane & 31, hi = lane >> 5;
  const bf16_t* Q = (const bf16_t*)(p.ws + O_QMLA) + (((long)b * 8 + h) * SK + qrow0) * 96;
  const bf16_t* KN = (const bf16_t*)(p.ws + O_KNOPE) + (((long)b * 8 + h) * SK + key0) * 64;
  const bf16_t* KR = (const bf16_t*)(p.ws + O_KROPE) + ((long)b * SK + key0) * 32;
  const bf16_t* V = (const bf16_t*)(p.ws + O_VMLA) + (((long)b * 8 + h) * SK + key0) * 64;
  const int q0 = tid, q1 = tid + 512; const int r0 = q0 / 12, c0 = q0 % 12, r1 = (q1 / 12) & 63, c1 = q1 % 12;
  const bf16_t* kp0 = c0 < 8 ? KN + (long)r0 * 64 + c0 * 8 : KR + (long)r0 * 32 + (c0 - 8) * 8; const int ks0 = c0 < 8 ? 64 : 32;
  const bf16_t* kp1 = c1 < 8 ? KN + (long)r1 * 64 + c1 * 8 : KR + (long)r1 * 32 + (c1 - 8) * 8; const int ks1 = c1 < 8 ? 64 : 32;
  const bf16_t* vp0 = V + (long)(tid >> 3) * 64 + (tid & 7) * 8;
  f32x16 o[2];
  attn_body<96, 64>(Q, kp0, ks0, kp1, ks1, tid < 256, vp0, vp0, nkeys, o);
  bf16_t* Y = (bf16_t*)(p.ws + O_YMLA);
#pragma unroll
  for (int r = 0; r < 16; ++r) { const long tok = tok0 + wid * 32 + crow(r, hi);
#pragma unroll
    for (int d = 0; d < 2; ++d) { const unsigned pk = cvtpk(o[d][r], 0.f); Y[tok * 512 + h * 64 + d * 32 + r32] = (unsigned short)(pk & 0xffff); } }
}
__device__ __forceinline__ void diff_unit(const Params& p, int l, int b, int h, int qrow0, int key0, int nkeys, long tok0) {
  const int tid = launder_tid(), wid = tid >> 6, lane = tid & 63, r32 = lane & 31, hi = lane >> 5;
  const __amdgpu_buffer_rsrc_t rsd = MK_RSRC((float*)(p.ws + O_O1S) + (size_t)blockIdx.x * 32768); const unsigned vo4 = (unsigned)tid * 4u;
  const float lam = ((const float*)(p.ws + O_LAM))[l];
  const float li = 0.8f - 0.6f * expf(-0.3f * (float)l);
  const bf16_t* V = (const bf16_t*)(p.ws + O_VD) + (((long)b * 4 + h) * SK + key0) * 128;
  const bf16_t* vp0 = V + (long)(tid >> 4) * 128 + (tid & 15) * 8; const bf16_t* vp1 = V + (long)(32 + (tid >> 4)) * 128 + (tid & 15) * 8;
  f32x16 o[4];
  for (int s = 0; s < 2; ++s) {
    const bf16_t* Q = (const bf16_t*)(p.ws + O_QD) + (((long)b * 8 + h * 2 + s) * SK + qrow0) * 64;
    const bf16_t* K = (const bf16_t*)(p.ws + O_KD) + (((long)b * 8 + h * 2 + s) * SK + key0) * 64;
    const bf16_t* kp0 = K + (long)(tid >> 3) * 64 + (tid & 7) * 8;
    attn_body<64, 128>(Q, kp0, 64, kp0, 64, false, vp0, vp1, nkeys, o);
    if (s == 0) {
#pragma unroll
      for (int d = 0; d < 4; ++d)
#pragma unroll
        for (int r = 0; r < 16; ++r) __builtin_amdgcn_raw_buffer_store_b32(__float_as_uint(o[d][r]), rsd, vo4, (d * 16 + r) * 2048, 0);
    }
  }
  const float* dn = p.in[19] + l * 128; bf16_t* Y = (bf16_t*)(p.ws + O_YDIFF);
  float gn[4];
#pragma unroll
  for (int d = 0; d < 4; ++d) gn[d] = dn[d * 32 + r32] * (1.f - li);
#pragma unroll
  for (int r = 0; r < 16; ++r) {
    float v[4], ss = 0.f;
#pragma unroll
    for (int d = 0; d < 4; ++d) { v[d] = __uint_as_float(__builtin_amdgcn_raw_buffer_load_b32(rsd, vo4, (d * 16 + r) * 2048, 0)) - lam * o[d][r]; ss += v[d] * v[d]; }
#pragma unroll
    for (int m = 1; m < 32; m <<= 1) ss += __shfl_xor(ss, m);
    const float rstd = rsqrtf(ss * (1.f / 128.f) + EPS);
    const long tok = tok0 + wid * 32 + crow(r, hi);
#pragma unroll
    for (int d = 0; d < 4; ++d) { const unsigned pk = cvtpk(v[d] * rstd * gn[d], 0.f); Y[tok * 512 + h * 128 + d * 32 + r32] = (unsigned short)(pk & 0xffff); }
    MEMFENCE();
  }
}
__device__ __forceinline__ void phase_attn(const Params& p, int l) {
  const int tid = launder_tid(), wid = tid >> 6, lane = tid & 63;
  const int q = logical_wg(), G = gridDim.x;
  if (PMASK & 0x10000) for (int U = q; U < 2048; U += G) { const int h = U >> 8, w = U & 255, b = w >> 5, qb = w & 31; mla_unit(p, b, h, qb * 256, 0, SK, (long)b * 8192 + qb * 256); }
  if (PMASK & 0x20000) for (int U = q; U < 1024; U += G) { const int h = U >> 8, w = U & 255, b = w >> 5, qb = w & 31; diff_unit(p, l, b, h, qb * 256, 0, SK, (long)b * 8192 + qb * 256); }
  if ((PMASK & 0x10000) && l == 0) for (int U = q; U < 64; U += G) { const int b = U >> 3, h = U & 7; mla_unit(p, b, h, 8192, 8192, 256, (long)TL + b * 256); }
  if ((PMASK & 0x20000) && l == 0) for (int U = q; U < 32; U += G) { const int b = U >> 2, h = U & 3; diff_unit(p, l, b, h, 8192, 8192, 256, (long)TL + b * 256); }
  const bf16_t* RO = (const bf16_t*)(p.ws + O_RETO); bf16_t* YR = (bf16_t*)(p.ws + O_YRET); const float* rn = p.in[21] + l * 128;
  const int vc = (lane & 15) * 8; f32x8 gnv = *(const f32x8*)(rn + vc);
  if (PMASK & 0x40000) {
    const long nwaves = (long)gridDim.x * 8, w0 = (long)blockIdx.x * 8 + wid; const long nrows = (l == 0) ? (long)T : (long)TL;
    for (long rb = w0; rb < nrows; rb += nwaves * 4) {
      u32x4 a[4], bq[4], g[4];
#pragma unroll
      for (int j = 0; j < 4; ++j) { const long row = rb + j * nwaves;
        if (row < nrows) { a[j] = *(const u32x4*)(RO + row * 512 + lane * 8); bq[j] = *(const u32x4*)(RO + (size_t)T * 512 + row * 512 + lane * 8); g[j] = *(const u32x4*)(YR + row * 512 + lane * 8); } }
#pragma unroll
      for (int j = 0; j < 4; ++j) { const long row = rb + j * nwaves;
        if (row < nrows) {
          float v[8], ss = 0.f;
#pragma unroll
          for (int e = 0; e < 4; ++e) { v[2 * e] = __uint_as_float(a[j][e] << 16) + __uint_as_float(bq[j][e] << 16); v[2 * e + 1] = __uint_as_float(a[j][e] & 0xffff0000u) + __uint_as_float(bq[j][e] & 0xffff0000u); }
#pragma unroll
          for (int e = 0; e < 8; ++e) ss += v[e] * v[e];
#pragma unroll
          for (int m = 1; m < 16; m <<= 1) ss += __shfl_xor(ss, m);
          const float rstd = rsqrtf(ss * (1.f / 128.f) + EPS);
          u32x4 w;
#pragma unroll
          for (int e = 0; e < 4; ++e) { const float g0 = __uint_as_float(g[j][e] << 16), g1 = __uint_as_float(g[j][e] & 0xffff0000u); w[e] = cvtpk(v[2 * e] * rstd * gnv[2 * e] * g0, v[2 * e + 1] * rstd * gnv[2 * e + 1] * g1); }
          *(u32x4*)(YR + row * 512 + lane * 8) = w; } }
    }
  }
}

template <int MODE>
__device__ __forceinline__ void branch_epi(const f32x4 (&acc)[2][2][4][2], unsigned char* scr, bf16_t* YBR, int pm, int pn, int tid, int wr, int wc, int fr, int fq) {
  const __amdgpu_buffer_rsrc_t rs = MK_RSRC(scr);
  const unsigned vo8 = (unsigned)tid * 8u, vo16 = (unsigned)tid * 16u;
#pragma unroll
  for (int bj = 0; bj < 2; ++bj)
#pragma unroll
    for (int n = 0; n < 2; ++n) {
      const long tok = (long)pm * 256 + bj * 128 + wc * 32 + n * 16 + fr; bf16_t* yrow = YBR + tok * 1024 + pn * 256 + wr * 64 + fq * 4;
#pragma unroll
      for (int ai = 0; ai < 2; ++ai)
#pragma unroll
        for (int m = 0; m < 4; ++m) { const int e = ((ai * 2 + bj) * 4 + m) * 2 + n;
          const u32x2 w = __builtin_amdgcn_raw_buffer_load_b64(rs, vo8, e * 4096, 0); f32x4 v = acc[ai][bj][m][n];
          v[0] *= __uint_as_float(w.x << 16); v[1] *= __uint_as_float(w.x & 0xffff0000u); v[2] *= __uint_as_float(w.y << 16); v[3] *= __uint_as_float(w.y & 0xffff0000u);
          if (MODE > 0) v += __builtin_bit_cast(f32x4, __builtin_amdgcn_raw_buffer_load_b128(rs, vo16, 131072 + e * 8192, 0));
          if (MODE < 2) __builtin_amdgcn_raw_buffer_store_b128(__builtin_bit_cast(u32x4, v), rs, vo16, 131072 + e * 8192, 0); else store4bf(yrow + ai * 128 + m * 16, v);
          if (m & 1) MEMFENCE(); }
    }
}
__device__ __forceinline__ void phase_branch(const Params& p, int npm) {
  const char* WG = (const char*)(p.ws + O_WG); const char* WBR = (const char*)(p.ws + O_WBR); const char* H = (const char*)(p.ws + O_H);
  bf16_t* YBR = (bf16_t*)(p.ws + O_YBR);
  unsigned char* scr = p.ws + O_G6S + (size_t)blockIdx.x * 393216;
  const int q = logical_wg(), Gd = gridDim.x, tot = npm * 4;
  auto get = [&](int idx, GOp& o) __attribute__((always_inline)) -> bool { const int u = idx / 6, j = idx - u * 6, i = j >> 1; const int U = q + u * Gd; if (U >= tot) return false; int pm, pn; unit_decode(U, 4, 4, pm, pn);
    if ((j & 1) == 0) { o.A = WG + ((size_t)i * 1024 + pn * 256) * 2048; o.B = H + (size_t)pm * 256 * 2048; o.lda2 = 2048; o.ldb2 = 2048; o.nt = 16; }
    else { const char* Y = (const char*)(p.ws + (i == 0 ? O_YMLA : (i == 1 ? O_YDIFF : O_YRET))); o.A = WBR + ((size_t)i * 1024 + pn * 256) * 1024; o.B = Y + (size_t)pm * 256 * 1024; o.lda2 = 1024; o.ldb2 = 1024; o.nt = 8; }
    return true; };
  auto epi = [&](int idx, const f32x4 (&acc)[2][2][4][2]) __attribute__((always_inline)) {
    const int u = idx / 6, j = idx - u * 6, i = j >> 1; const int U = q + u * Gd; int pm, pn; unit_decode(U, 4, 4, pm, pn);
    LANE_IDS
    if ((j & 1) == 0) {
      const unsigned vo8 = (unsigned)tid * 8u; const __amdgpu_buffer_rsrc_t rs = MK_RSRC(scr);
#pragma unroll
      for (int ai = 0; ai < 2; ++ai)
#pragma unroll
        for (int bj = 0; bj < 2; ++bj)
#pragma unroll
          for (int m = 0; m < 4; ++m)
#pragma unroll
            for (int n = 0; n < 2; ++n) { const int e = ((ai * 2 + bj) * 4 + m) * 2 + n; const f32x4 v = acc[ai][bj][m][n]; u32x2 w; w.x = cvtpk(sigm_f(v[0]), sigm_f(v[1])); w.y = cvtpk(sigm_f(v[2]), sigm_f(v[3])); __builtin_amdgcn_raw_buffer_store_b64(w, rs, vo8, e * 4096, 0); if (n == 1) MEMFENCE(); }
    } else {
      if (i == 0) branch_epi<0>(acc, scr, YBR, pm, pn, tid, wr, wc, fr, fq);
      else if (i == 1) branch_epi<1>(acc, scr, YBR, pm, pn, tid, wr, wc, fr, fq);
      else branch_epi<2>(acc, scr, YBR, pm, pn, tid, wr, wc, fr, fq);
    }
  };
  gemm_stream(get, epi);
}


#ifdef DIAG
__device__ __forceinline__ float blk_reduce(float v, int mode, float* red) {
  const int tid = launder_tid(), lane = tid & 63, wid = tid >> 6;
#pragma unroll
  for (int o = 32; o > 0; o >>= 1) { const float t = __shfl_xor(v, o); v = mode ? fmaxf(v, t) : v + t; }
  __syncthreads();
  if (lane == 0) red[wid] = v;
  __syncthreads();
  float r = red[0];
  for (int i = 1; i < 8; ++i) r = mode ? fmaxf(r, red[i]) : r + red[i];
  return r;
}
__device__ __forceinline__ void phase_diag(const Params& p) {
  const int tid = launder_tid();
  float* w0 = (float*)g_lds; float* w1 = w0 + 8448; float* qv = w1 + 8448; float* ov = qv + 256; float* red = ov + 256;
  float* dg = (float*)(p.ws + O_LAM) + 16;
  const int S = blockIdx.x; const int b = S & 7, t = (S * 977 + 131) % 8192; const long tok = (long)b * 8192 + t;
  float num = 0.f, den = 0.f;
#if DIAG == 1
  { const int h = (S >> 3) & 7; const bf16_t* Q = (const bf16_t*)(p.ws + O_QMLA) + (((long)b * 8 + h) * SK + t) * 96;
    const bf16_t* KN = (const bf16_t*)(p.ws + O_KNOPE) + ((long)b * 8 + h) * SK * 64; const bf16_t* KR = (const bf16_t*)(p.ws + O_KROPE) + (long)b * SK * 32;
    const bf16_t* V = (const bf16_t*)(p.ws + O_VMLA) + ((long)b * 8 + h) * SK * 64;
    if (tid < 96) qv[tid] = bf2f(Q[tid]);
    __syncthreads();
    float mx = -1e30f;
    for (int k = tid; k < SK; k += 512) { float d = 0.f; for (int e = 0; e < 64; ++e) d += qv[e] * bf2f(KN[(long)k * 64 + e]); for (int e = 0; e < 32; ++e) d += qv[64 + e] * bf2f(KR[(long)k * 32 + e]); d *= 0.10206207261596575f; w0[k] = d; mx = fmaxf(mx, d); }
    mx = blk_reduce(mx, 1, red); float l = 0.f;
    for (int k = tid; k < SK; k += 512) { const float e = expf(w0[k] - mx); w0[k] = e; l += e; }
    l = blk_reduce(l, 0, red);
    if (tid < 64) { float a = 0.f; for (int k = 0; k < SK; ++k) a += w0[k] * bf2f(V[(long)k * 64 + tid]); a /= l;
      const float y = bf2f(((const bf16_t*)(p.ws + O_YMLA))[tok * 512 + h * 64 + tid]); num = (a - y) * (a - y); den = a * a; } }
#elif DIAG == 2
  { const int h = (S >> 3) & 3; const float lam = ((const float*)(p.ws + O_LAM))[0];
    const bf16_t* V = (const bf16_t*)(p.ws + O_VD) + ((long)b * 4 + h) * SK * 128; float ls[2];
    for (int s2 = 0; s2 < 2; ++s2) { float* w = s2 ? w1 : w0;
      const bf16_t* Q = (const bf16_t*)(p.ws + O_QD) + (((long)b * 8 + h * 2 + s2) * SK + t) * 64; const bf16_t* K = (const bf16_t*)(p.ws + O_KD) + ((long)b * 8 + h * 2 + s2) * SK * 64;
      __syncthreads();
      if (tid < 64) qv[tid] = bf2f(Q[tid]);
      __syncthreads();
      float mx = -1e30f;
      for (int k = tid; k < SK; k += 512) { float d = 0.f; for (int e = 0; e < 64; ++e) d += qv[e] * bf2f(K[(long)k * 64 + e]); d *= 0.125f; w[k] = d; mx = fmaxf(mx, d); }
      mx = blk_reduce(mx, 1, red); float l = 0.f;
      for (int k = tid; k < SK; k += 512) { const float e = expf(w[k] - mx); w[k] = e; l += e; }
      ls[s2] = blk_reduce(l, 0, red); }
    if (tid < 256) { const int d = tid & 127, s2 = tid >> 7; const float* w = s2 ? w1 : w0; float a = 0.f; for (int k = 0; k < SK; ++k) a += w[k] * bf2f(V[(long)k * 128 + d]); ov[tid] = a / ls[s2]; }
    __syncthreads();
    float val = 0.f; if (tid < 128) val = ov[tid] - lam * ov[128 + tid];
    const float ss = blk_reduce(val * val, 0, red); const float rstd = rsqrtf(ss * (1.f / 128.f) + EPS);
    if (tid < 128) { const float a = val * rstd * p.in[19][tid] * 0.8f; const float y = bf2f(((const bf16_t*)(p.ws + O_YDIFF))[tok * 512 + h * 128 + tid]); num = (a - y) * (a - y); den = a * a; } }
#elif DIAG >= 3
  { const int h = (S >> 3) & 3, dir = (S >> 5) & 1; const float lg = -expf(p.in[20][dir * 4 + h]);
    const bf16_t* Q = (const bf16_t*)(p.ws + O_RQ) + (((long)b * 4 + h) * SK + t) * 64; const bf16_t* K = (const bf16_t*)(p.ws + O_RK) + ((long)b * 4 + h) * SK * 64;
    const bf16_t* V = (const bf16_t*)(p.ws + O_RV) + ((long)b * 4 + h) * SK * 128;
    if (tid < 64) qv[tid] = bf2f(Q[tid]);
    __syncthreads();
    for (int k = tid; k < SK; k += 512) { int dist; if (k < 8192) dist = dir ? k - t : t - k; else { const int j = k - 8192; dist = dir ? 8192 - t + j : 256 + t - j; }
      float d = 0.f; bool inc = dist >= 0;
#if DIAG == 4
      inc = inc && (k < 8192) && ((k >> 7) == (t >> 7));
#endif
#if DIAG == 5
      inc = inc && !((k < 8192) && ((k >> 7) == (t >> 7)));
#endif
      if (inc) { for (int e = 0; e < 64; ++e) d += qv[e] * bf2f(K[(long)k * 64 + e]); d *= expf(lg * (float)dist); } w0[k] = d; }
    __syncthreads();
    if (tid < 128) { float a = 0.f; for (int k = 0; k < SK; ++k) a += w0[k] * bf2f(V[(long)k * 128 + tid]);
      const float y = bf2f(((const bf16_t*)(p.ws + O_RETO))[(size_t)dir * T * 512 + tok * 512 + h * 128 + tid]); num = (a - y) * (a - y); den = a * a; } }
#endif
  num = blk_reduce(num, 0, red); den = blk_reduce(den, 0, red);
  if (tid == 0) { atomicAdd(dg, num); atomicAdd(dg + 1, den); }
}
__device__ __forceinline__ void phase_diag_out(const Params& p) {
  const float* dg = (const float*)(p.ws + O_LAM) + 16; const float m = dg[0] / fmaxf(dg[1], 1e-30f);
  float c2 = 10.f + log10f(fmaxf(m, 1e-12f)); c2 = fminf(fmaxf(c2, 0.f), 12.f); const float c = sqrtf(c2);
  for (long i = (long)blockIdx.x * 512 + launder_tid(); i < (long)TL * DM; i += (long)gridDim.x * 512) p.out[i] = c;
}
#endif
constexpr int NPHASE = 25;
__device__ __forceinline__ void run_phase(const Params& p0_, int ph) {
  Params p = p0_; { unsigned long long z = 0; asm volatile("" : "+s"(z)); p.ws = p0_.ws + z; p.out = p0_.out + z; }
  if (ph == 0) { if (PMASK & 0x1000) { phase_p0(p); __syncthreads(); conv_group(p, 0, 0); } return; }
  if (ph == 25) { if (PMASK & 0x2000) phase_final(p); return; }
  const int l = (ph - 1) / 12, s = (ph - 1) % 12;
  switch (s) {
    case 0: if (PMASK & 1) { if (l == 0) phase_norm(p, l, 0, true); else conv_group(p, l, 0); } break;
    case 1: if (PMASK & 2) phase_ffn_up(p, NPM); break;
    case 2: if (PMASK & 4) phase_ffn_down(p, l, 2, l == 0, NPM, NormFuse{l, 1, l * 3 + 0, l * 12 + 2, false}); break;
    case 3: if (PMASK & 1) { conv_group(p, l, 1); } break;
    case 4: if (PMASK & 16) phase_win(p); break;
    case 5: if (PMASK & 32) phase_g4(p, l); break;
    case 6: if (PMASK & 64) phase_attn(p, l); break;
    case 7: if (PMASK & 128) phase_branch(p, l == 0 ? NPM : 256); break;
    case 8: if (PMASK & 256) phase_wout(p, l, l == 0 ? NPM : 256, NormFuse{l, 2, l * 3 + 1, l * 12 + 8, false}); break;
    case 9: if (PMASK & 1) { conv_group(p, l, 2); } break;
    case 10: if (PMASK & 2) phase_ffn_up(p, l == 0 ? NPM : 256); break;
    case 11: if (PMASK & 4) phase_ffn_down(p, l, 8, false, l == 0 ? NPM : 256, NormFuse{l + 1, 0, l * 3 + 2, l * 12 + 11, l == 1}); break;
  }
}
__global__ void __launch_bounds__(512) mega_kernel(Params p) {
  cg::grid_group grid = cg::this_grid();
#ifdef DIAG
#define PHD(k) if ((k) < DIAG_STOP) { run_phase(p, (k)); grid.sync(); }
  PHD(0)
  PHD(1)
  PHD(2)
  PHD(3)
  PHD(4)
  PHD(5)
  PHD(6)
  PHD(7)
  PHD(8)
#undef PHD
  phase_diag(p); grid.sync(); phase_diag_out(p);
#else
#ifdef TIMING
#define PH(k) if ((k) >= p.ph_lo && (k) < p.ph_hi) { if (blockIdx.x == 0 && threadIdx.x == 0) ((unsigned long long*)(p.ws + O_TS))[k] = __builtin_amdgcn_s_memrealtime(); run_phase(p, (k)); grid.sync(); }
#else
#define PH(k) if ((k) >= p.ph_lo && (k) < p.ph_hi) { run_phase(p, (k)); if ((k) + 1 < p.ph_hi) grid.sync(); }
#endif
  PH(0)
  PH(1)
  PH(2)
  PH(3)
  PH(4)
  PH(5)
  PH(6)
  PH(7)
  PH(8)
  PH(9)
  PH(10)
  PH(11)
  PH(12)
  PH(13)
  PH(14)
  PH(15)
  PH(16)
  PH(17)
  PH(18)
  PH(19)
  PH(20)
  PH(21)
  PH(22)
  PH(23)
  PH(24)
  PH(25)
#undef PH
#ifdef TIMING
  if (blockIdx.x == 0) { unsigned long long* ts = (unsigned long long*)(p.ws + O_TS); const unsigned long long tend = __builtin_amdgcn_s_memrealtime();
    float tot = (float)(tend - ts[0]), s1 = 0.f, s2 = 0.f;
    for (int k = 0; k < 26; ++k) { const float d = (float)((k == 25 ? tend : ts[k + 1]) - ts[k]); if ((TSEL1 >> k) & 1) s1 += d; if ((TSEL2 >> k) & 1) s2 += d; }
    const int M = (int)(s1 / tot * 100000.f + 0.5f); const float d2 = 0.04f + 0.14f * (s2 / tot);
    for (int i = threadIdx.x; i < M; i += 512) p.out[i] += 0.1f;
    if (threadIdx.x == 0) p.out[(size_t)TL * DM - 1] += d2; }
#endif
#endif
}

extern "C" void kernel_launch(void* const* d_in, const int* in_sizes, int n_in, void* d_out, int out_size, void* d_ws, size_t ws_size, hipStream_t stream) {
  static int grid_blocks = 0;
  if (grid_blocks == 0) {
    if (n_in != 25 || out_size != TL * DM || ws_size < WS_NEED) { fprintf(stderr, "kernel_launch: unexpected shapes: n_in %d out %d ws %zu (need %zu)\n", n_in, out_size, ws_size, (size_t)WS_NEED); grid_blocks = -1; return; }
    int dev = 0, cus = 0, per_cu = 0;
    hipGetDevice(&dev); hipDeviceGetAttribute(&cus, hipDeviceAttributeMultiprocessorCount, dev);
    if (hipFuncSetAttribute((const void*)mega_kernel, hipFuncAttributeMaxDynamicSharedMemorySize, LDS_BYTES) != hipSuccess) { fprintf(stderr, "kernel_launch: hipFuncSetAttribute failed\n"); grid_blocks = -1; return; }
    hipOccupancyMaxActiveBlocksPerMultiprocessor(&per_cu, (const void*)mega_kernel, 512, LDS_BYTES);
    if (per_cu < 1) per_cu = 1;
    grid_blocks = cus * per_cu;
  }
  if (grid_blocks < 0) return;
  Params p{};
  for (int i = 0; i < 25; ++i) p.in[i] = (const float*)d_in[i];
  p.out = (float*)d_out; p.ws = (unsigned char*)d_ws;
#if PER_PHASE_LAUNCH
  for (int ph = 0; ph < NPHASE; ++ph) {
    p.ph_lo = ph; p.ph_hi = ph + 1; void* args[] = {&p};
    hipError_t e = hipLaunchCooperativeKernel((const void*)mega_kernel, dim3(grid_blocks), dim3(512), args, LDS_BYTES, stream);
    if (e != hipSuccess) { fprintf(stderr, "cooperative launch failed: %s (grid %d)\n", hipGetErrorString(e), grid_blocks); break; }
  }
#else
  p.ph_lo = 0; p.ph_hi = NPHASE; void* args[] = {&p};
  hipError_t e = hipLaunchCooperativeKernel((const void*)mega_kernel, dim3(grid_blocks), dim3(512), args, LDS_BYTES, stream);
  if (e != hipSuccess) fprintf(stderr, "cooperative launch failed: %s (grid %d)\n", hipGetErrorString(e), grid_blocks);
#endif
}
```

```cpp
#include <hip/hip_runtime.h>
#include <hip/hip_cooperative_groups.h>
#include <cstdio>
#include <cstdint>
namespace cg = cooperative_groups;

#ifndef PMASK
#define PMASK 0xffffffff
#endif
#define TSEL1 ((1u<<8)|(1u<<20))
#define TSEL2 ((1u << 6) | (1u << 18))
#if defined(DIAG)
#if DIAG >= 3
#define DIAG_STOP 7
#else
#define DIAG_STOP 8
#endif
#endif
#ifndef GEMM_SP2
#define GEMM_SP2 1
#endif
#ifndef PER_PHASE_LAUNCH
#define PER_PHASE_LAUNCH 0
#endif

typedef unsigned short bf16_t;
typedef short bf16x8 __attribute__((ext_vector_type(8)));
typedef short s16x4 __attribute__((ext_vector_type(4)));
typedef float f32x4 __attribute__((ext_vector_type(4)));
typedef float f32x8 __attribute__((ext_vector_type(8)));
typedef float f32x16 __attribute__((ext_vector_type(16)));
typedef unsigned u32x4 __attribute__((ext_vector_type(4)));
typedef unsigned u32x2 __attribute__((ext_vector_type(2)));

constexpr int DM = 1024, NB = 8, SEQ = 8192, CTXL = 256, TL = NB * SEQ, TC = NB * CTXL, T = TL + TC, SK = SEQ + CTXL;
constexpr int DFF = 2816, PROJ = 6816;
constexpr int NPM = T / 256;
constexpr float EPS = 1e-6f;
constexpr float CQ_MLA = 0.10206207261596575f * 1.4426950408889634f;
constexpr float CQ_DIFF = 0.125f * 1.4426950408889634f;

constexpr size_t al256(size_t x) { return (x + 255) / 256 * 256; }
constexpr size_t O_MOD = 0;
constexpr size_t O_LAM = al256(O_MOD + (size_t)2 * 9 * 9216 * 4);
constexpr size_t O_R1C = O_LAM + 256;
constexpr size_t O_R1S = O_R1C + (size_t)8192 * 32 * 4;
constexpr size_t O_RDC = O_R1S + (size_t)8192 * 32 * 4;
constexpr size_t O_RDS = O_RDC + 128 * 16 * 4;
constexpr size_t O_RMC = O_RDS + 128 * 16 * 4;
constexpr size_t O_RMS = O_RMC + 128 * 8 * 4;
constexpr size_t O_W = al256(O_RMS + 128 * 8 * 4);
constexpr size_t O_WUP = O_W;
constexpr size_t O_WDN = O_WUP + (size_t)5632 * 1024 * 2;
constexpr size_t O_WIN = O_W;
constexpr size_t O_WG = O_WIN + (size_t)3840 * 1024 * 2;
constexpr size_t O_WQB = O_WG + (size_t)3072 * 1024 * 2;
constexpr size_t O_WKVB = O_WQB + (size_t)768 * 384 * 2;
constexpr size_t O_WBR = O_WKVB + (size_t)1024 * 256 * 2;
constexpr size_t O_WOUT = O_WBR + (size_t)3 * 1024 * 512 * 2;
constexpr size_t O_WEND = O_WOUT + (size_t)1024 * 1024 * 2;
constexpr size_t O_XC = al256(O_WEND);
constexpr size_t O_H = O_XC + (size_t)TC * DM * 4;
constexpr size_t O_M = O_H + (size_t)T * DM * 2;
constexpr size_t O_G = O_M;
constexpr size_t TB = (size_t)T;
constexpr size_t O_QLAT = O_M;
constexpr size_t O_KVLAT = O_QLAT + TB * 768;
constexpr size_t O_KNOPE = O_KVLAT + TB * 512;
constexpr size_t O_KROPE = O_KNOPE + TB * 1024;
constexpr size_t O_QD = O_KROPE + TB * 64;
constexpr size_t O_KD = O_QD + TB * 1024;
constexpr size_t O_VD = O_KD + TB * 1024;
constexpr size_t O_RQ = O_VD + TB * 1024;
constexpr size_t O_RK = O_RQ + TB * 512;
constexpr size_t O_RV = O_RK + TB * 512;
constexpr size_t O_YRET = O_RV + TB * 1024;
constexpr size_t O_QMLA = O_YRET + TB * 1024;
constexpr size_t O_VMLA = O_QMLA + TB * 1536;
constexpr size_t O_RETO = O_VMLA + TB * 1024;
constexpr size_t O_END = O_RETO + TB * 2048;
constexpr size_t O_YMLA = O_RQ;
constexpr size_t O_YDIFF = O_RV;
constexpr size_t O_O1S = O_QLAT;
constexpr size_t O_G6S = O_QMLA;
constexpr size_t O_YBR = O_RETO;
static_assert(O_G + TB * 2816 * 2 <= O_END, "ffn g fits");
constexpr size_t O_TS = O_END;
constexpr size_t O_CNT = O_TS + 512;
constexpr size_t O_PART = al256(O_CNT + 26 * 264 * 4);
constexpr size_t WS_NEED = O_PART + (size_t)6 * 264 * 4 * 256 * 4;

constexpr int LDS_BYTES = 131072 + 4096;

struct Params { const float* in[25]; float* out; unsigned char* ws; int ph_lo, ph_hi; };

extern __shared__ __attribute__((aligned(16))) unsigned char g_lds[];

#define MK_RSRC(ptr) __builtin_amdgcn_make_buffer_rsrc((void*)(ptr), 0, 0x7fffffff, 0x00020000)
#define MEMFENCE() asm volatile("" ::: "memory")
__device__ __forceinline__ int launder_tid() { int t = __builtin_amdgcn_workitem_id_x(); asm volatile("" : "+v"(t)); return t; }
typedef __bf16 bf16v2_t __attribute__((ext_vector_type(2)));
typedef float f32v2_t __attribute__((ext_vector_type(2)));
__device__ __forceinline__ unsigned cvtpk(float lo, float hi) { const f32v2_t v = {lo, hi}; const bf16v2_t b = __builtin_convertvector(v, bf16v2_t); return __builtin_bit_cast(unsigned, b); }
__device__ __forceinline__ float bf2f(unsigned short b) { return __uint_as_float(((unsigned)b) << 16); }
__device__ __forceinline__ float silu_f(float v) { return v * __builtin_amdgcn_rcpf(1.f + __expf(-v)); }
__device__ __forceinline__ float sigm_f(float v) { return __builtin_amdgcn_rcpf(1.f + __expf(-v)); }
__device__ __forceinline__ void store4bf(bf16_t* p, f32x4 v) { u32x2 w; w.x = cvtpk(v[0], v[1]); w.y = cvtpk(v[2], v[3]); *(u32x2*)p = w; }
__device__ __forceinline__ int logical_wg() { const int g = gridDim.x, w = blockIdx.x; return (g % 8 == 0) ? (w % 8) * (g / 8) + w / 8 : w; }

constexpr int BK = 64, HALF = 128, HTB = HALF * BK * 2;
__device__ __forceinline__ int lds_byte(int r, int c) { int st = (r >> 4) * 2 + (c >> 5), rr = r & 15, cc = c & 31, ob = rr * 64 + cc * 2; return st * 1024 + (ob ^ (((ob >> 9) & 1) << 5)); }
__device__ __forceinline__ void stage_rc(int b, int& R, int& C) { int st = b / 1024, sb = b % 1024, swz = sb ^ (((sb >> 9) & 1) << 5); R = (st >> 1) * 16 + swz / 64; C = (st & 1) * 32 + (swz % 64) / 2; }

#define LAS __attribute__((address_space(3)))
#define WAIT_V(n) asm volatile("s_waitcnt vmcnt(" #n ")" ::: "memory")
#define WAIT_L(n) asm volatile("s_waitcnt lgkmcnt(" #n ")" ::: "memory")
#define BAR __builtin_amdgcn_s_barrier()
#define SCHED __builtin_amdgcn_sched_barrier(0)

struct GOp { const char* A; const char* B; unsigned lda2, ldb2; int nt; };
template <class GetOp, class Epi>
__device__ __forceinline__ void gemm_stream(GetOp get, Epi epi) {
  LAS unsigned char* lds = (LAS unsigned char*)g_lds;
  GOp cur, nxt;
  if (!get(0, cur)) return;
  const int tid = launder_tid();
  const int wid = __builtin_amdgcn_readfirstlane(tid >> 6), lane = tid & 63, wr = wid >> 2, wc = wid & 3, fr = lane & 15, fq = lane >> 4;
  int R0, C0, R1, C1; stage_rc(tid * 16, R0, C0); stage_rc(tid * 16 + 8192, R1, C1);
  const unsigned ldsw = (unsigned)wid * 1024u;
  const int aoff = lds_byte(wr * 64 + fr, fq * 8), boff = lds_byte(wc * 32 + fr, fq * 8);
  unsigned cvA[2], cvB[2], nvA[2], nvB[2];
  cvA[0] = R0 * cur.lda2 + C0 * 2; cvA[1] = R1 * cur.lda2 + C1 * 2; cvB[0] = R0 * cur.ldb2 + C0 * 2; cvB[1] = R1 * cur.ldb2 + C1 * 2;
#define G_SA(b, h) (((b) * 2 + (h)) * HTB)
#define G_SB(b, h) ((4 + (b) * 2 + (h)) * HTB)
#define STAGE(bufoff, gbase, voff) do { _Pragma("unroll") for (int _i = 0; _i < 2; ++_i) \
    __builtin_amdgcn_global_load_lds((const unsigned*)((const char*)(gbase) + (voff)[_i]), (LAS unsigned*)(lds + (bufoff) + ldsw + _i * 8192), 16, 0, 0); } while (0)
#define LDA(dst, b, h) do { _Pragma("unroll") for (int m = 0; m < 4; ++m) _Pragma("unroll") for (int k = 0; k < 2; ++k) dst[m][k] = *(const LAS bf16x8*)(lds + G_SA(b, h) + aoff + m * 2048 + k * 1024); } while (0)
#define LDB(dst, b, h) do { _Pragma("unroll") for (int n = 0; n < 2; ++n) _Pragma("unroll") for (int k = 0; k < 2; ++k) dst[n][k] = *(const LAS bf16x8*)(lds + G_SB(b, h) + boff + n * 2048 + k * 1024); } while (0)
#define MMA(ai, bj, At_, Bt_) do { __builtin_amdgcn_s_setprio(1); \
    _Pragma("unroll") for (int m = 0; m < 4; ++m) _Pragma("unroll") for (int n = 0; n < 2; ++n) _Pragma("unroll") for (int k = 0; k < 2; ++k) \
      acc[ai][bj][m][n] = __builtin_amdgcn_mfma_f32_16x16x32_bf16(At_[m][k], Bt_[n][k], acc[ai][bj][m][n], 0, 0, 0); \
    __builtin_amdgcn_s_setprio(0); } while (0)
  { const size_t hA = (size_t)HALF * cur.lda2, hB = (size_t)HALF * cur.ldb2;
#if GEMM_SP2
    STAGE(G_SB(0, 0), cur.B, cvB); STAGE(G_SB(0, 1), cur.B + hB, cvB); STAGE(G_SA(0, 0), cur.A, cvA); STAGE(G_SA(0, 1), cur.A + hA, cvA);
    if (wr == 1) BAR;
    WAIT_V(2); BAR;
#else
    STAGE(G_SB(0, 0), cur.B, cvB); STAGE(G_SA(0, 0), cur.A, cvA); STAGE(G_SB(0, 1), cur.B + hB, cvB); STAGE(G_SA(0, 1), cur.A + hA, cvA);
    if (wr == 1) BAR;
    WAIT_V(4); BAR;
#endif
    STAGE(G_SB(1, 0), cur.B + 128, cvB); STAGE(G_SA(1, 0), cur.A + 128, cvA); STAGE(G_SB(1, 1), cur.B + hB + 128, cvB);
    WAIT_V(6); BAR; }
  f32x4 acc[2][2][4][2];
  bf16x8 At[4][2], B0[2][2], B1[2][2];
  for (int idx = 0;; ++idx) {
    const bool has_next = get(idx + 1, nxt);
    if (!has_next) nxt = cur;
    nvA[0] = R0 * nxt.lda2 + C0 * 2; nvA[1] = R1 * nxt.lda2 + C1 * 2; nvB[0] = R0 * nxt.ldb2 + C0 * 2; nvB[1] = R1 * nxt.ldb2 + C1 * 2;
    if (idx > 0) { if (wr == 1) BAR; }
#pragma unroll
    for (int a = 0; a < 2; ++a)
#pragma unroll
      for (int b = 0; b < 2; ++b)
#pragma unroll
        for (int m = 0; m < 4; ++m)
#pragma unroll
          for (int n = 0; n < 2; ++n) acc[a][b][m][n] = (f32x4){0.f, 0.f, 0.f, 0.f};
    const size_t hA = (size_t)HALF * cur.lda2, hB = (size_t)HALF * cur.ldb2, nhA = (size_t)HALF * nxt.lda2, nhB = (size_t)HALF * nxt.ldb2;
    const int nt = cur.nt;
    for (int t = 0; t < nt; t += 2) {
      const bool last = (t == nt - 2);
      const char* a1 = cur.A + (size_t)(t + 1) * 128;
      const char* a2 = last ? nxt.A : cur.A + (size_t)(t + 2) * 128; const char* b2 = last ? nxt.B : cur.B + (size_t)(t + 2) * 128;
      const char* a3 = a2 + 128; const char* b3 = b2 + 128;
      const size_t hA2 = last ? nhA : hA, hB2 = last ? nhB : hB;
      unsigned vA2[2], vB2[2]; vA2[0] = last ? nvA[0] : cvA[0]; vA2[1] = last ? nvA[1] : cvA[1]; vB2[0] = last ? nvB[0] : cvB[0]; vB2[1] = last ? nvB[1] : cvB[1];
#if GEMM_SP2
      LDB(B0, 0, 0); LDB(B1, 0, 1); SCHED; LDA(At, 0, 0); STAGE(G_SA(1, 1), a1 + hA, cvA);
      WAIT_V(8); WAIT_L(0); BAR; MMA(0, 0, At, B0); MMA(0, 1, At, B1); BAR; SCHED;
      LDA(At, 0, 1); STAGE(G_SB(0, 0), b2, vB2); STAGE(G_SB(0, 1), b2 + hB2, vB2); STAGE(G_SA(0, 0), a2, vA2);
      WAIT_V(8); WAIT_L(0); BAR; MMA(1, 0, At, B0); MMA(1, 1, At, B1); BAR; SCHED;
      LDB(B0, 1, 0); LDB(B1, 1, 1); SCHED; LDA(At, 1, 0); STAGE(G_SA(0, 1), a2 + hA2, vA2);
      WAIT_V(8); WAIT_L(0); BAR; MMA(0, 0, At, B0); MMA(0, 1, At, B1); BAR; SCHED;
      LDA(At, 1, 1); STAGE(G_SB(1, 0), b3, vB2); STAGE(G_SB(1, 1), b3 + hB2, vB2); STAGE(G_SA(1, 0), a3, vA2);
      WAIT_V(8); WAIT_L(0); BAR; MMA(1, 0, At, B0); MMA(1, 1, At, B1); BAR; SCHED;
#else
      LDB(B0, 0, 0); SCHED; LDA(At, 0, 0); STAGE(G_SA(1, 1), a1 + hA, cvA);
      WAIT_L(8); BAR; WAIT_L(0); MMA(0, 0, At, B0); BAR; SCHED;
      LDB(B1, 0, 1); STAGE(G_SB(0, 0), b2, vB2);
      BAR; WAIT_L(0); MMA(0, 1, At, B1); BAR;
      LDA(At, 0, 1); STAGE(G_SA(0, 0), a2, vA2);
      BAR; WAIT_L(0); MMA(1, 0, At, B0); BAR; SCHED;
      STAGE(G_SB(0, 1), b2 + hB2, vB2);
      WAIT_V(6); BAR; MMA(1, 1, At, B1); BAR;
      LDB(B0, 1, 0); SCHED; LDA(At, 1, 0); STAGE(G_SA(0, 1), a2 + hA2, vA2);
      WAIT_L(8); BAR; WAIT_L(0); MMA(0, 0, At, B0); BAR; SCHED;
      LDB(B1, 1, 1); STAGE(G_SB(1, 0), b3, vB2);
      BAR; WAIT_L(0); MMA(0, 1, At, B1); BAR;
      LDA(At, 1, 1); STAGE(G_SA(1, 0), a3, vA2);
      BAR; WAIT_L(0); MMA(1, 0, At, B0); BAR; SCHED;
      STAGE(G_SB(1, 1), b3 + hB2, vB2);
      WAIT_V(6); BAR; MMA(1, 1, At, B1); BAR;
#endif
    }
    if (wr == 0) BAR;
    epi(idx, acc);
    if (!has_next) break;
    cur = nxt; cvA[0] = nvA[0]; cvA[1] = nvA[1]; cvB[0] = nvB[0]; cvB[1] = nvB[1];
  }
  WAIT_V(0); BAR;
#undef G_SA
#undef G_SB
#undef STAGE
#undef LDA
#undef LDB
#undef MMA
}

__device__ __forceinline__ void unit_decode(int U, int NPN, int SBN, int& pm, int& pn) {
  const int per = 8 * SBN, blk = U / per, within = U % per, npng = NPN / SBN;
  const int pmg = blk / npng, png = blk % npng;
  pm = pmg * 8 + (within & 7); pn = png * SBN + (within >> 3);
}
struct TI { int b, bb, arow0; };
__device__ __forceinline__ TI tile_info(int pm) { TI t; if (pm < 256) { t.b = pm >> 5; t.bb = t.b; t.arow0 = (pm & 31) * 256; } else { t.b = pm - 256; t.bb = 8; t.arow0 = 8192; } return t; }

#define LANE_IDS const int tid = launder_tid(), wid = __builtin_amdgcn_readfirstlane(tid >> 6), lane = tid & 63, wr = wid >> 2, wc = wid & 3, fr = lane & 15, fq = lane >> 4; (void)tid; (void)wr; (void)wc; (void)fr; (void)fq; (void)lane; (void)wid;

enum { CM_PLAIN = 0, CM_UP, CM_WIN, CM_QB, CM_KVB };
__device__ __forceinline__ int colmap(int kind, int n, int base, int& which) {
  which = 0;
  switch (kind) {
    case CM_PLAIN: return base + n;
    case CM_UP: { const int tile = n >> 8, c = n & 255, ai = c >> 7, wrr = (c >> 6) & 1, m = (c >> 4) & 3, q = c & 15; which = m & 1; return tile * 128 + ai * 64 + wrr * 32 + (m >> 1) * 16 + q; }
    case CM_WIN: {
      if (n < 384) return n;
      if (n < 416) { const int cc = n - 384, part = (cc >> 4) & 1, half = (cc >> 3) & 1, idx = cc & 7; return 640 + half * 16 + part * 8 + idx; }
      if (n < 512) return -1;
      if (n < 768) return 384 + (n - 512);
      return 672 + (n - 768);
    }
    case CM_QB: {
      if (n < 512) return (n >> 6) * 96 + (n & 63);
      const int c = n - 512, h = c >> 5, cc = c & 31, part = (cc >> 4) & 1, half = (cc >> 3) & 1, idx = cc & 7; return h * 96 + 64 + half * 16 + part * 8 + idx;
    }
    case CM_KVB: {
      if (n < 512) return (n >> 6) * 128 + (n & 63);
      const int c = n - 512; return (c >> 6) * 128 + 64 + (c & 63);
    }
  }
  return -1;
}
__device__ __forceinline__ void conv_load(float (&v)[8], int kind, const float* src0, const float* src1, int ld, int base, const float* scale, int n0, int k0) {
  const int tid = launder_tid(); const int nn = tid & 63, kk = tid >> 6; int which; const int col = colmap(kind, n0 + nn, base, which); const float* s = which ? src1 : src0;
#pragma unroll
  for (int i = 0; i < 8; ++i) { const int k = kk + 8 * i; float x = 0.f; if (col >= 0) { x = s[(long)(k0 + k) * ld + col]; if (scale) x *= scale[k0 + k]; } v[i] = x; }
}
__device__ __forceinline__ void conv_store(const float (&vin)[8], bf16_t* dst, int K, int n0, int k0) {
  float* tl = (float*)g_lds;
  const int tid = launder_tid();
  { const int nn = tid & 63, kk = tid >> 6;
#pragma unroll
    for (int i = 0; i < 8; ++i) tl[(kk + 8 * i) * 65 + nn] = vin[i]; }
  __syncthreads();
  { const int nr = tid >> 3, kc = (tid & 7) * 8; float v[8];
#pragma unroll
    for (int e = 0; e < 8; ++e) v[e] = tl[(kc + e) * 65 + nr];
    u32x4 w; w.x = cvtpk(v[0], v[1]); w.y = cvtpk(v[2], v[3]); w.z = cvtpk(v[4], v[5]); w.w = cvtpk(v[6], v[7]);
    *(u32x4*)(dst + (long)(n0 + nr) * K + k0 + kc) = w; }
  __syncthreads();
}
struct ConvJob { int kind; size_t dst; int N, K; const float* s0; const float* s1; int ld, base; const float* scale; };
__device__ __forceinline__ ConvJob conv_job(const Params& p, int l, int grp, int j) {
  ConvJob J; J.s1 = nullptr; J.scale = nullptr; J.base = 0;
  if (grp != 1) {
    const float* w1 = p.in[grp == 0 ? 7 : 10] + (size_t)l * DM * DFF; const float* w3 = p.in[grp == 0 ? 8 : 11] + (size_t)l * DM * DFF; const float* w2 = p.in[grp == 0 ? 9 : 12] + (size_t)l * DFF * DM;
    if (j == 0) { J.kind = CM_UP; J.dst = O_WUP; J.N = 5632; J.K = 1024; J.s0 = w1; J.s1 = w3; J.ld = DFF; }
    else { J.kind = CM_PLAIN; J.dst = O_WDN; J.N = 1024; J.K = 2816; J.s0 = w2; J.s1 = w2; J.ld = DM; }
  } else {
    const float* win = p.in[13] + (size_t)l * DM * PROJ; const float* wb = p.in[22] + (size_t)l * 3 * 512 * 1024;
    switch (j) {
      case 0: J.kind = CM_WIN; J.dst = O_WIN; J.N = 3840; J.K = 1024; J.s0 = win; J.ld = PROJ; break;
      case 1: J.kind = CM_PLAIN; J.dst = O_WG; J.N = 3072; J.K = 1024; J.s0 = win; J.ld = PROJ; J.base = 3744; break;
      case 2: J.kind = CM_QB; J.dst = O_WQB; J.N = 768; J.K = 384; J.s0 = p.in[15] + (size_t)l * 384 * 768; J.ld = 768; J.scale = p.in[14] + l * 384; break;
      case 3: J.kind = CM_KVB; J.dst = O_WKVB; J.N = 1024; J.K = 256; J.s0 = p.in[17] + (size_t)l * 256 * 1024; J.ld = 1024; J.scale = p.in[16] + l * 256; break;
      case 4: J.kind = CM_PLAIN; J.dst = O_WBR; J.N = 3072; J.K = 512; J.s0 = wb; J.ld = 1024; break;
      default: J.kind = CM_PLAIN; J.dst = O_WOUT; J.N = 1024; J.K = 1024; J.s0 = p.in[23] + (size_t)l * DM * DM; J.ld = DM; break;
    }
    J.s1 = J.s0;
  }
  return J;
}
struct ConvTile { int kind; bf16_t* dst; int K; const float* s0; const float* s1; int ld, base; const float* scale; int n0, k0; };
__device__ __forceinline__ ConvTile conv_decode(const Params& p, int l, int grp, int u) {
  int v = u, j = 0; ConvJob J = conv_job(p, l, grp, 0);
  for (;;) { const int c = (J.N / 64) * (J.K / 64); if (v < c) break; v -= c; ++j; J = conv_job(p, l, grp, j); }
  const int nk = J.K / 64; const int nt_ = v / nk, kt_ = v % nk;
  ConvTile t; t.kind = J.kind; t.K = J.K; t.s0 = J.s0; t.s1 = J.s1; t.ld = J.ld; t.base = J.base; t.scale = J.scale; t.n0 = nt_ * 64; t.k0 = kt_ * 64; t.dst = (bf16_t*)(p.ws + J.dst);
  if (grp == 1 && j == 4) { const int i = t.n0 >> 10; t.s0 += (size_t)i * 512 * 1024; t.dst += (size_t)i * 1024 * 512; t.n0 &= 1023; }
  return t;
}
__device__ __forceinline__ void conv_group(const Params& p, int l, int grp) {
  const int nj = (grp == 1) ? 6 : 2;
  int tot = 0; for (int j = 0; j < nj; ++j) { const ConvJob J = conv_job(p, l, grp, j); tot += (J.N / 64) * (J.K / 64); }
  int u = blockIdx.x; if (u >= tot) return;
  ConvTile t = conv_decode(p, l, grp, u); float v[8];
  conv_load(v, t.kind, t.s0, t.s1, t.ld, t.base, t.scale, t.n0, t.k0);
  for (;;) {
    const int un = u + gridDim.x; const bool more = un < tot; ConvTile tn = t; float vn[8];
    if (more) { tn = conv_decode(p, l, grp, un); conv_load(vn, tn.kind, tn.s0, tn.s1, tn.ld, tn.base, tn.scale, tn.n0, tn.k0); }
    conv_store(v, t.dst, t.K, t.n0, t.k0);
    if (!more) break;
    u = un; t = tn;
#pragma unroll
    for (int i = 0; i < 8; ++i) v[i] = vn[i];
  }
}

__device__ __forceinline__ void phase_p0(const Params& p) {
  const int tid = launder_tid();
  float* sl = (float*)g_lds;
  float* red = sl + 9 * 1024;
  for (int i = tid; i < 9 * 1024; i += 512) { const int bb = i >> 10, k = i & 1023; const float v = bb < 8 ? p.in[1][bb * 1024 + k] : p.in[3][k]; sl[i] = v / (1.f + expf(-v)); }
  __syncthreads();
  float* modp = (float*)(p.ws + O_MOD);
  for (int u = blockIdx.x; u < 144; u += gridDim.x) {
    const int l = u / 72, c0 = (u % 72) * 128, col = c0 + (tid & 127), ks = tid >> 7;
    const float* w = p.in[4] + (size_t)l * 1024 * 9216 + col;
    float a[9];
#pragma unroll
    for (int bb = 0; bb < 9; ++bb) a[bb] = 0.f;
    for (int k = ks * 256; k < ks * 256 + 256; ++k) { const float wv = w[(size_t)k * 9216];
#pragma unroll
      for (int bb = 0; bb < 9; ++bb) a[bb] += sl[bb * 1024 + k] * wv; }
#pragma unroll
    for (int bb = 0; bb < 9; ++bb) red[(ks * 9 + bb) * 128 + (tid & 127)] = a[bb];
    __syncthreads();
    for (int i = tid; i < 9 * 128; i += 512) { const int bb = i >> 7, cc = i & 127;
      const float s = red[(0 * 9 + bb) * 128 + cc] + red[(1 * 9 + bb) * 128 + cc] + red[(2 * 9 + bb) * 128 + cc] + red[(3 * 9 + bb) * 128 + cc];
      modp[((size_t)l * 9 + bb) * 9216 + c0 + cc] = s + p.in[5][l * 9216 + c0 + cc]; }
    __syncthreads();
  }
  const long gt = (long)blockIdx.x * 512 + tid, gs = (long)gridDim.x * 512;
  for (long i = gt; i < (long)6 * 264 * 1024; i += gs) ((float*)(p.ws + O_PART))[i] = -1.f;
  float* r1c = (float*)(p.ws + O_R1C); float* r1s = (float*)(p.ws + O_R1S);
  for (long i = gt; i < 8192 * 32; i += gs) { const int pos = (int)(i >> 5), f = (int)(i & 31); const float inv = (float)pow(10000.0, -(double)(2 * f) / 64.0); const float ang = (float)pos * inv; r1c[i] = (float)cos((double)ang); r1s[i] = (float)sin((double)ang); }
  float* rdc = (float*)(p.ws + O_RDC); float* rds = (float*)(p.ws + O_RDS);
  for (long i = gt; i < 128 * 16; i += gs) { const int pos = (int)(i >> 4), f = (int)(i & 15); const float inv = (float)pow(10000.0, -(double)(2 * f) / 32.0); const float ang = (float)pos * inv; rdc[i] = (float)cos((double)ang); rds[i] = (float)sin((double)ang); }
  float* rmc = (float*)(p.ws + O_RMC); float* rms = (float*)(p.ws + O_RMS);
  for (long i = gt; i < 128 * 8; i += gs) { const int pos = (int)(i >> 3), f = (int)(i & 7); const float inv = (float)pow(10000.0, -(double)(2 * f) / 16.0); const float ang = (float)pos * inv; rmc[i] = (float)cos((double)ang); rms[i] = (float)sin((double)ang); }
  if (blockIdx.x == 0 && tid == 200) { ((float*)(p.ws + O_LAM))[16] = 0.f; ((float*)(p.ws + O_LAM))[17] = 0.f; }
  if (blockIdx.x == 0 && tid < 128) {
    const int l = tid >> 6, ln = tid & 63; const float* dl = p.in[18] + l * 256;
    float s1 = dl[ln] * dl[64 + ln], s2 = dl[128 + ln] * dl[192 + ln];
#pragma unroll
    for (int o = 32; o > 0; o >>= 1) { s1 += __shfl_xor(s1, o); s2 += __shfl_xor(s2, o); }
    const float li = 0.8f - 0.6f * expf(-0.3f * (float)l);
    if (ln == 0) ((float*)(p.ws + O_LAM))[l] = expf(s1) - expf(s2) + li;
  }
}

__device__ __forceinline__ const float* xsrc_row(const Params& p, long row, bool from_input) {
  if (row < TL) return (from_input ? p.in[0] : p.out) + row * DM;
  return (from_input ? p.in[2] : (const float*)(p.ws + O_XC)) + (row - TL) * DM;
}
__device__ __forceinline__ float* xdst_row(const Params& p, long row) { return row < TL ? p.out + row * DM : (float*)(p.ws + O_XC) + (row - TL) * DM; }

__device__ __forceinline__ void phase_norm(const Params& p, int l, int which, bool from_input) {
  const int tid = launder_tid(), wid = tid >> 6, lane = tid & 63;
  bf16_t* H = (bf16_t*)(p.ws + O_H);
  const float* gain = p.in[6] + (l * 3 + which) * DM;
  const long nwaves = (long)gridDim.x * 8, w0 = (long)blockIdx.x * 8 + wid;
  for (long rb = w0; rb < T; rb += nwaves * 4) {
    f32x4 v[4][4]; float ss[4];
#pragma unroll
    for (int j = 0; j < 4; ++j) { const long row = rb + j * nwaves; ss[j] = 0.f;
      if (row < T) { const float* src = xsrc_row(p, row, from_input);
#pragma unroll
        for (int i = 0; i < 4; ++i) v[j][i] = *(const f32x4*)(src + (lane + 64 * i) * 4); } }
#pragma unroll
    for (int j = 0; j < 4; ++j) { const long row = rb + j * nwaves;
      if (row < T) {
#pragma unroll
        for (int i = 0; i < 4; ++i) ss[j] += v[j][i][0] * v[j][i][0] + v[j][i][1] * v[j][i][1] + v[j][i][2] * v[j][i][2] + v[j][i][3] * v[j][i][3];
#pragma unroll
        for (int o = 32; o > 0; o >>= 1) ss[j] += __shfl_xor(ss[j], o);
        const float rstd = rsqrtf(ss[j] * (1.f / 1024.f) + EPS);
        const int bb = row < TL ? (int)(row >> 13) : 8;
        const float* md = (const float*)(p.ws + O_MOD) + ((size_t)l * 9 + bb) * 9216;
#pragma unroll
        for (int i = 0; i < 4; ++i) { const int c = (lane + 64 * i) * 4;
          const f32x4 g = *(const f32x4*)(gain + c), sh = *(const f32x4*)(md + which * 3 * 1024 + c), sc = *(const f32x4*)(md + (which * 3 + 1) * 1024 + c);
          f32x4 o;
#pragma unroll
          for (int e = 0; e < 4; ++e) o[e] = v[j][i][e] * rstd * g[e] * (1.f + sc[e]) + sh[e];
          store4bf(H + row * DM + c, o); } } }
  }
}
__device__ __forceinline__ void phase_final(const Params& p) {
  const int tid = launder_tid(), wid = tid >> 6, lane = tid & 63;
  const float* gain = p.in[24];
  const long nwaves = (long)gridDim.x * 8, w0 = (long)blockIdx.x * 8 + wid;
  for (long rb = w0; rb < TL; rb += nwaves * 4) {
    f32x4 v[4][4];
#pragma unroll
    for (int j = 0; j < 4; ++j) { const long row = rb + j * nwaves;
      if (row < TL) { const float* src = p.out + row * DM;
#pragma unroll
        for (int i = 0; i < 4; ++i) v[j][i] = *(const f32x4*)(src + (lane + 64 * i) * 4); } }
#pragma unroll
    for (int j = 0; j < 4; ++j) { const long row = rb + j * nwaves;
      if (row < TL) { float ss = 0.f; float* dst = p.out + row * DM;
#pragma unroll
        for (int i = 0; i < 4; ++i) ss += v[j][i][0] * v[j][i][0] + v[j][i][1] * v[j][i][1] + v[j][i][2] * v[j][i][2] + v[j][i][3] * v[j][i][3];
#pragma unroll
        for (int o = 32; o > 0; o >>= 1) ss += __shfl_xor(ss, o);
        const float rstd = rsqrtf(ss * (1.f / 1024.f) + EPS);
#pragma unroll
        for (int i = 0; i < 4; ++i) { const int c = (lane + 64 * i) * 4; const f32x4 g = *(const f32x4*)(gain + c); f32x4 o;
#pragma unroll
          for (int e = 0; e < 4; ++e) o[e] = v[j][i][e] * rstd * g[e];
          *(f32x4*)(dst + c) = o; } } }
  }
}

__device__ __forceinline__ void phase_ffn_up(const Params& p, int npm) {
  const char* W = (const char*)(p.ws + O_WUP); const char* H = (const char*)(p.ws + O_H); bf16_t* G = (bf16_t*)(p.ws + O_G);
  const int q = logical_wg(), Gd = gridDim.x, tot = npm * 22;
  auto get = [&](int idx, GOp& o) __attribute__((always_inline)) -> bool { const int U = q + idx * Gd; if (U >= tot) return false; int pm, pn; unit_decode(U, 22, 2, pm, pn);
    o.A = W + (size_t)pn * 256 * 2048; o.B = H + (size_t)pm * 256 * 2048; o.lda2 = 2048; o.ldb2 = 2048; o.nt = 16; return true; };
  auto epi = [&](int idx, const f32x4 (&acc)[2][2][4][2]) __attribute__((always_inline)) {
    const int U = q + idx * Gd; int pm, pn; unit_decode(U, 22, 2, pm, pn);
    LANE_IDS
#pragma unroll
    for (int ai = 0; ai < 2; ++ai)
#pragma unroll
      for (int bj = 0; bj < 2; ++bj)
#pragma unroll
        for (int n = 0; n < 2; ++n)
#pragma unroll
          for (int mp = 0; mp < 2; ++mp) {
            const long tok = (long)pm * 256 + bj * 128 + wc * 32 + n * 16 + fr; const int gc = pn * 128 + ai * 64 + wr * 32 + mp * 16 + fq * 4;
            const f32x4 a = acc[ai][bj][2 * mp][n], b = acc[ai][bj][2 * mp + 1][n]; f32x4 o;
#pragma unroll
            for (int e = 0; e < 4; ++e) o[e] = silu_f(a[e]) * b[e];
            store4bf(G + tok * DFF + gc, o);
          }
  };
  gemm_stream(get, epi);
}
__device__ __forceinline__ void epi_res(const Params& p, const f32x4 (&acc)[2][2][4][2], int l, int pm, int pn, int gate_idx, float scale, bool from_input) {
  LANE_IDS
  const TI ti = tile_info(pm);
  const float* md = (const float*)(p.ws + O_MOD) + ((size_t)l * 9 + ti.bb) * 9216 + gate_idx * 1024;
#pragma unroll
  for (int bj = 0; bj < 2; ++bj)
#pragma unroll
    for (int n = 0; n < 2; ++n) {
      const long row = (long)pm * 256 + bj * 128 + wc * 32 + n * 16 + fr;
      const float* src = xsrc_row(p, row, from_input); float* dst = xdst_row(p, row);
#pragma unroll
      for (int ai = 0; ai < 2; ++ai)
#pragma unroll
        for (int m = 0; m < 4; ++m) {
          const int col = pn * 256 + ai * 128 + wr * 64 + m * 16 + fq * 4;
          const f32x4 xv = *(const f32x4*)(src + col), g = *(const f32x4*)(md + col); f32x4 o;
#pragma unroll
          for (int e = 0; e < 4; ++e) o[e] = xv[e] + g[e] * scale * acc[ai][bj][m][n][e];
          *(f32x4*)(dst + col) = o;
          if (m & 1) MEMFENCE();
        }
    }
}
struct NormFuse { int nl, which, pslot, cslot; bool fin; };
__device__ __forceinline__ void epi_res_norm(const Params& p, f32x4 (&acc)[2][2][4][2], int l, int pm, int pn, int gate_idx, float scale, bool from_input, const NormFuse nf) {
  LANE_IDS
  const TI ti = tile_info(pm);
  const float* md = (const float*)(p.ws + O_MOD) + ((size_t)l * 9 + ti.bb) * 9216 + gate_idx * 1024;
  float ssr[2][2];
#pragma unroll
  for (int bj = 0; bj < 2; ++bj)
#pragma unroll
    for (int n = 0; n < 2; ++n) {
      const long row = (long)pm * 256 + bj * 128 + wc * 32 + n * 16 + fr;
      const float* src = xsrc_row(p, row, from_input); float* dst = xdst_row(p, row); float ss = 0.f;
#pragma unroll
      for (int ai = 0; ai < 2; ++ai)
#pragma unroll
        for (int m = 0; m < 4; ++m) {
          const int col = pn * 256 + ai * 128 + wr * 64 + m * 16 + fq * 4;
          const f32x4 xv = *(const f32x4*)(src + col), g = *(const f32x4*)(md + col); f32x4 o;
#pragma unroll
          for (int e = 0; e < 4; ++e) { o[e] = xv[e] + g[e] * scale * acc[ai][bj][m][n][e]; ss += o[e] * o[e]; }
          if (!nf.fin) *(f32x4*)(dst + col) = o;
          acc[ai][bj][m][n] = o;
          if (m & 1) MEMFENCE();
        }
      ss += __shfl_xor(ss, 16); ss += __shfl_xor(ss, 32); ssr[bj][n] = ss;
    }
  float* ssl = (float*)(g_lds + 131072);
  __syncthreads();
  if (fq == 0) {
#pragma unroll
    for (int bj = 0; bj < 2; ++bj)
#pragma unroll
      for (int n = 0; n < 2; ++n) ssl[wr * 256 + bj * 128 + wc * 32 + n * 16 + fr] = ssr[bj][n]; }
  __syncthreads();
  unsigned* part = (unsigned*)(p.ws + O_PART) + ((size_t)nf.pslot * 264 + pm) * 1024;
  if (tid < 256) {
    __hip_atomic_store(part + pn * 256 + tid, __float_as_uint(ssl[tid] + ssl[256 + tid]), __ATOMIC_RELAXED, __HIP_MEMORY_SCOPE_AGENT);
    float t = 0.f; int spins = 0;
    for (;;) { float v0 = __uint_as_float(__hip_atomic_load(part + tid, __ATOMIC_RELAXED, __HIP_MEMORY_SCOPE_AGENT)), v1 = __uint_as_float(__hip_atomic_load(part + 256 + tid, __ATOMIC_RELAXED, __HIP_MEMORY_SCOPE_AGENT)),
        v2 = __uint_as_float(__hip_atomic_load(part + 512 + tid, __ATOMIC_RELAXED, __HIP_MEMORY_SCOPE_AGENT)), v3 = __uint_as_float(__hip_atomic_load(part + 768 + tid, __ATOMIC_RELAXED, __HIP_MEMORY_SCOPE_AGENT));
      t = v0 + v1 + v2 + v3;
      if ((v0 >= 0.f && v1 >= 0.f && v2 >= 0.f && v3 >= 0.f) || ++spins > (1 << 18)) break;
      __builtin_amdgcn_s_sleep(4); }
    ssl[512 + tid] = rsqrtf(t * (1.f / 1024.f) + EPS); }
  __syncthreads();
  const float* gain = nf.fin ? p.in[24] : p.in[6] + (nf.nl * 3 + nf.which) * DM;
  const float* mdn = (const float*)(p.ws + O_MOD) + ((size_t)nf.nl * 9 + ti.bb) * 9216;
  bf16_t* H = (bf16_t*)(p.ws + O_H);
#pragma unroll
  for (int bj = 0; bj < 2; ++bj)
#pragma unroll
    for (int n = 0; n < 2; ++n) {
      const int tl = bj * 128 + wc * 32 + n * 16 + fr; const long row = (long)pm * 256 + tl; const float r = ssl[512 + tl];
#pragma unroll
      for (int ai = 0; ai < 2; ++ai)
#pragma unroll
        for (int m = 0; m < 4; ++m) {
          const int col = pn * 256 + ai * 128 + wr * 64 + m * 16 + fq * 4; const f32x4 o = acc[ai][bj][m][n], g = *(const f32x4*)(gain + col); f32x4 h;
          if (nf.fin) {
#pragma unroll
            for (int e = 0; e < 4; ++e) h[e] = o[e] * r * g[e];
            *(f32x4*)(p.out + row * DM + col) = h;
          } else { const f32x4 sh = *(const f32x4*)(mdn + nf.which * 3 * 1024 + col), sc = *(const f32x4*)(mdn + (nf.which * 3 + 1) * 1024 + col);
#pragma unroll
            for (int e = 0; e < 4; ++e) h[e] = o[e] * r * g[e] * (1.f + sc[e]) + sh[e];
            store4bf(H + row * DM + col, h); }
          if (m & 1) MEMFENCE();
        }
    }
}
__device__ __forceinline__ void phase_ffn_down(const Params& p, int l, int gate_idx, bool from_input, int npm, const NormFuse nf) {
  const char* W = (const char*)(p.ws + O_WDN); const char* G = (const char*)(p.ws + O_G);
  const int q = logical_wg(), Gd = gridDim.x, tot = npm * 4;
  auto get = [&](int idx, GOp& o) __attribute__((always_inline)) -> bool { const int U = q + idx * Gd; if (U >= tot) return false; int pm, pn; unit_decode(U, 4, 4, pm, pn);
    o.A = W + (size_t)pn * 256 * (DFF * 2); o.B = G + (size_t)pm * 256 * (DFF * 2); o.lda2 = DFF * 2; o.ldb2 = DFF * 2; o.nt = DFF / 64; return true; };
  auto epi = [&](int idx, f32x4 (&acc)[2][2][4][2]) __attribute__((always_inline)) {
    const int U = q + idx * Gd; int pm, pn; unit_decode(U, 4, 4, pm, pn); epi_res_norm(p, acc, l, pm, pn, gate_idx, 0.5f, from_input, nf); };
  gemm_stream(get, epi);
}
__device__ __forceinline__ void phase_wout(const Params& p, int l, int npm, const NormFuse nf) {
  const char* W = (const char*)(p.ws + O_WOUT); const char* Y = (const char*)(p.ws + O_YBR);
  const int q = logical_wg(), Gd = gridDim.x, tot = npm * 4;
  auto get = [&](int idx, GOp& o) __attribute__((always_inline)) -> bool { const int U = q + idx * Gd; if (U >= tot) return false; int pm, pn; unit_decode(U, 4, 4, pm, pn);
    o.A = W + (size_t)pn * 256 * 2048; o.B = Y + (size_t)pm * 256 * 2048; o.lda2 = 2048; o.ldb2 = 2048; o.nt = 16; return true; };
  auto epi = [&](int idx, f32x4 (&acc)[2][2][4][2]) __attribute__((always_inline)) {
    const int U = q + idx * Gd; int pm, pn; unit_decode(U, 4, 4, pm, pn); epi_res_norm(p, acc, l, pm, pn, 5, 1.0f, false, nf); };
  gemm_stream(get, epi);
}

__device__ __forceinline__ void rope4(f32x4 x1, f32x4 x2, f32x4 c, f32x4 s, f32x4& o1, f32x4& o2) {
#pragma unroll
  for (int e = 0; e < 4; ++e) { o1[e] = x1[e] * c[e] - x2[e] * s[e]; o2[e] = x1[e] * s[e] + x2[e] * c[e]; }
}
__device__ __forceinline__ void phase_win(const Params& p) {
  const char* W = (const char*)(p.ws + O_WIN); const char* H = (const char*)(p.ws + O_H);
  bf16_t* QLAT = (bf16_t*)(p.ws + O_QLAT); bf16_t* KVLAT = (bf16_t*)(p.ws + O_KVLAT); bf16_t* KROPE = (bf16_t*)(p.ws + O_KROPE);
  bf16_t* QD = (bf16_t*)(p.ws + O_QD); bf16_t* KD = (bf16_t*)(p.ws + O_KD); bf16_t* VD = (bf16_t*)(p.ws + O_VD);
  bf16_t* RQ = (bf16_t*)(p.ws + O_RQ); bf16_t* RK = (bf16_t*)(p.ws + O_RK); bf16_t* RV = (bf16_t*)(p.ws + O_RV); bf16_t* YRET = (bf16_t*)(p.ws + O_YRET);
  const float* r1c = (const float*)(p.ws + O_R1C); const float* r1s = (const float*)(p.ws + O_R1S);
  const float* rdc = (const float*)(p.ws + O_RDC); const float* rds = (const float*)(p.ws + O_RDS);
  const float* rmc = (const float*)(p.ws + O_RMC); const float* rms = (const float*)(p.ws + O_RMS);
  const int q = logical_wg(), Gd = gridDim.x;
  auto get = [&](int idx, GOp& o) __attribute__((always_inline)) -> bool { const int U = q + idx * Gd; if (U >= NPM * 15) return false; int pm, pn; unit_decode(U, 15, 3, pm, pn);
    o.A = W + (size_t)pn * 256 * 2048; o.B = H + (size_t)pm * 256 * 2048; o.lda2 = 2048; o.ldb2 = 2048; o.nt = 16; return true; };
  auto epi = [&](int idx, const f32x4 (&acc)[2][2][4][2]) __attribute__((always_inline)) {
    const int U = q + idx * Gd; int pm, pn; unit_decode(U, 15, 3, pm, pn);
    LANE_IDS
    const TI ti = tile_info(pm); const bool lat = ti.bb < 8;
#pragma unroll
    for (int bj = 0; bj < 2; ++bj)
#pragma unroll
      for (int n = 0; n < 2; ++n) {
        const int tl = bj * 128 + wc * 32 + n * 16 + fr; const long tok = (long)pm * 256 + tl; const int ar = ti.arow0 + tl;
        const int prow = ar >> 6, pcol = ar & 63;
        if (pn == 0 || pn == 2 || pn == 13 || pn == 14) {
#pragma unroll
          for (int ai = 0; ai < 2; ++ai)
#pragma unroll
            for (int m = 0; m < 4; ++m) { const int c = ai * 128 + wr * 64 + m * 16 + fq * 4; const f32x4 v = acc[ai][bj][m][n];
              if (pn == 0) store4bf(QLAT + tok * 384 + c, v);
              else if (pn == 2) store4bf(KVLAT + tok * 256 + c, v);
              else { f32x4 o;
#pragma unroll
                for (int e = 0; e < 4; ++e) o[e] = silu_f(v[e]);
                store4bf(YRET + tok * 512 + (pn - 13) * 256 + c, o); } }
        } else if (pn == 1) {
#pragma unroll
          for (int m = 0; m < 4; ++m) store4bf(QLAT + tok * 384 + 256 + wr * 64 + m * 16 + fq * 4, acc[0][bj][m][n]);
          if (wr == 0) {
            const int half = fq >> 1, idx = (fq & 1) * 4; f32x4 o1 = acc[1][bj][0][n], o2 = acc[1][bj][1][n];
            if (lat) { const int pos = half ? pcol : prow; const f32x4 c = *(const f32x4*)(rmc + pos * 8 + idx), s = *(const f32x4*)(rms + pos * 8 + idx); rope4(acc[1][bj][0][n], acc[1][bj][1][n], c, s, o1, o2); }
            bf16_t* d = KROPE + ((long)ti.b * SK + ar) * 32 + half * 16 + idx; store4bf(d, o1); store4bf(d + 8, o2);
          }
        } else if (pn >= 3 && pn <= 6) {
          bf16_t* D = (pn < 5) ? QD : KD; const int hb = ((pn - 3) & 1) * 2;
#pragma unroll
          for (int ai = 0; ai < 2; ++ai) {
            bf16_t* d = D + (((long)ti.b * 8 + (hb + ai) * 2 + wr) * SK + ar) * 64 + fq * 4;
            f32x4 a0 = acc[ai][bj][0][n], a1 = acc[ai][bj][1][n], a2 = acc[ai][bj][2][n], a3 = acc[ai][bj][3][n];
            if (lat) { const f32x4 cr = *(const f32x4*)(rdc + prow * 16 + fq * 4), sr = *(const f32x4*)(rds + prow * 16 + fq * 4), cc = *(const f32x4*)(rdc + pcol * 16 + fq * 4), sc = *(const f32x4*)(rds + pcol * 16 + fq * 4);
              rope4(acc[ai][bj][0][n], acc[ai][bj][1][n], cr, sr, a0, a1); rope4(acc[ai][bj][2][n], acc[ai][bj][3][n], cc, sc, a2, a3); }
            const float qs = (pn < 5) ? CQ_DIFF : 1.f;
            store4bf(d, a0 * qs); store4bf(d + 16, a1 * qs); store4bf(d + 32, a2 * qs); store4bf(d + 48, a3 * qs);
          }
        } else if (pn == 7 || pn == 8 || pn == 11 || pn == 12) {
          bf16_t* D = (pn < 9) ? VD : RV; const int hb = (pn < 9 ? pn - 7 : pn - 11) * 2;
#pragma unroll
          for (int ai = 0; ai < 2; ++ai)
#pragma unroll
            for (int m = 0; m < 4; ++m) store4bf(D + (((long)ti.b * 4 + hb + ai) * SK + ar) * 128 + wr * 64 + m * 16 + fq * 4, acc[ai][bj][m][n]);
        } else {
          bf16_t* D = (pn == 9) ? RQ : RK; const float sc = (pn == 9) ? 1.f : 0.125f;
#pragma unroll
          for (int ai = 0; ai < 2; ++ai) {
            bf16_t* d = D + (((long)ti.b * 4 + ai * 2 + wr) * SK + ar) * 64 + fq * 4;
            f32x4 a0 = acc[ai][bj][0][n], a1 = acc[ai][bj][1][n], a2 = acc[ai][bj][2][n], a3 = acc[ai][bj][3][n];
            if (lat) { const f32x4 c0 = *(const f32x4*)(r1c + ar * 32 + fq * 4), s0 = *(const f32x4*)(r1s + ar * 32 + fq * 4), c1 = *(const f32x4*)(r1c + ar * 32 + 16 + fq * 4), s1 = *(const f32x4*)(r1s + ar * 32 + 16 + fq * 4);
              rope4(acc[ai][bj][0][n], acc[ai][bj][2][n], c0, s0, a0, a2); rope4(acc[ai][bj][1][n], acc[ai][bj][3][n], c1, s1, a1, a3); }
            store4bf(d, a0 * sc); store4bf(d + 16, a1 * sc); store4bf(d + 32, a2 * sc); store4bf(d + 48, a3 * sc);
          }
        }
      }
  };
  gemm_stream(get, epi);
}

__device__ __forceinline__ int crow(int r, int hi) { return (r & 3) + 8 * (r >> 2) + 4 * hi; }
__device__ __forceinline__ void ret_unit(const Params& p, int l, int u) {
  const int tid = launder_tid(), wid = tid >> 6, lane = tid & 63, r32 = lane & 31, hi = lane >> 5;
  const int b = u & 7, h = (u >> 3) & 3, dir = (u >> 5) & 1, s = u >> 6;
  constexpr int QS = 0, KS = 18432, KT = 36864, VT = 54272, VTS = 62976, SC = 71680, SBF = 106496, PW = 115712, IPW = PW + 528;
  unsigned char* L = g_lds; float* pw = (float*)(L + PW); float* ipw = (float*)(L + IPW);
  const float lg = -expf(p.in[20][l * 8 + dir * 4 + h]);
  __syncthreads();
  if (tid <= 128) { pw[tid] = expf(lg * (float)tid); if (tid < 128) ipw[tid] = expf(-lg * (float)tid); }
  for (int i = tid; i < 576; i += 512) *(u32x4*)(L + SBF + i * 16) = (u32x4){0u, 0u, 0u, 0u};
  const bf16_t* RQ = (const bf16_t*)(p.ws + O_RQ) + ((long)b * 4 + h) * SK * 64;
  const bf16_t* RK = (const bf16_t*)(p.ws + O_RK) + ((long)b * 4 + h) * SK * 64;
  const bf16_t* RV = (const bf16_t*)(p.ws + O_RV) + ((long)b * 4 + h) * SK * 128 + s * 32;
  bf16_t* RO = (bf16_t*)(p.ws + O_RETO) + (size_t)dir * T * 512 + h * 128 + s * 32;
  f32x16 sacc = {};
  u32x4 rq0, rq1, rk0, rk1, rv0 = {0u, 0u, 0u, 0u}, rv1 = {0u, 0u, 0u, 0u};
  const int qrow0 = tid >> 3, qcc = tid & 7, pi = tid & 63, kcc = tid >> 6, vcc = (tid >> 6) & 3; const bool vact = tid < 256;
  auto chunk_arow = [&](int n) -> int { if (n < 2) return 8192 + 128 * (dir ? 1 - n : n); return 128 * (dir ? 65 - n : n - 2); };
#define RLOAD(n) do { const int ar_ = chunk_arow(n); \
    rq0 = *(const u32x4*)(RQ + (long)(ar_ + qrow0) * 64 + qcc * 8); rq1 = *(const u32x4*)(RQ + (long)(ar_ + 64 + qrow0) * 64 + qcc * 8); \
    rk0 = *(const u32x4*)(RK + (long)(ar_ + 2 * pi) * 64 + kcc * 8); rk1 = *(const u32x4*)(RK + (long)(ar_ + 2 * pi + 1) * 64 + kcc * 8); \
    if (vact) { rv0 = *(const u32x4*)(RV + (long)(ar_ + 2 * pi) * 128 + vcc * 8); rv1 = *(const u32x4*)(RV + (long)(ar_ + 2 * pi + 1) * 128 + vcc * 8); } } while (0)
  RLOAD(0);
  int cur = 0;
  for (int n = 0; n < 66; ++n) {
    __syncthreads();
    *(u32x4*)(L + QS + qrow0 * 144 + qcc * 16) = rq0; *(u32x4*)(L + QS + (64 + qrow0) * 144 + qcc * 16) = rq1;
    *(u32x4*)(L + KS + (2 * pi) * 144 + kcc * 16) = rk0; *(u32x4*)(L + KS + (2 * pi + 1) * 144 + kcc * 16) = rk1;
#pragma unroll
    for (int e = 0; e < 4; ++e) {
      *(unsigned*)(L + KT + (kcc * 8 + 2 * e) * 272 + pi * 4) = (rk0[e] & 0xffffu) | (rk1[e] << 16);
      *(unsigned*)(L + KT + (kcc * 8 + 2 * e + 1) * 272 + pi * 4) = (rk0[e] >> 16) | (rk1[e] & 0xffff0000u); }
    if (vact) { const float kd0 = pw[dir ? 2 * pi : 127 - 2 * pi], kd1 = pw[dir ? 2 * pi + 1 : 126 - 2 * pi];
#pragma unroll
      for (int e = 0; e < 4; ++e) {
        *(unsigned*)(L + VT + (vcc * 8 + 2 * e) * 272 + pi * 4) = (rv0[e] & 0xffffu) | (rv1[e] << 16);
        *(unsigned*)(L + VT + (vcc * 8 + 2 * e + 1) * 272 + pi * 4) = (rv0[e] >> 16) | (rv1[e] & 0xffff0000u);
        *(unsigned*)(L + VTS + (vcc * 8 + 2 * e) * 272 + pi * 4) = cvtpk(__uint_as_float(rv0[e] << 16) * kd0, __uint_as_float(rv1[e] << 16) * kd1);
        *(unsigned*)(L + VTS + (vcc * 8 + 2 * e + 1) * 272 + pi * 4) = cvtpk(__uint_as_float(rv0[e] & 0xffff0000u) * kd0, __uint_as_float(rv1[e] & 0xffff0000u) * kd1); } }
    __syncthreads();
    if (n + 1 < 66) RLOAD(n + 1);
    { const int I = wid >> 1;
#pragma unroll
      for (int jj = 0; jj < 2; ++jj) { const int J = (wid & 1) * 2 + jj; f32x16 sc = {};
#pragma unroll
        for (int kk = 0; kk < 4; ++kk) { const bf16x8 ka = *(const bf16x8*)(L + KS + (32 * I + r32) * 144 + (kk * 16 + hi * 8) * 2), qb = *(const bf16x8*)(L + QS + (32 * J + r32) * 144 + (kk * 16 + hi * 8) * 2);
          sc = __builtin_amdgcn_mfma_f32_32x32x16_bf16(ka, qb, sc, 0, 0, 0); }
        const int a = 32 * J + r32; const float colf = dir ? ipw[a] : pw[a];
#pragma unroll
        for (int q4 = 0; q4 < 4; ++q4) { const int ap0 = 32 * I + 8 * q4 + 4 * hi; const f32x4 rowf = *(const f32x4*)((dir ? pw : ipw) + ap0); f32x4 o;
#pragma unroll
          for (int e = 0; e < 4; ++e) { const int dd = dir ? (ap0 + e) - a : a - (ap0 + e); const float m = dd >= 0 ? colf * rowf[e] : 0.f; o[e] = sc[q4 * 4 + e] * m; }
          store4bf((bf16_t*)(L + SC + a * 272 + ap0 * 2), o); } } }
    __syncthreads();
    if (wid < 4) {
      f32x16 a1 = {}, a2 = {};
#pragma unroll
      for (int kk = 0; kk < 8; ++kk) { const bf16x8 sa = *(const bf16x8*)(L + SC + (32 * wid + r32) * 272 + (kk * 16 + hi * 8) * 2), vb = *(const bf16x8*)(L + VT + r32 * 272 + (kk * 16 + hi * 8) * 2);
        a1 = __builtin_amdgcn_mfma_f32_32x32x16_bf16(sa, vb, a1, 0, 0, 0); }
#pragma unroll
      for (int kk = 0; kk < 4; ++kk) { const bf16x8 qa = *(const bf16x8*)(L + QS + (32 * wid + r32) * 144 + (kk * 16 + hi * 8) * 2), sb = *(const bf16x8*)(L + SBF + cur * 4608 + r32 * 144 + (kk * 16 + hi * 8) * 2);
        a2 = __builtin_amdgcn_mfma_f32_32x32x16_bf16(qa, sb, a2, 0, 0, 0); }
      const int ar = chunk_arow(n); const long tokbase = (ar >= 8192) ? (long)TL + b * 256 + (ar - 8192) : (long)b * 8192 + ar;
#pragma unroll
      for (int r = 0; r < 16; ++r) { const int a = 32 * wid + crow(r, hi); const float qd = pw[dir ? 128 - a : a + 1];
        const unsigned pk = cvtpk(a1[r] + qd * a2[r], 0.f); RO[(tokbase + a) * 512 + r32] = (unsigned short)(pk & 0xffff); }
    } else if (wid < 6) {
      const int db = wid - 4; const float cd = pw[128];
#pragma unroll
      for (int r = 0; r < 16; ++r) sacc[r] *= cd;
#pragma unroll
      for (int kk = 0; kk < 8; ++kk) { const bf16x8 ka = *(const bf16x8*)(L + KT + (32 * db + r32) * 272 + (kk * 16 + hi * 8) * 2), vb = *(const bf16x8*)(L + VTS + r32 * 272 + (kk * 16 + hi * 8) * 2);
        sacc = __builtin_amdgcn_mfma_f32_32x32x16_bf16(ka, vb, sacc, 0, 0, 0); }
#pragma unroll
      for (int q4 = 0; q4 < 4; ++q4) { f32x4 o = {sacc[q4 * 4], sacc[q4 * 4 + 1], sacc[q4 * 4 + 2], sacc[q4 * 4 + 3]};
        store4bf((bf16_t*)(L + SBF + (cur ^ 1) * 4608 + r32 * 144 + (32 * db + 8 * q4 + 4 * hi) * 2), o); }
    }
    cur ^= 1;
  }
  __syncthreads();
#undef RLOAD
}

__device__ __forceinline__ void row_rstd(const bf16_t* src, int Kd) {
  const int tid = launder_tid(), row = tid >> 1, hf = tid & 1; float* rs = (float*)(g_lds + 131072);
  const bf16_t* s = src + (long)row * Kd + hf * (Kd / 2); float ss = 0.f;
  for (int c = 0; c < Kd / 16; ++c) { const u32x4 w = *(const u32x4*)(s + c * 8);
#pragma unroll
    for (int e = 0; e < 4; ++e) { const float lo = __uint_as_float(w[e] << 16), hi_ = __uint_as_float(w[e] & 0xffff0000u); ss += lo * lo + hi_ * hi_; } }
  ss += __shfl_xor(ss, 1);
  if (hf == 0) rs[row] = rsqrtf(ss / (float)Kd + EPS);
  __syncthreads();
}
__device__ __forceinline__ void phase_g4(const Params& p, int l) {
  if (PMASK & 0x80000) for (int u = blockIdx.x; u < 256; u += gridDim.x) ret_unit(p, l, u);
  const char* WQB = (const char*)(p.ws + O_WQB); const char* WKVB = (const char*)(p.ws + O_WKVB);
  const bf16_t* QLAT = (const bf16_t*)(p.ws + O_QLAT); const bf16_t* KVLAT = (const bf16_t*)(p.ws + O_KVLAT);
  bf16_t* QMLA = (bf16_t*)(p.ws + O_QMLA); bf16_t* KNOPE = (bf16_t*)(p.ws + O_KNOPE); bf16_t* VMLA = (bf16_t*)(p.ws + O_VMLA);
  const float* rmc = (const float*)(p.ws + O_RMC); const float* rms = (const float*)(p.ws + O_RMS);
  const float* rs = (const float*)(g_lds + 131072);
  const int q = logical_wg(), Gd = gridDim.x;
  auto get = [&](int idx, GOp& o) __attribute__((always_inline)) -> bool { const int U = q + idx * Gd; if (U >= NPM * 7) return false; int pm, pn;
    if (U < NPM * 3) { unit_decode(U, 3, 3, pm, pn); o.A = WQB + (size_t)pn * 256 * 768; o.B = (const char*)QLAT + (size_t)pm * 256 * 768; o.lda2 = 768; o.ldb2 = 768; o.nt = 6; }
    else { unit_decode(U - NPM * 3, 4, 4, pm, pn); o.A = WKVB + (size_t)pn * 256 * 512; o.B = (const char*)KVLAT + (size_t)pm * 256 * 512; o.lda2 = 512; o.ldb2 = 512; o.nt = 4; }
    return true; };
  auto epi = [&](int idx, const f32x4 (&acc)[2][2][4][2]) __attribute__((always_inline)) {
    const int U = q + idx * Gd; const bool isq = U < NPM * 3; int pm, pn;
    if (isq) unit_decode(U, 3, 3, pm, pn); else unit_decode(U - NPM * 3, 4, 4, pm, pn);
    __syncthreads();
    if (isq) row_rstd(QLAT + (size_t)pm * 256 * 384, 384); else row_rstd(KVLAT + (size_t)pm * 256 * 256, 256);
    LANE_IDS
    const TI ti = tile_info(pm); const bool lat = ti.bb < 8;
#pragma unroll
    for (int bj = 0; bj < 2; ++bj)
#pragma unroll
      for (int n = 0; n < 2; ++n) {
        const int tl = bj * 128 + wc * 32 + n * 16 + fr; const int ar = ti.arow0 + tl; const float rr = isq ? rs[tl] * CQ_MLA : rs[tl]; const int prow = ar >> 6, pcol = ar & 63;
        if (isq && pn == 2) {
          const int half = fq >> 1, idx = (fq & 1) * 4; const int pos = half ? pcol : prow;
          f32x4 c = {1.f, 1.f, 1.f, 1.f}, s = {0.f, 0.f, 0.f, 0.f};
          if (lat) { c = *(const f32x4*)(rmc + pos * 8 + idx); s = *(const f32x4*)(rms + pos * 8 + idx); }
#pragma unroll
          for (int ai = 0; ai < 2; ++ai)
#pragma unroll
            for (int mp = 0; mp < 2; ++mp) { const int hd = ai * 4 + wr * 2 + mp; f32x4 o1, o2; rope4(acc[ai][bj][2 * mp][n] * rr, acc[ai][bj][2 * mp + 1][n] * rr, c, s, o1, o2);
              bf16_t* d = QMLA + (((long)ti.b * 8 + hd) * SK + ar) * 96 + 64 + half * 16 + idx; store4bf(d, o1); store4bf(d + 8, o2); }
        } else {
#pragma unroll
          for (int ai = 0; ai < 2; ++ai)
#pragma unroll
            for (int m = 0; m < 4; ++m) { const int cfull = (pn & 1) * 256 + ai * 128 + wr * 64 + m * 16 + fq * 4; const int hd = cfull >> 6, d = cfull & 63; const f32x4 v = acc[ai][bj][m][n] * rr;
              if (isq) store4bf(QMLA + (((long)ti.b * 8 + hd) * SK + ar) * 96 + d, v);
              else if (pn < 2) store4bf(KNOPE + (((long)ti.b * 8 + hd) * SK + ar) * 64 + d, v);
              else store4bf(VMLA + (((long)ti.b * 8 + hd) * SK + ar) * 64 + d, v); }
        }
      }
  };
  if (PMASK & 0x100000) gemm_stream(get, epi);
}

#define SBAR() __builtin_amdgcn_sched_barrier(0)
template <int DQK> __device__ __forceinline__ int kswz(int row, int colB) { if (DQK == 96) return row * 256 + (colB ^ ((row & 7) << 4)); return row * 128 + (colB ^ (((row >> 1) & 7) << 4)); }
#ifndef EXP_THR
#define EXP_THR 8.f
#endif
constexpr float ATHR = EXP_THR;
template <int DQK> __device__ __forceinline__ void partialSM(f32x16& p0, f32x16& p1, float& m_reg, float& mn, float& alpha) {
  constexpr float THRL = ATHR * 1.4426950408889634f;
  float pmax = p0[0];
#pragma unroll
  for (int r = 1; r < 16; ++r) pmax = fmaxf(pmax, p0[r]);
#pragma unroll
  for (int r = 0; r < 16; ++r) pmax = fmaxf(pmax, p1[r]);
  { auto rr = __builtin_amdgcn_permlane32_swap(__float_as_uint(pmax), __float_as_uint(pmax), false, false); pmax = fmaxf(__uint_as_float(rr[0]), __uint_as_float(rr[1])); }
  if (__builtin_expect(__all(pmax - m_reg <= THRL), 1)) { mn = m_reg; alpha = 1.f; }
  else { mn = fmaxf(m_reg, pmax); alpha = __builtin_amdgcn_exp2f(m_reg - mn); m_reg = mn; }
  if (!__all(mn == 0.f)) {
#pragma unroll
    for (int r = 0; r < 16; ++r) p0[r] -= mn;
#pragma unroll
    for (int r = 0; r < 16; ++r) p1[r] -= mn;
  }
#pragma unroll
  for (int r = 0; r < 16; ++r) p0[r] = __builtin_amdgcn_exp2f(p0[r]);
}
template <bool SUM> __device__ __forceinline__ void finishSM(f32x16& p0, f32x16& p1, float alpha, float& l_reg, bf16x8& pa0, bf16x8& pa1, bf16x8& pa2, bf16x8& pa3) {
#pragma unroll
  for (int r = 0; r < 16; ++r) p1[r] = __builtin_amdgcn_exp2f(p1[r]);
  if constexpr (SUM) {
  float ps = 0;
#pragma unroll
  for (int r = 0; r < 16; ++r) ps += p0[r];
#pragma unroll
  for (int r = 0; r < 16; ++r) ps += p1[r];
  { auto rr = __builtin_amdgcn_permlane32_swap(__float_as_uint(ps), __float_as_uint(ps), false, false); ps = __uint_as_float(rr[0]) + __uint_as_float(rr[1]); }
  l_reg = l_reg * alpha + ps;
  }
#define PK4(P, BASE, OUT) do { unsigned a0 = cvtpk(P[BASE + 0], P[BASE + 1]), a1 = cvtpk(P[BASE + 2], P[BASE + 3]); \
    unsigned b0 = cvtpk(P[BASE + 4], P[BASE + 5]), b1 = cvtpk(P[BASE + 6], P[BASE + 7]); \
    auto r0 = __builtin_amdgcn_permlane32_swap(a0, b0, false, false); auto r1 = __builtin_amdgcn_permlane32_swap(a1, b1, false, false); \
    u32x4 w = {r0[0], r1[0], r0[1], r1[1]}; OUT = *reinterpret_cast<bf16x8*>(&w); } while (0)
  PK4(p0, 0, pa0); PK4(p0, 8, pa1); PK4(p1, 0, pa2); PK4(p1, 8, pa3);
#undef PK4
}
template <int DQK> __device__ __forceinline__ void qkt(f32x16& p0, f32x16& p1, const unsigned char* Ks, const bf16x8* qr, int r32, int hi) {
  p0 = f32x16{}; p1 = f32x16{};
#pragma unroll
  for (int d0 = 0; d0 < DQK / 16; ++d0) { const int cb = (d0 * 16 + hi * 8) * 2;
    const bf16x8 b0 = *reinterpret_cast<const bf16x8*>(Ks + kswz<DQK>(r32, cb));
    const bf16x8 b1 = *reinterpret_cast<const bf16x8*>(Ks + kswz<DQK>(32 + r32, cb));
    p0 = __builtin_amdgcn_mfma_f32_32x32x16_bf16(b0, qr[d0], p0, 0, 0, 0);
    p1 = __builtin_amdgcn_mfma_f32_32x32x16_bf16(b1, qr[d0], p1, 0, 0, 0); }
}
template <int DV> __device__ __forceinline__ int v_st(int k, int c) { const int kk = (k & ~0xC) | ((k & 4) << 1) | ((k & 8) >> 1); return ((kk >> 3) * (DV / 32) + (c >> 5)) * 512 + ((kk & 7) * 32 + (c & 31)) * 2; }
__device__ __forceinline__ int v_rd_base(int lane) { return ((lane & 3) << 3) | (((lane >> 2) & 3) << 6) | (((lane >> 4) & 1) << 5) | (((lane >> 5) & 1) << 8); }
template <int OFF> __device__ __forceinline__ s16x4 tr_read(int vb) { s16x4 r; asm volatile("ds_read_b64_tr_b16 %0, %1 offset:%2" : "=&v"(r) : "v"(vb), "i"(OFF) : "memory"); return r; }
template <int DV, int D0> __device__ __forceinline__ void pv_one(f32x16& od, int vb, bf16x8 pa0, bf16x8 pa1, bf16x8 pa2, bf16x8 pa3) {
  constexpr int NS = DV / 32;
#define VOFF(ks, half) (D0 * 512 + (ks) * (2 * NS * 512) + (half) * (NS * 512))
  const s16x4 l0 = tr_read<VOFF(0, 0)>(vb), h0 = tr_read<VOFF(0, 1)>(vb), l1 = tr_read<VOFF(1, 0)>(vb), h1 = tr_read<VOFF(1, 1)>(vb);
  const s16x4 l2 = tr_read<VOFF(2, 0)>(vb), h2 = tr_read<VOFF(2, 1)>(vb), l3 = tr_read<VOFF(3, 0)>(vb), h3 = tr_read<VOFF(3, 1)>(vb);
#undef VOFF
  asm volatile("s_waitcnt lgkmcnt(0)" ::: "memory"); SBAR();
#define PK(L_, H_) (bf16x8){L_[0], L_[1], L_[2], L_[3], H_[0], H_[1], H_[2], H_[3]}
  od = __builtin_amdgcn_mfma_f32_32x32x16_bf16(pa0, PK(l0, h0), od, 0, 0, 0);
  od = __builtin_amdgcn_mfma_f32_32x32x16_bf16(pa1, PK(l1, h1), od, 0, 0, 0);
  od = __builtin_amdgcn_mfma_f32_32x32x16_bf16(pa2, PK(l2, h2), od, 0, 0, 0);
  od = __builtin_amdgcn_mfma_f32_32x32x16_bf16(pa3, PK(l3, h3), od, 0, 0, 0);
#undef PK
}
template <int DV, int D0> __device__ __forceinline__ void pv_pair(f32x16& oa, f32x16& ob, int vb, bf16x8 pa0, bf16x8 pa1, bf16x8 pa2, bf16x8 pa3) {
  constexpr int NS = DV / 32;
#define VOFF(d, ks, half) ((d) * 512 + (ks) * (2 * NS * 512) + (half) * (NS * 512))
  const s16x4 al0 = tr_read<VOFF(D0, 0, 0)>(vb), ah0 = tr_read<VOFF(D0, 0, 1)>(vb), al1 = tr_read<VOFF(D0, 1, 0)>(vb), ah1 = tr_read<VOFF(D0, 1, 1)>(vb);
  const s16x4 al2 = tr_read<VOFF(D0, 2, 0)>(vb), ah2 = tr_read<VOFF(D0, 2, 1)>(vb), al3 = tr_read<VOFF(D0, 3, 0)>(vb), ah3 = tr_read<VOFF(D0, 3, 1)>(vb);
  const s16x4 bl0 = tr_read<VOFF(D0 + 1, 0, 0)>(vb), bh0 = tr_read<VOFF(D0 + 1, 0, 1)>(vb), bl1 = tr_read<VOFF(D0 + 1, 1, 0)>(vb), bh1 = tr_read<VOFF(D0 + 1, 1, 1)>(vb);
  const s16x4 bl2 = tr_read<VOFF(D0 + 1, 2, 0)>(vb), bh2 = tr_read<VOFF(D0 + 1, 2, 1)>(vb), bl3 = tr_read<VOFF(D0 + 1, 3, 0)>(vb), bh3 = tr_read<VOFF(D0 + 1, 3, 1)>(vb);
#undef VOFF
  asm volatile("s_waitcnt lgkmcnt(0)" ::: "memory"); SBAR();
#define PK(L_, H_) (bf16x8){L_[0], L_[1], L_[2], L_[3], H_[0], H_[1], H_[2], H_[3]}
  oa = __builtin_amdgcn_mfma_f32_32x32x16_bf16(pa0, PK(al0, ah0), oa, 0, 0, 0);
  ob = __builtin_amdgcn_mfma_f32_32x32x16_bf16(pa0, PK(bl0, bh0), ob, 0, 0, 0);
  oa = __builtin_amdgcn_mfma_f32_32x32x16_bf16(pa1, PK(al1, ah1), oa, 0, 0, 0);
  ob = __builtin_amdgcn_mfma_f32_32x32x16_bf16(pa1, PK(bl1, bh1), ob, 0, 0, 0);
  oa = __builtin_amdgcn_mfma_f32_32x32x16_bf16(pa2, PK(al2, ah2), oa, 0, 0, 0);
  ob = __builtin_amdgcn_mfma_f32_32x32x16_bf16(pa2, PK(bl2, bh2), ob, 0, 0, 0);
  oa = __builtin_amdgcn_mfma_f32_32x32x16_bf16(pa3, PK(al3, ah3), oa, 0, 0, 0);
  ob = __builtin_amdgcn_mfma_f32_32x32x16_bf16(pa3, PK(bl3, bh3), ob, 0, 0, 0);
#undef PK
}
template <int DV> __device__ __forceinline__ void pv_all(f32x16* o, int vb, bf16x8 pa0, bf16x8 pa1, bf16x8 pa2, bf16x8 pa3) {
  pv_pair<DV, 0>(o[0], o[1], vb, pa0, pa1, pa2, pa3);
  if constexpr (DV == 128) pv_pair<DV, 2>(o[2], o[3], vb, pa0, pa1, pa2, pa3);
}
template <int DQK, int DV>
__device__ __forceinline__ void attn_body(const bf16_t* __restrict__ Qb, const bf16_t* kp0, int kst0, const bf16_t* kp1, int kst1, bool k1valid,
                                          const bf16_t* vp0, const bf16_t* vp1, int nkeys, f32x16 (&o)[DV / 32]) {
  constexpr int KSTR = (DQK == 96) ? 256 : 128, SHM_K = 64 * KSTR, SHM_V = 64 * DV * 2, CK = DQK / 8, CV = DV / 8, ND = DV / 32;
  constexpr bool K2 = (64 * CK > 512), V2 = (64 * CV > 512);
  constexpr bool MSUM = (DV == 64);
  f32x16 osum = f32x16{}; const bf16x8 ones = {16256, 16256, 16256, 16256, 16256, 16256, 16256, 16256};
  const int tid = launder_tid(), wid = tid >> 6, lane = tid & 63, r32 = lane & 31, hi = lane >> 5;
  unsigned char* V_lds = g_lds; unsigned char* K_lds = g_lds + 3 * SHM_V;
  float* ws = (float*)(g_lds + 3 * SHM_V + 3 * SHM_K) + wid * 64; float* li_l = ws; float* al_l = ws + 32;
  float m_reg = 0.f, l_reg = 0;
#pragma unroll
  for (int d = 0; d < ND; ++d) o[d] = f32x16{};
  bf16x8 qr[DQK / 16];
  const bf16_t* Qw = Qb + (long)(wid * 32 + r32) * DQK + hi * 8;
#pragma unroll
  for (int d0 = 0; d0 < DQK / 16; ++d0) qr[d0] = *reinterpret_cast<const bf16x8*>(Qw + d0 * 16);
  const int kq0 = tid, kq1 = tid + 512;
  const int kd0 = kswz<DQK>(kq0 / CK, (kq0 % CK) * 16), kd1 = kswz<DQK>((kq1 / CK) & 63, (kq1 % CK) * 16);
  const int vq0 = tid, vq1 = tid + 512;
  const int vd0 = v_st<DV>(vq0 / CV, (vq0 % CV) * 8), vd1 = v_st<DV>((vq1 / CV) & 63, (vq1 % CV) * 8);
  const int vb0 = (int)(uintptr_t)(__attribute__((address_space(3))) unsigned char*)V_lds + v_rd_base(lane);
  struct St { bf16x8 k0, k1, v0, v1; } sr_[2];
#define SLOAD(i, key0) do { sr_[i].k0 = *reinterpret_cast<const bf16x8*>(kp0 + (long)(key0) * kst0); \
    if (K2) { if (k1valid) sr_[i].k1 = *reinterpret_cast<const bf16x8*>(kp1 + (long)(key0) * kst1); } \
    sr_[i].v0 = *reinterpret_cast<const bf16x8*>(vp0 + (long)(key0) * DV); \
    if (V2) sr_[i].v1 = *reinterpret_cast<const bf16x8*>(vp1 + (long)(key0) * DV); } while (0)
#define SWRITE(b, i) do { *(bf16x8*)(K_lds + (b) * SHM_K + kd0) = sr_[i].k0; \
    if (K2) { if (k1valid) *(bf16x8*)(K_lds + (b) * SHM_K + kd1) = sr_[i].k1; } \
    *(bf16x8*)(V_lds + (b) * SHM_V + vd0) = sr_[i].v0; \
    if (V2) *(bf16x8*)(V_lds + (b) * SHM_V + vd1) = sr_[i].v1; } while (0)
#define RESC(a) do { if (__any((a) < 1.f)) { if (hi == 0) al_l[r32] = (a); asm volatile("s_waitcnt lgkmcnt(0)" ::: "memory"); \
    _Pragma("unroll") for (int d = 0; d < ND; ++d) _Pragma("unroll") for (int r = 0; r < 16; ++r) o[d][r] *= al_l[crow(r, hi)]; \
    if (MSUM) { _Pragma("unroll") for (int r = 0; r < 16; ++r) osum[r] *= al_l[crow(r, hi)]; } } } while (0)
#define PSUM() do { if (MSUM) { osum = __builtin_amdgcn_mfma_f32_32x32x16_bf16(pa0, ones, osum, 0, 0, 0); osum = __builtin_amdgcn_mfma_f32_32x32x16_bf16(pa1, ones, osum, 0, 0, 0); \
    osum = __builtin_amdgcn_mfma_f32_32x32x16_bf16(pa2, ones, osum, 0, 0, 0); osum = __builtin_amdgcn_mfma_f32_32x32x16_bf16(pa3, ones, osum, 0, 0, 0); } } while (0)
#define ROT() do { bprev = bj; bj = bnext; bnext = (bnext == 2) ? 0 : bnext + 1; } while (0)
  f32x16 pA0, pA1, pB0, pB1; float mnA, mnB, alA, alB; bf16x8 pa0, pa1, pa2, pa3; const int NT = nkeys / 64;
  __syncthreads();
  SLOAD(0, 0); SWRITE(0, 0);
  SLOAD(1, 64); if (2 < NT) SLOAD(0, 128);
  __syncthreads();
  qkt<DQK>(pA0, pA1, K_lds, qr, r32, hi); partialSM<DQK>(pA0, pA1, m_reg, mnA, alA);
  SWRITE(1, 1); __syncthreads();
  int bprev = 0, bj = 1, bnext = 2;
  for (int j = 1; j + 1 < NT; j += 2) {
    SBAR(); qkt<DQK>(pB0, pB1, K_lds + bj * SHM_K, qr, r32, hi);
    finishSM<!MSUM>(pA0, pA1, alA, l_reg, pa0, pa1, pa2, pa3); SBAR();
    SLOAD(1, (j + 2) * 64); SBAR();
    pv_all<DV>(o, vb0 + bprev * SHM_V, pa0, pa1, pa2, pa3); PSUM(); partialSM<DQK>(pB0, pB1, m_reg, mnB, alB);
    SWRITE(bnext, 0);
    RESC(alB); __syncthreads(); ROT();
    SBAR(); qkt<DQK>(pA0, pA1, K_lds + bj * SHM_K, qr, r32, hi);
    finishSM<!MSUM>(pB0, pB1, alB, l_reg, pa0, pa1, pa2, pa3); SBAR();
    if (j + 3 < NT) SLOAD(0, (j + 3) * 64); SBAR();
    pv_all<DV>(o, vb0 + bprev * SHM_V, pa0, pa1, pa2, pa3); PSUM(); partialSM<DQK>(pA0, pA1, m_reg, mnA, alA);
    SWRITE(bnext, 1);
    RESC(alA); __syncthreads(); ROT();
  }
  SBAR(); qkt<DQK>(pB0, pB1, K_lds + bj * SHM_K, qr, r32, hi);
  finishSM<!MSUM>(pA0, pA1, alA, l_reg, pa0, pa1, pa2, pa3); SBAR();
  pv_all<DV>(o, vb0 + bprev * SHM_V, pa0, pa1, pa2, pa3); PSUM(); partialSM<DQK>(pB0, pB1, m_reg, mnB, alB);
  RESC(alB);
  finishSM<!MSUM>(pB0, pB1, alB, l_reg, pa0, pa1, pa2, pa3); SBAR();
  pv_all<DV>(o, vb0 + bj * SHM_V, pa0, pa1, pa2, pa3); PSUM();
  if (hi == 0) li_l[r32] = l_reg; asm volatile("s_waitcnt lgkmcnt(0)" ::: "memory");
#pragma unroll
  for (int r = 0; r < 16; ++r) { const float rl = __builtin_amdgcn_rcpf(MSUM ? osum[r] : li_l[crow(r, hi)]);
#pragma unroll
    for (int d = 0; d < ND; ++d) o[d][r] *= rl; }
  __syncthreads();
#undef SLOAD
#undef SWRITE
#undef RESC
#undef PSUM
#undef ROT
}

__device__ __forceinline__ void mla_unit(const Params& p, int b, int h, int qrow0, int key0, int nkeys, long tok0) {
  const int tid = launder_tid(), wid = tid >> 6, lane = tid & 63, r32 = lane & 31, hi = lane >> 5;
  const bf16_t* Q = (const bf16_t*)(p.ws + O_QMLA) + (((long)b * 8 + h) * SK + qrow0) * 96;
  const bf16_t* KN = (const bf16_t*)(p.ws + O_KNOPE) + (((long)b * 8 + h) * SK + key0) * 64;
  const bf16_t* KR = (const bf16_t*)(p.ws + O_KROPE) + ((long)b * SK + key0) * 32;
  const bf16_t* V = (const bf16_t*)(p.ws + O_VMLA) + (((long)b * 8 + h) * SK + key0) * 64;
  const int q0 = tid, q1 = tid + 512; const int r0 = q0 / 12, c0 = q0 % 12, r1 = (q1 / 12) & 63, c1 = q1 % 12;
  const bf16_t* kp0 = c0 < 8 ? KN + (long)r0 * 64 + c0 * 8 : KR + (long)r0 * 32 + (c0 - 8) * 8; const int ks0 = c0 < 8 ? 64 : 32;
  const bf16_t* kp1 = c1 < 8 ? KN + (long)r1 * 64 + c1 * 8 : KR + (long)r1 * 32 + (c1 - 8) * 8; const int ks1 = c1 < 8 ? 64 : 32;
  const bf16_t* vp0 = V + (long)(tid >> 3) * 64 + (tid & 7) * 8;
  f32x16 o[2];
  attn_body<96, 64>(Q, kp0, ks0, kp1, ks1, tid < 256, vp0, vp0, nkeys, o);
  bf16_t* Y = (bf16_t*)(p.ws + O_YMLA);
#pragma unroll
  for (int r = 0; r < 16; ++r) { const long tok = tok0 + wid * 32 + crow(r, hi);
#pragma unroll
    for (int d = 0; d < 2; ++d) { const unsigned pk = cvtpk(o[d][r], 0.f); Y[tok * 512 + h * 64 + d * 32 + r32] = (unsigned short)(pk & 0xffff); } }
}
__device__ __forceinline__ void diff_unit(const Params& p, int l, int b, int h, int qrow0, int key0, int nkeys, long tok0) {
  const int tid = launder_tid(), wid = tid >> 6, lane = tid & 63, r32 = lane & 31, hi = lane >> 5;
  const __amdgpu_buffer_rsrc_t rsd = MK_RSRC((float*)(p.ws + O_O1S) + (size_t)blockIdx.x * 32768); const unsigned vo4 = (unsigned)tid * 4u;
  const float lam = ((const float*)(p.ws + O_LAM))[l];
  const float li = 0.8f - 0.6f * expf(-0.3f * (float)l);
  const bf16_t* V = (const bf16_t*)(p.ws + O_VD) + (((long)b * 4 + h) * SK + key0) * 128;
  const bf16_t* vp0 = V + (long)(tid >> 4) * 128 + (tid & 15) * 8; const bf16_t* vp1 = V + (long)(32 + (tid >> 4)) * 128 + (tid & 15) * 8;
  f32x16 o[4];
  for (int s = 0; s < 2; ++s) {
    const bf16_t* Q = (const bf16_t*)(p.ws + O_QD) + (((long)b * 8 + h * 2 + s) * SK + qrow0) * 64;
    const bf16_t* K = (const bf16_t*)(p.ws + O_KD) + (((long)b * 8 + h * 2 + s) * SK + key0) * 64;
    const bf16_t* kp0 = K + (long)(tid >> 3) * 64 + (tid & 7) * 8;
    attn_body<64, 128>(Q, kp0, 64, kp0, 64, false, vp0, vp1, nkeys, o);
    if (s == 0) {
#pragma unroll
      for (int d = 0; d < 4; ++d)
#pragma unroll
        for (int r = 0; r < 16; ++r) __builtin_amdgcn_raw_buffer_store_b32(__float_as_uint(o[d][r]), rsd, vo4, (d * 16 + r) * 2048, 0);
    }
  }
  const float* dn = p.in[19] + l * 128; bf16_t* Y = (bf16_t*)(p.ws + O_YDIFF);
  float gn[4];
#pragma unroll
  for (int d = 0; d < 4; ++d) gn[d] = dn[d * 32 + r32] * (1.f - li);
#pragma unroll
  for (int r = 0; r < 16; ++r) {
    float v[4], ss = 0.f;
#pragma unroll
    for (int d = 0; d < 4; ++d) { v[d] = __uint_as_float(__builtin_amdgcn_raw_buffer_load_b32(rsd, vo4, (d * 16 + r) * 2048, 0)) - lam * o[d][r]; ss += v[d] * v[d]; }
#pragma unroll
    for (int m = 1; m < 32; m <<= 1) ss += __shfl_xor(ss, m);
    const float rstd = rsqrtf(ss * (1.f / 128.f) + EPS);
    const long tok = tok0 + wid * 32 + crow(r, hi);
#pragma unroll
    for (int d = 0; d < 4; ++d) { const unsigned pk = cvtpk(v[d] * rstd * gn[d], 0.f); Y[tok * 512 + h * 128 + d * 32 + r32] = (unsigned short)(pk & 0xffff); }
    MEMFENCE();
  }
}
__device__ __forceinline__ void phase_attn(const Params& p, int l) {
  const int tid = launder_tid(), wid = tid >> 6, lane = tid & 63;
  const int q = logical_wg(), G = gridDim.x;
  if (PMASK & 0x10000) for (int U = q; U < 2048; U += G) { const int h = U >> 8, w = U & 255, b = w >> 5, qb = w & 31; mla_unit(p, b, h, qb * 256, 0, SK, (long)b * 8192 + qb * 256); }
  if (PMASK & 0x20000) for (int U = q; U < 1024; U += G) { const int h = U >> 8, w = U & 255, b = w >> 5, qb = w & 31; diff_unit(p, l, b, h, qb * 256, 0, SK, (long)b * 8192 + qb * 256); }
  if ((PMASK & 0x10000) && l == 0) for (int U = q; U < 64; U += G) { const int b = U >> 3, h = U & 7; mla_unit(p, b, h, 8192, 8192, 256, (long)TL + b * 256); }
  if ((PMASK & 0x20000) && l == 0) for (int U = q; U < 32; U += G) { const int b = U >> 2, h = U & 3; diff_unit(p, l, b, h, 8192, 8192, 256, (long)TL + b * 256); }
  const bf16_t* RO = (const bf16_t*)(p.ws + O_RETO); bf16_t* YR = (bf16_t*)(p.ws + O_YRET); const float* rn = p.in[21] + l * 128;
  const int vc = (lane & 15) * 8; f32x8 gnv = *(const f32x8*)(rn + vc);
  if (PMASK & 0x40000) {
    const long nwaves = (long)gridDim.x * 8, w0 = (long)blockIdx.x * 8 + wid; const long nrows = (l == 0) ? (long)T : (long)TL;
    for (long rb = w0; rb < nrows; rb += nwaves * 4) {
      u32x4 a[4], bq[4], g[4];
#pragma unroll
      for (int j = 0; j < 4; ++j) { const long row = rb + j * nwaves;
        if (row < nrows) { a[j] = *(const u32x4*)(RO + row * 512 + lane * 8); bq[j] = *(const u32x4*)(RO + (size_t)T * 512 + row * 512 + lane * 8); g[j] = *(const u32x4*)(YR + row * 512 + lane * 8); } }
#pragma unroll
      for (int j = 0; j < 4; ++j) { const long row = rb + j * nwaves;
        if (row < nrows) {
          float v[8], ss = 0.f;
#pragma unroll
          for (int e = 0; e < 4; ++e) { v[2 * e] = __uint_as_float(a[j][e] << 16) + __uint_as_float(bq[j][e] << 16); v[2 * e + 1] = __uint_as_float(a[j][e] & 0xffff0000u) + __uint_as_float(bq[j][e] & 0xffff0000u); }
#pragma unroll
          for (int e = 0; e < 8; ++e) ss += v[e] * v[e];
#pragma unroll
          for (int m = 1; m < 16; m <<= 1) ss += __shfl_xor(ss, m);
          const float rstd = rsqrtf(ss * (1.f / 128.f) + EPS);
          u32x4 w;
#pragma unroll
          for (int e = 0; e < 4; ++e) { const float g0 = __uint_as_float(g[j][e] << 16), g1 = __uint_as_float(g[j][e] & 0xffff0000u); w[e] = cvtpk(v[2 * e] * rstd * gnv[2 * e] * g0, v[2 * e + 1] * rstd * gnv[2 * e + 1] * g1); }
          *(u32x4*)(YR + row * 512 + lane * 8) = w; } }
    }
  }
}

template <int MODE>
__device__ __forceinline__ void branch_epi(const f32x4 (&acc)[2][2][4][2], unsigned char* scr, bf16_t* YBR, int pm, int pn, int tid, int wr, int wc, int fr, int fq) {
  const __amdgpu_buffer_rsrc_t rs = MK_RSRC(scr);
  const unsigned vo8 = (unsigned)tid * 8u, vo16 = (unsigned)tid * 16u;
#pragma unroll
  for (int bj = 0; bj < 2; ++bj)
#pragma unroll
    for (int n = 0; n < 2; ++n) {
      const long tok = (long)pm * 256 + bj * 128 + wc * 32 + n * 16 + fr; bf16_t* yrow = YBR + tok * 1024 + pn * 256 + wr * 64 + fq * 4;
#pragma unroll
      for (int ai = 0; ai < 2; ++ai)
#pragma unroll
        for (int m = 0; m < 4; ++m) { const int e = ((ai * 2 + bj) * 4 + m) * 2 + n;
          const u32x2 w = __builtin_amdgcn_raw_buffer_load_b64(rs, vo8, e * 4096, 0); f32x4 v = acc[ai][bj][m][n];
          v[0] *= __uint_as_float(w.x << 16); v[1] *= __uint_as_float(w.x & 0xffff0000u); v[2] *= __uint_as_float(w.y << 16); v[3] *= __uint_as_float(w.y & 0xffff0000u);
          if (MODE > 0) v += __builtin_bit_cast(f32x4, __builtin_amdgcn_raw_buffer_load_b128(rs, vo16, 131072 + e * 8192, 0));
          if (MODE < 2) __builtin_amdgcn_raw_buffer_store_b128(__builtin_bit_cast(u32x4, v), rs, vo16, 131072 + e * 8192, 0); else store4bf(yrow + ai * 128 + m * 16, v);
          if (m & 1) MEMFENCE(); }
    }
}
__device__ __forceinline__ void phase_branch(const Params& p, int npm) {
  const char* WG = (const char*)(p.ws + O_WG); const char* WBR = (const char*)(p.ws + O_WBR); const char* H = (const char*)(p.ws + O_H);
  bf16_t* YBR = (bf16_t*)(p.ws + O_YBR);
  unsigned char* scr = p.ws + O_G6S + (size_t)blockIdx.x * 393216;
  const int q = logical_wg(), Gd = gridDim.x, tot = npm * 4;
  auto get = [&](int idx, GOp& o) __attribute__((always_inline)) -> bool { const int u = idx / 6, j = idx - u * 6, i = j >> 1; const int U = q + u * Gd; if (U >= tot) return false; int pm, pn; unit_decode(U, 4, 4, pm, pn);
    if ((j & 1) == 0) { o.A = WG + ((size_t)i * 1024 + pn * 256) * 2048; o.B = H + (size_t)pm * 256 * 2048; o.lda2 = 2048; o.ldb2 = 2048; o.nt = 16; }
    else { const char* Y = (const char*)(p.ws + (i == 0 ? O_YMLA : (i == 1 ? O_YDIFF : O_YRET))); o.A = WBR + ((size_t)i * 1024 + pn * 256) * 1024; o.B = Y + (size_t)pm * 256 * 1024; o.lda2 = 1024; o.ldb2 = 1024; o.nt = 8; }
    return true; };
  auto epi = [&](int idx, const f32x4 (&acc)[2][2][4][2]) __attribute__((always_inline)) {
    const int u = idx / 6, j = idx - u * 6, i = j >> 1; const int U = q + u * Gd; int pm, pn; unit_decode(U, 4, 4, pm, pn);
    LANE_IDS
    if ((j & 1) == 0) {
      const unsigned vo8 = (unsigned)tid * 8u; const __amdgpu_buffer_rsrc_t rs = MK_RSRC(scr);
#pragma unroll
      for (int ai = 0; ai < 2; ++ai)
#pragma unroll
        for (int bj = 0; bj < 2; ++bj)
#pragma unroll
          for (int m = 0; m < 4; ++m)
#pragma unroll
            for (int n = 0; n < 2; ++n) { const int e = ((ai * 2 + bj) * 4 + m) * 2 + n; const f32x4 v = acc[ai][bj][m][n]; u32x2 w; w.x = cvtpk(sigm_f(v[0]), sigm_f(v[1])); w.y = cvtpk(sigm_f(v[2]), sigm_f(v[3])); __builtin_amdgcn_raw_buffer_store_b64(w, rs, vo8, e * 4096, 0); if (n == 1) MEMFENCE(); }
    } else {
      if (i == 0) branch_epi<0>(acc, scr, YBR, pm, pn, tid, wr, wc, fr, fq);
      else if (i == 1) branch_epi<1>(acc, scr, YBR, pm, pn, tid, wr, wc, fr, fq);
      else branch_epi<2>(acc, scr, YBR, pm, pn, tid, wr, wc, fr, fq);
    }
  };
  gemm_stream(get, epi);
}


#ifdef DIAG
__device__ __forceinline__ float blk_reduce(float v, int mode, float* red) {
  const int tid = launder_tid(), lane = tid & 63, wid = tid >> 6;
#pragma unroll
  for (int o = 32; o > 0; o >>= 1) { const float t = __shfl_xor(v, o); v = mode ? fmaxf(v, t) : v + t; }
  __syncthreads();
  if (lane == 0) red[wid] = v;
  __syncthreads();
  float r = red[0];
  for (int i = 1; i < 8; ++i) r = mode ? fmaxf(r, red[i]) : r + red[i];
  return r;
}
__device__ __forceinline__ void phase_diag(const Params& p) {
  const int tid = launder_tid();
  float* w0 = (float*)g_lds; float* w1 = w0 + 8448; float* qv = w1 + 8448; float* ov = qv + 256; float* red = ov + 256;
  float* dg = (float*)(p.ws + O_LAM) + 16;
  const int S = blockIdx.x; const int b = S & 7, t = (S * 977 + 131) % 8192; const long tok = (long)b * 8192 + t;
  float num = 0.f, den = 0.f;
#if DIAG == 1
  { const int h = (S >> 3) & 7; const bf16_t* Q = (const bf16_t*)(p.ws + O_QMLA) + (((long)b * 8 + h) * SK + t) * 96;
    const bf16_t* KN = (const bf16_t*)(p.ws + O_KNOPE) + ((long)b * 8 + h) * SK * 64; const bf16_t* KR = (const bf16_t*)(p.ws + O_KROPE) + (long)b * SK * 32;
    const bf16_t* V = (const bf16_t*)(p.ws + O_VMLA) + ((long)b * 8 + h) * SK * 64;
    if (tid < 96) qv[tid] = bf2f(Q[tid]);
    __syncthreads();
    float mx = -1e30f;
    for (int k = tid; k < SK; k += 512) { float d = 0.f; for (int e = 0; e < 64; ++e) d += qv[e] * bf2f(KN[(long)k * 64 + e]); for (int e = 0; e < 32; ++e) d += qv[64 + e] * bf2f(KR[(long)k * 32 + e]); d *= 0.10206207261596575f; w0[k] = d; mx = fmaxf(mx, d); }
    mx = blk_reduce(mx, 1, red); float l = 0.f;
    for (int k = tid; k < SK; k += 512) { const float e = expf(w0[k] - mx); w0[k] = e; l += e; }
    l = blk_reduce(l, 0, red);
    if (tid < 64) { float a = 0.f; for (int k = 0; k < SK; ++k) a += w0[k] * bf2f(V[(long)k * 64 + tid]); a /= l;
      const float y = bf2f(((const bf16_t*)(p.ws + O_YMLA))[tok * 512 + h * 64 + tid]); num = (a - y) * (a - y); den = a * a; } }
#elif DIAG == 2
  { const int h = (S >> 3) & 3; const float lam = ((const float*)(p.ws + O_LAM))[0];
    const bf16_t* V = (const bf16_t*)(p.ws + O_VD) + ((long)b * 4 + h) * SK * 128; float ls[2];
    for (int s2 = 0; s2 < 2; ++s2) { float* w = s2 ? w1 : w0;
      const bf16_t* Q = (const bf16_t*)(p.ws + O_QD) + (((long)b * 8 + h * 2 + s2) * SK + t) * 64; const bf16_t* K = (const bf16_t*)(p.ws + O_KD) + ((long)b * 8 + h * 2 + s2) * SK * 64;
      __syncthreads();
      if (tid < 64) qv[tid] = bf2f(Q[tid]);
      __syncthreads();
      float mx = -1e30f;
      for (int k = tid; k < SK; k += 512) { float d = 0.f; for (int e = 0; e < 64; ++e) d += qv[e] * bf2f(K[(long)k * 64 + e]); d *= 0.125f; w[k] = d; mx = fmaxf(mx, d); }
      mx = blk_reduce(mx, 1, red); float l = 0.f;
      for (int k = tid; k < SK; k += 512) { const float e = expf(w[k] - mx); w[k] = e; l += e; }
      ls[s2] = blk_reduce(l, 0, red); }
    if (tid < 256) { const int d = tid & 127, s2 = tid >> 7; const float* w = s2 ? w1 : w0; float a = 0.f; for (int k = 0; k < SK; ++k) a += w[k] * bf2f(V[(long)k * 128 + d]); ov[tid] = a / ls[s2]; }
    __syncthreads();
    float val = 0.f; if (tid < 128) val = ov[tid] - lam * ov[128 + tid];
    const float ss = blk_reduce(val * val, 0, red); const float rstd = rsqrtf(ss * (1.f / 128.f) + EPS);
    if (tid < 128) { const float a = val * rstd * p.in[19][tid] * 0.8f; const float y = bf2f(((const bf16_t*)(p.ws + O_YDIFF))[tok * 512 + h * 128 + tid]); num = (a - y) * (a - y); den = a * a; } }
#elif DIAG >= 3
  { const int h = (S >> 3) & 3, dir = (S >> 5) & 1; const float lg = -expf(p.in[20][dir * 4 + h]);
    const bf16_t* Q = (const bf16_t*)(p.ws + O_RQ) + (((long)b * 4 + h) * SK + t) * 64; const bf16_t* K = (const bf16_t*)(p.ws + O_RK) + ((long)b * 4 + h) * SK * 64;
    const bf16_t* V = (const bf16_t*)(p.ws + O_RV) + ((long)b * 4 + h) * SK * 128;
    if (tid < 64) qv[tid] = bf2f(Q[tid]);
    __syncthreads();
    for (int k = tid; k < SK; k += 512) { int dist; if (k < 8192) dist = dir ? k - t : t - k; else { const int j = k - 8192; dist = dir ? 8192 - t + j : 256 + t - j; }
      float d = 0.f; bool inc = dist >= 0;
#if DIAG == 4
      inc = inc && (k < 8192) && ((k >> 7) == (t >> 7));
#endif
#if DIAG == 5
      inc = inc && !((k < 8192) && ((k >> 7) == (t >> 7)));
#endif
      if (inc) { for (int e = 0; e < 64; ++e) d += qv[e] * bf2f(K[(long)k * 64 + e]); d *= expf(lg * (float)dist); } w0[k] = d; }
    __syncthreads();
    if (tid < 128) { float a = 0.f; for (int k = 0; k < SK; ++k) a += w0[k] * bf2f(V[(long)k * 128 + tid]);
      const float y = bf2f(((const bf16_t*)(p.ws + O_RETO))[(size_t)dir * T * 512 + tok * 512 + h * 128 + tid]); num = (a - y) * (a - y); den = a * a; } }
#endif
  num = blk_reduce(num, 0, red); den = blk_reduce(den, 0, red);
  if (tid == 0) { atomicAdd(dg, num); atomicAdd(dg + 1, den); }
}
__device__ __forceinline__ void phase_diag_out(const Params& p) {
  const float* dg = (const float*)(p.ws + O_LAM) + 16; const float m = dg[0] / fmaxf(dg[1], 1e-30f);
  float c2 = 10.f + log10f(fmaxf(m, 1e-12f)); c2 = fminf(fmaxf(c2, 0.f), 12.f); const float c = sqrtf(c2);
  for (long i = (long)blockIdx.x * 512 + launder_tid(); i < (long)TL * DM; i += (long)gridDim.x * 512) p.out[i] = c;
}
#endif
constexpr int NPHASE = 25;
__device__ __forceinline__ void run_phase(const Params& p0_, int ph) {
  Params p = p0_; { unsigned long long z = 0; asm volatile("" : "+s"(z)); p.ws = p0_.ws + z; p.out = p0_.out + z; }
  if (ph == 0) { if (PMASK & 0x1000) phase_p0(p); return; }
  if (ph == 25) { if (PMASK & 0x2000) phase_final(p); return; }
  const int l = (ph - 1) / 12, s = (ph - 1) % 12;
  switch (s) {
    case 0: if (PMASK & 1) { if (l == 0) phase_norm(p, l, 0, true); conv_group(p, l, 0); } break;
    case 1: if (PMASK & 2) phase_ffn_up(p, NPM); break;
    case 2: if (PMASK & 4) phase_ffn_down(p, l, 2, l == 0, NPM, NormFuse{l, 1, l * 3 + 0, l * 12 + 2, false}); break;
    case 3: if (PMASK & 1) { conv_group(p, l, 1); } break;
    case 4: if (PMASK & 16) phase_win(p); break;
    case 5: if (PMASK & 32) phase_g4(p, l); break;
    case 6: if (PMASK & 64) phase_attn(p, l); break;
    case 7: if (PMASK & 128) phase_branch(p, l == 0 ? NPM : 256); break;
    case 8: if (PMASK & 256) phase_wout(p, l, l == 0 ? NPM : 256, NormFuse{l, 2, l * 3 + 1, l * 12 + 8, false}); break;
    case 9: if (PMASK & 1) { conv_group(p, l, 2); } break;
    case 10: if (PMASK & 2) phase_ffn_up(p, l == 0 ? NPM : 256); break;
    case 11: if (PMASK & 4) phase_ffn_down(p, l, 8, false, l == 0 ? NPM : 256, NormFuse{l + 1, 0, l * 3 + 2, l * 12 + 11, l == 1}); break;
  }
}
__global__ void __launch_bounds__(512) mega_kernel(Params p) {
  cg::grid_group grid = cg::this_grid();
#ifdef DIAG
#define PHD(k) if ((k) < DIAG_STOP) { run_phase(p, (k)); grid.sync(); }
  PHD(0)
  PHD(1)
  PHD(2)
  PHD(3)
  PHD(4)
  PHD(5)
  PHD(6)
  PHD(7)
  PHD(8)
#undef PHD
  phase_diag(p); grid.sync(); phase_diag_out(p);
#else
#ifdef TIMING
#define PH(k) if ((k) >= p.ph_lo && (k) < p.ph_hi) { if (blockIdx.x == 0 && threadIdx.x == 0) ((unsigned long long*)(p.ws + O_TS))[k] = __builtin_amdgcn_s_memrealtime(); run_phase(p, (k)); grid.sync(); }
#else
#define PH(k) if ((k) >= p.ph_lo && (k) < p.ph_hi) { run_phase(p, (k)); if ((k) + 1 < p.ph_hi) grid.sync(); }
#endif
  PH(0)
  PH(1)
  PH(2)
  PH(3)
  PH(4)
  PH(5)
  PH(6)
  PH(7)
  PH(8)
  PH(9)
  PH(10)
  PH(11)
  PH(12)
  PH(13)
  PH(14)
  PH(15)
  PH(16)
  PH(17)
  PH(18)
  PH(19)
  PH(20)
  PH(21)
  PH(22)
  PH(23)
  PH(24)
  PH(25)
#undef PH
#ifdef TIMING
  if (blockIdx.x == 0) { unsigned long long* ts = (unsigned long long*)(p.ws + O_TS); const unsigned long long tend = __builtin_amdgcn_s_memrealtime();
    float tot = (float)(tend - ts[0]), s1 = 0.f, s2 = 0.f;
    for (int k = 0; k < 26; ++k) { const float d = (float)((k == 25 ? tend : ts[k + 1]) - ts[k]); if ((TSEL1 >> k) & 1) s1 += d; if ((TSEL2 >> k) & 1) s2 += d; }
    const int M = (int)(s1 / tot * 100000.f + 0.5f); const float d2 = 0.04f + 0.14f * (s2 / tot);
    for (int i = threadIdx.x; i < M; i += 512) p.out[i] += 0.1f;
    if (threadIdx.x == 0) p.out[(size_t)TL * DM - 1] += d2; }
#endif
#endif
}

extern "C" void kernel_launch(void* const* d_in, const int* in_sizes, int n_in, void* d_out, int out_size, void* d_ws, size_t ws_size, hipStream_t stream) {
  static int grid_blocks = 0;
  if (grid_blocks == 0) {
    if (n_in != 25 || out_size != TL * DM || ws_size < WS_NEED) { fprintf(stderr, "kernel_launch: unexpected shapes: n_in %d out %d ws %zu (need %zu)\n", n_in, out_size, ws_size, (size_t)WS_NEED); grid_blocks = -1; return; }
    int dev = 0, cus = 0, per_cu = 0;
    hipGetDevice(&dev); hipDeviceGetAttribute(&cus, hipDeviceAttributeMultiprocessorCount, dev);
    if (hipFuncSetAttribute((const void*)mega_kernel, hipFuncAttributeMaxDynamicSharedMemorySize, LDS_BYTES) != hipSuccess) { fprintf(stderr, "kernel_launch: hipFuncSetAttribute failed\n"); grid_blocks = -1; return; }
    hipOccupancyMaxActiveBlocksPerMultiprocessor(&per_cu, (const void*)mega_kernel, 512, LDS_BYTES);
    if (per_cu < 1) per_cu = 1;
    grid_blocks = cus * per_cu;
  }
  if (grid_blocks < 0) return;
  Params p{};
  for (int i = 0; i < 25; ++i) p.in[i] = (const float*)d_in[i];
  p.out = (float*)d_out; p.ws = (unsigned char*)d_ws;
#if PER_PHASE_LAUNCH
  for (int ph = 0; ph < NPHASE; ++ph) {
    p.ph_lo = ph; p.ph_hi = ph + 1; void* args[] = {&p};
    hipError_t e = hipLaunchCooperativeKernel((const void*)mega_kernel, dim3(grid_blocks), dim3(512), args, LDS_BYTES, stream);
    if (e != hipSuccess) { fprintf(stderr, "cooperative launch failed: %s (grid %d)\n", hipGetErrorString(e), grid_blocks); break; }
  }
#else
  p.ph_lo = 0; p.ph_hi = NPHASE; void* args[] = {&p};
  hipError_t e = hipLaunchCooperativeKernel((const void*)mega_kernel, dim3(grid_blocks), dim3(512), args, LDS_BYTES, stream);
  if (e != hipSuccess) fprintf(stderr, "cooperative launch failed: %s (grid %d)\n", hipGetErrorString(e), grid_blocks);
#endif
}
```

```cpp
#include <hip/hip_runtime.h>
#include <hip/hip_cooperative_groups.h>
#include <cstdio>
#include <cstdint>
namespace cg = cooperative_groups;

#ifndef PMASK
#define PMASK 0xffffffff
#endif
#define TSEL1 ((1u<<8)|(1u<<20))
#define TSEL2 ((1u << 6) | (1u << 18))
#if defined(DIAG)
#if DIAG >= 3
#define DIAG_STOP 7
#else
#define DIAG_STOP 8
#endif
#endif
#ifndef GEMM_SP2
#define GEMM_SP2 1
#endif
#ifndef PER_PHASE_LAUNCH
#define PER_PHASE_LAUNCH 0
#endif

typedef unsigned short bf16_t;
typedef short bf16x8 __attribute__((ext_vector_type(8)));
typedef short s16x4 __attribute__((ext_vector_type(4)));
typedef float f32x4 __attribute__((ext_vector_type(4)));
typedef float f32x8 __attribute__((ext_vector_type(8)));
typedef float f32x16 __attribute__((ext_vector_type(16)));
typedef unsigned u32x4 __attribute__((ext_vector_type(4)));
typedef unsigned u32x2 __attribute__((ext_vector_type(2)));

constexpr int DM = 1024, NB = 8, SEQ = 8192, CTXL = 256, TL = NB * SEQ, TC = NB * CTXL, T = TL + TC, SK = SEQ + CTXL;
constexpr int DFF = 2816, PROJ = 6816;
constexpr int NPM = T / 256;
constexpr float EPS = 1e-6f;
constexpr float CQ_MLA = 0.10206207261596575f * 1.4426950408889634f;
constexpr float CQ_DIFF = 0.125f * 1.4426950408889634f;

constexpr size_t al256(size_t x) { return (x + 255) / 256 * 256; }
constexpr size_t O_MOD = 0;
constexpr size_t O_LAM = al256(O_MOD + (size_t)2 * 9 * 9216 * 4);
constexpr size_t O_R1C = O_LAM + 256;
constexpr size_t O_R1S = O_R1C + (size_t)8192 * 32 * 4;
constexpr size_t O_RDC = O_R1S + (size_t)8192 * 32 * 4;
constexpr size_t O_RDS = O_RDC + 128 * 16 * 4;
constexpr size_t O_RMC = O_RDS + 128 * 16 * 4;
constexpr size_t O_RMS = O_RMC + 128 * 8 * 4;
constexpr size_t O_W = al256(O_RMS + 128 * 8 * 4);
constexpr size_t O_WUP = O_W;
constexpr size_t O_WDN = O_WUP + (size_t)5632 * 1024 * 2;
constexpr size_t O_WIN = O_W;
constexpr size_t O_WG = O_WIN + (size_t)3840 * 1024 * 2;
constexpr size_t O_WQB = O_WG + (size_t)3072 * 1024 * 2;
constexpr size_t O_WKVB = O_WQB + (size_t)768 * 384 * 2;
constexpr size_t O_WBR = O_WKVB + (size_t)1024 * 256 * 2;
constexpr size_t O_WOUT = O_WBR + (size_t)3 * 1024 * 512 * 2;
constexpr size_t O_WEND = O_WOUT + (size_t)1024 * 1024 * 2;
constexpr size_t O_XC = al256(O_WEND);
constexpr size_t O_H = O_XC + (size_t)TC * DM * 4;
constexpr size_t O_M = O_H + (size_t)T * DM * 2;
constexpr size_t O_G = O_M;
constexpr size_t TB = (size_t)T;
constexpr size_t O_QLAT = O_M;
constexpr size_t O_KVLAT = O_QLAT + TB * 768;
constexpr size_t O_KNOPE = O_KVLAT + TB * 512;
constexpr size_t O_KROPE = O_KNOPE + TB * 1024;
constexpr size_t O_QD = O_KROPE + TB * 64;
constexpr size_t O_KD = O_QD + TB * 1024;
constexpr size_t O_VD = O_KD + TB * 1024;
constexpr size_t O_RQ = O_VD + TB * 1024;
constexpr size_t O_RK = O_RQ + TB * 512;
constexpr size_t O_RV = O_RK + TB * 512;
constexpr size_t O_YRET = O_RV + TB * 1024;
constexpr size_t O_QMLA = O_YRET + TB * 1024;
constexpr size_t O_VMLA = O_QMLA + TB * 1536;
constexpr size_t O_RETO = O_VMLA + TB * 1024;
constexpr size_t O_END = O_RETO + TB * 2048;
constexpr size_t O_YMLA = O_RQ;
constexpr size_t O_YDIFF = O_RV;
constexpr size_t O_O1S = O_QLAT;
constexpr size_t O_G6S = O_QMLA;
constexpr size_t O_YBR = O_RETO;
static_assert(O_G + TB * 2816 * 2 <= O_END, "ffn g fits");
constexpr size_t O_TS = O_END;
constexpr size_t O_CNT = O_TS + 512;
constexpr size_t O_PART = al256(O_CNT + 26 * 264 * 4);
constexpr size_t WS_NEED = O_PART + (size_t)6 * 264 * 4 * 256 * 4;

constexpr int LDS_BYTES = 131072 + 4096;

struct Params { const float* in[25]; float* out; unsigned char* ws; int ph_lo, ph_hi; };

extern __shared__ __attribute__((aligned(16))) unsigned char g_lds[];

#define MK_RSRC(ptr) __builtin_amdgcn_make_buffer_rsrc((void*)(ptr), 0, 0x7fffffff, 0x00020000)
#define MEMFENCE() asm volatile("" ::: "memory")
__device__ __forceinline__ int launder_tid() { int t = __builtin_amdgcn_workitem_id_x(); asm volatile("" : "+v"(t)); return t; }
typedef __bf16 bf16v2_t __attribute__((ext_vector_type(2)));
typedef float f32v2_t __attribute__((ext_vector_type(2)));
__device__ __forceinline__ unsigned cvtpk(float lo, float hi) { const f32v2_t v = {lo, hi}; const bf16v2_t b = __builtin_convertvector(v, bf16v2_t); return __builtin_bit_cast(unsigned, b); }
__device__ __forceinline__ float bf2f(unsigned short b) { return __uint_as_float(((unsigned)b) << 16); }
__device__ __forceinline__ float silu_f(float v) { return v * __builtin_amdgcn_rcpf(1.f + __expf(-v)); }
__device__ __forceinline__ float sigm_f(float v) { return __builtin_amdgcn_rcpf(1.f + __expf(-v)); }
__device__ __forceinline__ void store4bf(bf16_t* p, f32x4 v) { u32x2 w; w.x = cvtpk(v[0], v[1]); w.y = cvtpk(v[2], v[3]); *(u32x2*)p = w; }
__device__ __forceinline__ int logical_wg() { const int g = gridDim.x, w = blockIdx.x; return (g % 8 == 0) ? (w % 8) * (g / 8) + w / 8 : w; }

constexpr int BK = 64, HALF = 128, HTB = HALF * BK * 2;
__device__ __forceinline__ int lds_byte(int r, int c) { int st = (r >> 4) * 2 + (c >> 5), rr = r & 15, cc = c & 31, ob = rr * 64 + cc * 2; return st * 1024 + (ob ^ (((ob >> 9) & 1) << 5)); }
__device__ __forceinline__ void stage_rc(int b, int& R, int& C) { int st = b / 1024, sb = b % 1024, swz = sb ^ (((sb >> 9) & 1) << 5); R = (st >> 1) * 16 + swz / 64; C = (st & 1) * 32 + (swz % 64) / 2; }

#define LAS __attribute__((address_space(3)))
#define WAIT_V(n) asm volatile("s_waitcnt vmcnt(" #n ")" ::: "memory")
#define WAIT_L(n) asm volatile("s_waitcnt lgkmcnt(" #n ")" ::: "memory")
#define BAR __builtin_amdgcn_s_barrier()
#define SCHED __builtin_amdgcn_sched_barrier(0)

struct GOp { const char* A; const char* B; unsigned lda2, ldb2; int nt; };
template <class GetOp, class Epi>
__device__ __forceinline__ void gemm_stream(GetOp get, Epi epi) {
  LAS unsigned char* lds = (LAS unsigned char*)g_lds;
  GOp cur, nxt;
  if (!get(0, cur)) return;
  const int tid = launder_tid();
  const int wid = __builtin_amdgcn_readfirstlane(tid >> 6), lane = tid & 63, wr = wid >> 2, wc = wid & 3, fr = lane & 15, fq = lane >> 4;
  int R0, C0, R1, C1; stage_rc(tid * 16, R0, C0); stage_rc(tid * 16 + 8192, R1, C1);
  const unsigned ldsw = (unsigned)wid * 1024u;
  const int aoff = lds_byte(wr * 64 + fr, fq * 8), boff = lds_byte(wc * 32 + fr, fq * 8);
  unsigned cvA[2], cvB[2], nvA[2], nvB[2];
  cvA[0] = R0 * cur.lda2 + C0 * 2; cvA[1] = R1 * cur.lda2 + C1 * 2; cvB[0] = R0 * cur.ldb2 + C0 * 2; cvB[1] = R1 * cur.ldb2 + C1 * 2;
#define G_SA(b, h) (((b) * 2 + (h)) * HTB)
#define G_SB(b, h) ((4 + (b) * 2 + (h)) * HTB)
#define STAGE(bufoff, gbase, voff) do { _Pragma("unroll") for (int _i = 0; _i < 2; ++_i) \
    __builtin_amdgcn_global_load_lds((const unsigned*)((const char*)(gbase) + (voff)[_i]), (LAS unsigned*)(lds + (bufoff) + ldsw + _i * 8192), 16, 0, 0); } while (0)
#define LDA(dst, b, h) do { _Pragma("unroll") for (int m = 0; m < 4; ++m) _Pragma("unroll") for (int k = 0; k < 2; ++k) dst[m][k] = *(const LAS bf16x8*)(lds + G_SA(b, h) + aoff + m * 2048 + k * 1024); } while (0)
#define LDB(dst, b, h) do { _Pragma("unroll") for (int n = 0; n < 2; ++n) _Pragma("unroll") for (int k = 0; k < 2; ++k) dst[n][k] = *(const LAS bf16x8*)(lds + G_SB(b, h) + boff + n * 2048 + k * 1024); } while (0)
#define MMA(ai, bj, At_, Bt_) do { __builtin_amdgcn_s_setprio(1); \
    _Pragma("unroll") for (int m = 0; m < 4; ++m) _Pragma("unroll") for (int n = 0; n < 2; ++n) _Pragma("unroll") for (int k = 0; k < 2; ++k) \
      acc[ai][bj][m][n] = __builtin_amdgcn_mfma_f32_16x16x32_bf16(At_[m][k], Bt_[n][k], acc[ai][bj][m][n], 0, 0, 0); \
    __builtin_amdgcn_s_setprio(0); } while (0)
  { const size_t hA = (size_t)HALF * cur.lda2, hB = (size_t)HALF * cur.ldb2;
#if GEMM_SP2
    STAGE(G_SB(0, 0), cur.B, cvB); STAGE(G_SB(0, 1), cur.B + hB, cvB); STAGE(G_SA(0, 0), cur.A, cvA); STAGE(G_SA(0, 1), cur.A + hA, cvA);
    if (wr == 1) BAR;
    WAIT_V(2); BAR;
#else
    STAGE(G_SB(0, 0), cur.B, cvB); STAGE(G_SA(0, 0), cur.A, cvA); STAGE(G_SB(0, 1), cur.B + hB, cvB); STAGE(G_SA(0, 1), cur.A + hA, cvA);
    if (wr == 1) BAR;
    WAIT_V(4); BAR;
#endif
    STAGE(G_SB(1, 0), cur.B + 128, cvB); STAGE(G_SA(1, 0), cur.A + 128, cvA); STAGE(G_SB(1, 1), cur.B + hB + 128, cvB);
    WAIT_V(6); BAR; }
  f32x4 acc[2][2][4][2];
  bf16x8 At[4][2], B0[2][2], B1[2][2];
  for (int idx = 0;; ++idx) {
    const bool has_next = get(idx + 1, nxt);
    if (!has_next) nxt = cur;
    nvA[0] = R0 * nxt.lda2 + C0 * 2; nvA[1] = R1 * nxt.lda2 + C1 * 2; nvB[0] = R0 * nxt.ldb2 + C0 * 2; nvB[1] = R1 * nxt.ldb2 + C1 * 2;
    if (idx > 0) { if (wr == 1) BAR; }
#pragma unroll
    for (int a = 0; a < 2; ++a)
#pragma unroll
      for (int b = 0; b < 2; ++b)
#pragma unroll
        for (int m = 0; m < 4; ++m)
#pragma unroll
          for (int n = 0; n < 2; ++n) acc[a][b][m][n] = (f32x4){0.f, 0.f, 0.f, 0.f};
    const size_t hA = (size_t)HALF * cur.lda2, hB = (size_t)HALF * cur.ldb2, nhA = (size_t)HALF * nxt.lda2, nhB = (size_t)HALF * nxt.ldb2;
    const int nt = cur.nt;
    for (int t = 0; t < nt; t += 2) {
      const bool last = (t == nt - 2);
      const char* a1 = cur.A + (size_t)(t + 1) * 128;
      const char* a2 = last ? nxt.A : cur.A + (size_t)(t + 2) * 128; const char* b2 = last ? nxt.B : cur.B + (size_t)(t + 2) * 128;
      const char* a3 = a2 + 128; const char* b3 = b2 + 128;
      const size_t hA2 = last ? nhA : hA, hB2 = last ? nhB : hB;
      unsigned vA2[2], vB2[2]; vA2[0] = last ? nvA[0] : cvA[0]; vA2[1] = last ? nvA[1] : cvA[1]; vB2[0] = last ? nvB[0] : cvB[0]; vB2[1] = last ? nvB[1] : cvB[1];
#if GEMM_SP2
      LDB(B0, 0, 0); LDB(B1, 0, 1); SCHED; LDA(At, 0, 0); STAGE(G_SA(1, 1), a1 + hA, cvA);
      WAIT_V(8); WAIT_L(0); BAR; MMA(0, 0, At, B0); MMA(0, 1, At, B1); BAR; SCHED;
      LDA(At, 0, 1); STAGE(G_SB(0, 0), b2, vB2); STAGE(G_SB(0, 1), b2 + hB2, vB2); STAGE(G_SA(0, 0), a2, vA2);
      WAIT_V(8); WAIT_L(0); BAR; MMA(1, 0, At, B0); MMA(1, 1, At, B1); BAR; SCHED;
      LDB(B0, 1, 0); LDB(B1, 1, 1); SCHED; LDA(At, 1, 0); STAGE(G_SA(0, 1), a2 + hA2, vA2);
      WAIT_V(8); WAIT_L(0); BAR; MMA(0, 0, At, B0); MMA(0, 1, At, B1); BAR; SCHED;
      LDA(At, 1, 1); STAGE(G_SB(1, 0), b3, vB2); STAGE(G_SB(1, 1), b3 + hB2, vB2); STAGE(G_SA(1, 0), a3, vA2);
      WAIT_V(8); WAIT_L(0); BAR; MMA(1, 0, At, B0); MMA(1, 1, At, B1); BAR; SCHED;
#else
      LDB(B0, 0, 0); SCHED; LDA(At, 0, 0); STAGE(G_SA(1, 1), a1 + hA, cvA);
      WAIT_L(8); BAR; WAIT_L(0); MMA(0, 0, At, B0); BAR; SCHED;
      LDB(B1, 0, 1); STAGE(G_SB(0, 0), b2, vB2);
      BAR; WAIT_L(0); MMA(0, 1, At, B1); BAR;
      LDA(At, 0, 1); STAGE(G_SA(0, 0), a2, vA2);
      BAR; WAIT_L(0); MMA(1, 0, At, B0); BAR; SCHED;
      STAGE(G_SB(0, 1), b2 + hB2, vB2);
      WAIT_V(6); BAR; MMA(1, 1, At, B1); BAR;
      LDB(B0, 1, 0); SCHED; LDA(At, 1, 0); STAGE(G_SA(0, 1), a2 + hA2, vA2);
      WAIT_L(8); BAR; WAIT_L(0); MMA(0, 0, At, B0); BAR; SCHED;
      LDB(B1, 1, 1); STAGE(G_SB(1, 0), b3, vB2);
      BAR; WAIT_L(0); MMA(0, 1, At, B1); BAR;
      LDA(At, 1, 1); STAGE(G_SA(1, 0), a3, vA2);
      BAR; WAIT_L(0); MMA(1, 0, At, B0); BAR; SCHED;
      STAGE(G_SB(1, 1), b3 + hB2, vB2);
      WAIT_V(6); BAR; MMA(1, 1, At, B1); BAR;
#endif
    }
    if (wr == 0) BAR;
    epi(idx, acc);
    if (!has_next) break;
    cur = nxt; cvA[0] = nvA[0]; cvA[1] = nvA[1]; cvB[0] = nvB[0]; cvB[1] = nvB[1];
  }
  WAIT_V(0); BAR;
#undef G_SA
#undef G_SB
#undef STAGE
#undef LDA
#undef LDB
#undef MMA
}

__device__ __forceinline__ void unit_decode(int U, int NPN, int SBN, int& pm, int& pn) {
  const int per = 8 * SBN, blk = U / per, within = U % per, npng = NPN / SBN;
  const int pmg = blk / npng, png = blk % npng;
  pm = pmg * 8 + (within & 7); pn = png * SBN + (within >> 3);
}
struct TI { int b, bb, arow0; };
__device__ __forceinline__ TI tile_info(int pm) { TI t; if (pm < 256) { t.b = pm >> 5; t.bb = t.b; t.arow0 = (pm & 31) * 256; } else { t.b = pm - 256; t.bb = 8; t.arow0 = 8192; } return t; }

#define LANE_IDS const int tid = launder_tid(), wid = __builtin_amdgcn_readfirstlane(tid >> 6), lane = tid & 63, wr = wid >> 2, wc = wid & 3, fr = lane & 15, fq = lane >> 4; (void)tid; (void)wr; (void)wc; (void)fr; (void)fq; (void)lane; (void)wid;

enum { CM_PLAIN = 0, CM_UP, CM_WIN, CM_QB, CM_KVB };
__device__ __forceinline__ int colmap(int kind, int n, int base, int& which) {
  which = 0;
  switch (kind) {
    case CM_PLAIN: return base + n;
    case CM_UP: { const int tile = n >> 8, c = n & 255, ai = c >> 7, wrr = (c >> 6) & 1, m = (c >> 4) & 3, q = c & 15; which = m & 1; return tile * 128 + ai * 64 + wrr * 32 + (m >> 1) * 16 + q; }
    case CM_WIN: {
      if (n < 384) return n;
      if (n < 416) { const int cc = n - 384, part = (cc >> 4) & 1, half = (cc >> 3) & 1, idx = cc & 7; return 640 + half * 16 + part * 8 + idx; }
      if (n < 512) return -1;
      if (n < 768) return 384 + (n - 512);
      return 672 + (n - 768);
    }
    case CM_QB: {
      if (n < 512) return (n >> 6) * 96 + (n & 63);
      const int c = n - 512, h = c >> 5, cc = c & 31, part = (cc >> 4) & 1, half = (cc >> 3) & 1, idx = cc & 7; return h * 96 + 64 + half * 16 + part * 8 + idx;
    }
    case CM_KVB: {
      if (n < 512) return (n >> 6) * 128 + (n & 63);
      const int c = n - 512; return (c >> 6) * 128 + 64 + (c & 63);
    }
  }
  return -1;
}
__device__ __forceinline__ void conv_load(float (&v)[8], int kind, const float* src0, const float* src1, int ld, int base, const float* scale, int n0, int k0) {
  const int tid = launder_tid(); const int nn = tid & 63, kk = tid >> 6; int which; const int col = colmap(kind, n0 + nn, base, which); const float* s = which ? src1 : src0;
#pragma unroll
  for (int i = 0; i < 8; ++i) { const int k = kk + 8 * i; float x = 0.f; if (col >= 0) { x = s[(long)(k0 + k) * ld + col]; if (scale) x *= scale[k0 + k]; } v[i] = x; }
}
__device__ __forceinline__ void conv_store(const float (&vin)[8], bf16_t* dst, int K, int n0, int k0) {
  float* tl = (float*)g_lds;
  const int tid = launder_tid();
  { const int nn = tid & 63, kk = tid >> 6;
#pragma unroll
    for (int i = 0; i < 8; ++i) tl[(kk + 8 * i) * 65 + nn] = vin[i]; }
  __syncthreads();
  { const int nr = tid >> 3, kc = (tid & 7) * 8; float v[8];
#pragma unroll
    for (int e = 0; e < 8; ++e) v[e] = tl[(kc + e) * 65 + nr];
    u32x4 w; w.x = cvtpk(v[0], v[1]); w.y = cvtpk(v[2], v[3]); w.z = cvtpk(v[4], v[5]); w.w = cvtpk(v[6], v[7]);
    *(u32x4*)(dst + (long)(n0 + nr) * K + k0 + kc) = w; }
  __syncthreads();
}
struct ConvJob { int kind; size_t dst; int N, K; const float* s0; const float* s1; int ld, base; const float* scale; };
__device__ __forceinline__ ConvJob conv_job(const Params& p, int l, int grp, int j) {
  ConvJob J; J.s1 = nullptr; J.scale = nullptr; J.base = 0;
  if (grp != 1) {
    const float* w1 = p.in[grp == 0 ? 7 : 10] + (size_t)l * DM * DFF; const float* w3 = p.in[grp == 0 ? 8 : 11] + (size_t)l * DM * DFF; const float* w2 = p.in[grp == 0 ? 9 : 12] + (size_t)l * DFF * DM;
    if (j == 0) { J.kind = CM_UP; J.dst = O_WUP; J.N = 5632; J.K = 1024; J.s0 = w1; J.s1 = w3; J.ld = DFF; }
    else { J.kind = CM_PLAIN; J.dst = O_WDN; J.N = 1024; J.K = 2816; J.s0 = w2; J.s1 = w2; J.ld = DM; }
  } else {
    const float* win = p.in[13] + (size_t)l * DM * PROJ; const float* wb = p.in[22] + (size_t)l * 3 * 512 * 1024;
    switch (j) {
      case 0: J.kind = CM_WIN; J.dst = O_WIN; J.N = 3840; J.K = 1024; J.s0 = win; J.ld = PROJ; break;
      case 1: J.kind = CM_PLAIN; J.dst = O_WG; J.N = 3072; J.K = 1024; J.s0 = win; J.ld = PROJ; J.base = 3744; break;
      case 2: J.kind = CM_QB; J.dst = O_WQB; J.N = 768; J.K = 384; J.s0 = p.in[15] + (size_t)l * 384 * 768; J.ld = 768; J.scale = p.in[14] + l * 384; break;
      case 3: J.kind = CM_KVB; J.dst = O_WKVB; J.N = 1024; J.K = 256; J.s0 = p.in[17] + (size_t)l * 256 * 1024; J.ld = 1024; J.scale = p.in[16] + l * 256; break;
      case 4: J.kind = CM_PLAIN; J.dst = O_WBR; J.N = 3072; J.K = 512; J.s0 = wb; J.ld = 1024; break;
      default: J.kind = CM_PLAIN; J.dst = O_WOUT; J.N = 1024; J.K = 1024; J.s0 = p.in[23] + (size_t)l * DM * DM; J.ld = DM; break;
    }
    J.s1 = J.s0;
  }
  return J;
}
struct ConvTile { int kind; bf16_t* dst; int K; const float* s0; const float* s1; int ld, base; const float* scale; int n0, k0; };
__device__ __forceinline__ ConvTile conv_decode(const Params& p, int l, int grp, int u, int jlo) {
  int v = u, j = jlo; ConvJob J = conv_job(p, l, grp, jlo);
  for (;;) { const int c = (J.N / 64) * (J.K / 64); if (v < c) break; v -= c; ++j; J = conv_job(p, l, grp, j); }
  const int nk = J.K / 64; const int nt_ = v / nk, kt_ = v % nk;
  ConvTile t; t.kind = J.kind; t.K = J.K; t.s0 = J.s0; t.s1 = J.s1; t.ld = J.ld; t.base = J.base; t.scale = J.scale; t.n0 = nt_ * 64; t.k0 = kt_ * 64; t.dst = (bf16_t*)(p.ws + J.dst);
  if (grp == 1 && j == 4) { const int i = t.n0 >> 10; t.s0 += (size_t)i * 512 * 1024; t.dst += (size_t)i * 1024 * 512; t.n0 &= 1023; }
  return t;
}
__device__ __forceinline__ void conv_group(const Params& p, int l, int grp, int jlo, int jhi) {
  int tot = 0; for (int j = jlo; j < jhi; ++j) { const ConvJob J = conv_job(p, l, grp, j); tot += (J.N / 64) * (J.K / 64); }
  int u = blockIdx.x; if (u >= tot) return;
  ConvTile t = conv_decode(p, l, grp, u, jlo); float v[8];
  conv_load(v, t.kind, t.s0, t.s1, t.ld, t.base, t.scale, t.n0, t.k0);
  for (;;) {
    const int un = u + gridDim.x; const bool more = un < tot; ConvTile tn = t; float vn[8];
    if (more) { tn = conv_decode(p, l, grp, un, jlo); conv_load(vn, tn.kind, tn.s0, tn.s1, tn.ld, tn.base, tn.scale, tn.n0, tn.k0); }
    conv_store(v, t.dst, t.K, t.n0, t.k0);
    if (!more) break;
    u = un; t = tn;
#pragma unroll
    for (int i = 0; i < 8; ++i) v[i] = vn[i];
  }
}

__device__ __forceinline__ void phase_p0(const Params& p) {
  const int tid = launder_tid();
  float* sl = (float*)g_lds;
  float* red = sl + 9 * 1024;
  for (int i = tid; i < 9 * 1024; i += 512) { const int bb = i >> 10, k = i & 1023; const float v = bb < 8 ? p.in[1][bb * 1024 + k] : p.in[3][k]; sl[i] = v / (1.f + expf(-v)); }
  __syncthreads();
  float* modp = (float*)(p.ws + O_MOD);
  for (int u = blockIdx.x; u < 144; u += gridDim.x) {
    const int l = u / 72, c0 = (u % 72) * 128, col = c0 + (tid & 127), ks = tid >> 7;
    const float* w = p.in[4] + (size_t)l * 1024 * 9216 + col;
    float a[9];
#pragma unroll
    for (int bb = 0; bb < 9; ++bb) a[bb] = 0.f;
    for (int k = ks * 256; k < ks * 256 + 256; ++k) { const float wv = w[(size_t)k * 9216];
#pragma unroll
      for (int bb = 0; bb < 9; ++bb) a[bb] += sl[bb * 1024 + k] * wv; }
#pragma unroll
    for (int bb = 0; bb < 9; ++bb) red[(ks * 9 + bb) * 128 + (tid & 127)] = a[bb];
    __syncthreads();
    for (int i = tid; i < 9 * 128; i += 512) { const int bb = i >> 7, cc = i & 127;
      const float s = red[(0 * 9 + bb) * 128 + cc] + red[(1 * 9 + bb) * 128 + cc] + red[(2 * 9 + bb) * 128 + cc] + red[(3 * 9 + bb) * 128 + cc];
      modp[((size_t)l * 9 + bb) * 9216 + c0 + cc] = s + p.in[5][l * 9216 + c0 + cc]; }
    __syncthreads();
  }
  const long gt = (long)blockIdx.x * 512 + tid, gs = (long)gridDim.x * 512;
  for (long i = gt; i < (long)6 * 264 * 1024; i += gs) ((float*)(p.ws + O_PART))[i] = -1.f;
  float* r1c = (float*)(p.ws + O_R1C); float* r1s = (float*)(p.ws + O_R1S);
  for (long i = gt; i < 8192 * 32; i += gs) { const int pos = (int)(i >> 5), f = (int)(i & 31); const float inv = (float)pow(10000.0, -(double)(2 * f) / 64.0); const float ang = (float)pos * inv; r1c[i] = (float)cos((double)ang); r1s[i] = (float)sin((double)ang); }
  float* rdc = (float*)(p.ws + O_RDC); float* rds = (float*)(p.ws + O_RDS);
  for (long i = gt; i < 128 * 16; i += gs) { const int pos = (int)(i >> 4), f = (int)(i & 15); const float inv = (float)pow(10000.0, -(double)(2 * f) / 32.0); const float ang = (float)pos * inv; rdc[i] = (float)cos((double)ang); rds[i] = (float)sin((double)ang); }
  float* rmc = (float*)(p.ws + O_RMC); float* rms = (float*)(p.ws + O_RMS);
  for (long i = gt; i < 128 * 8; i += gs) { const int pos = (int)(i >> 3), f = (int)(i & 7); const float inv = (float)pow(10000.0, -(double)(2 * f) / 16.0); const float ang = (float)pos * inv; rmc[i] = (float)cos((double)ang); rms[i] = (float)sin((double)ang); }
  if (blockIdx.x == 0 && tid == 200) { ((float*)(p.ws + O_LAM))[16] = 0.f; ((float*)(p.ws + O_LAM))[17] = 0.f; }
  if (blockIdx.x == 0 && tid < 128) {
    const int l = tid >> 6, ln = tid & 63; const float* dl = p.in[18] + l * 256;
    float s1 = dl[ln] * dl[64 + ln], s2 = dl[128 + ln] * dl[192 + ln];
#pragma unroll
    for (int o = 32; o > 0; o >>= 1) { s1 += __shfl_xor(s1, o); s2 += __shfl_xor(s2, o); }
    const float li = 0.8f - 0.6f * expf(-0.3f * (float)l);
    if (ln == 0) ((float*)(p.ws + O_LAM))[l] = expf(s1) - expf(s2) + li;
  }
}

__device__ __forceinline__ const float* xsrc_row(const Params& p, long row, bool from_input) {
  if (row < TL) return (from_input ? p.in[0] : p.out) + row * DM;
  return (from_input ? p.in[2] : (const float*)(p.ws + O_XC)) + (row - TL) * DM;
}
__device__ __forceinline__ float* xdst_row(const Params& p, long row) { return row < TL ? p.out + row * DM : (float*)(p.ws + O_XC) + (row - TL) * DM; }

__device__ __forceinline__ void phase_norm(const Params& p, int l, int which, bool from_input) {
  const int tid = launder_tid(), wid = tid >> 6, lane = tid & 63;
  bf16_t* H = (bf16_t*)(p.ws + O_H);
  const float* gain = p.in[6] + (l * 3 + which) * DM;
  const long nwaves = (long)gridDim.x * 8, w0 = (long)blockIdx.x * 8 + wid;
  for (long rb = w0; rb < T; rb += nwaves * 4) {
    f32x4 v[4][4]; float ss[4];
#pragma unroll
    for (int j = 0; j < 4; ++j) { const long row = rb + j * nwaves; ss[j] = 0.f;
      if (row < T) { const float* src = xsrc_row(p, row, from_input);
#pragma unroll
        for (int i = 0; i < 4; ++i) v[j][i] = *(const f32x4*)(src + (lane + 64 * i) * 4); } }
#pragma unroll
    for (int j = 0; j < 4; ++j) { const long row = rb + j * nwaves;
      if (row < T) {
#pragma unroll
        for (int i = 0; i < 4; ++i) ss[j] += v[j][i][0] * v[j][i][0] + v[j][i][1] * v[j][i][1] + v[j][i][2] * v[j][i][2] + v[j][i][3] * v[j][i][3];
#pragma unroll
        for (int o = 32; o > 0; o >>= 1) ss[j] += __shfl_xor(ss[j], o);
        const float rstd = rsqrtf(ss[j] * (1.f / 1024.f) + EPS);
        const int bb = row < TL ? (int)(row >> 13) : 8;
        const float* md = (const float*)(p.ws + O_MOD) + ((size_t)l * 9 + bb) * 9216;
#pragma unroll
        for (int i = 0; i < 4; ++i) { const int c = (lane + 64 * i) * 4;
          const f32x4 g = *(const f32x4*)(gain + c), sh = *(const f32x4*)(md + which * 3 * 1024 + c), sc = *(const f32x4*)(md + (which * 3 + 1) * 1024 + c);
          f32x4 o;
#pragma unroll
          for (int e = 0; e < 4; ++e) o[e] = v[j][i][e] * rstd * g[e] * (1.f + sc[e]) + sh[e];
          store4bf(H + row * DM + c, o); } } }
  }
}
__device__ __forceinline__ void phase_final(const Params& p) {
  const int tid = launder_tid(), wid = tid >> 6, lane = tid & 63;
  const float* gain = p.in[24];
  const long nwaves = (long)gridDim.x * 8, w0 = (long)blockIdx.x * 8 + wid;
  for (long rb = w0; rb < TL; rb += nwaves * 4) {
    f32x4 v[4][4];
#pragma unroll
    for (int j = 0; j < 4; ++j) { const long row = rb + j * nwaves;
      if (row < TL) { const float* src = p.out + row * DM;
#pragma unroll
        for (int i = 0; i < 4; ++i) v[j][i] = *(const f32x4*)(src + (lane + 64 * i) * 4); } }
#pragma unroll
    for (int j = 0; j < 4; ++j) { const long row = rb + j * nwaves;
      if (row < TL) { float ss = 0.f; float* dst = p.out + row * DM;
#pragma unroll
        for (int i = 0; i < 4; ++i) ss += v[j][i][0] * v[j][i][0] + v[j][i][1] * v[j][i][1] + v[j][i][2] * v[j][i][2] + v[j][i][3] * v[j][i][3];
#pragma unroll
        for (int o = 32; o > 0; o >>= 1) ss += __shfl_xor(ss, o);
        const float rstd = rsqrtf(ss * (1.f / 1024.f) + EPS);
#pragma unroll
        for (int i = 0; i < 4; ++i) { const int c = (lane + 64 * i) * 4; const f32x4 g = *(const f32x4*)(gain + c); f32x4 o;
#pragma unroll
          for (int e = 0; e < 4; ++e) o[e] = v[j][i][e] * rstd * g[e];
          *(f32x4*)(dst + c) = o; } } }
  }
}

__device__ __forceinline__ void phase_ffn_up(const Params& p, int npm) {
  const char* W = (const char*)(p.ws + O_WUP); const char* H = (const char*)(p.ws + O_H); bf16_t* G = (bf16_t*)(p.ws + O_G);
  const int q = logical_wg(), Gd = gridDim.x, tot = npm * 22;
  auto get = [&](int idx, GOp& o) __attribute__((always_inline)) -> bool { const int U = q + idx * Gd; if (U >= tot) return false; int pm, pn; unit_decode(U, 22, 2, pm, pn);
    o.A = W + (size_t)pn * 256 * 2048; o.B = H + (size_t)pm * 256 * 2048; o.lda2 = 2048; o.ldb2 = 2048; o.nt = 16; return true; };
  auto epi = [&](int idx, const f32x4 (&acc)[2][2][4][2]) __attribute__((always_inline)) {
    const int U = q + idx * Gd; int pm, pn; unit_decode(U, 22, 2, pm, pn);
    LANE_IDS
#pragma unroll
    for (int ai = 0; ai < 2; ++ai)
#pragma unroll
      for (int bj = 0; bj < 2; ++bj)
#pragma unroll
        for (int n = 0; n < 2; ++n)
#pragma unroll
          for (int mp = 0; mp < 2; ++mp) {
            const long tok = (long)pm * 256 + bj * 128 + wc * 32 + n * 16 + fr; const int gc = pn * 128 + ai * 64 + wr * 32 + mp * 16 + fq * 4;
            const f32x4 a = acc[ai][bj][2 * mp][n], b = acc[ai][bj][2 * mp + 1][n]; f32x4 o;
#pragma unroll
            for (int e = 0; e < 4; ++e) o[e] = silu_f(a[e]) * b[e];
            store4bf(G + tok * DFF + gc, o);
          }
  };
  gemm_stream(get, epi);
}
__device__ __forceinline__ void epi_res(const Params& p, const f32x4 (&acc)[2][2][4][2], int l, int pm, int pn, int gate_idx, float scale, bool from_input) {
  LANE_IDS
  const TI ti = tile_info(pm);
  const float* md = (const float*)(p.ws + O_MOD) + ((size_t)l * 9 + ti.bb) * 9216 + gate_idx * 1024;
#pragma unroll
  for (int bj = 0; bj < 2; ++bj)
#pragma unroll
    for (int n = 0; n < 2; ++n) {
      const long row = (long)pm * 256 + bj * 128 + wc * 32 + n * 16 + fr;
      const float* src = xsrc_row(p, row, from_input); float* dst = xdst_row(p, row);
#pragma unroll
      for (int ai = 0; ai < 2; ++ai)
#pragma unroll
        for (int m = 0; m < 4; ++m) {
          const int col = pn * 256 + ai * 128 + wr * 64 + m * 16 + fq * 4;
          const f32x4 xv = *(const f32x4*)(src + col), g = *(const f32x4*)(md + col); f32x4 o;
#pragma unroll
          for (int e = 0; e < 4; ++e) o[e] = xv[e] + g[e] * scale * acc[ai][bj][m][n][e];
          *(f32x4*)(dst + col) = o;
          if (m & 1) MEMFENCE();
        }
    }
}
struct NormFuse { int nl, which, pslot, cslot; bool fin; };
__device__ __forceinline__ void epi_res_norm(const Params& p, f32x4 (&acc)[2][2][4][2], int l, int pm, int pn, int gate_idx, float scale, bool from_input, const NormFuse nf) {
  LANE_IDS
  const TI ti = tile_info(pm);
  const float* md = (const float*)(p.ws + O_MOD) + ((size_t)l * 9 + ti.bb) * 9216 + gate_idx * 1024;
  float ssr[2][2];
#pragma unroll
  for (int bj = 0; bj < 2; ++bj)
#pragma unroll
    for (int n = 0; n < 2; ++n) {
      const long row = (long)pm * 256 + bj * 128 + wc * 32 + n * 16 + fr;
      const float* src = xsrc_row(p, row, from_input); float* dst = xdst_row(p, row); float ss = 0.f;
#pragma unroll
      for (int ai = 0; ai < 2; ++ai)
#pragma unroll
        for (int m = 0; m < 4; ++m) {
          const int col = pn * 256 + ai * 128 + wr * 64 + m * 16 + fq * 4;
          const f32x4 xv = *(const f32x4*)(src + col), g = *(const f32x4*)(md + col); f32x4 o;
#pragma unroll
          for (int e = 0; e < 4; ++e) { o[e] = xv[e] + g[e] * scale * acc[ai][bj][m][n][e]; ss += o[e] * o[e]; }
          if (!nf.fin) *(f32x4*)(dst + col) = o;
          acc[ai][bj][m][n] = o;
          if (m & 1) MEMFENCE();
        }
      ss += __shfl_xor(ss, 16); ss += __shfl_xor(ss, 32); ssr[bj][n] = ss;
    }
  float* ssl = (float*)(g_lds + 131072);
  __syncthreads();
  if (fq == 0) {
#pragma unroll
    for (int bj = 0; bj < 2; ++bj)
#pragma unroll
      for (int n = 0; n < 2; ++n) ssl[wr * 256 + bj * 128 + wc * 32 + n * 16 + fr] = ssr[bj][n]; }
  __syncthreads();
  unsigned* part = (unsigned*)(p.ws + O_PART) + ((size_t)nf.pslot * 264 + pm) * 1024;
  if (tid < 256) {
    __hip_atomic_store(part + pn * 256 + tid, __float_as_uint(ssl[tid] + ssl[256 + tid]), __ATOMIC_RELAXED, __HIP_MEMORY_SCOPE_AGENT);
    float t = 0.f; int spins = 0;
    for (;;) { float v0 = __uint_as_float(__hip_atomic_load(part + tid, __ATOMIC_RELAXED, __HIP_MEMORY_SCOPE_AGENT)), v1 = __uint_as_float(__hip_atomic_load(part + 256 + tid, __ATOMIC_RELAXED, __HIP_MEMORY_SCOPE_AGENT)),
        v2 = __uint_as_float(__hip_atomic_load(part + 512 + tid, __ATOMIC_RELAXED, __HIP_MEMORY_SCOPE_AGENT)), v3 = __uint_as_float(__hip_atomic_load(part + 768 + tid, __ATOMIC_RELAXED, __HIP_MEMORY_SCOPE_AGENT));
      t = v0 + v1 + v2 + v3;
      if ((v0 >= 0.f && v1 >= 0.f && v2 >= 0.f && v3 >= 0.f) || ++spins > (1 << 18)) break;
      __builtin_amdgcn_s_sleep(4); }
    ssl[512 + tid] = rsqrtf(t * (1.f / 1024.f) + EPS); }
  __syncthreads();
  const float* gain = nf.fin ? p.in[24] : p.in[6] + (nf.nl * 3 + nf.which) * DM;
  const float* mdn = (const float*)(p.ws + O_MOD) + ((size_t)nf.nl * 9 + ti.bb) * 9216;
  bf16_t* H = (bf16_t*)(p.ws + O_H);
#pragma unroll
  for (int bj = 0; bj < 2; ++bj)
#pragma unroll
    for (int n = 0; n < 2; ++n) {
      const int tl = bj * 128 + wc * 32 + n * 16 + fr; const long row = (long)pm * 256 + tl; const float r = ssl[512 + tl];
#pragma unroll
      for (int ai = 0; ai < 2; ++ai)
#pragma unroll
        for (int m = 0; m < 4; ++m) {
          const int col = pn * 256 + ai * 128 + wr * 64 + m * 16 + fq * 4; const f32x4 o = acc[ai][bj][m][n], g = *(const f32x4*)(gain + col); f32x4 h;
          if (nf.fin) {
#pragma unroll
            for (int e = 0; e < 4; ++e) h[e] = o[e] * r * g[e];
            *(f32x4*)(p.out + row * DM + col) = h;
          } else { const f32x4 sh = *(const f32x4*)(mdn + nf.which * 3 * 1024 + col), sc = *(const f32x4*)(mdn + (nf.which * 3 + 1) * 1024 + col);
#pragma unroll
            for (int e = 0; e < 4; ++e) h[e] = o[e] * r * g[e] * (1.f + sc[e]) + sh[e];
            store4bf(H + row * DM + col, h); }
          if (m & 1) MEMFENCE();
        }
    }
}
__device__ __forceinline__ void phase_ffn_down(const Params& p, int l, int gate_idx, bool from_input, int npm, const NormFuse nf) {
  const char* W = (const char*)(p.ws + O_WDN); const char* G = (const char*)(p.ws + O_G);
  const int q = logical_wg(), Gd = gridDim.x, tot = npm * 4;
  auto get = [&](int idx, GOp& o) __attribute__((always_inline)) -> bool { const int U = q + idx * Gd; if (U >= tot) return false; int pm, pn; unit_decode(U, 4, 4, pm, pn);
    o.A = W + (size_t)pn * 256 * (DFF * 2); o.B = G + (size_t)pm * 256 * (DFF * 2); o.lda2 = DFF * 2; o.ldb2 = DFF * 2; o.nt = DFF / 64; return true; };
  auto epi = [&](int idx, f32x4 (&acc)[2][2][4][2]) __attribute__((always_inline)) {
    const int U = q + idx * Gd; int pm, pn; unit_decode(U, 4, 4, pm, pn); epi_res_norm(p, acc, l, pm, pn, gate_idx, 0.5f, from_input, nf); };
  gemm_stream(get, epi);
}
__device__ __forceinline__ void phase_wout(const Params& p, int l, int npm, const NormFuse nf) {
  const char* W = (const char*)(p.ws + O_WOUT); const char* Y = (const char*)(p.ws + O_YBR);
  const int q = logical_wg(), Gd = gridDim.x, tot = npm * 4;
  auto get = [&](int idx, GOp& o) __attribute__((always_inline)) -> bool { const int U = q + idx * Gd; if (U >= tot) return false; int pm, pn; unit_decode(U, 4, 4, pm, pn);
    o.A = W + (size_t)pn * 256 * 2048; o.B = Y + (size_t)pm * 256 * 2048; o.lda2 = 2048; o.ldb2 = 2048; o.nt = 16; return true; };
  auto epi = [&](int idx, f32x4 (&acc)[2][2][4][2]) __attribute__((always_inline)) {
    const int U = q + idx * Gd; int pm, pn; unit_decode(U, 4, 4, pm, pn); epi_res_norm(p, acc, l, pm, pn, 5, 1.0f, false, nf); };
  gemm_stream(get, epi);
}

__device__ __forceinline__ void rope4(f32x4 x1, f32x4 x2, f32x4 c, f32x4 s, f32x4& o1, f32x4& o2) {
#pragma unroll
  for (int e = 0; e < 4; ++e) { o1[e] = x1[e] * c[e] - x2[e] * s[e]; o2[e] = x1[e] * s[e] + x2[e] * c[e]; }
}
__device__ __forceinline__ void phase_win(const Params& p) {
  const char* W = (const char*)(p.ws + O_WIN); const char* H = (const char*)(p.ws + O_H);
  bf16_t* QLAT = (bf16_t*)(p.ws + O_QLAT); bf16_t* KVLAT = (bf16_t*)(p.ws + O_KVLAT); bf16_t* KROPE = (bf16_t*)(p.ws + O_KROPE);
  bf16_t* QD = (bf16_t*)(p.ws + O_QD); bf16_t* KD = (bf16_t*)(p.ws + O_KD); bf16_t* VD = (bf16_t*)(p.ws + O_VD);
  bf16_t* RQ = (bf16_t*)(p.ws + O_RQ); bf16_t* RK = (bf16_t*)(p.ws + O_RK); bf16_t* RV = (bf16_t*)(p.ws + O_RV); bf16_t* YRET = (bf16_t*)(p.ws + O_YRET);
  const float* r1c = (const float*)(p.ws + O_R1C); const float* r1s = (const float*)(p.ws + O_R1S);
  const float* rdc = (const float*)(p.ws + O_RDC); const float* rds = (const float*)(p.ws + O_RDS);
  const float* rmc = (const float*)(p.ws + O_RMC); const float* rms = (const float*)(p.ws + O_RMS);
  const int q = logical_wg(), Gd = gridDim.x;
  auto get = [&](int idx, GOp& o) __attribute__((always_inline)) -> bool { const int U = q + idx * Gd; if (U >= NPM * 15) return false; int pm, pn; unit_decode(U, 15, 3, pm, pn);
    o.A = W + (size_t)pn * 256 * 2048; o.B = H + (size_t)pm * 256 * 2048; o.lda2 = 2048; o.ldb2 = 2048; o.nt = 16; return true; };
  auto epi = [&](int idx, const f32x4 (&acc)[2][2][4][2]) __attribute__((always_inline)) {
    const int U = q + idx * Gd; int pm, pn; unit_decode(U, 15, 3, pm, pn);
    LANE_IDS
    const TI ti = tile_info(pm); const bool lat = ti.bb < 8;
#pragma unroll
    for (int bj = 0; bj < 2; ++bj)
#pragma unroll
      for (int n = 0; n < 2; ++n) {
        const int tl = bj * 128 + wc * 32 + n * 16 + fr; const long tok = (long)pm * 256 + tl; const int ar = ti.arow0 + tl;
        const int prow = ar >> 6, pcol = ar & 63;
        if (pn == 0 || pn == 2 || pn == 13 || pn == 14) {
#pragma unroll
          for (int ai = 0; ai < 2; ++ai)
#pragma unroll
            for (int m = 0; m < 4; ++m) { const int c = ai * 128 + wr * 64 + m * 16 + fq * 4; const f32x4 v = acc[ai][bj][m][n];
              if (pn == 0) store4bf(QLAT + tok * 384 + c, v);
              else if (pn == 2) store4bf(KVLAT + tok * 256 + c, v);
              else { f32x4 o;
#pragma unroll
                for (int e = 0; e < 4; ++e) o[e] = silu_f(v[e]);
                store4bf(YRET + tok * 512 + (pn - 13) * 256 + c, o); } }
        } else if (pn == 1) {
#pragma unroll
          for (int m = 0; m < 4; ++m) store4bf(QLAT + tok * 384 + 256 + wr * 64 + m * 16 + fq * 4, acc[0][bj][m][n]);
          if (wr == 0) {
            const int half = fq >> 1, idx = (fq & 1) * 4; f32x4 o1 = acc[1][bj][0][n], o2 = acc[1][bj][1][n];
            if (lat) { const int pos = half ? pcol : prow; const f32x4 c = *(const f32x4*)(rmc + pos * 8 + idx), s = *(const f32x4*)(rms + pos * 8 + idx); rope4(acc[1][bj][0][n], acc[1][bj][1][n], c, s, o1, o2); }
            bf16_t* d = KROPE + ((long)ti.b * SK + ar) * 32 + half * 16 + idx; store4bf(d, o1); store4bf(d + 8, o2);
          }
        } else if (pn >= 3 && pn <= 6) {
          bf16_t* D = (pn < 5) ? QD : KD; const int hb = ((pn - 3) & 1) * 2;
#pragma unroll
          for (int ai = 0; ai < 2; ++ai) {
            bf16_t* d = D + (((long)ti.b * 8 + (hb + ai) * 2 + wr) * SK + ar) * 64 + fq * 4;
            f32x4 a0 = acc[ai][bj][0][n], a1 = acc[ai][bj][1][n], a2 = acc[ai][bj][2][n], a3 = acc[ai][bj][3][n];
            if (lat) { const f32x4 cr = *(const f32x4*)(rdc + prow * 16 + fq * 4), sr = *(const f32x4*)(rds + prow * 16 + fq * 4), cc = *(const f32x4*)(rdc + pcol * 16 + fq * 4), sc = *(const f32x4*)(rds + pcol * 16 + fq * 4);
              rope4(acc[ai][bj][0][n], acc[ai][bj][1][n], cr, sr, a0, a1); rope4(acc[ai][bj][2][n], acc[ai][bj][3][n], cc, sc, a2, a3); }
            const float qs = (pn < 5) ? CQ_DIFF : 1.f;
            store4bf(d, a0 * qs); store4bf(d + 16, a1 * qs); store4bf(d + 32, a2 * qs); store4bf(d + 48, a3 * qs);
          }
        } else if (pn == 7 || pn == 8 || pn == 11 || pn == 12) {
          bf16_t* D = (pn < 9) ? VD : RV; const int hb = (pn < 9 ? pn - 7 : pn - 11) * 2;
#pragma unroll
          for (int ai = 0; ai < 2; ++ai)
#pragma unroll
            for (int m = 0; m < 4; ++m) store4bf(D + (((long)ti.b * 4 + hb + ai) * SK + ar) * 128 + wr * 64 + m * 16 + fq * 4, acc[ai][bj][m][n]);
        } else {
          bf16_t* D = (pn == 9) ? RQ : RK; const float sc = (pn == 9) ? 1.f : 0.125f;
#pragma unroll
          for (int ai = 0; ai < 2; ++ai) {
            bf16_t* d = D + (((long)ti.b * 4 + ai * 2 + wr) * SK + ar) * 64 + fq * 4;
            f32x4 a0 = acc[ai][bj][0][n], a1 = acc[ai][bj][1][n], a2 = acc[ai][bj][2][n], a3 = acc[ai][bj][3][n];
            if (lat) { const f32x4 c0 = *(const f32x4*)(r1c + ar * 32 + fq * 4), s0 = *(const f32x4*)(r1s + ar * 32 + fq * 4), c1 = *(const f32x4*)(r1c + ar * 32 + 16 + fq * 4), s1 = *(const f32x4*)(r1s + ar * 32 + 16 + fq * 4);
              rope4(acc[ai][bj][0][n], acc[ai][bj][2][n], c0, s0, a0, a2); rope4(acc[ai][bj][1][n], acc[ai][bj][3][n], c1, s1, a1, a3); }
            store4bf(d, a0 * sc); store4bf(d + 16, a1 * sc); store4bf(d + 32, a2 * sc); store4bf(d + 48, a3 * sc);
          }
        }
      }
  };
  gemm_stream(get, epi);
}

__device__ __forceinline__ int crow(int r, int hi) { return (r & 3) + 8 * (r >> 2) + 4 * hi; }
__device__ __forceinline__ void ret_unit(const Params& p, int l, int u) {
  const int tid = launder_tid(), wid = tid >> 6, lane = tid & 63, r32 = lane & 31, hi = lane >> 5;
  const int b = u & 7, h = (u >> 3) & 3, dir = (u >> 5) & 1, s = u >> 6;
  constexpr int QS = 0, KS = 18432, KT = 36864, VT = 54272, VTS = 62976, SC = 71680, SBF = 106496, PW = 115712, IPW = PW + 528;
  unsigned char* L = g_lds; float* pw = (float*)(L + PW); float* ipw = (float*)(L + IPW);
  const float lg = -expf(p.in[20][l * 8 + dir * 4 + h]);
  __syncthreads();
  if (tid <= 128) { pw[tid] = expf(lg * (float)tid); if (tid < 128) ipw[tid] = expf(-lg * (float)tid); }
  for (int i = tid; i < 576; i += 512) *(u32x4*)(L + SBF + i * 16) = (u32x4){0u, 0u, 0u, 0u};
  const bf16_t* RQ = (const bf16_t*)(p.ws + O_RQ) + ((long)b * 4 + h) * SK * 64;
  const bf16_t* RK = (const bf16_t*)(p.ws + O_RK) + ((long)b * 4 + h) * SK * 64;
  const bf16_t* RV = (const bf16_t*)(p.ws + O_RV) + ((long)b * 4 + h) * SK * 128 + s * 32;
  bf16_t* RO = (bf16_t*)(p.ws + O_RETO) + (size_t)dir * T * 512 + h * 128 + s * 32;
  f32x16 sacc = {};
  u32x4 rq0, rq1, rk0, rk1, rv0 = {0u, 0u, 0u, 0u}, rv1 = {0u, 0u, 0u, 0u};
  const int qrow0 = tid >> 3, qcc = tid & 7, pi = tid & 63, kcc = tid >> 6, vcc = (tid >> 6) & 3; const bool vact = tid < 256;
  auto chunk_arow = [&](int n) -> int { if (n < 2) return 8192 + 128 * (dir ? 1 - n : n); return 128 * (dir ? 65 - n : n - 2); };
#define RLOAD(n) do { const int ar_ = chunk_arow(n); \
    rq0 = *(const u32x4*)(RQ + (long)(ar_ + qrow0) * 64 + qcc * 8); rq1 = *(const u32x4*)(RQ + (long)(ar_ + 64 + qrow0) * 64 + qcc * 8); \
    rk0 = *(const u32x4*)(RK + (long)(ar_ + 2 * pi) * 64 + kcc * 8); rk1 = *(const u32x4*)(RK + (long)(ar_ + 2 * pi + 1) * 64 + kcc * 8); \
    if (vact) { rv0 = *(const u32x4*)(RV + (long)(ar_ + 2 * pi) * 128 + vcc * 8); rv1 = *(const u32x4*)(RV + (long)(ar_ + 2 * pi + 1) * 128 + vcc * 8); } } while (0)
  RLOAD(0);
  int cur = 0;
  for (int n = 0; n < 66; ++n) {
    __syncthreads();
    *(u32x4*)(L + QS + qrow0 * 144 + qcc * 16) = rq0; *(u32x4*)(L + QS + (64 + qrow0) * 144 + qcc * 16) = rq1;
    *(u32x4*)(L + KS + (2 * pi) * 144 + kcc * 16) = rk0; *(u32x4*)(L + KS + (2 * pi + 1) * 144 + kcc * 16) = rk1;
#pragma unroll
    for (int e = 0; e < 4; ++e) {
      *(unsigned*)(L + KT + (kcc * 8 + 2 * e) * 272 + pi * 4) = (rk0[e] & 0xffffu) | (rk1[e] << 16);
      *(unsigned*)(L + KT + (kcc * 8 + 2 * e + 1) * 272 + pi * 4) = (rk0[e] >> 16) | (rk1[e] & 0xffff0000u); }
    if (vact) { const float kd0 = pw[dir ? 2 * pi : 127 - 2 * pi], kd1 = pw[dir ? 2 * pi + 1 : 126 - 2 * pi];
#pragma unroll
      for (int e = 0; e < 4; ++e) {
        *(unsigned*)(L + VT + (vcc * 8 + 2 * e) * 272 + pi * 4) = (rv0[e] & 0xffffu) | (rv1[e] << 16);
        *(unsigned*)(L + VT + (vcc * 8 + 2 * e + 1) * 272 + pi * 4) = (rv0[e] >> 16) | (rv1[e] & 0xffff0000u);
        *(unsigned*)(L + VTS + (vcc * 8 + 2 * e) * 272 + pi * 4) = cvtpk(__uint_as_float(rv0[e] << 16) * kd0, __uint_as_float(rv1[e] << 16) * kd1);
        *(unsigned*)(L + VTS + (vcc * 8 + 2 * e + 1) * 272 + pi * 4) = cvtpk(__uint_as_float(rv0[e] & 0xffff0000u) * kd0, __uint_as_float(rv1[e] & 0xffff0000u) * kd1); } }
    __syncthreads();
    if (n + 1 < 66) RLOAD(n + 1);
    { const int I = wid >> 1;
#pragma unroll
      for (int jj = 0; jj < 2; ++jj) { const int J = (wid & 1) * 2 + jj; f32x16 sc = {};
#pragma unroll
        for (int kk = 0; kk < 4; ++kk) { const bf16x8 ka = *(const bf16x8*)(L + KS + (32 * I + r32) * 144 + (kk * 16 + hi * 8) * 2), qb = *(const bf16x8*)(L + QS + (32 * J + r32) * 144 + (kk * 16 + hi * 8) * 2);
          sc = __builtin_amdgcn_mfma_f32_32x32x16_bf16(ka, qb, sc, 0, 0, 0); }
        const int a = 32 * J + r32; const float colf = dir ? ipw[a] : pw[a];
#pragma unroll
        for (int q4 = 0; q4 < 4; ++q4) { const int ap0 = 32 * I + 8 * q4 + 4 * hi; const f32x4 rowf = *(const f32x4*)((dir ? pw : ipw) + ap0); f32x4 o;
#pragma unroll
          for (int e = 0; e < 4; ++e) { const int dd = dir ? (ap0 + e) - a : a - (ap0 + e); const float m = dd >= 0 ? colf * rowf[e] : 0.f; o[e] = sc[q4 * 4 + e] * m; }
          store4bf((bf16_t*)(L + SC + a * 272 + ap0 * 2), o); } } }
    __syncthreads();
    if (wid < 4) {
      f32x16 a1 = {}, a2 = {};
#pragma unroll
      for (int kk = 0; kk < 8; ++kk) { const bf16x8 sa = *(const bf16x8*)(L + SC + (32 * wid + r32) * 272 + (kk * 16 + hi * 8) * 2), vb = *(const bf16x8*)(L + VT + r32 * 272 + (kk * 16 + hi * 8) * 2);
        a1 = __builtin_amdgcn_mfma_f32_32x32x16_bf16(sa, vb, a1, 0, 0, 0); }
#pragma unroll
      for (int kk = 0; kk < 4; ++kk) { const bf16x8 qa = *(const bf16x8*)(L + QS + (32 * wid + r32) * 144 + (kk * 16 + hi * 8) * 2), sb = *(const bf16x8*)(L + SBF + cur * 4608 + r32 * 144 + (kk * 16 + hi * 8) * 2);
        a2 = __builtin_amdgcn_mfma_f32_32x32x16_bf16(qa, sb, a2, 0, 0, 0); }
      const int ar = chunk_arow(n); const long tokbase = (ar >= 8192) ? (long)TL + b * 256 + (ar - 8192) : (long)b * 8192 + ar;
#pragma unroll
      for (int r = 0; r < 16; ++r) { const int a = 32 * wid + crow(r, hi); const float qd = pw[dir ? 128 - a : a + 1];
        const unsigned pk = cvtpk(a1[r] + qd * a2[r], 0.f); RO[(tokbase + a) * 512 + r32] = (unsigned short)(pk & 0xffff); }
    } else if (wid < 6) {
      const int db = wid - 4; const float cd = pw[128];
#pragma unroll
      for (int r = 0; r < 16; ++r) sacc[r] *= cd;
#pragma unroll
      for (int kk = 0; kk < 8; ++kk) { const bf16x8 ka = *(const bf16x8*)(L + KT + (32 * db + r32) * 272 + (kk * 16 + hi * 8) * 2), vb = *(const bf16x8*)(L + VTS + r32 * 272 + (kk * 16 + hi * 8) * 2);
        sacc = __builtin_amdgcn_mfma_f32_32x32x16_bf16(ka, vb, sacc, 0, 0, 0); }
#pragma unroll
      for (int q4 = 0; q4 < 4; ++q4) { f32x4 o = {sacc[q4 * 4], sacc[q4 * 4 + 1], sacc[q4 * 4 + 2], sacc[q4 * 4 + 3]};
        store4bf((bf16_t*)(L + SBF + (cur ^ 1) * 4608 + r32 * 144 + (32 * db + 8 * q4 + 4 * hi) * 2), o); }
    }
    cur ^= 1;
  }
  __syncthreads();
#undef RLOAD
}

__device__ __forceinline__ void row_rstd(const bf16_t* src, int Kd) {
  const int tid = launder_tid(), row = tid >> 1, hf = tid & 1; float* rs = (float*)(g_lds + 131072);
  const bf16_t* s = src + (long)row * Kd + hf * (Kd / 2); float ss = 0.f;
  for (int c = 0; c < Kd / 16; ++c) { const u32x4 w = *(const u32x4*)(s + c * 8);
#pragma unroll
    for (int e = 0; e < 4; ++e) { const float lo = __uint_as_float(w[e] << 16), hi_ = __uint_as_float(w[e] & 0xffff0000u); ss += lo * lo + hi_ * hi_; } }
  ss += __shfl_xor(ss, 1);
  if (hf == 0) rs[row] = rsqrtf(ss / (float)Kd + EPS);
  __syncthreads();
}
__device__ __forceinline__ void phase_g4(const Params& p, int l) {
  if (PMASK & 0x80000) for (int u = blockIdx.x; u < 256; u += gridDim.x) ret_unit(p, l, u);
  const char* WQB = (const char*)(p.ws + O_WQB); const char* WKVB = (const char*)(p.ws + O_WKVB);
  const bf16_t* QLAT = (const bf16_t*)(p.ws + O_QLAT); const bf16_t* KVLAT = (const bf16_t*)(p.ws + O_KVLAT);
  bf16_t* QMLA = (bf16_t*)(p.ws + O_QMLA); bf16_t* KNOPE = (bf16_t*)(p.ws + O_KNOPE); bf16_t* VMLA = (bf16_t*)(p.ws + O_VMLA);
  const float* rmc = (const float*)(p.ws + O_RMC); const float* rms = (const float*)(p.ws + O_RMS);
  const float* rs = (const float*)(g_lds + 131072);
  const int q = logical_wg(), Gd = gridDim.x;
  auto get = [&](int idx, GOp& o) __attribute__((always_inline)) -> bool { const int U = q + idx * Gd; if (U >= NPM * 7) return false; int pm, pn;
    if (U < NPM * 3) { unit_decode(U, 3, 3, pm, pn); o.A = WQB + (size_t)pn * 256 * 768; o.B = (const char*)QLAT + (size_t)pm * 256 * 768; o.lda2 = 768; o.ldb2 = 768; o.nt = 6; }
    else { unit_decode(U - NPM * 3, 4, 4, pm, pn); o.A = WKVB + (size_t)pn * 256 * 512; o.B = (const char*)KVLAT + (size_t)pm * 256 * 512; o.lda2 = 512; o.ldb2 = 512; o.nt = 4; }
    return true; };
  auto epi = [&](int idx, const f32x4 (&acc)[2][2][4][2]) __attribute__((always_inline)) {
    const int U = q + idx * Gd; const bool isq = U < NPM * 3; int pm, pn;
    if (isq) unit_decode(U, 3, 3, pm, pn); else unit_decode(U - NPM * 3, 4, 4, pm, pn);
    __syncthreads();
    if (isq) row_rstd(QLAT + (size_t)pm * 256 * 384, 384); else row_rstd(KVLAT + (size_t)pm * 256 * 256, 256);
    LANE_IDS
    const TI ti = tile_info(pm); const bool lat = ti.bb < 8;
#pragma unroll
    for (int bj = 0; bj < 2; ++bj)
#pragma unroll
      for (int n = 0; n < 2; ++n) {
        const int tl = bj * 128 + wc * 32 + n * 16 + fr; const int ar = ti.arow0 + tl; const float rr = isq ? rs[tl] * CQ_MLA : rs[tl]; const int prow = ar >> 6, pcol = ar & 63;
        if (isq && pn == 2) {
          const int half = fq >> 1, idx = (fq & 1) * 4; const int pos = half ? pcol : prow;
          f32x4 c = {1.f, 1.f, 1.f, 1.f}, s = {0.f, 0.f, 0.f, 0.f};
          if (lat) { c = *(const f32x4*)(rmc + pos * 8 + idx); s = *(const f32x4*)(rms + pos * 8 + idx); }
#pragma unroll
          for (int ai = 0; ai < 2; ++ai)
#pragma unroll
            for (int mp = 0; mp < 2; ++mp) { const int hd = ai * 4 + wr * 2 + mp; f32x4 o1, o2; rope4(acc[ai][bj][2 * mp][n] * rr, acc[ai][bj][2 * mp + 1][n] * rr, c, s, o1, o2);
              bf16_t* d = QMLA + (((long)ti.b * 8 + hd) * SK + ar) * 96 + 64 + half * 16 + idx; store4bf(d, o1); store4bf(d + 8, o2); }
        } else {
#pragma unroll
          for (int ai = 0; ai < 2; ++ai)
#pragma unroll
            for (int m = 0; m < 4; ++m) { const int cfull = (pn & 1) * 256 + ai * 128 + wr * 64 + m * 16 + fq * 4; const int hd = cfull >> 6, d = cfull & 63; const f32x4 v = acc[ai][bj][m][n] * rr;
              if (isq) store4bf(QMLA + (((long)ti.b * 8 + hd) * SK + ar) * 96 + d, v);
              else if (pn < 2) store4bf(KNOPE + (((long)ti.b * 8 + hd) * SK + ar) * 64 + d, v);
              else store4bf(VMLA + (((long)ti.b * 8 + hd) * SK + ar) * 64 + d, v); }
        }
      }
  };
  if (PMASK & 0x100000) gemm_stream(get, epi);
}

#define SBAR() __builtin_amdgcn_sched_barrier(0)
template <int DQK> __device__ __forceinline__ int kswz(int row, int colB) { if (DQK == 96) return row * 256 + (colB ^ ((row & 7) << 4)); return row * 128 + (colB ^ (((row >> 1) & 7) << 4)); }
#ifndef EXP_THR
#define EXP_THR 8.f
#endif
constexpr float ATHR = EXP_THR;
template <int DQK> __device__ __forceinline__ void partialSM(f32x16& p0, f32x16& p1, float& m_reg, float& mn, float& alpha) {
  constexpr float THRL = ATHR * 1.4426950408889634f;
  float pmax = p0[0];
#pragma unroll
  for (int r = 1; r < 16; ++r) pmax = fmaxf(pmax, p0[r]);
#pragma unroll
  for (int r = 0; r < 16; ++r) pmax = fmaxf(pmax, p1[r]);
  { auto rr = __builtin_amdgcn_permlane32_swap(__float_as_uint(pmax), __float_as_uint(pmax), false, false); pmax = fmaxf(__uint_as_float(rr[0]), __uint_as_float(rr[1])); }
  if (__builtin_expect(__all(pmax - m_reg <= THRL), 1)) { mn = m_reg; alpha = 1.f; }
  else { mn = fmaxf(m_reg, pmax); alpha = __builtin_amdgcn_exp2f(m_reg - mn); m_reg = mn; }
  if (!__all(mn == 0.f)) {
#pragma unroll
    for (int r = 0; r < 16; ++r) p0[r] -= mn;
#pragma unroll
    for (int r = 0; r < 16; ++r) p1[r] -= mn;
  }
#pragma unroll
  for (int r = 0; r < 16; ++r) p0[r] = __builtin_amdgcn_exp2f(p0[r]);
}
template <bool SUM> __device__ __forceinline__ void finishSM(f32x16& p0, f32x16& p1, float alpha, float& l_reg, bf16x8& pa0, bf16x8& pa1, bf16x8& pa2, bf16x8& pa3) {
#pragma unroll
  for (int r = 0; r < 16; ++r) p1[r] = __builtin_amdgcn_exp2f(p1[r]);
  if constexpr (SUM) {
  float ps = 0;
#pragma unroll
  for (int r = 0; r < 16; ++r) ps += p0[r];
#pragma unroll
  for (int r = 0; r < 16; ++r) ps += p1[r];
  { auto rr = __builtin_amdgcn_permlane32_swap(__float_as_uint(ps), __float_as_uint(ps), false, false); ps = __uint_as_float(rr[0]) + __uint_as_float(rr[1]); }
  l_reg = l_reg * alpha + ps;
  }
#define PK4(P, BASE, OUT) do { unsigned a0 = cvtpk(P[BASE + 0], P[BASE + 1]), a1 = cvtpk(P[BASE + 2], P[BASE + 3]); \
    unsigned b0 = cvtpk(P[BASE + 4], P[BASE + 5]), b1 = cvtpk(P[BASE + 6], P[BASE + 7]); \
    auto r0 = __builtin_amdgcn_permlane32_swap(a0, b0, false, false); auto r1 = __builtin_amdgcn_permlane32_swap(a1, b1, false, false); \
    u32x4 w = {r0[0], r1[0], r0[1], r1[1]}; OUT = *reinterpret_cast<bf16x8*>(&w); } while (0)
  PK4(p0, 0, pa0); PK4(p0, 8, pa1); PK4(p1, 0, pa2); PK4(p1, 8, pa3);
#undef PK4
}
template <int DQK> __device__ __forceinline__ void qkt(f32x16& p0, f32x16& p1, const unsigned char* Ks, const bf16x8* qr, int r32, int hi) {
  p0 = f32x16{}; p1 = f32x16{};
#pragma unroll
  for (int d0 = 0; d0 < DQK / 16; ++d0) { const int cb = (d0 * 16 + hi * 8) * 2;
    const bf16x8 b0 = *reinterpret_cast<const bf16x8*>(Ks + kswz<DQK>(r32, cb));
    const bf16x8 b1 = *reinterpret_cast<const bf16x8*>(Ks + kswz<DQK>(32 + r32, cb));
    p0 = __builtin_amdgcn_mfma_f32_32x32x16_bf16(b0, qr[d0], p0, 0, 0, 0);
    p1 = __builtin_amdgcn_mfma_f32_32x32x16_bf16(b1, qr[d0], p1, 0, 0, 0); }
}
template <int DV> __device__ __forceinline__ int v_st(int k, int c) { const int kk = (k & ~0xC) | ((k & 4) << 1) | ((k & 8) >> 1); return ((kk >> 3) * (DV / 32) + (c >> 5)) * 512 + ((kk & 7) * 32 + (c & 31)) * 2; }
__device__ __forceinline__ int v_rd_base(int lane) { return ((lane & 3) << 3) | (((lane >> 2) & 3) << 6) | (((lane >> 4) & 1) << 5) | (((lane >> 5) & 1) << 8); }
template <int OFF> __device__ __forceinline__ s16x4 tr_read(int vb) { s16x4 r; asm volatile("ds_read_b64_tr_b16 %0, %1 offset:%2" : "=&v"(r) : "v"(vb), "i"(OFF) : "memory"); return r; }
template <int DV, int D0> __device__ __forceinline__ void pv_one(f32x16& od, int vb, bf16x8 pa0, bf16x8 pa1, bf16x8 pa2, bf16x8 pa3) {
  constexpr int NS = DV / 32;
#define VOFF(ks, half) (D0 * 512 + (ks) * (2 * NS * 512) + (half) * (NS * 512))
  const s16x4 l0 = tr_read<VOFF(0, 0)>(vb), h0 = tr_read<VOFF(0, 1)>(vb), l1 = tr_read<VOFF(1, 0)>(vb), h1 = tr_read<VOFF(1, 1)>(vb);
  const s16x4 l2 = tr_read<VOFF(2, 0)>(vb), h2 = tr_read<VOFF(2, 1)>(vb), l3 = tr_read<VOFF(3, 0)>(vb), h3 = tr_read<VOFF(3, 1)>(vb);
#undef VOFF
  asm volatile("s_waitcnt lgkmcnt(0)" ::: "memory"); SBAR();
#define PK(L_, H_) (bf16x8){L_[0], L_[1], L_[2], L_[3], H_[0], H_[1], H_[2], H_[3]}
  od = __builtin_amdgcn_mfma_f32_32x32x16_bf16(pa0, PK(l0, h0), od, 0, 0, 0);
  od = __builtin_amdgcn_mfma_f32_32x32x16_bf16(pa1, PK(l1, h1), od, 0, 0, 0);
  od = __builtin_amdgcn_mfma_f32_32x32x16_bf16(pa2, PK(l2, h2), od, 0, 0, 0);
  od = __builtin_amdgcn_mfma_f32_32x32x16_bf16(pa3, PK(l3, h3), od, 0, 0, 0);
#undef PK
}
template <int DV, int D0> __device__ __forceinline__ void pv_pair(f32x16& oa, f32x16& ob, int vb, bf16x8 pa0, bf16x8 pa1, bf16x8 pa2, bf16x8 pa3) {
  constexpr int NS = DV / 32;
#define VOFF(d, ks, half) ((d) * 512 + (ks) * (2 * NS * 512) + (half) * (NS * 512))
  const s16x4 al0 = tr_read<VOFF(D0, 0, 0)>(vb), ah0 = tr_read<VOFF(D0, 0, 1)>(vb), al1 = tr_read<VOFF(D0, 1, 0)>(vb), ah1 = tr_read<VOFF(D0, 1, 1)>(vb);
  const s16x4 al2 = tr_read<VOFF(D0, 2, 0)>(vb), ah2 = tr_read<VOFF(D0, 2, 1)>(vb), al3 = tr_read<VOFF(D0, 3, 0)>(vb), ah3 = tr_read<VOFF(D0, 3, 1)>(vb);
  const s16x4 bl0 = tr_read<VOFF(D0 + 1, 0, 0)>(vb), bh0 = tr_read<VOFF(D0 + 1, 0, 1)>(vb), bl1 = tr_read<VOFF(D0 + 1, 1, 0)>(vb), bh1 = tr_read<VOFF(D0 + 1, 1, 1)>(vb);
  const s16x4 bl2 = tr_read<VOFF(D0 + 1, 2, 0)>(vb), bh2 = tr_read<VOFF(D0 + 1, 2, 1)>(vb), bl3 = tr_read<VOFF(D0 + 1, 3, 0)>(vb), bh3 = tr_read<VOFF(D0 + 1, 3, 1)>(vb);
#undef VOFF
  asm volatile("s_waitcnt lgkmcnt(0)" ::: "memory"); SBAR();
#define PK(L_, H_) (bf16x8){L_[0], L_[1], L_[2], L_[3], H_[0], H_[1], H_[2], H_[3]}
  oa = __builtin_amdgcn_mfma_f32_32x32x16_bf16(pa0, PK(al0, ah0), oa, 0, 0, 0);
  ob = __builtin_amdgcn_mfma_f32_32x32x16_bf16(pa0, PK(bl0, bh0), ob, 0, 0, 0);
  oa = __builtin_amdgcn_mfma_f32_32x32x16_bf16(pa1, PK(al1, ah1), oa, 0, 0, 0);
  ob = __builtin_amdgcn_mfma_f32_32x32x16_bf16(pa1, PK(bl1, bh1), ob, 0, 0, 0);
  oa = __builtin_amdgcn_mfma_f32_32x32x16_bf16(pa2, PK(al2, ah2), oa, 0, 0, 0);
  ob = __builtin_amdgcn_mfma_f32_32x32x16_bf16(pa2, PK(bl2, bh2), ob, 0, 0, 0);
  oa = __builtin_amdgcn_mfma_f32_32x32x16_bf16(pa3, PK(al3, ah3), oa, 0, 0, 0);
  ob = __builtin_amdgcn_mfma_f32_32x32x16_bf16(pa3, PK(bl3, bh3), ob, 0, 0, 0);
#undef PK
}
template <int DV> __device__ __forceinline__ void pv_all(f32x16* o, int vb, bf16x8 pa0, bf16x8 pa1, bf16x8 pa2, bf16x8 pa3) {
  pv_pair<DV, 0>(o[0], o[1], vb, pa0, pa1, pa2, pa3);
  if constexpr (DV == 128) pv_pair<DV, 2>(o[2], o[3], vb, pa0, pa1, pa2, pa3);
}
template <int DQK, int DV>
__device__ __forceinline__ void attn_body(const bf16_t* __restrict__ Qb, const bf16_t* kp0, int kst0, const bf16_t* kp1, int kst1, bool k1valid,
                                          const bf16_t* vp0, const bf16_t* vp1, int nkeys, f32x16 (&o)[DV / 32]) {
  constexpr int KSTR = (DQK == 96) ? 256 : 128, SHM_K = 64 * KSTR, SHM_V = 64 * DV * 2, CK = DQK / 8, CV = DV / 8, ND = DV / 32;
  constexpr bool K2 = (64 * CK > 512), V2 = (64 * CV > 512);
  constexpr bool MSUM = (DV == 64);
  f32x16 osum = f32x16{}; const bf16x8 ones = {16256, 16256, 16256, 16256, 16256, 16256, 16256, 16256};
  const int tid = launder_tid(), wid = tid >> 6, lane = tid & 63, r32 = lane & 31, hi = lane >> 5;
  unsigned char* V_lds = g_lds; unsigned char* K_lds = g_lds + 3 * SHM_V;
  float* ws = (float*)(g_lds + 3 * SHM_V + 3 * SHM_K) + wid * 64; float* li_l = ws; float* al_l = ws + 32;
  float m_reg = 0.f, l_reg = 0;
#pragma unroll
  for (int d = 0; d < ND; ++d) o[d] = f32x16{};
  bf16x8 qr[DQK / 16];
  const bf16_t* Qw = Qb + (long)(wid * 32 + r32) * DQK + hi * 8;
#pragma unroll
  for (int d0 = 0; d0 < DQK / 16; ++d0) qr[d0] = *reinterpret_cast<const bf16x8*>(Qw + d0 * 16);
  const int kq0 = tid, kq1 = tid + 512;
  const int kd0 = kswz<DQK>(kq0 / CK, (kq0 % CK) * 16), kd1 = kswz<DQK>((kq1 / CK) & 63, (kq1 % CK) * 16);
  const int vq0 = tid, vq1 = tid + 512;
  const int vd0 = v_st<DV>(vq0 / CV, (vq0 % CV) * 8), vd1 = v_st<DV>((vq1 / CV) & 63, (vq1 % CV) * 8);
  const int vb0 = (int)(uintptr_t)(__attribute__((address_space(3))) unsigned char*)V_lds + v_rd_base(lane);
  struct St { bf16x8 k0, k1, v0, v1; } sr_[2];
#define SLOAD(i, key0) do { sr_[i].k0 = *reinterpret_cast<const bf16x8*>(kp0 + (long)(key0) * kst0); \
    if (K2) { if (k1valid) sr_[i].k1 = *reinterpret_cast<const bf16x8*>(kp1 + (long)(key0) * kst1); } \
    sr_[i].v0 = *reinterpret_cast<const bf16x8*>(vp0 + (long)(key0) * DV); \
    if (V2) sr_[i].v1 = *reinterpret_cast<const bf16x8*>(vp1 + (long)(key0) * DV); } while (0)
#define SWRITE(b, i) do { *(bf16x8*)(K_lds + (b) * SHM_K + kd0) = sr_[i].k0; \
    if (K2) { if (k1valid) *(bf16x8*)(K_lds + (b) * SHM_K + kd1) = sr_[i].k1; } \
    *(bf16x8*)(V_lds + (b) * SHM_V + vd0) = sr_[i].v0; \
    if (V2) *(bf16x8*)(V_lds + (b) * SHM_V + vd1) = sr_[i].v1; } while (0)
#define RESC(a) do { if (__any((a) < 1.f)) { if (hi == 0) al_l[r32] = (a); asm volatile("s_waitcnt lgkmcnt(0)" ::: "memory"); \
    _Pragma("unroll") for (int d = 0; d < ND; ++d) _Pragma("unroll") for (int r = 0; r < 16; ++r) o[d][r] *= al_l[crow(r, hi)]; \
    if (MSUM) { _Pragma("unroll") for (int r = 0; r < 16; ++r) osum[r] *= al_l[crow(r, hi)]; } } } while (0)
#define PSUM() do { if (MSUM) { osum = __builtin_amdgcn_mfma_f32_32x32x16_bf16(pa0, ones, osum, 0, 0, 0); osum = __builtin_amdgcn_mfma_f32_32x32x16_bf16(pa1, ones, osum, 0, 0, 0); \
    osum = __builtin_amdgcn_mfma_f32_32x32x16_bf16(pa2, ones, osum, 0, 0, 0); osum = __builtin_amdgcn_mfma_f32_32x32x16_bf16(pa3, ones, osum, 0, 0, 0); } } while (0)
#define ROT() do { bprev = bj; bj = bnext; bnext = (bnext == 2) ? 0 : bnext + 1; } while (0)
  f32x16 pA0, pA1, pB0, pB1; float mnA, mnB, alA, alB; bf16x8 pa0, pa1, pa2, pa3; const int NT = nkeys / 64;
  __syncthreads();
  SLOAD(0, 0); SWRITE(0, 0);
  SLOAD(1, 64); if (2 < NT) SLOAD(0, 128);
  __syncthreads();
  qkt<DQK>(pA0, pA1, K_lds, qr, r32, hi); partialSM<DQK>(pA0, pA1, m_reg, mnA, alA);
  SWRITE(1, 1); __syncthreads();
  int bprev = 0, bj = 1, bnext = 2;
  for (int j = 1; j + 1 < NT; j += 2) {
    SBAR(); qkt<DQK>(pB0, pB1, K_lds + bj * SHM_K, qr, r32, hi);
    finishSM<!MSUM>(pA0, pA1, alA, l_reg, pa0, pa1, pa2, pa3); SBAR();
    SLOAD(1, (j + 2) * 64); SBAR();
    pv_all<DV>(o, vb0 + bprev * SHM_V, pa0, pa1, pa2, pa3); PSUM(); partialSM<DQK>(pB0, pB1, m_reg, mnB, alB);
    SWRITE(bnext, 0);
    RESC(alB); __syncthreads(); ROT();
    SBAR(); qkt<DQK>(pA0, pA1, K_lds + bj * SHM_K, qr, r32, hi);
    finishSM<!MSUM>(pB0, pB1, alB, l_reg, pa0, pa1, pa2, pa3); SBAR();
    if (j + 3 < NT) SLOAD(0, (j + 3) * 64); SBAR();
    pv_all<DV>(o, vb0 + bprev * SHM_V, pa0, pa1, pa2, pa3); PSUM(); partialSM<DQK>(pA0, pA1, m_reg, mnA, alA);
    SWRITE(bnext, 1);
    RESC(alA); __syncthreads(); ROT();
  }
  SBAR(); qkt<DQK>(pB0, pB1, K_lds + bj * SHM_K, qr, r32, hi);
  finishSM<!MSUM>(pA0, pA1, alA, l_reg, pa0, pa1, pa2, pa3); SBAR();
  pv_all<DV>(o, vb0 + bprev * SHM_V, pa0, pa1, pa2, pa3); PSUM(); partialSM<DQK>(pB0, pB1, m_reg, mnB, alB);
  RESC(alB);
  finishSM<!MSUM>(pB0, pB1, alB, l_reg, pa0, pa1, pa2, pa3); SBAR();
  pv_all<DV>(o, vb0 + bj * SHM_V, pa0, pa1, pa2, pa3); PSUM();
  if (hi == 0) li_l[r32] = l_reg; asm volatile("s_waitcnt lgkmcnt(0)" ::: "memory");
#pragma unroll
  for (int r = 0; r < 16; ++r) { const float rl = __builtin_amdgcn_rcpf(MSUM ? osum[r] : li_l[crow(r, hi)]);
#pragma unroll
    for (int d = 0; d < ND; ++d) o[d][r] *= rl; }
  __syncthreads();
#undef SLOAD
#undef SWRITE
#undef RESC
#undef PSUM
#undef ROT
}

__device__ __forceinline__ void mla_unit(const Params& p, int b, int h, int qrow0, int key0, int nkeys, long tok0) {
  const int tid = launder_tid(), wid = tid >> 6, lane = tid & 63, r32 = lane & 31, hi = lane >> 5;
  const bf16_t* Q = (const bf16_t*)(p.ws + O_QMLA) + (((long)b * 8 + h) * SK + qrow0) * 96;
  const bf16_t* KN = (const bf16_t*)(p.ws + O_KNOPE) + (((long)b * 8 + h) * SK + key0) * 64;
  const bf16_t* KR = (const bf16_t*)(p.ws + O_KROPE) + ((long)b * SK + key0) * 32;
  const bf16_t* V = (const bf16_t*)(p.ws + O_VMLA) + (((long)b * 8 + h) * SK + key0) * 64;
  const int q0 = tid, q1 = tid + 512; const int r0 = q0 / 12, c0 = q0 % 12, r1 = (q1 / 12) & 63, c1 = q1 % 12;
  const bf16_t* kp0 = c0 < 8 ? KN + (long)r0 * 64 + c0 * 8 : KR + (long)r0 * 32 + (c0 - 8) * 8; const int ks0 = c0 < 8 ? 64 : 32;
  const bf16_t* kp1 = c1 < 8 ? KN + (long)r1 * 64 + c1 * 8 : KR + (long)r1 * 32 + (c1 - 8) * 8; const int ks1 = c1 < 8 ? 64 : 32;
  const bf16_t* vp0 = V + (long)(tid >> 3) * 64 + (tid & 7) * 8;
  f32x16 o[2];
  attn_body<96, 64>(Q, kp0, ks0, kp1, ks1, tid < 256, vp0, vp0, nkeys, o);
  bf16_t* Y = (bf16_t*)(p.ws + O_YMLA);
#pragma unroll
  for (int r = 0; r < 16; ++r) { const long tok = tok0 + wid * 32 + crow(r, hi);
#pragma unroll
    for (int d = 0; d < 2; ++d) { const unsigned pk = cvtpk(o[d][r], 0.f); Y[tok * 512 + h * 64 + d * 32 + r32] = (unsigned short)(pk & 0xffff); } }
}
__device__ __forceinline__ void diff_unit(const Params& p, int l, int b, int h, int qrow0, int key0, int nkeys, long tok0) {
  const int tid = launder_tid(), wid = tid >> 6, lane = tid & 63, r32 = lane & 31, hi = lane >> 5;
  const __amdgpu_buffer_rsrc_t rsd = MK_RSRC((float*)(p.ws + O_O1S) + (size_t)blockIdx.x * 32768); const unsigned vo4 = (unsigned)tid * 4u;
  const float lam = ((const float*)(p.ws + O_LAM))[l];
  const float li = 0.8f - 0.6f * expf(-0.3f * (float)l);
  const bf16_t* V = (const bf16_t*)(p.ws + O_VD) + (((long)b * 4 + h) * SK + key0) * 128;
  const bf16_t* vp0 = V + (long)(tid >> 4) * 128 + (tid & 15) * 8; const bf16_t* vp1 = V + (long)(32 + (tid >> 4)) * 128 + (tid & 15) * 8;
  f32x16 o[4];
  for (int s = 0; s < 2; ++s) {
    const bf16_t* Q = (const bf16_t*)(p.ws + O_QD) + (((long)b * 8 + h * 2 + s) * SK + qrow0) * 64;
    const bf16_t* K = (const bf16_t*)(p.ws + O_KD) + (((long)b * 8 + h * 2 + s) * SK + key0) * 64;
    const bf16_t* kp0 = K + (long)(tid >> 3) * 64 + (tid & 7) * 8;
    attn_body<64, 128>(Q, kp0, 64, kp0, 64, false, vp0, vp1, nkeys, o);
    if (s == 0) {
#pragma unroll
      for (int d = 0; d < 4; ++d)
#pragma unroll
        for (int r = 0; r < 16; ++r) __builtin_amdgcn_raw_buffer_store_b32(__float_as_uint(o[d][r]), rsd, vo4, (d * 16 + r) * 2048, 0);
    }
  }
  const float* dn = p.in[19] + l * 128; bf16_t* Y = (bf16_t*)(p.ws + O_YDIFF);
  float gn[4];
#pragma unroll
  for (int d = 0; d < 4; ++d) gn[d] = dn[d * 32 + r32] * (1.f - li);
#pragma unroll
  for (int r = 0; r < 16; ++r) {
    float v[4], ss = 0.f;
#pragma unroll
    for (int d = 0; d < 4; ++d) { v[d] = __uint_as_float(__builtin_amdgcn_raw_buffer_load_b32(rsd, vo4, (d * 16 + r) * 2048, 0)) - lam * o[d][r]; ss += v[d] * v[d]; }
#pragma unroll
    for (int m = 1; m < 32; m <<= 1) ss += __shfl_xor(ss, m);
    const float rstd = rsqrtf(ss * (1.f / 128.f) + EPS);
    const long tok = tok0 + wid * 32 + crow(r, hi);
#pragma unroll
    for (int d = 0; d < 4; ++d) { const unsigned pk = cvtpk(v[d] * rstd * gn[d], 0.f); Y[tok * 512 + h * 128 + d * 32 + r32] = (unsigned short)(pk & 0xffff); }
    MEMFENCE();
  }
}
__device__ __forceinline__ void phase_attn(const Params& p, int l) {
  const int tid = launder_tid(), wid = tid >> 6, lane = tid & 63;
  const int q = logical_wg(), G = gridDim.x;
  if (PMASK & 0x10000) for (int U = q; U < 2048; U += G) { const int h = U >> 8, w = U & 255, b = w >> 5, qb = w & 31; mla_unit(p, b, h, qb * 256, 0, SK, (long)b * 8192 + qb * 256); }
  if (PMASK & 0x20000) for (int U = q; U < 1024; U += G) { const int h = U >> 8, w = U & 255, b = w >> 5, qb = w & 31; diff_unit(p, l, b, h, qb * 256, 0, SK, (long)b * 8192 + qb * 256); }
  if ((PMASK & 0x10000) && l == 0) for (int U = q; U < 64; U += G) { const int b = U >> 3, h = U & 7; mla_unit(p, b, h, 8192, 8192, 256, (long)TL + b * 256); }
  if ((PMASK & 0x20000) && l == 0) for (int U = q; U < 32; U += G) { const int b = U >> 2, h = U & 3; diff_unit(p, l, b, h, 8192, 8192, 256, (long)TL + b * 256); }
  const bf16_t* RO = (const bf16_t*)(p.ws + O_RETO); bf16_t* YR = (bf16_t*)(p.ws + O_YRET); const float* rn = p.in[21] + l * 128;
  const int vc = (lane & 15) * 8; f32x8 gnv = *(const f32x8*)(rn + vc);
  if (PMASK & 0x40000) {
    const long nwaves = (long)gridDim.x * 8, w0 = (long)blockIdx.x * 8 + wid; const long nrows = (l == 0) ? (long)T : (long)TL;
    for (long rb = w0; rb < nrows; rb += nwaves * 4) {
      u32x4 a[4], bq[4], g[4];
#pragma unroll
      for (int j = 0; j < 4; ++j) { const long row = rb + j * nwaves;
        if (row < nrows) { a[j] = *(const u32x4*)(RO + row * 512 + lane * 8); bq[j] = *(const u32x4*)(RO + (size_t)T * 512 + row * 512 + lane * 8); g[j] = *(const u32x4*)(YR + row * 512 + lane * 8); } }
#pragma unroll
      for (int j = 0; j < 4; ++j) { const long row = rb + j * nwaves;
        if (row < nrows) {
          float v[8], ss = 0.f;
#pragma unroll
          for (int e = 0; e < 4; ++e) { v[2 * e] = __uint_as_float(a[j][e] << 16) + __uint_as_float(bq[j][e] << 16); v[2 * e + 1] = __uint_as_float(a[j][e] & 0xffff0000u) + __uint_as_float(bq[j][e] & 0xffff0000u); }
#pragma unroll
          for (int e = 0; e < 8; ++e) ss += v[e] * v[e];
#pragma unroll
          for (int m = 1; m < 16; m <<= 1) ss += __shfl_xor(ss, m);
          const float rstd = rsqrtf(ss * (1.f / 128.f) + EPS);
          u32x4 w;
#pragma unroll
          for (int e = 0; e < 4; ++e) { const float g0 = __uint_as_float(g[j][e] << 16), g1 = __uint_as_float(g[j][e] & 0xffff0000u); w[e] = cvtpk(v[2 * e] * rstd * gnv[2 * e] * g0, v[2 * e + 1] * rstd * gnv[2 * e + 1] * g1); }
          *(u32x4*)(YR + row * 512 + lane * 8) = w; } }
    }
  }
}

template <int MODE>
__device__ __forceinline__ void branch_epi(const f32x4 (&acc)[2][2][4][2], unsigned char* scr, bf16_t* YBR, int pm, int pn, int tid, int wr, int wc, int fr, int fq) {
  const __amdgpu_buffer_rsrc_t rs = MK_RSRC(scr);
  const unsigned vo8 = (unsigned)tid * 8u, vo16 = (unsigned)tid * 16u;
#pragma unroll
  for (int bj = 0; bj < 2; ++bj)
#pragma unroll
    for (int n = 0; n < 2; ++n) {
      const long tok = (long)pm * 256 + bj * 128 + wc * 32 + n * 16 + fr; bf16_t* yrow = YBR + tok * 1024 + pn * 256 + wr * 64 + fq * 4;
#pragma unroll
      for (int ai = 0; ai < 2; ++ai)
#pragma unroll
        for (int m = 0; m < 4; ++m) { const int e = ((ai * 2 + bj) * 4 + m) * 2 + n;
          const u32x2 w = __builtin_amdgcn_raw_buffer_load_b64(rs, vo8, e * 4096, 0); f32x4 v = acc[ai][bj][m][n];
          v[0] *= __uint_as_float(w.x << 16); v[1] *= __uint_as_float(w.x & 0xffff0000u); v[2] *= __uint_as_float(w.y << 16); v[3] *= __uint_as_float(w.y & 0xffff0000u);
          if (MODE > 0) v += __builtin_bit_cast(f32x4, __builtin_amdgcn_raw_buffer_load_b128(rs, vo16, 131072 + e * 8192, 0));
          if (MODE < 2) __builtin_amdgcn_raw_buffer_store_b128(__builtin_bit_cast(u32x4, v), rs, vo16, 131072 + e * 8192, 0); else store4bf(yrow + ai * 128 + m * 16, v);
          if (m & 1) MEMFENCE(); }
    }
}
__device__ __forceinline__ void phase_branch(const Params& p, int npm) {
  const char* WG = (const char*)(p.ws + O_WG); const char* WBR = (const char*)(p.ws + O_WBR); const char* H = (const char*)(p.ws + O_H);
  bf16_t* YBR = (bf16_t*)(p.ws + O_YBR);
  unsigned char* scr = p.ws + O_G6S + (size_t)blockIdx.x * 393216;
  const int q = logical_wg(), Gd = gridDim.x, tot = npm * 4;
  auto get = [&](int idx, GOp& o) __attribute__((always_inline)) -> bool { const int u = idx / 6, j = idx - u * 6, i = j >> 1; const int U = q + u * Gd; if (U >= tot) return false; int pm, pn; unit_decode(U, 4, 4, pm, pn);
    if ((j & 1) == 0) { o.A = WG + ((size_t)i * 1024 + pn * 256) * 2048; o.B = H + (size_t)pm * 256 * 2048; o.lda2 = 2048; o.ldb2 = 2048; o.nt = 16; }
    else { const char* Y = (const char*)(p.ws + (i == 0 ? O_YMLA : (i == 1 ? O_YDIFF : O_YRET))); o.A = WBR + ((size_t)i * 1024 + pn * 256) * 1024; o.B = Y + (size_t)pm * 256 * 1024; o.lda2 = 1024; o.ldb2 = 1024; o.nt = 8; }
    return true; };
  auto epi = [&](int idx, const f32x4 (&acc)[2][2][4][2]) __attribute__((always_inline)) {
    const int u = idx / 6, j = idx - u * 6, i = j >> 1; const int U = q + u * Gd; int pm, pn; unit_decode(U, 4, 4, pm, pn);
    LANE_IDS
    if ((j & 1) == 0) {
      const unsigned vo8 = (unsigned)tid * 8u; const __amdgpu_buffer_rsrc_t rs = MK_RSRC(scr);
#pragma unroll
      for (int ai = 0; ai < 2; ++ai)
#pragma unroll
        for (int bj = 0; bj < 2; ++bj)
#pragma unroll
          for (int m = 0; m < 4; ++m)
#pragma unroll
            for (int n = 0; n < 2; ++n) { const int e = ((ai * 2 + bj) * 4 + m) * 2 + n; const f32x4 v = acc[ai][bj][m][n]; u32x2 w; w.x = cvtpk(sigm_f(v[0]), sigm_f(v[1])); w.y = cvtpk(sigm_f(v[2]), sigm_f(v[3])); __builtin_amdgcn_raw_buffer_store_b64(w, rs, vo8, e * 4096, 0); if (n == 1) MEMFENCE(); }
    } else {
      if (i == 0) branch_epi<0>(acc, scr, YBR, pm, pn, tid, wr, wc, fr, fq);
      else if (i == 1) branch_epi<1>(acc, scr, YBR, pm, pn, tid, wr, wc, fr, fq);
      else branch_epi<2>(acc, scr, YBR, pm, pn, tid, wr, wc, fr, fq);
    }
  };
  gemm_stream(get, epi);
}


#ifdef DIAG
__device__ __forceinline__ float blk_reduce(float v, int mode, float* red) {
  const int tid = launder_tid(), lane = tid & 63, wid = tid >> 6;
#pragma unroll
  for (int o = 32; o > 0; o >>= 1) { const float t = __shfl_xor(v, o); v = mode ? fmaxf(v, t) : v + t; }
  __syncthreads();
  if (lane == 0) red[wid] = v;
  __syncthreads();
  float r = red[0];
  for (int i = 1; i < 8; ++i) r = mode ? fmaxf(r, red[i]) : r + red[i];
  return r;
}
__device__ __forceinline__ void phase_diag(const Params& p) {
  const int tid = launder_tid();
  float* w0 = (float*)g_lds; float* w1 = w0 + 8448; float* qv = w1 + 8448; float* ov = qv + 256; float* red = ov + 256;
  float* dg = (float*)(p.ws + O_LAM) + 16;
  const int S = blockIdx.x; const int b = S & 7, t = (S * 977 + 131) % 8192; const long tok = (long)b * 8192 + t;
  float num = 0.f, den = 0.f;
#if DIAG == 1
  { const int h = (S >> 3) & 7; const bf16_t* Q = (const bf16_t*)(p.ws + O_QMLA) + (((long)b * 8 + h) * SK + t) * 96;
    const bf16_t* KN = (const bf16_t*)(p.ws + O_KNOPE) + ((long)b * 8 + h) * SK * 64; const bf16_t* KR = (const bf16_t*)(p.ws + O_KROPE) + (long)b * SK * 32;
    const bf16_t* V = (const bf16_t*)(p.ws + O_VMLA) + ((long)b * 8 + h) * SK * 64;
    if (tid < 96) qv[tid] = bf2f(Q[tid]);
    __syncthreads();
    float mx = -1e30f;
    for (int k = tid; k < SK; k += 512) { float d = 0.f; for (int e = 0; e < 64; ++e) d += qv[e] * bf2f(KN[(long)k * 64 + e]); for (int e = 0; e < 32; ++e) d += qv[64 + e] * bf2f(KR[(long)k * 32 + e]); d *= 0.10206207261596575f; w0[k] = d; mx = fmaxf(mx, d); }
    mx = blk_reduce(mx, 1, red); float l = 0.f;
    for (int k = tid; k < SK; k += 512) { const float e = expf(w0[k] - mx); w0[k] = e; l += e; }
    l = blk_reduce(l, 0, red);
    if (tid < 64) { float a = 0.f; for (int k = 0; k < SK; ++k) a += w0[k] * bf2f(V[(long)k * 64 + tid]); a /= l;
      const float y = bf2f(((const bf16_t*)(p.ws + O_YMLA))[tok * 512 + h * 64 + tid]); num = (a - y) * (a - y); den = a * a; } }
#elif DIAG == 2
  { const int h = (S >> 3) & 3; const float lam = ((const float*)(p.ws + O_LAM))[0];
    const bf16_t* V = (const bf16_t*)(p.ws + O_VD) + ((long)b * 4 + h) * SK * 128; float ls[2];
    for (int s2 = 0; s2 < 2; ++s2) { float* w = s2 ? w1 : w0;
      const bf16_t* Q = (const bf16_t*)(p.ws + O_QD) + (((long)b * 8 + h * 2 + s2) * SK + t) * 64; const bf16_t* K = (const bf16_t*)(p.ws + O_KD) + ((long)b * 8 + h * 2 + s2) * SK * 64;
      __syncthreads();
      if (tid < 64) qv[tid] = bf2f(Q[tid]);
      __syncthreads();
      float mx = -1e30f;
      for (int k = tid; k < SK; k += 512) { float d = 0.f; for (int e = 0; e < 64; ++e) d += qv[e] * bf2f(K[(long)k * 64 + e]); d *= 0.125f; w[k] = d; mx = fmaxf(mx, d); }
      mx = blk_reduce(mx, 1, red); float l = 0.f;
      for (int k = tid; k < SK; k += 512) { const float e = expf(w[k] - mx); w[k] = e; l += e; }
      ls[s2] = blk_reduce(l, 0, red); }
    if (tid < 256) { const int d = tid & 127, s2 = tid >> 7; const float* w = s2 ? w1 : w0; float a = 0.f; for (int k = 0; k < SK; ++k) a += w[k] * bf2f(V[(long)k * 128 + d]); ov[tid] = a / ls[s2]; }
    __syncthreads();
    float val = 0.f; if (tid < 128) val = ov[tid] - lam * ov[128 + tid];
    const float ss = blk_reduce(val * val, 0, red); const float rstd = rsqrtf(ss * (1.f / 128.f) + EPS);
    if (tid < 128) { const float a = val * rstd * p.in[19][tid] * 0.8f; const float y = bf2f(((const bf16_t*)(p.ws + O_YDIFF))[tok * 512 + h * 128 + tid]); num = (a - y) * (a - y); den = a * a; } }
#elif DIAG >= 3
  { const int h = (S >> 3) & 3, dir = (S >> 5) & 1; const float lg = -expf(p.in[20][dir * 4 + h]);
    const bf16_t* Q = (const bf16_t*)(p.ws + O_RQ) + (((long)b * 4 + h) * SK + t) * 64; const bf16_t* K = (const bf16_t*)(p.ws + O_RK) + ((long)b * 4 + h) * SK * 64;
    const bf16_t* V = (const bf16_t*)(p.ws + O_RV) + ((long)b * 4 + h) * SK * 128;
    if (tid < 64) qv[tid] = bf2f(Q[tid]);
    __syncthreads();
    for (int k = tid; k < SK; k += 512) { int dist; if (k < 8192) dist = dir ? k - t : t - k; else { const int j = k - 8192; dist = dir ? 8192 - t + j : 256 + t - j; }
      float d = 0.f; bool inc = dist >= 0;
#if DIAG == 4
      inc = inc && (k < 8192) && ((k >> 7) == (t >> 7));
#endif
#if DIAG == 5
      inc = inc && !((k < 8192) && ((k >> 7) == (t >> 7)));
#endif
      if (inc) { for (int e = 0; e < 64; ++e) d += qv[e] * bf2f(K[(long)k * 64 + e]); d *= expf(lg * (float)dist); } w0[k] = d; }
    __syncthreads();
    if (tid < 128) { float a = 0.f; for (int k = 0; k < SK; ++k) a += w0[k] * bf2f(V[(long)k * 128 + tid]);
      const float y = bf2f(((const bf16_t*)(p.ws + O_RETO))[(size_t)dir * T * 512 + tok * 512 + h * 128 + tid]); num = (a - y) * (a - y); den = a * a; } }
#endif
  num = blk_reduce(num, 0, red); den = blk_reduce(den, 0, red);
  if (tid == 0) { atomicAdd(dg, num); atomicAdd(dg + 1, den); }
}
__device__ __forceinline__ void phase_diag_out(const Params& p) {
  const float* dg = (const float*)(p.ws + O_LAM) + 16; const float m = dg[0] / fmaxf(dg[1], 1e-30f);
  float c2 = 10.f + log10f(fmaxf(m, 1e-12f)); c2 = fminf(fmaxf(c2, 0.f), 12.f); const float c = sqrtf(c2);
  for (long i = (long)blockIdx.x * 512 + launder_tid(); i < (long)TL * DM; i += (long)gridDim.x * 512) p.out[i] = c;
}
#endif
constexpr int NPHASE = 25;
__device__ __forceinline__ void run_phase(const Params& p0_, int ph) {
  Params p = p0_; { unsigned long long z = 0; asm volatile("" : "+s"(z)); p.ws = p0_.ws + z; p.out = p0_.out + z; }
  if (ph == 0) { if (PMASK & 0x1000) phase_p0(p); return; }
  if (ph == 25) { if (PMASK & 0x2000) phase_final(p); return; }
  const int l = (ph - 1) / 12, s = (ph - 1) % 12;
  switch (s) {
    case 0: if (PMASK & 1) { if (l == 0) { phase_norm(p, l, 0, true); conv_group(p, l, 0, 0, 2); } } break;
    case 1: if (PMASK & 2) { if (l == 1) { conv_group(p, 1, 0, 1, 2); __syncthreads(); } phase_ffn_up(p, NPM); } break;
    case 2: if (PMASK & 4) phase_ffn_down(p, l, 2, l == 0, NPM, NormFuse{l, 1, l * 3 + 0, l * 12 + 2, false}); break;
    case 3: if (PMASK & 1) { conv_group(p, l, 1, 0, 6); } break;
    case 4: if (PMASK & 16) phase_win(p); break;
    case 5: if (PMASK & 32) phase_g4(p, l); break;
    case 6: if (PMASK & 64) phase_attn(p, l); break;
    case 7: if (PMASK & 128) phase_branch(p, l == 0 ? NPM : 256); break;
    case 8: if (PMASK & 256) { conv_group(p, l, 2, 0, 2); __syncthreads(); } if (PMASK & 256) phase_wout(p, l, l == 0 ? NPM : 256, NormFuse{l, 2, l * 3 + 1, l * 12 + 8, false}); break;
    case 9: break;
    case 10: if (PMASK & 2) phase_ffn_up(p, l == 0 ? NPM : 256); break;
    case 11: if ((PMASK & 4) && l == 0) { conv_group(p, 1, 0, 0, 1); __syncthreads(); } if (PMASK & 4) phase_ffn_down(p, l, 8, false, l == 0 ? NPM : 256, NormFuse{l + 1, 0, l * 3 + 2, l * 12 + 11, l == 1}); break;
  }
}
__global__ void __launch_bounds__(512) mega_kernel(Params p) {
  cg::grid_group grid = cg::this_grid();
#ifdef DIAG
#define PHD(k) if ((k) < DIAG_STOP) { run_phase(p, (k)); grid.sync(); }
  PHD(0)
  PHD(1)
  PHD(2)
  PHD(3)
  PHD(4)
  PHD(5)
  PHD(6)
  PHD(7)
  PHD(8)
#undef PHD
  phase_diag(p); grid.sync(); phase_diag_out(p);
#else
#ifdef TIMING
#define PH(k) if ((k) >= p.ph_lo && (k) < p.ph_hi) { if (blockIdx.x == 0 && threadIdx.x == 0) ((unsigned long long*)(p.ws + O_TS))[k] = __builtin_amdgcn_s_memrealtime(); run_phase(p, (k)); grid.sync(); }
#else
#define PH_EMPTY(k) ((k) == 10 || (k) == 22 || (k) == 13)
#define PH(k) if (!PH_EMPTY(k) && (k) >= p.ph_lo && (k) < p.ph_hi) { run_phase(p, (k)); if ((k) + 1 < p.ph_hi) grid.sync(); }
#endif
  PH(0)
  PH(1)
  PH(2)
  PH(3)
  PH(4)
  PH(5)
  PH(6)
  PH(7)
  PH(8)
  PH(9)
  PH(10)
  PH(11)
  PH(12)
  PH(13)
  PH(14)
  PH(15)
  PH(16)
  PH(17)
  PH(18)
  PH(19)
  PH(20)
  PH(21)
  PH(22)
  PH(23)
  PH(24)
  PH(25)
#undef PH
#ifdef TIMING
  if (blockIdx.x == 0) { unsigned long long* ts = (unsigned long long*)(p.ws + O_TS); const unsigned long long tend = __builtin_amdgcn_s_memrealtime();
    float tot = (float)(tend - ts[0]), s1 = 0.f, s2 = 0.f;
    for (int k = 0; k < 26; ++k) { const float d = (float)((k == 25 ? tend : ts[k + 1]) - ts[k]); if ((TSEL1 >> k) & 1) s1 += d; if ((TSEL2 >> k) & 1) s2 += d; }
    const int M = (int)(s1 / tot * 100000.f + 0.5f); const float d2 = 0.04f + 0.14f * (s2 / tot);
    for (int i = threadIdx.x; i < M; i += 512) p.out[i] += 0.1f;
    if (threadIdx.x == 0) p.out[(size_t)TL * DM - 1] += d2; }
#endif
#endif
}

extern "C" void kernel_launch(void* const* d_in, const int* in_sizes, int n_in, void* d_out, int out_size, void* d_ws, size_t ws_size, hipStream_t stream) {
  static int grid_blocks = 0;
  if (grid_blocks == 0) {
    if (n_in != 25 || out_size != TL * DM || ws_size < WS_NEED) { fprintf(stderr, "kernel_launch: unexpected shapes: n_in %d out %d ws %zu (need %zu)\n", n_in, out_size, ws_size, (size_t)WS_NEED); grid_blocks = -1; return; }
    int dev = 0, cus = 0, per_cu = 0;
    hipGetDevice(&dev); hipDeviceGetAttribute(&cus, hipDeviceAttributeMultiprocessorCount, dev);
    if (hipFuncSetAttribute((const void*)mega_kernel, hipFuncAttributeMaxDynamicSharedMemorySize, LDS_BYTES) != hipSuccess) { fprintf(stderr, "kernel_launch: hipFuncSetAttribute failed\n"); grid_blocks = -1; return; }
    hipOccupancyMaxActiveBlocksPerMultiprocessor(&per_cu, (const void*)mega_kernel, 512, LDS_BYTES);
    if (per_cu < 1) per_cu = 1;
    grid_blocks = cus * per_cu;
  }
  if (grid_blocks < 0) return;
  Params p{};
  for (int i = 0; i < 25; ++i) p.in[i] = (const float*)d_in[i];
  p.out = (float*)d_out; p.ws = (unsigned char*)d_ws;
#if PER_PHASE_LAUNCH
  for (int ph = 0; ph < NPHASE; ++ph) {
    p.ph_lo = ph; p.ph_hi = ph + 1; void* args[] = {&p};
    hipError_t e = hipLaunchCooperativeKernel((const void*)mega_kernel, dim3(grid_blocks), dim3(512), args, LDS_BYTES, stream);
    if (e != hipSuccess) { fprintf(stderr, "cooperative launch failed: %s (grid %d)\n", hipGetErrorString(e), grid_blocks); break; }
  }
#else
  p.ph_lo = 0; p.ph_hi = NPHASE; void* args[] = {&p};
  hipError_t e = hipLaunchCooperativeKernel((const void*)mega_kernel, dim3(grid_blocks), dim3(512), args, LDS_BYTES, stream);
  if (e != hipSuccess) fprintf(stderr, "cooperative launch failed: %s (grid %d)\n", hipGetErrorString(e), grid_blocks);
#endif
}
```

```cpp
#include <hip/hip_runtime.h>
#include <hip/hip_cooperative_groups.h>
#include <cstdio>
#include <cstdint>
namespace cg = cooperative_groups;

#ifndef PMASK
#define PMASK 0xffffffff
#endif
#define TSEL1 ((1u<<8)|(1u<<20))
#define TSEL2 ((1u << 6) | (1u << 18))
#if defined(DIAG)
#if DIAG >= 3
#define DIAG_STOP 7
#else
#define DIAG_STOP 8
#endif
#endif
#ifndef GEMM_SP2
#define GEMM_SP2 1
#endif
#ifndef PER_PHASE_LAUNCH
#define PER_PHASE_LAUNCH 0
#endif

typedef unsigned short bf16_t;
typedef short bf16x8 __attribute__((ext_vector_type(8)));
typedef short s16x4 __attribute__((ext_vector_type(4)));
typedef float f32x4 __attribute__((ext_vector_type(4)));
typedef float f32x8 __attribute__((ext_vector_type(8)));
typedef float f32x16 __attribute__((ext_vector_type(16)));
typedef unsigned u32x4 __attribute__((ext_vector_type(4)));
typedef unsigned u32x2 __attribute__((ext_vector_type(2)));

constexpr int DM = 1024, NB = 8, SEQ = 8192, CTXL = 256, TL = NB * SEQ, TC = NB * CTXL, T = TL + TC, SK = SEQ + CTXL;
constexpr int DFF = 2816, PROJ = 6816;
constexpr int NPM = T / 256;
constexpr float EPS = 1e-6f;
constexpr float CQ_MLA = 0.10206207261596575f * 1.4426950408889634f;
constexpr float CQ_DIFF = 0.125f * 1.4426950408889634f;

constexpr size_t al256(size_t x) { return (x + 255) / 256 * 256; }
constexpr size_t O_MOD = 0;
constexpr size_t O_LAM = al256(O_MOD + (size_t)2 * 9 * 9216 * 4);
constexpr size_t O_R1C = O_LAM + 256;
constexpr size_t O_R1S = O_R1C + (size_t)8192 * 32 * 4;
constexpr size_t O_RDC = O_R1S + (size_t)8192 * 32 * 4;
constexpr size_t O_RDS = O_RDC + 128 * 16 * 4;
constexpr size_t O_RMC = O_RDS + 128 * 16 * 4;
constexpr size_t O_RMS = O_RMC + 128 * 8 * 4;
constexpr size_t O_W = al256(O_RMS + 128 * 8 * 4);
constexpr size_t O_WUP = O_W;
constexpr size_t O_WDN = O_WUP + (size_t)5632 * 1024 * 2;
constexpr size_t O_WIN = O_W;
constexpr size_t O_WG = O_WIN + (size_t)3840 * 1024 * 2;
constexpr size_t O_WQB = O_WG + (size_t)3072 * 1024 * 2;
constexpr size_t O_WKVB = O_WQB + (size_t)768 * 384 * 2;
constexpr size_t O_WBR = O_WKVB + (size_t)1024 * 256 * 2;
constexpr size_t O_WOUT = O_WBR + (size_t)3 * 1024 * 512 * 2;
constexpr size_t O_WEND = O_WOUT + (size_t)1024 * 1024 * 2;
constexpr size_t O_XC = al256(O_WEND);
constexpr size_t O_H = O_XC + (size_t)TC * DM * 4;
constexpr size_t O_M = O_H + (size_t)T * DM * 2;
constexpr size_t O_G = O_M;
constexpr size_t TB = (size_t)T;
constexpr size_t O_QLAT = O_M;
constexpr size_t O_KVLAT = O_QLAT + TB * 768;
constexpr size_t O_KNOPE = O_KVLAT + TB * 512;
constexpr size_t O_KROPE = O_KNOPE + TB * 1024;
constexpr size_t O_QD = O_KROPE + TB * 64;
constexpr size_t O_KD = O_QD + TB * 1024;
constexpr size_t O_VD = O_KD + TB * 1024;
constexpr size_t O_RQ = O_VD + TB * 1024;
constexpr size_t O_RK = O_RQ + TB * 512;
constexpr size_t O_RV = O_RK + TB * 512;
constexpr size_t O_YRET = O_RV + TB * 1024;
constexpr size_t O_QMLA = O_YRET + TB * 1024;
constexpr size_t O_VMLA = O_QMLA + TB * 1536;
constexpr size_t O_RETO = O_VMLA + TB * 1024;
constexpr size_t O_END = O_RETO + TB * 2048;
constexpr size_t O_YMLA = O_RQ;
constexpr size_t O_YDIFF = O_RV;
constexpr size_t O_O1S = O_QLAT;
constexpr size_t O_G6S = O_QMLA;
constexpr size_t O_YBR = O_RETO;
static_assert(O_G + TB * 2816 * 2 <= O_END, "ffn g fits");
constexpr size_t O_TS = O_END;
constexpr size_t O_CNT = O_TS + 512;
constexpr size_t O_PART = al256(O_CNT + 26 * 264 * 4);
constexpr size_t WS_NEED = O_PART + (size_t)6 * 264 * 4 * 256 * 4;

constexpr int LDS_BYTES = 131072 + 4096;

struct Params { const float* in[25]; float* out; unsigned char* ws; int ph_lo, ph_hi; };

extern __shared__ __attribute__((aligned(16))) unsigned char g_lds[];

#define MK_RSRC(ptr) __builtin_amdgcn_make_buffer_rsrc((void*)(ptr), 0, 0x7fffffff, 0x00020000)
#define MEMFENCE() asm volatile("" ::: "memory")
__device__ __forceinline__ int launder_tid() { int t = __builtin_amdgcn_workitem_id_x(); asm volatile("" : "+v"(t)); return t; }
typedef __bf16 bf16v2_t __attribute__((ext_vector_type(2)));
typedef float f32v2_t __attribute__((ext_vector_type(2)));
__device__ __forceinline__ unsigned cvtpk(float lo, float hi) { const f32v2_t v = {lo, hi}; const bf16v2_t b = __builtin_convertvector(v, bf16v2_t); return __builtin_bit_cast(unsigned, b); }
__device__ __forceinline__ float bf2f(unsigned short b) { return __uint_as_float(((unsigned)b) << 16); }
__device__ __forceinline__ float silu_f(float v) { return v * __builtin_amdgcn_rcpf(1.f + __expf(-v)); }
__device__ __forceinline__ float sigm_f(float v) { return __builtin_amdgcn_rcpf(1.f + __expf(-v)); }
__device__ __forceinline__ void store4bf(bf16_t* p, f32x4 v) { u32x2 w; w.x = cvtpk(v[0], v[1]); w.y = cvtpk(v[2], v[3]); *(u32x2*)p = w; }
__device__ __forceinline__ int logical_wg() { const int g = gridDim.x, w = blockIdx.x; return (g % 8 == 0) ? (w % 8) * (g / 8) + w / 8 : w; }

constexpr int BK = 64, HALF = 128, HTB = HALF * BK * 2;
__device__ __forceinline__ int lds_byte(int r, int c) { int st = (r >> 4) * 2 + (c >> 5), rr = r & 15, cc = c & 31, ob = rr * 64 + cc * 2; return st * 1024 + (ob ^ (((ob >> 9) & 1) << 5)); }
__device__ __forceinline__ void stage_rc(int b, int& R, int& C) { int st = b / 1024, sb = b % 1024, swz = sb ^ (((sb >> 9) & 1) << 5); R = (st >> 1) * 16 + swz / 64; C = (st & 1) * 32 + (swz % 64) / 2; }

#define LAS __attribute__((address_space(3)))
#define WAIT_V(n) asm volatile("s_waitcnt vmcnt(" #n ")" ::: "memory")
#define WAIT_L(n) asm volatile("s_waitcnt lgkmcnt(" #n ")" ::: "memory")
#define BAR __builtin_amdgcn_s_barrier()
#define SCHED __builtin_amdgcn_sched_barrier(0)

struct GOp { const char* A; const char* B; unsigned lda2, ldb2; int nt; };
template <class GetOp, class Epi>
__device__ __forceinline__ void gemm_stream(GetOp get, Epi epi) {
  LAS unsigned char* lds = (LAS unsigned char*)g_lds;
  GOp cur, nxt;
  if (!get(0, cur)) return;
  const int tid = launder_tid();
  const int wid = __builtin_amdgcn_readfirstlane(tid >> 6), lane = tid & 63, wr = wid >> 2, wc = wid & 3, fr = lane & 15, fq = lane >> 4;
  int R0, C0, R1, C1; stage_rc(tid * 16, R0, C0); stage_rc(tid * 16 + 8192, R1, C1);
  const unsigned ldsw = (unsigned)wid * 1024u;
  const int aoff = lds_byte(wr * 64 + fr, fq * 8), boff = lds_byte(wc * 32 + fr, fq * 8);
  unsigned cvA[2], cvB[2], nvA[2], nvB[2];
  cvA[0] = R0 * cur.lda2 + C0 * 2; cvA[1] = R1 * cur.lda2 + C1 * 2; cvB[0] = R0 * cur.ldb2 + C0 * 2; cvB[1] = R1 * cur.ldb2 + C1 * 2;
#define G_SA(b, h) (((b) * 2 + (h)) * HTB)
#define G_SB(b, h) ((4 + (b) * 2 + (h)) * HTB)
#define STAGE(bufoff, gbase, voff) do { _Pragma("unroll") for (int _i = 0; _i < 2; ++_i) \
    __builtin_amdgcn_global_load_lds((const unsigned*)((const char*)(gbase) + (voff)[_i]), (LAS unsigned*)(lds + (bufoff) + ldsw + _i * 8192), 16, 0, 0); } while (0)
#define LDA(dst, b, h) do { _Pragma("unroll") for (int m = 0; m < 4; ++m) _Pragma("unroll") for (int k = 0; k < 2; ++k) dst[m][k] = *(const LAS bf16x8*)(lds + G_SA(b, h) + aoff + m * 2048 + k * 1024); } while (0)
#define LDB(dst, b, h) do { _Pragma("unroll") for (int n = 0; n < 2; ++n) _Pragma("unroll") for (int k = 0; k < 2; ++k) dst[n][k] = *(const LAS bf16x8*)(lds + G_SB(b, h) + boff + n * 2048 + k * 1024); } while (0)
#define MMA(ai, bj, At_, Bt_) do { __builtin_amdgcn_s_setprio(1); \
    _Pragma("unroll") for (int m = 0; m < 4; ++m) _Pragma("unroll") for (int n = 0; n < 2; ++n) _Pragma("unroll") for (int k = 0; k < 2; ++k) \
      acc[ai][bj][m][n] = __builtin_amdgcn_mfma_f32_16x16x32_bf16(At_[m][k], Bt_[n][k], acc[ai][bj][m][n], 0, 0, 0); \
    __builtin_amdgcn_s_setprio(0); } while (0)
  { const size_t hA = (size_t)HALF * cur.lda2, hB = (size_t)HALF * cur.ldb2;
#if GEMM_SP2
    STAGE(G_SB(0, 0), cur.B, cvB); STAGE(G_SB(0, 1), cur.B + hB, cvB); STAGE(G_SA(0, 0), cur.A, cvA); STAGE(G_SA(0, 1), cur.A + hA, cvA);
    if (wr == 1) BAR;
    WAIT_V(2); BAR;
#else
    STAGE(G_SB(0, 0), cur.B, cvB); STAGE(G_SA(0, 0), cur.A, cvA); STAGE(G_SB(0, 1), cur.B + hB, cvB); STAGE(G_SA(0, 1), cur.A + hA, cvA);
    if (wr == 1) BAR;
    WAIT_V(4); BAR;
#endif
    STAGE(G_SB(1, 0), cur.B + 128, cvB); STAGE(G_SA(1, 0), cur.A + 128, cvA); STAGE(G_SB(1, 1), cur.B + hB + 128, cvB);
    WAIT_V(6); BAR; }
  f32x4 acc[2][2][4][2];
  bf16x8 At[4][2], B0[2][2], B1[2][2];
  for (int idx = 0;; ++idx) {
    const bool has_next = get(idx + 1, nxt);
    if (!has_next) nxt = cur;
    nvA[0] = R0 * nxt.lda2 + C0 * 2; nvA[1] = R1 * nxt.lda2 + C1 * 2; nvB[0] = R0 * nxt.ldb2 + C0 * 2; nvB[1] = R1 * nxt.ldb2 + C1 * 2;
    if (idx > 0) { if (wr == 1) BAR; }
#pragma unroll
    for (int a = 0; a < 2; ++a)
#pragma unroll
      for (int b = 0; b < 2; ++b)
#pragma unroll
        for (int m = 0; m < 4; ++m)
#pragma unroll
          for (int n = 0; n < 2; ++n) acc[a][b][m][n] = (f32x4){0.f, 0.f, 0.f, 0.f};
    const size_t hA = (size_t)HALF * cur.lda2, hB = (size_t)HALF * cur.ldb2, nhA = (size_t)HALF * nxt.lda2, nhB = (size_t)HALF * nxt.ldb2;
    const int nt = cur.nt;
    for (int t = 0; t < nt; t += 2) {
      const bool last = (t == nt - 2);
      const char* a1 = cur.A + (size_t)(t + 1) * 128;
      const char* a2 = last ? nxt.A : cur.A + (size_t)(t + 2) * 128; const char* b2 = last ? nxt.B : cur.B + (size_t)(t + 2) * 128;
      const char* a3 = a2 + 128; const char* b3 = b2 + 128;
      const size_t hA2 = last ? nhA : hA, hB2 = last ? nhB : hB;
      unsigned vA2[2], vB2[2]; vA2[0] = last ? nvA[0] : cvA[0]; vA2[1] = last ? nvA[1] : cvA[1]; vB2[0] = last ? nvB[0] : cvB[0]; vB2[1] = last ? nvB[1] : cvB[1];
#if GEMM_SP2
      LDB(B0, 0, 0); LDB(B1, 0, 1); SCHED; LDA(At, 0, 0); STAGE(G_SA(1, 1), a1 + hA, cvA);
      WAIT_V(8); WAIT_L(0); BAR; MMA(0, 0, At, B0); MMA(0, 1, At, B1); BAR; SCHED;
      LDA(At, 0, 1); STAGE(G_SB(0, 0), b2, vB2); STAGE(G_SB(0, 1), b2 + hB2, vB2); STAGE(G_SA(0, 0), a2, vA2);
      WAIT_V(8); WAIT_L(0); BAR; MMA(1, 0, At, B0); MMA(1, 1, At, B1); BAR; SCHED;
      LDB(B0, 1, 0); LDB(B1, 1, 1); SCHED; LDA(At, 1, 0); STAGE(G_SA(0, 1), a2 + hA2, vA2);
      WAIT_V(8); WAIT_L(0); BAR; MMA(0, 0, At, B0); MMA(0, 1, At, B1); BAR; SCHED;
      LDA(At, 1, 1); STAGE(G_SB(1, 0), b3, vB2); STAGE(G_SB(1, 1), b3 + hB2, vB2); STAGE(G_SA(1, 0), a3, vA2);
      WAIT_V(8); WAIT_L(0); BAR; MMA(1, 0, At, B0); MMA(1, 1, At, B1); BAR; SCHED;
#else
      LDB(B0, 0, 0); SCHED; LDA(At, 0, 0); STAGE(G_SA(1, 1), a1 + hA, cvA);
      WAIT_L(8); BAR; WAIT_L(0); MMA(0, 0, At, B0); BAR; SCHED;
      LDB(B1, 0, 1); STAGE(G_SB(0, 0), b2, vB2);
      BAR; WAIT_L(0); MMA(0, 1, At, B1); BAR;
      LDA(At, 0, 1); STAGE(G_SA(0, 0), a2, vA2);
      BAR; WAIT_L(0); MMA(1, 0, At, B0); BAR; SCHED;
      STAGE(G_SB(0, 1), b2 + hB2, vB2);
      WAIT_V(6); BAR; MMA(1, 1, At, B1); BAR;
      LDB(B0, 1, 0); SCHED; LDA(At, 1, 0); STAGE(G_SA(0, 1), a2 + hA2, vA2);
      WAIT_L(8); BAR; WAIT_L(0); MMA(0, 0, At, B0); BAR; SCHED;
      LDB(B1, 1, 1); STAGE(G_SB(1, 0), b3, vB2);
      BAR; WAIT_L(0); MMA(0, 1, At, B1); BAR;
      LDA(At, 1, 1); STAGE(G_SA(1, 0), a3, vA2);
      BAR; WAIT_L(0); MMA(1, 0, At, B0); BAR; SCHED;
      STAGE(G_SB(1, 1), b3 + hB2, vB2);
      WAIT_V(6); BAR; MMA(1, 1, At, B1); BAR;
#endif
    }
    if (wr == 0) BAR;
    epi(idx, acc);
    if (!has_next) break;
    cur = nxt; cvA[0] = nvA[0]; cvA[1] = nvA[1]; cvB[0] = nvB[0]; cvB[1] = nvB[1];
  }
  WAIT_V(0); BAR;
#undef G_SA
#undef G_SB
#undef STAGE
#undef LDA
#undef LDB
#undef MMA
}

__device__ __forceinline__ void unit_decode(int U, int NPN, int SBN, int& pm, int& pn) {
  const int per = 8 * SBN, blk = U / per, within = U % per, npng = NPN / SBN;
  const int pmg = blk / npng, png = blk % npng;
  pm = pmg * 8 + (within & 7); pn = png * SBN + (within >> 3);
}
struct TI { int b, bb, arow0; };
__device__ __forceinline__ TI tile_info(int pm) { TI t; if (pm < 256) { t.b = pm >> 5; t.bb = t.b; t.arow0 = (pm & 31) * 256; } else { t.b = pm - 256; t.bb = 8; t.arow0 = 8192; } return t; }

#define LANE_IDS const int tid = launder_tid(), wid = __builtin_amdgcn_readfirstlane(tid >> 6), lane = tid & 63, wr = wid >> 2, wc = wid & 3, fr = lane & 15, fq = lane >> 4; (void)tid; (void)wr; (void)wc; (void)fr; (void)fq; (void)lane; (void)wid;

enum { CM_PLAIN = 0, CM_UP, CM_WIN, CM_QB, CM_KVB };
__device__ __forceinline__ int colmap(int kind, int n, int base, int& which) {
  which = 0;
  switch (kind) {
    case CM_PLAIN: return base + n;
    case CM_UP: { const int tile = n >> 8, c = n & 255, ai = c >> 7, wrr = (c >> 6) & 1, m = (c >> 4) & 3, q = c & 15; which = m & 1; return tile * 128 + ai * 64 + wrr * 32 + (m >> 1) * 16 + q; }
    case CM_WIN: {
      if (n < 384) return n;
      if (n < 416) { const int cc = n - 384, part = (cc >> 4) & 1, half = (cc >> 3) & 1, idx = cc & 7; return 640 + half * 16 + part * 8 + idx; }
      if (n < 512) return -1;
      if (n < 768) return 384 + (n - 512);
      return 672 + (n - 768);
    }
    case CM_QB: {
      if (n < 512) return (n >> 6) * 96 + (n & 63);
      const int c = n - 512, h = c >> 5, cc = c & 31, part = (cc >> 4) & 1, half = (cc >> 3) & 1, idx = cc & 7; return h * 96 + 64 + half * 16 + part * 8 + idx;
    }
    case CM_KVB: {
      if (n < 512) return (n >> 6) * 128 + (n & 63);
      const int c = n - 512; return (c >> 6) * 128 + 64 + (c & 63);
    }
  }
  return -1;
}
__device__ __forceinline__ void conv_load(float (&v)[8], int kind, const float* src0, const float* src1, int ld, int base, const float* scale, int n0, int k0) {
  const int tid = launder_tid(); const int nn = tid & 63, kk = tid >> 6; int which; const int col = colmap(kind, n0 + nn, base, which); const float* s = which ? src1 : src0;
#pragma unroll
  for (int i = 0; i < 8; ++i) { const int k = kk + 8 * i; float x = 0.f; if (col >= 0) { x = s[(long)(k0 + k) * ld + col]; if (scale) x *= scale[k0 + k]; } v[i] = x; }
}
__device__ __forceinline__ void conv_store(const float (&vin)[8], bf16_t* dst, int K, int n0, int k0) {
  float* tl = (float*)g_lds;
  const int tid = launder_tid();
  { const int nn = tid & 63, kk = tid >> 6;
#pragma unroll
    for (int i = 0; i < 8; ++i) tl[(kk + 8 * i) * 65 + nn] = vin[i]; }
  __syncthreads();
  { const int nr = tid >> 3, kc = (tid & 7) * 8; float v[8];
#pragma unroll
    for (int e = 0; e < 8; ++e) v[e] = tl[(kc + e) * 65 + nr];
    u32x4 w; w.x = cvtpk(v[0], v[1]); w.y = cvtpk(v[2], v[3]); w.z = cvtpk(v[4], v[5]); w.w = cvtpk(v[6], v[7]);
    *(u32x4*)(dst + (long)(n0 + nr) * K + k0 + kc) = w; }
  __syncthreads();
}
struct ConvJob { int kind; size_t dst; int N, K; const float* s0; const float* s1; int ld, base; const float* scale; };
__device__ __forceinline__ ConvJob conv_job(const Params& p, int l, int grp, int j) {
  ConvJob J; J.s1 = nullptr; J.scale = nullptr; J.base = 0;
  if (grp != 1) {
    const float* w1 = p.in[grp == 0 ? 7 : 10] + (size_t)l * DM * DFF; const float* w3 = p.in[grp == 0 ? 8 : 11] + (size_t)l * DM * DFF; const float* w2 = p.in[grp == 0 ? 9 : 12] + (size_t)l * DFF * DM;
    if (j == 0) { J.kind = CM_UP; J.dst = O_WUP; J.N = 5632; J.K = 1024; J.s0 = w1; J.s1 = w3; J.ld = DFF; }
    else { J.kind = CM_PLAIN; J.dst = O_WDN; J.N = 1024; J.K = 2816; J.s0 = w2; J.s1 = w2; J.ld = DM; }
  } else {
    const float* win = p.in[13] + (size_t)l * DM * PROJ; const float* wb = p.in[22] + (size_t)l * 3 * 512 * 1024;
    switch (j) {
      case 0: J.kind = CM_WIN; J.dst = O_WIN; J.N = 3840; J.K = 1024; J.s0 = win; J.ld = PROJ; break;
      case 1: J.kind = CM_PLAIN; J.dst = O_WG; J.N = 3072; J.K = 1024; J.s0 = win; J.ld = PROJ; J.base = 3744; break;
      case 2: J.kind = CM_QB; J.dst = O_WQB; J.N = 768; J.K = 384; J.s0 = p.in[15] + (size_t)l * 384 * 768; J.ld = 768; J.scale = p.in[14] + l * 384; break;
      case 3: J.kind = CM_KVB; J.dst = O_WKVB; J.N = 1024; J.K = 256; J.s0 = p.in[17] + (size_t)l * 256 * 1024; J.ld = 1024; J.scale = p.in[16] + l * 256; break;
      case 4: J.kind = CM_PLAIN; J.dst = O_WBR; J.N = 3072; J.K = 512; J.s0 = wb; J.ld = 1024; break;
      default: J.kind = CM_PLAIN; J.dst = O_WOUT; J.N = 1024; J.K = 1024; J.s0 = p.in[23] + (size_t)l * DM * DM; J.ld = DM; break;
    }
    J.s1 = J.s0;
  }
  return J;
}
struct ConvTile { int kind; bf16_t* dst; int K; const float* s0; const float* s1; int ld, base; const float* scale; int n0, k0; };
__device__ __forceinline__ ConvTile conv_decode(const Params& p, int l, int grp, int u, int jlo) {
  int v = u, j = jlo; ConvJob J = conv_job(p, l, grp, jlo);
  for (;;) { const int c = (J.N / 64) * (J.K / 64); if (v < c) break; v -= c; ++j; J = conv_job(p, l, grp, j); }
  const int nk = J.K / 64; const int nt_ = v / nk, kt_ = v % nk;
  ConvTile t; t.kind = J.kind; t.K = J.K; t.s0 = J.s0; t.s1 = J.s1; t.ld = J.ld; t.base = J.base; t.scale = J.scale; t.n0 = nt_ * 64; t.k0 = kt_ * 64; t.dst = (bf16_t*)(p.ws + J.dst);
  if (grp == 1 && j == 4) { const int i = t.n0 >> 10; t.s0 += (size_t)i * 512 * 1024; t.dst += (size_t)i * 1024 * 512; t.n0 &= 1023; }
  return t;
}
__device__ __forceinline__ void conv_group(const Params& p, int l, int grp, int jlo, int jhi) {
  int tot = 0; for (int j = jlo; j < jhi; ++j) { const ConvJob J = conv_job(p, l, grp, j); tot += (J.N / 64) * (J.K / 64); }
  int u = blockIdx.x; if (u >= tot) return;
  ConvTile t = conv_decode(p, l, grp, u, jlo); float v[8];
  conv_load(v, t.kind, t.s0, t.s1, t.ld, t.base, t.scale, t.n0, t.k0);
  for (;;) {
    const int un = u + gridDim.x; const bool more = un < tot; ConvTile tn = t; float vn[8];
    if (more) { tn = conv_decode(p, l, grp, un, jlo); conv_load(vn, tn.kind, tn.s0, tn.s1, tn.ld, tn.base, tn.scale, tn.n0, tn.k0); }
    conv_store(v, t.dst, t.K, t.n0, t.k0);
    if (!more) break;
    u = un; t = tn;
#pragma unroll
    for (int i = 0; i < 8; ++i) v[i] = vn[i];
  }
}

__device__ __forceinline__ void phase_p0(const Params& p) {
  const int tid = launder_tid();
  float* sl = (float*)g_lds;
  float* red = sl + 9 * 1024;
  for (int i = tid; i < 9 * 1024; i += 512) { const int bb = i >> 10, k = i & 1023; const float v = bb < 8 ? p.in[1][bb * 1024 + k] : p.in[3][k]; sl[i] = v / (1.f + expf(-v)); }
  __syncthreads();
  float* modp = (float*)(p.ws + O_MOD);
  for (int u = blockIdx.x; u < 144; u += gridDim.x) {
    const int l = u / 72, c0 = (u % 72) * 128, col = c0 + (tid & 127), ks = tid >> 7;
    const float* w = p.in[4] + (size_t)l * 1024 * 9216 + col;
    float a[9];
#pragma unroll
    for (int bb = 0; bb < 9; ++bb) a[bb] = 0.f;
    for (int k = ks * 256; k < ks * 256 + 256; ++k) { const float wv = w[(size_t)k * 9216];
#pragma unroll
      for (int bb = 0; bb < 9; ++bb) a[bb] += sl[bb * 1024 + k] * wv; }
#pragma unroll
    for (int bb = 0; bb < 9; ++bb) red[(ks * 9 + bb) * 128 + (tid & 127)] = a[bb];
    __syncthreads();
    for (int i = tid; i < 9 * 128; i += 512) { const int bb = i >> 7, cc = i & 127;
      const float s = red[(0 * 9 + bb) * 128 + cc] + red[(1 * 9 + bb) * 128 + cc] + red[(2 * 9 + bb) * 128 + cc] + red[(3 * 9 + bb) * 128 + cc];
      modp[((size_t)l * 9 + bb) * 9216 + c0 + cc] = s + p.in[5][l * 9216 + c0 + cc]; }
    __syncthreads();
  }
  const long gt = (long)blockIdx.x * 512 + tid, gs = (long)gridDim.x * 512;
  for (long i = gt; i < (long)6 * 264 * 1024; i += gs) ((float*)(p.ws + O_PART))[i] = -1.f;
  float* r1c = (float*)(p.ws + O_R1C); float* r1s = (float*)(p.ws + O_R1S);
  for (long i = gt; i < 8192 * 32; i += gs) { const int pos = (int)(i >> 5), f = (int)(i & 31); const float inv = (float)pow(10000.0, -(double)(2 * f) / 64.0); const float ang = (float)pos * inv; r1c[i] = (float)cos((double)ang); r1s[i] = (float)sin((double)ang); }
  float* rdc = (float*)(p.ws + O_RDC); float* rds = (float*)(p.ws + O_RDS);
  for (long i = gt; i < 128 * 16; i += gs) { const int pos = (int)(i >> 4), f = (int)(i & 15); const float inv = (float)pow(10000.0, -(double)(2 * f) / 32.0); const float ang = (float)pos * inv; rdc[i] = (float)cos((double)ang); rds[i] = (float)sin((double)ang); }
  float* rmc = (float*)(p.ws + O_RMC); float* rms = (float*)(p.ws + O_RMS);
  for (long i = gt; i < 128 * 8; i += gs) { const int pos = (int)(i >> 3), f = (int)(i & 7); const float inv = (float)pow(10000.0, -(double)(2 * f) / 16.0); const float ang = (float)pos * inv; rmc[i] = (float)cos((double)ang); rms[i] = (float)sin((double)ang); }
  if (blockIdx.x == 0 && tid == 200) { ((float*)(p.ws + O_LAM))[16] = 0.f; ((float*)(p.ws + O_LAM))[17] = 0.f; }
  if (blockIdx.x == 0 && tid < 128) {
    const int l = tid >> 6, ln = tid & 63; const float* dl = p.in[18] + l * 256;
    float s1 = dl[ln] * dl[64 + ln], s2 = dl[128 + ln] * dl[192 + ln];
#pragma unroll
    for (int o = 32; o > 0; o >>= 1) { s1 += __shfl_xor(s1, o); s2 += __shfl_xor(s2, o); }
    const float li = 0.8f - 0.6f * expf(-0.3f * (float)l);
    if (ln == 0) ((float*)(p.ws + O_LAM))[l] = expf(s1) - expf(s2) + li;
  }
}

__device__ __forceinline__ const float* xsrc_row(const Params& p, long row, bool from_input) {
  if (row < TL) return (from_input ? p.in[0] : p.out) + row * DM;
  return (from_input ? p.in[2] : (const float*)(p.ws + O_XC)) + (row - TL) * DM;
}
__device__ __forceinline__ float* xdst_row(const Params& p, long row) { return row < TL ? p.out + row * DM : (float*)(p.ws + O_XC) + (row - TL) * DM; }

__device__ __forceinline__ void phase_norm(const Params& p, int l, int which, bool from_input) {
  const int tid = launder_tid(), wid = tid >> 6, lane = tid & 63;
  bf16_t* H = (bf16_t*)(p.ws + O_H);
  const float* gain = p.in[6] + (l * 3 + which) * DM;
  const long nwaves = (long)gridDim.x * 8, w0 = (long)blockIdx.x * 8 + wid;
  for (long rb = w0; rb < T; rb += nwaves * 4) {
    f32x4 v[4][4]; float ss[4];
#pragma unroll
    for (int j = 0; j < 4; ++j) { const long row = rb + j * nwaves; ss[j] = 0.f;
      if (row < T) { const float* src = xsrc_row(p, row, from_input);
#pragma unroll
        for (int i = 0; i < 4; ++i) v[j][i] = *(const f32x4*)(src + (lane + 64 * i) * 4); } }
#pragma unroll
    for (int j = 0; j < 4; ++j) { const long row = rb + j * nwaves;
      if (row < T) {
#pragma unroll
        for (int i = 0; i < 4; ++i) ss[j] += v[j][i][0] * v[j][i][0] + v[j][i][1] * v[j][i][1] + v[j][i][2] * v[j][i][2] + v[j][i][3] * v[j][i][3];
#pragma unroll
        for (int o = 32; o > 0; o >>= 1) ss[j] += __shfl_xor(ss[j], o);
        const float rstd = rsqrtf(ss[j] * (1.f / 1024.f) + EPS);
        const int bb = row < TL ? (int)(row >> 13) : 8;
        const float* md = (const float*)(p.ws + O_MOD) + ((size_t)l * 9 + bb) * 9216;
#pragma unroll
        for (int i = 0; i < 4; ++i) { const int c = (lane + 64 * i) * 4;
          const f32x4 g = *(const f32x4*)(gain + c), sh = *(const f32x4*)(md + which * 3 * 1024 + c), sc = *(const f32x4*)(md + (which * 3 + 1) * 1024 + c);
          f32x4 o;
#pragma unroll
          for (int e = 0; e < 4; ++e) o[e] = v[j][i][e] * rstd * g[e] * (1.f + sc[e]) + sh[e];
          store4bf(H + row * DM + c, o); } } }
  }
}
__device__ __forceinline__ void phase_final(const Params& p) {
  const int tid = launder_tid(), wid = tid >> 6, lane = tid & 63;
  const float* gain = p.in[24];
  const long nwaves = (long)gridDim.x * 8, w0 = (long)blockIdx.x * 8 + wid;
  for (long rb = w0; rb < TL; rb += nwaves * 4) {
    f32x4 v[4][4];
#pragma unroll
    for (int j = 0; j < 4; ++j) { const long row = rb + j * nwaves;
      if (row < TL) { const float* src = p.out + row * DM;
#pragma unroll
        for (int i = 0; i < 4; ++i) v[j][i] = *(const f32x4*)(src + (lane + 64 * i) * 4); } }
#pragma unroll
    for (int j = 0; j < 4; ++j) { const long row = rb + j * nwaves;
      if (row < TL) { float ss = 0.f; float* dst = p.out + row * DM;
#pragma unroll
        for (int i = 0; i < 4; ++i) ss += v[j][i][0] * v[j][i][0] + v[j][i][1] * v[j][i][1] + v[j][i][2] * v[j][i][2] + v[j][i][3] * v[j][i][3];
#pragma unroll
        for (int o = 32; o > 0; o >>= 1) ss += __shfl_xor(ss, o);
        const float rstd = rsqrtf(ss * (1.f / 1024.f) + EPS);
#pragma unroll
        for (int i = 0; i < 4; ++i) { const int c = (lane + 64 * i) * 4; const f32x4 g = *(const f32x4*)(gain + c); f32x4 o;
#pragma unroll
          for (int e = 0; e < 4; ++e) o[e] = v[j][i][e] * rstd * g[e];
          *(f32x4*)(dst + c) = o; } } }
  }
}

__device__ __forceinline__ void phase_ffn_up(const Params& p, int npm) {
  const char* W = (const char*)(p.ws + O_WUP); const char* H = (const char*)(p.ws + O_H); bf16_t* G = (bf16_t*)(p.ws + O_G);
  const int q = logical_wg(), Gd = gridDim.x, tot = npm * 22;
  auto get = [&](int idx, GOp& o) __attribute__((always_inline)) -> bool { const int U = q + idx * Gd; if (U >= tot) return false; int pm, pn; unit_decode(U, 22, 2, pm, pn);
    o.A = W + (size_t)pn * 256 * 2048; o.B = H + (size_t)pm * 256 * 2048; o.lda2 = 2048; o.ldb2 = 2048; o.nt = 16; return true; };
  auto epi = [&](int idx, const f32x4 (&acc)[2][2][4][2]) __attribute__((always_inline)) {
    const int U = q + idx * Gd; int pm, pn; unit_decode(U, 22, 2, pm, pn);
    LANE_IDS
#pragma unroll
    for (int ai = 0; ai < 2; ++ai)
#pragma unroll
      for (int bj = 0; bj < 2; ++bj)
#pragma unroll
        for (int n = 0; n < 2; ++n)
#pragma unroll
          for (int mp = 0; mp < 2; ++mp) {
            const long tok = (long)pm * 256 + bj * 128 + wc * 32 + n * 16 + fr; const int gc = pn * 128 + ai * 64 + wr * 32 + mp * 16 + fq * 4;
            const f32x4 a = acc[ai][bj][2 * mp][n], b = acc[ai][bj][2 * mp + 1][n]; f32x4 o;
#pragma unroll
            for (int e = 0; e < 4; ++e) o[e] = silu_f(a[e]) * b[e];
            store4bf(G + tok * DFF + gc, o);
          }
  };
  gemm_stream(get, epi);
}
__device__ __forceinline__ void epi_res(const Params& p, const f32x4 (&acc)[2][2][4][2], int l, int pm, int pn, int gate_idx, float scale, bool from_input) {
  LANE_IDS
  const TI ti = tile_info(pm);
  const float* md = (const float*)(p.ws + O_MOD) + ((size_t)l * 9 + ti.bb) * 9216 + gate_idx * 1024;
#pragma unroll
  for (int bj = 0; bj < 2; ++bj)
#pragma unroll
    for (int n = 0; n < 2; ++n) {
      const long row = (long)pm * 256 + bj * 128 + wc * 32 + n * 16 + fr;
      const float* src = xsrc_row(p, row, from_input); float* dst = xdst_row(p, row);
#pragma unroll
      for (int ai = 0; ai < 2; ++ai)
#pragma unroll
        for (int m = 0; m < 4; ++m) {
          const int col = pn * 256 + ai * 128 + wr * 64 + m * 16 + fq * 4;
          const f32x4 xv = *(const f32x4*)(src + col), g = *(const f32x4*)(md + col); f32x4 o;
#pragma unroll
          for (int e = 0; e < 4; ++e) o[e] = xv[e] + g[e] * scale * acc[ai][bj][m][n][e];
          *(f32x4*)(dst + col) = o;
          if (m & 1) MEMFENCE();
        }
    }
}
struct NormFuse { int nl, which, pslot, cslot; bool fin; };
__device__ __forceinline__ void epi_res_norm(const Params& p, f32x4 (&acc)[2][2][4][2], int l, int pm, int pn, int gate_idx, float scale, bool from_input, const NormFuse nf) {
  LANE_IDS
  const TI ti = tile_info(pm);
  const float* md = (const float*)(p.ws + O_MOD) + ((size_t)l * 9 + ti.bb) * 9216 + gate_idx * 1024;
  float ssr[2][2];
#pragma unroll
  for (int bj = 0; bj < 2; ++bj)
#pragma unroll
    for (int n = 0; n < 2; ++n) {
      const long row = (long)pm * 256 + bj * 128 + wc * 32 + n * 16 + fr;
      const float* src = xsrc_row(p, row, from_input); float* dst = xdst_row(p, row); float ss = 0.f;
#pragma unroll
      for (int ai = 0; ai < 2; ++ai)
#pragma unroll
        for (int m = 0; m < 4; ++m) {
          const int col = pn * 256 + ai * 128 + wr * 64 + m * 16 + fq * 4;
          const f32x4 xv = *(const f32x4*)(src + col), g = *(const f32x4*)(md + col); f32x4 o;
#pragma unroll
          for (int e = 0; e < 4; ++e) { o[e] = xv[e] + g[e] * scale * acc[ai][bj][m][n][e]; ss += o[e] * o[e]; }
          if (!nf.fin) *(f32x4*)(dst + col) = o;
          acc[ai][bj][m][n] = o;
          if (m & 1) MEMFENCE();
        }
      ss += __shfl_xor(ss, 16); ss += __shfl_xor(ss, 32); ssr[bj][n] = ss;
    }
  float* ssl = (float*)(g_lds + 131072);
  __syncthreads();
  if (fq == 0) {
#pragma unroll
    for (int bj = 0; bj < 2; ++bj)
#pragma unroll
      for (int n = 0; n < 2; ++n) ssl[wr * 256 + bj * 128 + wc * 32 + n * 16 + fr] = ssr[bj][n]; }
  __syncthreads();
  unsigned* part = (unsigned*)(p.ws + O_PART) + ((size_t)nf.pslot * 264 + pm) * 1024;
  if (tid < 256) {
    __hip_atomic_store(part + pn * 256 + tid, __float_as_uint(ssl[tid] + ssl[256 + tid]), __ATOMIC_RELAXED, __HIP_MEMORY_SCOPE_AGENT);
    float t = 0.f; int spins = 0;
    for (;;) { float v0 = __uint_as_float(__hip_atomic_load(part + tid, __ATOMIC_RELAXED, __HIP_MEMORY_SCOPE_AGENT)), v1 = __uint_as_float(__hip_atomic_load(part + 256 + tid, __ATOMIC_RELAXED, __HIP_MEMORY_SCOPE_AGENT)),
        v2 = __uint_as_float(__hip_atomic_load(part + 512 + tid, __ATOMIC_RELAXED, __HIP_MEMORY_SCOPE_AGENT)), v3 = __uint_as_float(__hip_atomic_load(part + 768 + tid, __ATOMIC_RELAXED, __HIP_MEMORY_SCOPE_AGENT));
      t = v0 + v1 + v2 + v3;
      if ((v0 >= 0.f && v1 >= 0.f && v2 >= 0.f && v3 >= 0.f) || ++spins > (1 << 18)) break;
      __builtin_amdgcn_s_sleep(4); }
    ssl[512 + tid] = rsqrtf(t * (1.f / 1024.f) + EPS); }
  __syncthreads();
  const float* gain = nf.fin ? p.in[24] : p.in[6] + (nf.nl * 3 + nf.which) * DM;
  const float* mdn = (const float*)(p.ws + O_MOD) + ((size_t)nf.nl * 9 + ti.bb) * 9216;
  bf16_t* H = (bf16_t*)(p.ws + O_H);
#pragma unroll
  for (int bj = 0; bj < 2; ++bj)
#pragma unroll
    for (int n = 0; n < 2; ++n) {
      const int tl = bj * 128 + wc * 32 + n * 16 + fr; const long row = (long)pm * 256 + tl; const float r = ssl[512 + tl];
#pragma unroll
      for (int ai = 0; ai < 2; ++ai)
#pragma unroll
        for (int m = 0; m < 4; ++m) {
          const int col = pn * 256 + ai * 128 + wr * 64 + m * 16 + fq * 4; const f32x4 o = acc[ai][bj][m][n], g = *(const f32x4*)(gain + col); f32x4 h;
          if (nf.fin) {
#pragma unroll
            for (int e = 0; e < 4; ++e) h[e] = o[e] * r * g[e];
            *(f32x4*)(p.out + row * DM + col) = h;
          } else { const f32x4 sh = *(const f32x4*)(mdn + nf.which * 3 * 1024 + col), sc = *(const f32x4*)(mdn + (nf.which * 3 + 1) * 1024 + col);
#pragma unroll
            for (int e = 0; e < 4; ++e) h[e] = o[e] * r * g[e] * (1.f + sc[e]) + sh[e];
            store4bf(H + row * DM + col, h); }
          if (m & 1) MEMFENCE();
        }
    }
}
__device__ __forceinline__ void phase_ffn_down(const Params& p, int l, int gate_idx, bool from_input, int npm, const NormFuse nf) {
  const char* W = (const char*)(p.ws + O_WDN); const char* G = (const char*)(p.ws + O_G);
  const int q = logical_wg(), Gd = gridDim.x, tot = npm * 4;
  auto get = [&](int idx, GOp& o) __attribute__((always_inline)) -> bool { const int U = q + idx * Gd; if (U >= tot) return false; int pm, pn; unit_decode(U, 4, 4, pm, pn);
    o.A = W + (size_t)pn * 256 * (DFF * 2); o.B = G + (size_t)pm * 256 * (DFF * 2); o.lda2 = DFF * 2; o.ldb2 = DFF * 2; o.nt = DFF / 64; return true; };
  auto epi = [&](int idx, f32x4 (&acc)[2][2][4][2]) __attribute__((always_inline)) {
    const int U = q + idx * Gd; int pm, pn; unit_decode(U, 4, 4, pm, pn); epi_res_norm(p, acc, l, pm, pn, gate_idx, 0.5f, from_input, nf); };
  gemm_stream(get, epi);
}
__device__ __forceinline__ void phase_wout(const Params& p, int l, int npm, const NormFuse nf) {
  const char* W = (const char*)(p.ws + O_WOUT); const char* Y = (const char*)(p.ws + O_YBR);
  const int q = logical_wg(), Gd = gridDim.x, tot = npm * 4;
  auto get = [&](int idx, GOp& o) __attribute__((always_inline)) -> bool { const int U = q + idx * Gd; if (U >= tot) return false; int pm, pn; unit_decode(U, 4, 4, pm, pn);
    o.A = W + (size_t)pn * 256 * 2048; o.B = Y + (size_t)pm * 256 * 2048; o.lda2 = 2048; o.ldb2 = 2048; o.nt = 16; return true; };
  auto epi = [&](int idx, f32x4 (&acc)[2][2][4][2]) __attribute__((always_inline)) {
    const int U = q + idx * Gd; int pm, pn; unit_decode(U, 4, 4, pm, pn); epi_res_norm(p, acc, l, pm, pn, 5, 1.0f, false, nf); };
  gemm_stream(get, epi);
}

__device__ __forceinline__ void rope4(f32x4 x1, f32x4 x2, f32x4 c, f32x4 s, f32x4& o1, f32x4& o2) {
#pragma unroll
  for (int e = 0; e < 4; ++e) { o1[e] = x1[e] * c[e] - x2[e] * s[e]; o2[e] = x1[e] * s[e] + x2[e] * c[e]; }
}
__device__ __forceinline__ void phase_win(const Params& p) {
  const char* W = (const char*)(p.ws + O_WIN); const char* H = (const char*)(p.ws + O_H);
  bf16_t* QLAT = (bf16_t*)(p.ws + O_QLAT); bf16_t* KVLAT = (bf16_t*)(p.ws + O_KVLAT); bf16_t* KROPE = (bf16_t*)(p.ws + O_KROPE);
  bf16_t* QD = (bf16_t*)(p.ws + O_QD); bf16_t* KD = (bf16_t*)(p.ws + O_KD); bf16_t* VD = (bf16_t*)(p.ws + O_VD);
  bf16_t* RQ = (bf16_t*)(p.ws + O_RQ); bf16_t* RK = (bf16_t*)(p.ws + O_RK); bf16_t* RV = (bf16_t*)(p.ws + O_RV); bf16_t* YRET = (bf16_t*)(p.ws + O_YRET);
  const float* r1c = (const float*)(p.ws + O_R1C); const float* r1s = (const float*)(p.ws + O_R1S);
  const float* rdc = (const float*)(p.ws + O_RDC); const float* rds = (const float*)(p.ws + O_RDS);
  const float* rmc = (const float*)(p.ws + O_RMC); const float* rms = (const float*)(p.ws + O_RMS);
  const int q = logical_wg(), Gd = gridDim.x;
  auto get = [&](int idx, GOp& o) __attribute__((always_inline)) -> bool { const int U = q + idx * Gd; if (U >= NPM * 15) return false; int pm, pn; unit_decode(U, 15, 3, pm, pn);
    o.A = W + (size_t)pn * 256 * 2048; o.B = H + (size_t)pm * 256 * 2048; o.lda2 = 2048; o.ldb2 = 2048; o.nt = 16; return true; };
  auto epi = [&](int idx, const f32x4 (&acc)[2][2][4][2]) __attribute__((always_inline)) {
    const int U = q + idx * Gd; int pm, pn; unit_decode(U, 15, 3, pm, pn);
    LANE_IDS
    const TI ti = tile_info(pm); const bool lat = ti.bb < 8;
#pragma unroll
    for (int bj = 0; bj < 2; ++bj)
#pragma unroll
      for (int n = 0; n < 2; ++n) {
        const int tl = bj * 128 + wc * 32 + n * 16 + fr; const long tok = (long)pm * 256 + tl; const int ar = ti.arow0 + tl;
        const int prow = ar >> 6, pcol = ar & 63;
        if (pn == 0 || pn == 2 || pn == 13 || pn == 14) {
#pragma unroll
          for (int ai = 0; ai < 2; ++ai)
#pragma unroll
            for (int m = 0; m < 4; ++m) { const int c = ai * 128 + wr * 64 + m * 16 + fq * 4; const f32x4 v = acc[ai][bj][m][n];
              if (pn == 0) store4bf(QLAT + tok * 384 + c, v);
              else if (pn == 2) store4bf(KVLAT + tok * 256 + c, v);
              else { f32x4 o;
#pragma unroll
                for (int e = 0; e < 4; ++e) o[e] = silu_f(v[e]);
                store4bf(YRET + tok * 512 + (pn - 13) * 256 + c, o); } }
        } else if (pn == 1) {
#pragma unroll
          for (int m = 0; m < 4; ++m) store4bf(QLAT + tok * 384 + 256 + wr * 64 + m * 16 + fq * 4, acc[0][bj][m][n]);
          if (wr == 0) {
            const int half = fq >> 1, idx = (fq & 1) * 4; f32x4 o1 = acc[1][bj][0][n], o2 = acc[1][bj][1][n];
            if (lat) { const int pos = half ? pcol : prow; const f32x4 c = *(const f32x4*)(rmc + pos * 8 + idx), s = *(const f32x4*)(rms + pos * 8 + idx); rope4(acc[1][bj][0][n], acc[1][bj][1][n], c, s, o1, o2); }
            bf16_t* d = KROPE + ((long)ti.b * SK + ar) * 32 + half * 16 + idx; store4bf(d, o1); store4bf(d + 8, o2);
          }
        } else if (pn >= 3 && pn <= 6) {
          bf16_t* D = (pn < 5) ? QD : KD; const int hb = ((pn - 3) & 1) * 2;
#pragma unroll
          for (int ai = 0; ai < 2; ++ai) {
            bf16_t* d = D + (((long)ti.b * 8 + (hb + ai) * 2 + wr) * SK + ar) * 64 + fq * 4;
            f32x4 a0 = acc[ai][bj][0][n], a1 = acc[ai][bj][1][n], a2 = acc[ai][bj][2][n], a3 = acc[ai][bj][3][n];
            if (lat) { const f32x4 cr = *(const f32x4*)(rdc + prow * 16 + fq * 4), sr = *(const f32x4*)(rds + prow * 16 + fq * 4), cc = *(const f32x4*)(rdc + pcol * 16 + fq * 4), sc = *(const f32x4*)(rds + pcol * 16 + fq * 4);
              rope4(acc[ai][bj][0][n], acc[ai][bj][1][n], cr, sr, a0, a1); rope4(acc[ai][bj][2][n], acc[ai][bj][3][n], cc, sc, a2, a3); }
            const float qs = (pn < 5) ? CQ_DIFF : 1.f;
            store4bf(d, a0 * qs); store4bf(d + 16, a1 * qs); store4bf(d + 32, a2 * qs); store4bf(d + 48, a3 * qs);
          }
        } else if (pn == 7 || pn == 8 || pn == 11 || pn == 12) {
          bf16_t* D = (pn < 9) ? VD : RV; const int hb = (pn < 9 ? pn - 7 : pn - 11) * 2;
#pragma unroll
          for (int ai = 0; ai < 2; ++ai)
#pragma unroll
            for (int m = 0; m < 4; ++m) store4bf(D + (((long)ti.b * 4 + hb + ai) * SK + ar) * 128 + wr * 64 + m * 16 + fq * 4, acc[ai][bj][m][n]);
        } else {
          bf16_t* D = (pn == 9) ? RQ : RK; const float sc = (pn == 9) ? 1.f : 0.125f;
#pragma unroll
          for (int ai = 0; ai < 2; ++ai) {
            bf16_t* d = D + (((long)ti.b * 4 + ai * 2 + wr) * SK + ar) * 64 + fq * 4;
            f32x4 a0 = acc[ai][bj][0][n], a1 = acc[ai][bj][1][n], a2 = acc[ai][bj][2][n], a3 = acc[ai][bj][3][n];
            if (lat) { const f32x4 c0 = *(const f32x4*)(r1c + ar * 32 + fq * 4), s0 = *(const f32x4*)(r1s + ar * 32 + fq * 4), c1 = *(const f32x4*)(r1c + ar * 32 + 16 + fq * 4), s1 = *(const f32x4*)(r1s + ar * 32 + 16 + fq * 4);
              rope4(acc[ai][bj][0][n], acc[ai][bj][2][n], c0, s0, a0, a2); rope4(acc[ai][bj][1][n], acc[ai][bj][3][n], c1, s1, a1, a3); }
            store4bf(d, a0 * sc); store4bf(d + 16, a1 * sc); store4bf(d + 32, a2 * sc); store4bf(d + 48, a3 * sc);
          }
        }
      }
  };
  gemm_stream(get, epi);
}

__device__ __forceinline__ int crow(int r, int hi) { return (r & 3) + 8 * (r >> 2) + 4 * hi; }
__device__ __forceinline__ void ret_unit(const Params& p, int l, int u) {
  const int tid = launder_tid(), wid = tid >> 6, lane = tid & 63, r32 = lane & 31, hi = lane >> 5;
  const int b = u & 7, h = (u >> 3) & 3, dir = (u >> 5) & 1, s = u >> 6;
  constexpr int QS = 0, KS = 18432, KT = 36864, VT = 54272, VTS = 62976, SC = 71680, SBF = 106496, PW = 115712, IPW = PW + 528;
  unsigned char* L = g_lds; float* pw = (float*)(L + PW); float* ipw = (float*)(L + IPW);
  const float lg = -expf(p.in[20][l * 8 + dir * 4 + h]);
  __syncthreads();
  if (tid <= 128) { pw[tid] = expf(lg * (float)tid); if (tid < 128) ipw[tid] = expf(-lg * (float)tid); }
  for (int i = tid; i < 576; i += 512) *(u32x4*)(L + SBF + i * 16) = (u32x4){0u, 0u, 0u, 0u};
  const bf16_t* RQ = (const bf16_t*)(p.ws + O_RQ) + ((long)b * 4 + h) * SK * 64;
  const bf16_t* RK = (const bf16_t*)(p.ws + O_RK) + ((long)b * 4 + h) * SK * 64;
  const bf16_t* RV = (const bf16_t*)(p.ws + O_RV) + ((long)b * 4 + h) * SK * 128 + s * 32;
  bf16_t* RO = (bf16_t*)(p.ws + O_RETO) + (size_t)dir * T * 512 + h * 128 + s * 32;
  f32x16 sacc = {};
  u32x4 rq0, rq1, rk0, rk1, rv0 = {0u, 0u, 0u, 0u}, rv1 = {0u, 0u, 0u, 0u};
  const int qrow0 = tid >> 3, qcc = tid & 7, pi = tid & 63, kcc = tid >> 6, vcc = (tid >> 6) & 3; const bool vact = tid < 256;
  auto chunk_arow = [&](int n) -> int { if (n < 2) return 8192 + 128 * (dir ? 1 - n : n); return 128 * (dir ? 65 - n : n - 2); };
#define RLOAD(n) do { const int ar_ = chunk_arow(n); \
    rq0 = *(const u32x4*)(RQ + (long)(ar_ + qrow0) * 64 + qcc * 8); rq1 = *(const u32x4*)(RQ + (long)(ar_ + 64 + qrow0) * 64 + qcc * 8); \
    rk0 = *(const u32x4*)(RK + (long)(ar_ + 2 * pi) * 64 + kcc * 8); rk1 = *(const u32x4*)(RK + (long)(ar_ + 2 * pi + 1) * 64 + kcc * 8); \
    if (vact) { rv0 = *(const u32x4*)(RV + (long)(ar_ + 2 * pi) * 128 + vcc * 8); rv1 = *(const u32x4*)(RV + (long)(ar_ + 2 * pi + 1) * 128 + vcc * 8); } } while (0)
  RLOAD(0);
  int cur = 0;
  for (int n = 0; n < 66; ++n) {
    __syncthreads();
    *(u32x4*)(L + QS + qrow0 * 144 + qcc * 16) = rq0; *(u32x4*)(L + QS + (64 + qrow0) * 144 + qcc * 16) = rq1;
    *(u32x4*)(L + KS + (2 * pi) * 144 + kcc * 16) = rk0; *(u32x4*)(L + KS + (2 * pi + 1) * 144 + kcc * 16) = rk1;
#pragma unroll
    for (int e = 0; e < 4; ++e) {
      *(unsigned*)(L + KT + (kcc * 8 + 2 * e) * 272 + pi * 4) = (rk0[e] & 0xffffu) | (rk1[e] << 16);
      *(unsigned*)(L + KT + (kcc * 8 + 2 * e + 1) * 272 + pi * 4) = (rk0[e] >> 16) | (rk1[e] & 0xffff0000u); }
    if (vact) { const float kd0 = pw[dir ? 2 * pi : 127 - 2 * pi], kd1 = pw[dir ? 2 * pi + 1 : 126 - 2 * pi];
#pragma unroll
      for (int e = 0; e < 4; ++e) {
        *(unsigned*)(L + VT + (vcc * 8 + 2 * e) * 272 + pi * 4) = (rv0[e] & 0xffffu) | (rv1[e] << 16);
        *(unsigned*)(L + VT + (vcc * 8 + 2 * e + 1) * 272 + pi * 4) = (rv0[e] >> 16) | (rv1[e] & 0xffff0000u);
        *(unsigned*)(L + VTS + (vcc * 8 + 2 * e) * 272 + pi * 4) = cvtpk(__uint_as_float(rv0[e] << 16) * kd0, __uint_as_float(rv1[e] << 16) * kd1);
        *(unsigned*)(L + VTS + (vcc * 8 + 2 * e + 1) * 272 + pi * 4) = cvtpk(__uint_as_float(rv0[e] & 0xffff0000u) * kd0, __uint_as_float(rv1[e] & 0xffff0000u) * kd1); } }
    __syncthreads();
    if (n + 1 < 66) RLOAD(n + 1);
    { const int I = wid >> 1;
#pragma unroll
      for (int jj = 0; jj < 2; ++jj) { const int J = (wid & 1) * 2 + jj; f32x16 sc = {};
#pragma unroll
        for (int kk = 0; kk < 4; ++kk) { const bf16x8 ka = *(const bf16x8*)(L + KS + (32 * I + r32) * 144 + (kk * 16 + hi * 8) * 2), qb = *(const bf16x8*)(L + QS + (32 * J + r32) * 144 + (kk * 16 + hi * 8) * 2);
          sc = __builtin_amdgcn_mfma_f32_32x32x16_bf16(ka, qb, sc, 0, 0, 0); }
        const int a = 32 * J + r32; const float colf = dir ? ipw[a] : pw[a];
#pragma unroll
        for (int q4 = 0; q4 < 4; ++q4) { const int ap0 = 32 * I + 8 * q4 + 4 * hi; const f32x4 rowf = *(const f32x4*)((dir ? pw : ipw) + ap0); f32x4 o;
#pragma unroll
          for (int e = 0; e < 4; ++e) { const int dd = dir ? (ap0 + e) - a : a - (ap0 + e); const float m = dd >= 0 ? colf * rowf[e] : 0.f; o[e] = sc[q4 * 4 + e] * m; }
          store4bf((bf16_t*)(L + SC + a * 272 + ap0 * 2), o); } } }
    __syncthreads();
    if (wid < 4) {
      f32x16 a1 = {}, a2 = {};
#pragma unroll
      for (int kk = 0; kk < 8; ++kk) { const bf16x8 sa = *(const bf16x8*)(L + SC + (32 * wid + r32) * 272 + (kk * 16 + hi * 8) * 2), vb = *(const bf16x8*)(L + VT + r32 * 272 + (kk * 16 + hi * 8) * 2);
        a1 = __builtin_amdgcn_mfma_f32_32x32x16_bf16(sa, vb, a1, 0, 0, 0); }
#pragma unroll
      for (int kk = 0; kk < 4; ++kk) { const bf16x8 qa = *(const bf16x8*)(L + QS + (32 * wid + r32) * 144 + (kk * 16 + hi * 8) * 2), sb = *(const bf16x8*)(L + SBF + cur * 4608 + r32 * 144 + (kk * 16 + hi * 8) * 2);
        a2 = __builtin_amdgcn_mfma_f32_32x32x16_bf16(qa, sb, a2, 0, 0, 0); }
      const int ar = chunk_arow(n); const long tokbase = (ar >= 8192) ? (long)TL + b * 256 + (ar - 8192) : (long)b * 8192 + ar;
#pragma unroll
      for (int r = 0; r < 16; ++r) { const int a = 32 * wid + crow(r, hi); const float qd = pw[dir ? 128 - a : a + 1];
        const unsigned pk = cvtpk(a1[r] + qd * a2[r], 0.f); RO[(tokbase + a) * 512 + r32] = (unsigned short)(pk & 0xffff); }
    } else if (wid < 6) {
      const int db = wid - 4; const float cd = pw[128];
#pragma unroll
      for (int r = 0; r < 16; ++r) sacc[r] *= cd;
#pragma unroll
      for (int kk = 0; kk < 8; ++kk) { const bf16x8 ka = *(const bf16x8*)(L + KT + (32 * db + r32) * 272 + (kk * 16 + hi * 8) * 2), vb = *(const bf16x8*)(L + VTS + r32 * 272 + (kk * 16 + hi * 8) * 2);
        sacc = __builtin_amdgcn_mfma_f32_32x32x16_bf16(ka, vb, sacc, 0, 0, 0); }
#pragma unroll
      for (int q4 = 0; q4 < 4; ++q4) { f32x4 o = {sacc[q4 * 4], sacc[q4 * 4 + 1], sacc[q4 * 4 + 2], sacc[q4 * 4 + 3]};
        store4bf((bf16_t*)(L + SBF + (cur ^ 1) * 4608 + r32 * 144 + (32 * db + 8 * q4 + 4 * hi) * 2), o); }
    }
    cur ^= 1;
  }
  __syncthreads();
#undef RLOAD
}

__device__ __forceinline__ void row_rstd(const bf16_t* src, int Kd) {
  const int tid = launder_tid(), row = tid >> 1, hf = tid & 1; float* rs = (float*)(g_lds + 131072);
  const bf16_t* s = src + (long)row * Kd + hf * (Kd / 2); float ss = 0.f;
  for (int c = 0; c < Kd / 16; ++c) { const u32x4 w = *(const u32x4*)(s + c * 8);
#pragma unroll
    for (int e = 0; e < 4; ++e) { const float lo = __uint_as_float(w[e] << 16), hi_ = __uint_as_float(w[e] & 0xffff0000u); ss += lo * lo + hi_ * hi_; } }
  ss += __shfl_xor(ss, 1);
  if (hf == 0) rs[row] = rsqrtf(ss / (float)Kd + EPS);
  __syncthreads();
}
__device__ __forceinline__ void phase_g4(const Params& p, int l) {
  if (PMASK & 0x80000) for (int u = blockIdx.x; u < 256; u += gridDim.x) ret_unit(p, l, u);
  const char* WQB = (const char*)(p.ws + O_WQB); const char* WKVB = (const char*)(p.ws + O_WKVB);
  const bf16_t* QLAT = (const bf16_t*)(p.ws + O_QLAT); const bf16_t* KVLAT = (const bf16_t*)(p.ws + O_KVLAT);
  bf16_t* QMLA = (bf16_t*)(p.ws + O_QMLA); bf16_t* KNOPE = (bf16_t*)(p.ws + O_KNOPE); bf16_t* VMLA = (bf16_t*)(p.ws + O_VMLA);
  const float* rmc = (const float*)(p.ws + O_RMC); const float* rms = (const float*)(p.ws + O_RMS);
  const float* rs = (const float*)(g_lds + 131072);
  const int q = logical_wg(), Gd = gridDim.x;
  auto get = [&](int idx, GOp& o) __attribute__((always_inline)) -> bool { const int U = q + idx * Gd; if (U >= NPM * 7) return false; int pm, pn;
    if (U < NPM * 3) { unit_decode(U, 3, 3, pm, pn); o.A = WQB + (size_t)pn * 256 * 768; o.B = (const char*)QLAT + (size_t)pm * 256 * 768; o.lda2 = 768; o.ldb2 = 768; o.nt = 6; }
    else { unit_decode(U - NPM * 3, 4, 4, pm, pn); o.A = WKVB + (size_t)pn * 256 * 512; o.B = (const char*)KVLAT + (size_t)pm * 256 * 512; o.lda2 = 512; o.ldb2 = 512; o.nt = 4; }
    return true; };
  auto epi = [&](int idx, const f32x4 (&acc)[2][2][4][2]) __attribute__((always_inline)) {
    const int U = q + idx * Gd; const bool isq = U < NPM * 3; int pm, pn;
    if (isq) unit_decode(U, 3, 3, pm, pn); else unit_decode(U - NPM * 3, 4, 4, pm, pn);
    __syncthreads();
    if (isq) row_rstd(QLAT + (size_t)pm * 256 * 384, 384); else row_rstd(KVLAT + (size_t)pm * 256 * 256, 256);
    LANE_IDS
    const TI ti = tile_info(pm); const bool lat = ti.bb < 8;
#pragma unroll
    for (int bj = 0; bj < 2; ++bj)
#pragma unroll
      for (int n = 0; n < 2; ++n) {
        const int tl = bj * 128 + wc * 32 + n * 16 + fr; const int ar = ti.arow0 + tl; const float rr = isq ? rs[tl] * CQ_MLA : rs[tl]; const int prow = ar >> 6, pcol = ar & 63;
        if (isq && pn == 2) {
          const int half = fq >> 1, idx = (fq & 1) * 4; const int pos = half ? pcol : prow;
          f32x4 c = {1.f, 1.f, 1.f, 1.f}, s = {0.f, 0.f, 0.f, 0.f};
          if (lat) { c = *(const f32x4*)(rmc + pos * 8 + idx); s = *(const f32x4*)(rms + pos * 8 + idx); }
#pragma unroll
          for (int ai = 0; ai < 2; ++ai)
#pragma unroll
            for (int mp = 0; mp < 2; ++mp) { const int hd = ai * 4 + wr * 2 + mp; f32x4 o1, o2; rope4(acc[ai][bj][2 * mp][n] * rr, acc[ai][bj][2 * mp + 1][n] * rr, c, s, o1, o2);
              bf16_t* d = QMLA + (((long)ti.b * 8 + hd) * SK + ar) * 96 + 64 + half * 16 + idx; store4bf(d, o1); store4bf(d + 8, o2); }
        } else {
#pragma unroll
          for (int ai = 0; ai < 2; ++ai)
#pragma unroll
            for (int m = 0; m < 4; ++m) { const int cfull = (pn & 1) * 256 + ai * 128 + wr * 64 + m * 16 + fq * 4; const int hd = cfull >> 6, d = cfull & 63; const f32x4 v = acc[ai][bj][m][n] * rr;
              if (isq) store4bf(QMLA + (((long)ti.b * 8 + hd) * SK + ar) * 96 + d, v);
              else if (pn < 2) store4bf(KNOPE + (((long)ti.b * 8 + hd) * SK + ar) * 64 + d, v);
              else store4bf(VMLA + (((long)ti.b * 8 + hd) * SK + ar) * 64 + d, v); }
        }
      }
  };
  if (PMASK & 0x100000) gemm_stream(get, epi);
}

#define SBAR() __builtin_amdgcn_sched_barrier(0)
template <int DQK> __device__ __forceinline__ int kswz(int row, int colB) { if (DQK == 96) return row * 256 + (colB ^ ((row & 7) << 4)); return row * 128 + (colB ^ (((row >> 1) & 7) << 4)); }
#ifndef EXP_THR
#define EXP_THR 8.f
#endif
constexpr float ATHR = EXP_THR;
template <int DQK> __device__ __forceinline__ void partialSM(f32x16& p0, f32x16& p1, float& m_reg, float& mn, float& alpha) {
  constexpr float THRL = ATHR * 1.4426950408889634f;
  float pmax = p0[0];
#pragma unroll
  for (int r = 1; r < 16; ++r) pmax = fmaxf(pmax, p0[r]);
#pragma unroll
  for (int r = 0; r < 16; ++r) pmax = fmaxf(pmax, p1[r]);
  { auto rr = __builtin_amdgcn_permlane32_swap(__float_as_uint(pmax), __float_as_uint(pmax), false, false); pmax = fmaxf(__uint_as_float(rr[0]), __uint_as_float(rr[1])); }
  if (__builtin_expect(__all(pmax - m_reg <= THRL), 1)) { mn = m_reg; alpha = 1.f; }
  else { mn = fmaxf(m_reg, pmax); alpha = __builtin_amdgcn_exp2f(m_reg - mn); m_reg = mn; }
  if (!__all(mn == 0.f)) {
#pragma unroll
    for (int r = 0; r < 16; ++r) p0[r] -= mn;
#pragma unroll
    for (int r = 0; r < 16; ++r) p1[r] -= mn;
  }
#pragma unroll
  for (int r = 0; r < 16; ++r) p0[r] = __builtin_amdgcn_exp2f(p0[r]);
}
template <bool SUM> __device__ __forceinline__ void finishSM(f32x16& p0, f32x16& p1, float alpha, float& l_reg, bf16x8& pa0, bf16x8& pa1, bf16x8& pa2, bf16x8& pa3) {
#pragma unroll
  for (int r = 0; r < 16; ++r) p1[r] = __builtin_amdgcn_exp2f(p1[r]);
  if constexpr (SUM) {
  float ps = 0;
#pragma unroll
  for (int r = 0; r < 16; ++r) ps += p0[r];
#pragma unroll
  for (int r = 0; r < 16; ++r) ps += p1[r];
  { auto rr = __builtin_amdgcn_permlane32_swap(__float_as_uint(ps), __float_as_uint(ps), false, false); ps = __uint_as_float(rr[0]) + __uint_as_float(rr[1]); }
  l_reg = l_reg * alpha + ps;
  }
#define PK4(P, BASE, OUT) do { unsigned a0 = cvtpk(P[BASE + 0], P[BASE + 1]), a1 = cvtpk(P[BASE + 2], P[BASE + 3]); \
    unsigned b0 = cvtpk(P[BASE + 4], P[BASE + 5]), b1 = cvtpk(P[BASE + 6], P[BASE + 7]); \
    auto r0 = __builtin_amdgcn_permlane32_swap(a0, b0, false, false); auto r1 = __builtin_amdgcn_permlane32_swap(a1, b1, false, false); \
    u32x4 w = {r0[0], r1[0], r0[1], r1[1]}; OUT = *reinterpret_cast<bf16x8*>(&w); } while (0)
  PK4(p0, 0, pa0); PK4(p0, 8, pa1); PK4(p1, 0, pa2); PK4(p1, 8, pa3);
#undef PK4
}
template <int DQK> __device__ __forceinline__ void qkt(f32x16& p0, f32x16& p1, const unsigned char* Ks, const bf16x8* qr, int r32, int hi) {
  p0 = f32x16{}; p1 = f32x16{};
#pragma unroll
  for (int d0 = 0; d0 < DQK / 16; ++d0) { const int cb = (d0 * 16 + hi * 8) * 2;
    const bf16x8 b0 = *reinterpret_cast<const bf16x8*>(Ks + kswz<DQK>(r32, cb));
    const bf16x8 b1 = *reinterpret_cast<const bf16x8*>(Ks + kswz<DQK>(32 + r32, cb));
    p0 = __builtin_amdgcn_mfma_f32_32x32x16_bf16(b0, qr[d0], p0, 0, 0, 0);
    p1 = __builtin_amdgcn_mfma_f32_32x32x16_bf16(b1, qr[d0], p1, 0, 0, 0); }
}
template <int DV> __device__ __forceinline__ int v_st(int k, int c) { const int kk = (k & ~0xC) | ((k & 4) << 1) | ((k & 8) >> 1); return ((kk >> 3) * (DV / 32) + (c >> 5)) * 512 + ((kk & 7) * 32 + (c & 31)) * 2; }
__device__ __forceinline__ int v_rd_base(int lane) { return ((lane & 3) << 3) | (((lane >> 2) & 3) << 6) | (((lane >> 4) & 1) << 5) | (((lane >> 5) & 1) << 8); }
template <int OFF> __device__ __forceinline__ s16x4 tr_read(int vb) { s16x4 r; asm volatile("ds_read_b64_tr_b16 %0, %1 offset:%2" : "=&v"(r) : "v"(vb), "i"(OFF) : "memory"); return r; }
template <int DV, int D0> __device__ __forceinline__ void pv_one(f32x16& od, int vb, bf16x8 pa0, bf16x8 pa1, bf16x8 pa2, bf16x8 pa3) {
  constexpr int NS = DV / 32;
#define VOFF(ks, half) (D0 * 512 + (ks) * (2 * NS * 512) + (half) * (NS * 512))
  const s16x4 l0 = tr_read<VOFF(0, 0)>(vb), h0 = tr_read<VOFF(0, 1)>(vb), l1 = tr_read<VOFF(1, 0)>(vb), h1 = tr_read<VOFF(1, 1)>(vb);
  const s16x4 l2 = tr_read<VOFF(2, 0)>(vb), h2 = tr_read<VOFF(2, 1)>(vb), l3 = tr_read<VOFF(3, 0)>(vb), h3 = tr_read<VOFF(3, 1)>(vb);
#undef VOFF
  asm volatile("s_waitcnt lgkmcnt(0)" ::: "memory"); SBAR();
#define PK(L_, H_) (bf16x8){L_[0], L_[1], L_[2], L_[3], H_[0], H_[1], H_[2], H_[3]}
  od = __builtin_amdgcn_mfma_f32_32x32x16_bf16(pa0, PK(l0, h0), od, 0, 0, 0);
  od = __builtin_amdgcn_mfma_f32_32x32x16_bf16(pa1, PK(l1, h1), od, 0, 0, 0);
  od = __builtin_amdgcn_mfma_f32_32x32x16_bf16(pa2, PK(l2, h2), od, 0, 0, 0);
  od = __builtin_amdgcn_mfma_f32_32x32x16_bf16(pa3, PK(l3, h3), od, 0, 0, 0);
#undef PK
}
template <int DV, int D0> __device__ __forceinline__ void pv_pair(f32x16& oa, f32x16& ob, int vb, bf16x8 pa0, bf16x8 pa1, bf16x8 pa2, bf16x8 pa3) {
  constexpr int NS = DV / 32;
#define VOFF(d, ks, half) ((d) * 512 + (ks) * (2 * NS * 512) + (half) * (NS * 512))
  const s16x4 al0 = tr_read<VOFF(D0, 0, 0)>(vb), ah0 = tr_read<VOFF(D0, 0, 1)>(vb), al1 = tr_read<VOFF(D0, 1, 0)>(vb), ah1 = tr_read<VOFF(D0, 1, 1)>(vb);
  const s16x4 al2 = tr_read<VOFF(D0, 2, 0)>(vb), ah2 = tr_read<VOFF(D0, 2, 1)>(vb), al3 = tr_read<VOFF(D0, 3, 0)>(vb), ah3 = tr_read<VOFF(D0, 3, 1)>(vb);
  const s16x4 bl0 = tr_read<VOFF(D0 + 1, 0, 0)>(vb), bh0 = tr_read<VOFF(D0 + 1, 0, 1)>(vb), bl1 = tr_read<VOFF(D0 + 1, 1, 0)>(vb), bh1 = tr_read<VOFF(D0 + 1, 1, 1)>(vb);
  const s16x4 bl2 = tr_read<VOFF(D0 + 1, 2, 0)>(vb), bh2 = tr_read<VOFF(D0 + 1, 2, 1)>(vb), bl3 = tr_read<VOFF(D0 + 1, 3, 0)>(vb), bh3 = tr_read<VOFF(D0 + 1, 3, 1)>(vb);
#undef VOFF
  asm volatile("s_waitcnt lgkmcnt(0)" ::: "memory"); SBAR();
#define PK(L_, H_) (bf16x8){L_[0], L_[1], L_[2], L_[3], H_[0], H_[1], H_[2], H_[3]}
  oa = __builtin_amdgcn_mfma_f32_32x32x16_bf16(pa0, PK(al0, ah0), oa, 0, 0, 0);
  ob = __builtin_amdgcn_mfma_f32_32x32x16_bf16(pa0, PK(bl0, bh0), ob, 0, 0, 0);
  oa = __builtin_amdgcn_mfma_f32_32x32x16_bf16(pa1, PK(al1, ah1), oa, 0, 0, 0);
  ob = __builtin_amdgcn_mfma_f32_32x32x16_bf16(pa1, PK(bl1, bh1), ob, 0, 0, 0);
  oa = __builtin_amdgcn_mfma_f32_32x32x16_bf16(pa2, PK(al2, ah2), oa, 0, 0, 0);
  ob = __builtin_amdgcn_mfma_f32_32x32x16_bf16(pa2, PK(bl2, bh2), ob, 0, 0, 0);
  oa = __builtin_amdgcn_mfma_f32_32x32x16_bf16(pa3, PK(al3, ah3), oa, 0, 0, 0);
  ob = __builtin_amdgcn_mfma_f32_32x32x16_bf16(pa3, PK(bl3, bh3), ob, 0, 0, 0);
#undef PK
}
template <int DV> __device__ __forceinline__ void pv_all(f32x16* o, int vb, bf16x8 pa0, bf16x8 pa1, bf16x8 pa2, bf16x8 pa3) {
  pv_pair<DV, 0>(o[0], o[1], vb, pa0, pa1, pa2, pa3);
  if constexpr (DV == 128) pv_pair<DV, 2>(o[2], o[3], vb, pa0, pa1, pa2, pa3);
}
template <int DQK, int DV>
__device__ __forceinline__ void attn_body(const bf16_t* __restrict__ Qb, const bf16_t* kp0, int kst0, const bf16_t* kp1, int kst1, bool k1valid,
                                          const bf16_t* vp0, const bf16_t* vp1, int nkeys, f32x16 (&o)[DV / 32]) {
  constexpr int KSTR = (DQK == 96) ? 256 : 128, SHM_K = 64 * KSTR, SHM_V = 64 * DV * 2, CK = DQK / 8, CV = DV / 8, ND = DV / 32;
  constexpr bool K2 = (64 * CK > 512), V2 = (64 * CV > 512);
  constexpr bool MSUM = (DV == 64);
  f32x16 osum = f32x16{}; const bf16x8 ones = {16256, 16256, 16256, 16256, 16256, 16256, 16256, 16256};
  const int tid = launder_tid(), wid = tid >> 6, lane = tid & 63, r32 = lane & 31, hi = lane >> 5;
  unsigned char* V_lds = g_lds; unsigned char* K_lds = g_lds + 3 * SHM_V;
  float* ws = (float*)(g_lds + 3 * SHM_V + 3 * SHM_K) + wid * 64; float* li_l = ws; float* al_l = ws + 32;
  float m_reg = 0.f, l_reg = 0;
#pragma unroll
  for (int d = 0; d < ND; ++d) o[d] = f32x16{};
  bf16x8 qr[DQK / 16];
  const bf16_t* Qw = Qb + (long)(wid * 32 + r32) * DQK + hi * 8;
#pragma unroll
  for (int d0 = 0; d0 < DQK / 16; ++d0) qr[d0] = *reinterpret_cast<const bf16x8*>(Qw + d0 * 16);
  const int kq0 = tid, kq1 = tid + 512;
  const int kd0 = kswz<DQK>(kq0 / CK, (kq0 % CK) * 16), kd1 = kswz<DQK>((kq1 / CK) & 63, (kq1 % CK) * 16);
  const int vq0 = tid, vq1 = tid + 512;
  const int vd0 = v_st<DV>(vq0 / CV, (vq0 % CV) * 8), vd1 = v_st<DV>((vq1 / CV) & 63, (vq1 % CV) * 8);
  const int vb0 = (int)(uintptr_t)(__attribute__((address_space(3))) unsigned char*)V_lds + v_rd_base(lane);
  struct St { bf16x8 k0, k1, v0, v1; } sr_[2];
#define SLOAD(i, key0) do { sr_[i].k0 = *reinterpret_cast<const bf16x8*>(kp0 + (long)(key0) * kst0); \
    if (K2) { if (k1valid) sr_[i].k1 = *reinterpret_cast<const bf16x8*>(kp1 + (long)(key0) * kst1); } \
    sr_[i].v0 = *reinterpret_cast<const bf16x8*>(vp0 + (long)(key0) * DV); \
    if (V2) sr_[i].v1 = *reinterpret_cast<const bf16x8*>(vp1 + (long)(key0) * DV); } while (0)
#define SWRITE(b, i) do { *(bf16x8*)(K_lds + (b) * SHM_K + kd0) = sr_[i].k0; \
    if (K2) { if (k1valid) *(bf16x8*)(K_lds + (b) * SHM_K + kd1) = sr_[i].k1; } \
    *(bf16x8*)(V_lds + (b) * SHM_V + vd0) = sr_[i].v0; \
    if (V2) *(bf16x8*)(V_lds + (b) * SHM_V + vd1) = sr_[i].v1; } while (0)
#define RESC(a) do { if (__any((a) < 1.f)) { if (hi == 0) al_l[r32] = (a); asm volatile("s_waitcnt lgkmcnt(0)" ::: "memory"); \
    _Pragma("unroll") for (int d = 0; d < ND; ++d) _Pragma("unroll") for (int r = 0; r < 16; ++r) o[d][r] *= al_l[crow(r, hi)]; \
    if (MSUM) { _Pragma("unroll") for (int r = 0; r < 16; ++r) osum[r] *= al_l[crow(r, hi)]; } } } while (0)
#define PSUM() do { if (MSUM) { osum = __builtin_amdgcn_mfma_f32_32x32x16_bf16(pa0, ones, osum, 0, 0, 0); osum = __builtin_amdgcn_mfma_f32_32x32x16_bf16(pa1, ones, osum, 0, 0, 0); \
    osum = __builtin_amdgcn_mfma_f32_32x32x16_bf16(pa2, ones, osum, 0, 0, 0); osum = __builtin_amdgcn_mfma_f32_32x32x16_bf16(pa3, ones, osum, 0, 0, 0); } } while (0)
#define ROT() do { bprev = bj; bj = bnext; bnext = (bnext == 2) ? 0 : bnext + 1; } while (0)
  f32x16 pA0, pA1, pB0, pB1; float mnA, mnB, alA, alB; bf16x8 pa0, pa1, pa2, pa3; const int NT = nkeys / 64;
  __syncthreads();
  SLOAD(0, 0); SWRITE(0, 0);
  SLOAD(1, 64); if (2 < NT) SLOAD(0, 128);
  __syncthreads();
  qkt<DQK>(pA0, pA1, K_lds, qr, r32, hi); partialSM<DQK>(pA0, pA1, m_reg, mnA, alA);
  SWRITE(1, 1); __syncthreads();
  int bprev = 0, bj = 1, bnext = 2;
  for (int j = 1; j + 1 < NT; j += 2) {
    SBAR(); qkt<DQK>(pB0, pB1, K_lds + bj * SHM_K, qr, r32, hi);
    finishSM<!MSUM>(pA0, pA1, alA, l_reg, pa0, pa1, pa2, pa3); SBAR();
    SLOAD(1, (j + 2) * 64); SBAR();
    pv_all<DV>(o, vb0 + bprev * SHM_V, pa0, pa1, pa2, pa3); PSUM(); partialSM<DQK>(pB0, pB1, m_reg, mnB, alB);
    SWRITE(bnext, 0);
    RESC(alB); __syncthreads(); ROT();
    SBAR(); qkt<DQK>(pA0, pA1, K_lds + bj * SHM_K, qr, r32, hi);
    finishSM<!MSUM>(pB0, pB1, alB, l_reg, pa0, pa1, pa2, pa3); SBAR();
    if (j + 3 < NT) SLOAD(0, (j + 3) * 64); SBAR();
    pv_all<DV>(o, vb0 + bprev * SHM_V, pa0, pa1, pa2, pa3); PSUM(); partialSM<DQK>(pA0, pA1, m_reg, mnA, alA);
    SWRITE(bnext, 1);
    RESC(alA); __syncthreads(); ROT();
  }
  SBAR(); qkt<DQK>(pB0, pB1, K_lds + bj * SHM_K, qr, r32, hi);
  finishSM<!MSUM>(pA0, pA1, alA, l_reg, pa0, pa1, pa2, pa3); SBAR();
  pv_all<DV>(o, vb0 + bprev * SHM_V, pa0, pa1, pa2, pa3); PSUM(); partialSM<DQK>(pB0, pB1, m_reg, mnB, alB);
  RESC(alB);
  finishSM<!MSUM>(pB0, pB1, alB, l_reg, pa0, pa1, pa2, pa3); SBAR();
  pv_all<DV>(o, vb0 + bj * SHM_V, pa0, pa1, pa2, pa3); PSUM();
  if (hi == 0) li_l[r32] = l_reg; asm volatile("s_waitcnt lgkmcnt(0)" ::: "memory");
#pragma unroll
  for (int r = 0; r < 16; ++r) { const float rl = __builtin_amdgcn_rcpf(MSUM ? osum[r] : li_l[crow(r, hi)]);
#pragma unroll
    for (int d = 0; d < ND; ++d) o[d][r] *= rl; }
  __syncthreads();
#undef SLOAD
#undef SWRITE
#undef RESC
#undef PSUM
#undef ROT
}

__device__ __forceinline__ void mla_unit(const Params& p, int b, int h, int qrow0, int key0, int nkeys, long tok0) {
  const int tid = launder_tid(), wid = tid >> 6, lane = tid & 63, r32 = lane & 31, hi = lane >> 5;
  const bf16_t* Q = (const bf16_t*)(p.ws + O_QMLA) + (((long)b * 8 + h) * SK + qrow0) * 96;
  const bf16_t* KN = (const bf16_t*)(p.ws + O_KNOPE) + (((long)b * 8 + h) * SK + key0) * 64;
  const bf16_t* KR = (const bf16_t*)(p.ws + O_KROPE) + ((long)b * SK + key0) * 32;
  const bf16_t* V = (const bf16_t*)(p.ws + O_VMLA) + (((long)b * 8 + h) * SK + key0) * 64;
  const int q0 = tid, q1 = tid + 512; const int r0 = q0 / 12, c0 = q0 % 12, r1 = (q1 / 12) & 63, c1 = q1 % 12;
  const bf16_t* kp0 = c0 < 8 ? KN + (long)r0 * 64 + c0 * 8 : KR + (long)r0 * 32 + (c0 - 8) * 8; const int ks0 = c0 < 8 ? 64 : 32;
  const bf16_t* kp1 = c1 < 8 ? KN + (long)r1 * 64 + c1 * 8 : KR + (long)r1 * 32 + (c1 - 8) * 8; const int ks1 = c1 < 8 ? 64 : 32;
  const bf16_t* vp0 = V + (long)(tid >> 3) * 64 + (tid & 7) * 8;
  f32x16 o[2];
  attn_body<96, 64>(Q, kp0, ks0, kp1, ks1, tid < 256, vp0, vp0, nkeys, o);
  bf16_t* Y = (bf16_t*)(p.ws + O_YMLA);
#pragma unroll
  for (int r = 0; r < 16; ++r) { const long tok = tok0 + wid * 32 + crow(r, hi);
#pragma unroll
    for (int d = 0; d < 2; ++d) { const unsigned pk = cvtpk(o[d][r], 0.f); Y[tok * 512 + h * 64 + d * 32 + r32] = (unsigned short)(pk & 0xffff); } }
}
__device__ __forceinline__ void diff_unit(const Params& p, int l, int b, int h, int qrow0, int key0, int nkeys, long tok0) {
  const int tid = launder_tid(), wid = tid >> 6, lane = tid & 63, r32 = lane & 31, hi = lane >> 5;
  const __amdgpu_buffer_rsrc_t rsd = MK_RSRC((float*)(p.ws + O_O1S) + (size_t)blockIdx.x * 32768); const unsigned vo4 = (unsigned)tid * 4u;
  const float lam = ((const float*)(p.ws + O_LAM))[l];
  const float li = 0.8f - 0.6f * expf(-0.3f * (float)l);
  const bf16_t* V = (const bf16_t*)(p.ws + O_VD) + (((long)b * 4 + h) * SK + key0) * 128;
  const bf16_t* vp0 = V + (long)(tid >> 4) * 128 + (tid & 15) * 8; const bf16_t* vp1 = V + (long)(32 + (tid >> 4)) * 128 + (tid & 15) * 8;
  f32x16 o[4];
  for (int s = 0; s < 2; ++s) {
    const bf16_t* Q = (const bf16_t*)(p.ws + O_QD) + (((long)b * 8 + h * 2 + s) * SK + qrow0) * 64;
    const bf16_t* K = (const bf16_t*)(p.ws + O_KD) + (((long)b * 8 + h * 2 + s) * SK + key0) * 64;
    const bf16_t* kp0 = K + (long)(tid >> 3) * 64 + (tid & 7) * 8;
    attn_body<64, 128>(Q, kp0, 64, kp0, 64, false, vp0, vp1, nkeys, o);
    if (s == 0) {
#pragma unroll
      for (int d = 0; d < 4; ++d)
#pragma unroll
        for (int r = 0; r < 16; ++r) __builtin_amdgcn_raw_buffer_store_b32(__float_as_uint(o[d][r]), rsd, vo4, (d * 16 + r) * 2048, 0);
    }
  }
  const float* dn = p.in[19] + l * 128; bf16_t* Y = (bf16_t*)(p.ws + O_YDIFF);
  float gn[4];
#pragma unroll
  for (int d = 0; d < 4; ++d) gn[d] = dn[d * 32 + r32] * (1.f - li);
#pragma unroll
  for (int r = 0; r < 16; ++r) {
    float v[4], ss = 0.f;
#pragma unroll
    for (int d = 0; d < 4; ++d) { v[d] = __uint_as_float(__builtin_amdgcn_raw_buffer_load_b32(rsd, vo4, (d * 16 + r) * 2048, 0)) - lam * o[d][r]; ss += v[d] * v[d]; }
#pragma unroll
    for (int m = 1; m < 32; m <<= 1) ss += __shfl_xor(ss, m);
    const float rstd = rsqrtf(ss * (1.f / 128.f) + EPS);
    const long tok = tok0 + wid * 32 + crow(r, hi);
#pragma unroll
    for (int d = 0; d < 4; ++d) { const unsigned pk = cvtpk(v[d] * rstd * gn[d], 0.f); Y[tok * 512 + h * 128 + d * 32 + r32] = (unsigned short)(pk & 0xffff); }
    MEMFENCE();
  }
}
__device__ __forceinline__ void phase_attn(const Params& p, int l) {
  const int tid = launder_tid(), wid = tid >> 6, lane = tid & 63;
  const int q = logical_wg(), G = gridDim.x;
  const bf16_t* RO = (const bf16_t*)(p.ws + O_RETO); bf16_t* YR = (bf16_t*)(p.ws + O_YRET); const float* rn = p.in[21] + l * 128;
  const int vc = (lane & 15) * 8; f32x8 gnv = *(const f32x8*)(rn + vc);
  const int rp_slot = blockIdx.x % 3;
  auto ret_post = [&]() __attribute__((always_inline)) {
  if (PMASK & 0x40000) {
    const long nwaves = (long)gridDim.x * 8, w0 = (long)blockIdx.x * 8 + wid; const long nrows = (l == 0) ? (long)T : (long)TL;
    for (long rb = w0; rb < nrows; rb += nwaves * 4) {
      u32x4 a[4], bq[4], g[4];
#pragma unroll
      for (int j = 0; j < 4; ++j) { const long row = rb + j * nwaves;
        if (row < nrows) { a[j] = *(const u32x4*)(RO + row * 512 + lane * 8); bq[j] = *(const u32x4*)(RO + (size_t)T * 512 + row * 512 + lane * 8); g[j] = *(const u32x4*)(YR + row * 512 + lane * 8); } }
#pragma unroll
      for (int j = 0; j < 4; ++j) { const long row = rb + j * nwaves;
        if (row < nrows) {
          float v[8], ss = 0.f;
#pragma unroll
          for (int e = 0; e < 4; ++e) { v[2 * e] = __uint_as_float(a[j][e] << 16) + __uint_as_float(bq[j][e] << 16); v[2 * e + 1] = __uint_as_float(a[j][e] & 0xffff0000u) + __uint_as_float(bq[j][e] & 0xffff0000u); }
#pragma unroll
          for (int e = 0; e < 8; ++e) ss += v[e] * v[e];
#pragma unroll
          for (int m = 1; m < 16; m <<= 1) ss += __shfl_xor(ss, m);
          const float rstd = rsqrtf(ss * (1.f / 128.f) + EPS);
          u32x4 w;
#pragma unroll
          for (int e = 0; e < 4; ++e) { const float g0 = __uint_as_float(g[j][e] << 16), g1 = __uint_as_float(g[j][e] & 0xffff0000u); w[e] = cvtpk(v[2 * e] * rstd * gnv[2 * e] * g0, v[2 * e + 1] * rstd * gnv[2 * e + 1] * g1); }
          *(u32x4*)(YR + row * 512 + lane * 8) = w; } }
    }
  }
  };
  if (rp_slot == 0) ret_post();
  if (PMASK & 0x10000) for (int U = q; U < 2048; U += G) { const int h = U >> 8, w = U & 255, b = w >> 5, qb = w & 31; mla_unit(p, b, h, qb * 256, 0, SK, (long)b * 8192 + qb * 256); }
  if (rp_slot == 1) ret_post();
  if (PMASK & 0x20000) for (int U = q; U < 1024; U += G) { const int h = U >> 8, w = U & 255, b = w >> 5, qb = w & 31; diff_unit(p, l, b, h, qb * 256, 0, SK, (long)b * 8192 + qb * 256); }
  if ((PMASK & 0x10000) && l == 0) for (int U = q; U < 64; U += G) { const int b = U >> 3, h = U & 7; mla_unit(p, b, h, 8192, 8192, 256, (long)TL + b * 256); }
  if ((PMASK & 0x20000) && l == 0) for (int U = q; U < 32; U += G) { const int b = U >> 2, h = U & 3; diff_unit(p, l, b, h, 8192, 8192, 256, (long)TL + b * 256); }
  if (rp_slot == 2) ret_post();
}

template <int MODE>
__device__ __forceinline__ void branch_epi(const f32x4 (&acc)[2][2][4][2], unsigned char* scr, bf16_t* YBR, int pm, int pn, int tid, int wr, int wc, int fr, int fq) {
  const __amdgpu_buffer_rsrc_t rs = MK_RSRC(scr);
  const unsigned vo8 = (unsigned)tid * 8u, vo16 = (unsigned)tid * 16u;
#pragma unroll
  for (int bj = 0; bj < 2; ++bj)
#pragma unroll
    for (int n = 0; n < 2; ++n) {
      const long tok = (long)pm * 256 + bj * 128 + wc * 32 + n * 16 + fr; bf16_t* yrow = YBR + tok * 1024 + pn * 256 + wr * 64 + fq * 4;
#pragma unroll
      for (int ai = 0; ai < 2; ++ai)
#pragma unroll
        for (int m = 0; m < 4; ++m) { const int e = ((ai * 2 + bj) * 4 + m) * 2 + n;
          const u32x2 w = __builtin_amdgcn_raw_buffer_load_b64(rs, vo8, e * 4096, 0); f32x4 v = acc[ai][bj][m][n];
          v[0] *= __uint_as_float(w.x << 16); v[1] *= __uint_as_float(w.x & 0xffff0000u); v[2] *= __uint_as_float(w.y << 16); v[3] *= __uint_as_float(w.y & 0xffff0000u);
          if (MODE > 0) v += __builtin_bit_cast(f32x4, __builtin_amdgcn_raw_buffer_load_b128(rs, vo16, 131072 + e * 8192, 0));
          if (MODE < 2) __builtin_amdgcn_raw_buffer_store_b128(__builtin_bit_cast(u32x4, v), rs, vo16, 131072 + e * 8192, 0); else store4bf(yrow + ai * 128 + m * 16, v);
          if (m & 1) MEMFENCE(); }
    }
}
__device__ __forceinline__ void phase_branch(const Params& p, int npm) {
  const char* WG = (const char*)(p.ws + O_WG); const char* WBR = (const char*)(p.ws + O_WBR); const char* H = (const char*)(p.ws + O_H);
  bf16_t* YBR = (bf16_t*)(p.ws + O_YBR);
  unsigned char* scr = p.ws + O_G6S + (size_t)blockIdx.x * 393216;
  const int q = logical_wg(), Gd = gridDim.x, tot = npm * 4;
  auto get = [&](int idx, GOp& o) __attribute__((always_inline)) -> bool { const int u = idx / 6, j = idx - u * 6, i = j >> 1; const int U = q + u * Gd; if (U >= tot) return false; int pm, pn; unit_decode(U, 4, 4, pm, pn);
    if ((j & 1) == 0) { o.A = WG + ((size_t)i * 1024 + pn * 256) * 2048; o.B = H + (size_t)pm * 256 * 2048; o.lda2 = 2048; o.ldb2 = 2048; o.nt = 16; }
    else { const char* Y = (const char*)(p.ws + (i == 0 ? O_YMLA : (i == 1 ? O_YDIFF : O_YRET))); o.A = WBR + ((size_t)i * 1024 + pn * 256) * 1024; o.B = Y + (size_t)pm * 256 * 1024; o.lda2 = 1024; o.ldb2 = 1024; o.nt = 8; }
    return true; };
  auto epi = [&](int idx, const f32x4 (&acc)[2][2][4][2]) __attribute__((always_inline)) {
    const int u = idx / 6, j = idx - u * 6, i = j >> 1; const int U = q + u * Gd; int pm, pn; unit_decode(U, 4, 4, pm, pn);
    LANE_IDS
    if ((j & 1) == 0) {
      const unsigned vo8 = (unsigned)tid * 8u; const __amdgpu_buffer_rsrc_t rs = MK_RSRC(scr);
#pragma unroll
      for (int ai = 0; ai < 2; ++ai)
#pragma unroll
        for (int bj = 0; bj < 2; ++bj)
#pragma unroll
          for (int m = 0; m < 4; ++m)
#pragma unroll
            for (int n = 0; n < 2; ++n) { const int e = ((ai * 2 + bj) * 4 + m) * 2 + n; const f32x4 v = acc[ai][bj][m][n]; u32x2 w; w.x = cvtpk(sigm_f(v[0]), sigm_f(v[1])); w.y = cvtpk(sigm_f(v[2]), sigm_f(v[3])); __builtin_amdgcn_raw_buffer_store_b64(w, rs, vo8, e * 4096, 0); if (n == 1) MEMFENCE(); }
    } else {
      if (i == 0) branch_epi<0>(acc, scr, YBR, pm, pn, tid, wr, wc, fr, fq);
      else if (i == 1) branch_epi<1>(acc, scr, YBR, pm, pn, tid, wr, wc, fr, fq);
      else branch_epi<2>(acc, scr, YBR, pm, pn, tid, wr, wc, fr, fq);
    }
  };
  gemm_stream(get, epi);
}


#ifdef DIAG
__device__ __forceinline__ float blk_reduce(float v, int mode, float* red) {
  const int tid = launder_tid(), lane = tid & 63, wid = tid >> 6;
#pragma unroll
  for (int o = 32; o > 0; o >>= 1) { const float t = __shfl_xor(v, o); v = mode ? fmaxf(v, t) : v + t; }
  __syncthreads();
  if (lane == 0) red[wid] = v;
  __syncthreads();
  float r = red[0];
  for (int i = 1; i < 8; ++i) r = mode ? fmaxf(r, red[i]) : r + red[i];
  return r;
}
__device__ __forceinline__ void phase_diag(const Params& p) {
  const int tid = launder_tid();
  float* w0 = (float*)g_lds; float* w1 = w0 + 8448; float* qv = w1 + 8448; float* ov = qv + 256; float* red = ov + 256;
  float* dg = (float*)(p.ws + O_LAM) + 16;
  const int S = blockIdx.x; const int b = S & 7, t = (S * 977 + 131) % 8192; const long tok = (long)b * 8192 + t;
  float num = 0.f, den = 0.f;
#if DIAG == 1
  { const int h = (S >> 3) & 7; const bf16_t* Q = (const bf16_t*)(p.ws + O_QMLA) + (((long)b * 8 + h) * SK + t) * 96;
    const bf16_t* KN = (const bf16_t*)(p.ws + O_KNOPE) + ((long)b * 8 + h) * SK * 64; const bf16_t* KR = (const bf16_t*)(p.ws + O_KROPE) + (long)b * SK * 32;
    const bf16_t* V = (const bf16_t*)(p.ws + O_VMLA) + ((long)b * 8 + h) * SK * 64;
    if (tid < 96) qv[tid] = bf2f(Q[tid]);
    __syncthreads();
    float mx = -1e30f;
    for (int k = tid; k < SK; k += 512) { float d = 0.f; for (int e = 0; e < 64; ++e) d += qv[e] * bf2f(KN[(long)k * 64 + e]); for (int e = 0; e < 32; ++e) d += qv[64 + e] * bf2f(KR[(long)k * 32 + e]); d *= 0.10206207261596575f; w0[k] = d; mx = fmaxf(mx, d); }
    mx = blk_reduce(mx, 1, red); float l = 0.f;
    for (int k = tid; k < SK; k += 512) { const float e = expf(w0[k] - mx); w0[k] = e; l += e; }
    l = blk_reduce(l, 0, red);
    if (tid < 64) { float a = 0.f; for (int k = 0; k < SK; ++k) a += w0[k] * bf2f(V[(long)k * 64 + tid]); a /= l;
      const float y = bf2f(((const bf16_t*)(p.ws + O_YMLA))[tok * 512 + h * 64 + tid]); num = (a - y) * (a - y); den = a * a; } }
#elif DIAG == 2
  { const int h = (S >> 3) & 3; const float lam = ((const float*)(p.ws + O_LAM))[0];
    const bf16_t* V = (const bf16_t*)(p.ws + O_VD) + ((long)b * 4 + h) * SK * 128; float ls[2];
    for (int s2 = 0; s2 < 2; ++s2) { float* w = s2 ? w1 : w0;
      const bf16_t* Q = (const bf16_t*)(p.ws + O_QD) + (((long)b * 8 + h * 2 + s2) * SK + t) * 64; const bf16_t* K = (const bf16_t*)(p.ws + O_KD) + ((long)b * 8 + h * 2 + s2) * SK * 64;
      __syncthreads();
      if (tid < 64) qv[tid] = bf2f(Q[tid]);
      __syncthreads();
      float mx = -1e30f;
      for (int k = tid; k < SK; k += 512) { float d = 0.f; for (int e = 0; e < 64; ++e) d += qv[e] * bf2f(K[(long)k * 64 + e]); d *= 0.125f; w[k] = d; mx = fmaxf(mx, d); }
      mx = blk_reduce(mx, 1, red); float l = 0.f;
      for (int k = tid; k < SK; k += 512) { const float e = expf(w[k] - mx); w[k] = e; l += e; }
      ls[s2] = blk_reduce(l, 0, red); }
    if (tid < 256) { const int d = tid & 127, s2 = tid >> 7; const float* w = s2 ? w1 : w0; float a = 0.f; for (int k = 0; k < SK; ++k) a += w[k] * bf2f(V[(long)k * 128 + d]); ov[tid] = a / ls[s2]; }
    __syncthreads();
    float val = 0.f; if (tid < 128) val = ov[tid] - lam * ov[128 + tid];
    const float ss = blk_reduce(val * val, 0, red); const float rstd = rsqrtf(ss * (1.f / 128.f) + EPS);
    if (tid < 128) { const float a = val * rstd * p.in[19][tid] * 0.8f; const float y = bf2f(((const bf16_t*)(p.ws + O_YDIFF))[tok * 512 + h * 128 + tid]); num = (a - y) * (a - y); den = a * a; } }
#elif DIAG >= 3
  { const int h = (S >> 3) & 3, dir = (S >> 5) & 1; const float lg = -expf(p.in[20][dir * 4 + h]);
    const bf16_t* Q = (const bf16_t*)(p.ws + O_RQ) + (((long)b * 4 + h) * SK + t) * 64; const bf16_t* K = (const bf16_t*)(p.ws + O_RK) + ((long)b * 4 + h) * SK * 64;
    const bf16_t* V = (const bf16_t*)(p.ws + O_RV) + ((long)b * 4 + h) * SK * 128;
    if (tid < 64) qv[tid] = bf2f(Q[tid]);
    __syncthreads();
    for (int k = tid; k < SK; k += 512) { int dist; if (k < 8192) dist = dir ? k - t : t - k; else { const int j = k - 8192; dist = dir ? 8192 - t + j : 256 + t - j; }
      float d = 0.f; bool inc = dist >= 0;
#if DIAG == 4
      inc = inc && (k < 8192) && ((k >> 7) == (t >> 7));
#endif
#if DIAG == 5
      inc = inc && !((k < 8192) && ((k >> 7) == (t >> 7)));
#endif
      if (inc) { for (int e = 0; e < 64; ++e) d += qv[e] * bf2f(K[(long)k * 64 + e]); d *= expf(lg * (float)dist); } w0[k] = d; }
    __syncthreads();
    if (tid < 128) { float a = 0.f; for (int k = 0; k < SK; ++k) a += w0[k] * bf2f(V[(long)k * 128 + tid]);
      const float y = bf2f(((const bf16_t*)(p.ws + O_RETO))[(size_t)dir * T * 512 + tok * 512 + h * 128 + tid]); num = (a - y) * (a - y); den = a * a; } }
#endif
  num = blk_reduce(num, 0, red); den = blk_reduce(den, 0, red);
  if (tid == 0) { atomicAdd(dg, num); atomicAdd(dg + 1, den); }
}
__device__ __forceinline__ void phase_diag_out(const Params& p) {
  const float* dg = (const float*)(p.ws + O_LAM) + 16; const float m = dg[0] / fmaxf(dg[1], 1e-30f);
  float c2 = 10.f + log10f(fmaxf(m, 1e-12f)); c2 = fminf(fmaxf(c2, 0.f), 12.f); const float c = sqrtf(c2);
  for (long i = (long)blockIdx.x * 512 + launder_tid(); i < (long)TL * DM; i += (long)gridDim.x * 512) p.out[i] = c;
}
#endif
constexpr int NPHASE = 25;
__device__ __forceinline__ void run_phase(const Params& p0_, int ph) {
  Params p = p0_; { unsigned long long z = 0; asm volatile("" : "+s"(z)); p.ws = p0_.ws + z; p.out = p0_.out + z; }
  if (ph == 0) { if (PMASK & 0x1000) phase_p0(p); return; }
  if (ph == 25) { if (PMASK & 0x2000) phase_final(p); return; }
  const int l = (ph - 1) / 12, s = (ph - 1) % 12;
  switch (s) {
    case 0: if (PMASK & 1) { if (l == 0) { phase_norm(p, l, 0, true); conv_group(p, l, 0, 0, 2); } } break;
    case 1: if (PMASK & 2) { if (l == 1) { conv_group(p, 1, 0, 1, 2); __syncthreads(); } phase_ffn_up(p, NPM); } break;
    case 2: if (PMASK & 4) phase_ffn_down(p, l, 2, l == 0, NPM, NormFuse{l, 1, l * 3 + 0, l * 12 + 2, false}); break;
    case 3: if (PMASK & 1) { conv_group(p, l, 1, 0, 6); } break;
    case 4: if (PMASK & 16) phase_win(p); break;
    case 5: if (PMASK & 32) phase_g4(p, l); break;
    case 6: if (PMASK & 64) phase_attn(p, l); break;
    case 7: if (PMASK & 128) phase_branch(p, l == 0 ? NPM : 256); break;
    case 8: if (PMASK & 256) { conv_group(p, l, 2, 0, 2); __syncthreads(); } if (PMASK & 256) phase_wout(p, l, l == 0 ? NPM : 256, NormFuse{l, 2, l * 3 + 1, l * 12 + 8, false}); break;
    case 9: break;
    case 10: if (PMASK & 2) phase_ffn_up(p, l == 0 ? NPM : 256); break;
    case 11: if ((PMASK & 4) && l == 0) { conv_group(p, 1, 0, 0, 1); __syncthreads(); } if (PMASK & 4) phase_ffn_down(p, l, 8, false, l == 0 ? NPM : 256, NormFuse{l + 1, 0, l * 3 + 2, l * 12 + 11, l == 1}); break;
  }
}
__global__ void __launch_bounds__(512) mega_kernel(Params p) {
  cg::grid_group grid = cg::this_grid();
#ifdef DIAG
#define PHD(k) if ((k) < DIAG_STOP) { run_phase(p, (k)); grid.sync(); }
  PHD(0)
  PHD(1)
  PHD(2)
  PHD(3)
  PHD(4)
  PHD(5)
  PHD(6)
  PHD(7)
  PHD(8)
#undef PHD
  phase_diag(p); grid.sync(); phase_diag_out(p);
#else
#ifdef TIMING
#define PH(k) if ((k) >= p.ph_lo && (k) < p.ph_hi) { if (blockIdx.x == 0 && threadIdx.x == 0) ((unsigned long long*)(p.ws + O_TS))[k] = __builtin_amdgcn_s_memrealtime(); run_phase(p, (k)); grid.sync(); }
#else
#define PH_EMPTY(k) ((k) == 10 || (k) == 22 || (k) == 13)
#define PH(k) if (!PH_EMPTY(k) && (k) >= p.ph_lo && (k) < p.ph_hi) { run_phase(p, (k)); if ((k) + 1 < p.ph_hi) grid.sync(); }
#endif
  PH(0)
  PH(1)
  PH(2)
  PH(3)
  PH(4)
  PH(5)
  PH(6)
  PH(7)
  PH(8)
  PH(9)
  PH(10)
  PH(11)
  PH(12)
  PH(13)
  PH(14)
  PH(15)
  PH(16)
  PH(17)
  PH(18)
  PH(19)
  PH(20)
  PH(21)
  PH(22)
  PH(23)
  PH(24)
  PH(25)
#undef PH
#ifdef TIMING
  if (blockIdx.x == 0) { unsigned long long* ts = (unsigned long long*)(p.ws + O_TS); const unsigned long long tend = __builtin_amdgcn_s_memrealtime();
    float tot = (float)(tend - ts[0]), s1 = 0.f, s2 = 0.f;
    for (int k = 0; k < 26; ++k) { const float d = (float)((k == 25 ? tend : ts[k + 1]) - ts[k]); if ((TSEL1 >> k) & 1) s1 += d; if ((TSEL2 >> k) & 1) s2 += d; }
    const int M = (int)(s1 / tot * 100000.f + 0.5f); const float d2 = 0.04f + 0.14f * (s2 / tot);
    for (int i = threadIdx.x; i < M; i += 512) p.out[i] += 0.1f;
    if (threadIdx.x == 0) p.out[(size_t)TL * DM - 1] += d2; }
#endif
#endif
}

extern "C" void kernel_launch(void* const* d_in, const int* in_sizes, int n_in, void* d_out, int out_size, void* d_ws, size_t ws_size, hipStream_t stream) {
  static int grid_blocks = 0;
  if (grid_blocks == 0) {
    if (n_in != 25 || out_size != TL * DM || ws_size < WS_NEED) { fprintf(stderr, "kernel_launch: unexpected shapes: n_in %d out %d ws %zu (need %zu)\n", n_in, out_size, ws_size, (size_t)WS_NEED); grid_blocks = -1; return; }
    int dev = 0, cus = 0, per_cu = 0;
    hipGetDevice(&dev); hipDeviceGetAttribute(&cus, hipDeviceAttributeMultiprocessorCount, dev);
    if (hipFuncSetAttribute((const void*)mega_kernel, hipFuncAttributeMaxDynamicSharedMemorySize, LDS_BYTES) != hipSuccess) { fprintf(stderr, "kernel_launch: hipFuncSetAttribute failed\n"); grid_blocks = -1; return; }
    hipOccupancyMaxActiveBlocksPerMultiprocessor(&per_cu, (const void*)mega_kernel, 512, LDS_BYTES);
    if (per_cu < 1) per_cu = 1;
    grid_blocks = cus * per_cu;
  }
  if (grid_blocks < 0) return;
  Params p{};
  for (int i = 0; i < 25; ++i) p.in[i] = (const float*)d_in[i];
  p.out = (float*)d_out; p.ws = (unsigned char*)d_ws;
#if PER_PHASE_LAUNCH
  for (int ph = 0; ph < NPHASE; ++ph) {
    p.ph_lo = ph; p.ph_hi = ph + 1; void* args[] = {&p};
    hipError_t e = hipLaunchCooperativeKernel((const void*)mega_kernel, dim3(grid_blocks), dim3(512), args, LDS_BYTES, stream);
    if (e != hipSuccess) { fprintf(stderr, "cooperative launch failed: %s (grid %d)\n", hipGetErrorString(e), grid_blocks); break; }
  }
#else
  p.ph_lo = 0; p.ph_hi = NPHASE; void* args[] = {&p};
  hipError_t e = hipLaunchCooperativeKernel((const void*)mega_kernel, dim3(grid_blocks), dim3(512), args, LDS_BYTES, stream);
  if (e != hipSuccess) fprintf(stderr, "cooperative launch failed: %s (grid %d)\n", hipGetErrorString(e), grid_blocks);
#endif
}
```

```cpp
#include <hip/hip_runtime.h>
#include <hip/hip_cooperative_groups.h>
#include <cstdio>
#include <cstdint>
namespace cg = cooperative_groups;

#ifndef PMASK
#define PMASK 0xffffffff
#endif
#define TSEL1 ((1u<<8)|(1u<<20))
#define TSEL2 ((1u << 6) | (1u << 18))
#if defined(DIAG)
#if DIAG >= 3
#define DIAG_STOP 7
#else
#define DIAG_STOP 8
#endif
#endif
#ifndef GEMM_SP2
#define GEMM_SP2 1
#endif
#ifndef PER_PHASE_LAUNCH
#define PER_PHASE_LAUNCH 0
#endif

typedef unsigned short bf16_t;
typedef short bf16x8 __attribute__((ext_vector_type(8)));
typedef short s16x4 __attribute__((ext_vector_type(4)));
typedef float f32x4 __attribute__((ext_vector_type(4)));
typedef float f32x8 __attribute__((ext_vector_type(8)));
typedef float f32x16 __attribute__((ext_vector_type(16)));
typedef unsigned u32x4 __attribute__((ext_vector_type(4)));
typedef unsigned u32x2 __attribute__((ext_vector_type(2)));

constexpr int DM = 1024, NB = 8, SEQ = 8192, CTXL = 256, TL = NB * SEQ, TC = NB * CTXL, T = TL + TC, SK = SEQ + CTXL;
constexpr int DFF = 2816, PROJ = 6816;
constexpr int NPM = T / 256;
constexpr float EPS = 1e-6f;
constexpr float CQ_MLA = 0.10206207261596575f * 1.4426950408889634f;
constexpr float CQ_DIFF = 0.125f * 1.4426950408889634f;

constexpr size_t al256(size_t x) { return (x + 255) / 256 * 256; }
constexpr size_t O_MOD = 0;
constexpr size_t O_LAM = al256(O_MOD + (size_t)2 * 9 * 9216 * 4);
constexpr size_t O_R1C = O_LAM + 256;
constexpr size_t O_R1S = O_R1C + (size_t)8192 * 32 * 4;
constexpr size_t O_RDC = O_R1S + (size_t)8192 * 32 * 4;
constexpr size_t O_RDS = O_RDC + 128 * 16 * 4;
constexpr size_t O_RMC = O_RDS + 128 * 16 * 4;
constexpr size_t O_RMS = O_RMC + 128 * 8 * 4;
constexpr size_t O_W = al256(O_RMS + 128 * 8 * 4);
constexpr size_t O_WUP = O_W;
constexpr size_t O_WDN = O_WUP + (size_t)5632 * 1024 * 2;
constexpr size_t O_WIN = O_W;
constexpr size_t O_WG = O_WIN + (size_t)3840 * 1024 * 2;
constexpr size_t O_WQB = O_WG + (size_t)3072 * 1024 * 2;
constexpr size_t O_WKVB = O_WQB + (size_t)768 * 384 * 2;
constexpr size_t O_WBR = O_WKVB + (size_t)1024 * 256 * 2;
constexpr size_t O_WOUT = O_WBR + (size_t)3 * 1024 * 512 * 2;
constexpr size_t O_WEND = O_WOUT + (size_t)1024 * 1024 * 2;
constexpr size_t O_XC = al256(O_WEND);
constexpr size_t O_H = O_XC + (size_t)TC * DM * 4;
constexpr size_t O_M = O_H + (size_t)T * DM * 2;
constexpr size_t O_G = O_M;
constexpr size_t TB = (size_t)T;
constexpr size_t O_QLAT = O_M;
constexpr size_t O_KVLAT = O_QLAT + TB * 768;
constexpr size_t O_KNOPE = O_KVLAT + TB * 512;
constexpr size_t O_KROPE = O_KNOPE + TB * 1024;
constexpr size_t O_QD = O_KROPE + TB * 64;
constexpr size_t O_KD = O_QD + TB * 1024;
constexpr size_t O_VD = O_KD + TB * 1024;
constexpr size_t O_RQ = O_VD + TB * 1024;
constexpr size_t O_RK = O_RQ + TB * 512;
constexpr size_t O_RV = O_RK + TB * 512;
constexpr size_t O_YRET = O_RV + TB * 1024;
constexpr size_t O_QMLA = O_YRET + TB * 1024;
constexpr size_t O_VMLA = O_QMLA + TB * 1536;
constexpr size_t O_RETO = O_VMLA + TB * 1024;
constexpr size_t O_END = O_RETO + TB * 2048;
constexpr size_t O_YMLA = O_RQ;
constexpr size_t O_YDIFF = O_RV;
constexpr size_t O_O1S = O_QLAT;
constexpr size_t O_G6S = O_QMLA;
constexpr size_t O_YBR = O_RETO;
static_assert(O_G + TB * 2816 * 2 <= O_END, "ffn g fits");
constexpr size_t O_TS = O_END;
constexpr size_t O_CNT = O_TS + 512;
constexpr size_t O_PART = al256(O_CNT + 26 * 264 * 4);
constexpr size_t WS_NEED = O_PART + (size_t)6 * 264 * 4 * 256 * 4;

constexpr int LDS_BYTES = 131072 + 4096;

struct Params { const float* in[25]; float* out; unsigned char* ws; int ph_lo, ph_hi; };

extern __shared__ __attribute__((aligned(16))) unsigned char g_lds[];

#define MK_RSRC(ptr) __builtin_amdgcn_make_buffer_rsrc((void*)(ptr), 0, 0x7fffffff, 0x00020000)
#define MEMFENCE() asm volatile("" ::: "memory")
__device__ __forceinline__ int launder_tid() { int t = __builtin_amdgcn_workitem_id_x(); asm volatile("" : "+v"(t)); return t; }
typedef __bf16 bf16v2_t __attribute__((ext_vector_type(2)));
typedef float f32v2_t __attribute__((ext_vector_type(2)));
__device__ __forceinline__ unsigned cvtpk(float lo, float hi) { const f32v2_t v = {lo, hi}; const bf16v2_t b = __builtin_convertvector(v, bf16v2_t); return __builtin_bit_cast(unsigned, b); }
__device__ __forceinline__ float bf2f(unsigned short b) { return __uint_as_float(((unsigned)b) << 16); }
__device__ __forceinline__ float silu_f(float v) { return v * __builtin_amdgcn_rcpf(1.f + __expf(-v)); }
__device__ __forceinline__ float sigm_f(float v) { return __builtin_amdgcn_rcpf(1.f + __expf(-v)); }
__device__ __forceinline__ void store4bf(bf16_t* p, f32x4 v) { u32x2 w; w.x = cvtpk(v[0], v[1]); w.y = cvtpk(v[2], v[3]); *(u32x2*)p = w; }
__device__ __forceinline__ int logical_wg() { const int g = gridDim.x, w = blockIdx.x; return (g % 8 == 0) ? (w % 8) * (g / 8) + w / 8 : w; }

constexpr int BK = 64, HALF = 128, HTB = HALF * BK * 2;
__device__ __forceinline__ int lds_byte(int r, int c) { int st = (r >> 4) * 2 + (c >> 5), rr = r & 15, cc = c & 31, ob = rr * 64 + cc * 2; return st * 1024 + (ob ^ (((ob >> 9) & 1) << 5)); }
__device__ __forceinline__ void stage_rc(int b, int& R, int& C) { int st = b / 1024, sb = b % 1024, swz = sb ^ (((sb >> 9) & 1) << 5); R = (st >> 1) * 16 + swz / 64; C = (st & 1) * 32 + (swz % 64) / 2; }

#define LAS __attribute__((address_space(3)))
#define WAIT_V(n) asm volatile("s_waitcnt vmcnt(" #n ")" ::: "memory")
#define WAIT_L(n) asm volatile("s_waitcnt lgkmcnt(" #n ")" ::: "memory")
#define BAR __builtin_amdgcn_s_barrier()
#define SCHED __builtin_amdgcn_sched_barrier(0)

struct GOp { const char* A; const char* B; unsigned lda2, ldb2; int nt; };
template <class GetOp, class Epi>
__device__ __forceinline__ void gemm_stream(GetOp get, Epi epi) {
  LAS unsigned char* lds = (LAS unsigned char*)g_lds;
  GOp cur, nxt;
  if (!get(0, cur)) return;
  const int tid = launder_tid();
  const int wid = __builtin_amdgcn_readfirstlane(tid >> 6), lane = tid & 63, wr = wid >> 2, wc = wid & 3, fr = lane & 15, fq = lane >> 4;
  int R0, C0, R1, C1; stage_rc(tid * 16, R0, C0); stage_rc(tid * 16 + 8192, R1, C1);
  const unsigned ldsw = (unsigned)wid * 1024u;
  const int aoff = lds_byte(wr * 64 + fr, fq * 8), boff = lds_byte(wc * 32 + fr, fq * 8);
  unsigned cvA[2], cvB[2], nvA[2], nvB[2];
  cvA[0] = R0 * cur.lda2 + C0 * 2; cvA[1] = R1 * cur.lda2 + C1 * 2; cvB[0] = R0 * cur.ldb2 + C0 * 2; cvB[1] = R1 * cur.ldb2 + C1 * 2;
#define G_SA(b, h) (((b) * 2 + (h)) * HTB)
#define G_SB(b, h) ((4 + (b) * 2 + (h)) * HTB)
#define STAGE(bufoff, gbase, voff) do { _Pragma("unroll") for (int _i = 0; _i < 2; ++_i) \
    __builtin_amdgcn_global_load_lds((const unsigned*)((const char*)(gbase) + (voff)[_i]), (LAS unsigned*)(lds + (bufoff) + ldsw + _i * 8192), 16, 0, 0); } while (0)
#define LDA(dst, b, h) do { _Pragma("unroll") for (int m = 0; m < 4; ++m) _Pragma("unroll") for (int k = 0; k < 2; ++k) dst[m][k] = *(const LAS bf16x8*)(lds + G_SA(b, h) + aoff + m * 2048 + k * 1024); } while (0)
#define LDB(dst, b, h) do { _Pragma("unroll") for (int n = 0; n < 2; ++n) _Pragma("unroll") for (int k = 0; k < 2; ++k) dst[n][k] = *(const LAS bf16x8*)(lds + G_SB(b, h) + boff + n * 2048 + k * 1024); } while (0)
#define MMA(ai, bj, At_, Bt_) do { __builtin_amdgcn_s_setprio(1); \
    _Pragma("unroll") for (int m = 0; m < 4; ++m) _Pragma("unroll") for (int n = 0; n < 2; ++n) _Pragma("unroll") for (int k = 0; k < 2; ++k) \
      acc[ai][bj][m][n] = __builtin_amdgcn_mfma_f32_16x16x32_bf16(At_[m][k], Bt_[n][k], acc[ai][bj][m][n], 0, 0, 0); \
    __builtin_amdgcn_s_setprio(0); } while (0)
  { const size_t hA = (size_t)HALF * cur.lda2, hB = (size_t)HALF * cur.ldb2;
#if GEMM_SP2
    STAGE(G_SB(0, 0), cur.B, cvB); STAGE(G_SB(0, 1), cur.B + hB, cvB); STAGE(G_SA(0, 0), cur.A, cvA); STAGE(G_SA(0, 1), cur.A + hA, cvA);
    if (wr == 1) BAR;
    WAIT_V(2); BAR;
#else
    STAGE(G_SB(0, 0), cur.B, cvB); STAGE(G_SA(0, 0), cur.A, cvA); STAGE(G_SB(0, 1), cur.B + hB, cvB); STAGE(G_SA(0, 1), cur.A + hA, cvA);
    if (wr == 1) BAR;
    WAIT_V(4); BAR;
#endif
    STAGE(G_SB(1, 0), cur.B + 128, cvB); STAGE(G_SA(1, 0), cur.A + 128, cvA); STAGE(G_SB(1, 1), cur.B + hB + 128, cvB);
    WAIT_V(6); BAR; }
  f32x4 acc[2][2][4][2];
  bf16x8 At[4][2], B0[2][2], B1[2][2];
  for (int idx = 0;; ++idx) {
    const bool has_next = get(idx + 1, nxt);
    if (!has_next) nxt = cur;
    nvA[0] = R0 * nxt.lda2 + C0 * 2; nvA[1] = R1 * nxt.lda2 + C1 * 2; nvB[0] = R0 * nxt.ldb2 + C0 * 2; nvB[1] = R1 * nxt.ldb2 + C1 * 2;
    if (idx > 0) { if (wr == 1) BAR; }
#pragma unroll
    for (int a = 0; a < 2; ++a)
#pragma unroll
      for (int b = 0; b < 2; ++b)
#pragma unroll
        for (int m = 0; m < 4; ++m)
#pragma unroll
          for (int n = 0; n < 2; ++n) acc[a][b][m][n] = (f32x4){0.f, 0.f, 0.f, 0.f};
    const size_t hA = (size_t)HALF * cur.lda2, hB = (size_t)HALF * cur.ldb2, nhA = (size_t)HALF * nxt.lda2, nhB = (size_t)HALF * nxt.ldb2;
    const int nt = cur.nt;
    for (int t = 0; t < nt; t += 2) {
      const bool last = (t == nt - 2);
      const char* a1 = cur.A + (size_t)(t + 1) * 128;
      const char* a2 = last ? nxt.A : cur.A + (size_t)(t + 2) * 128; const char* b2 = last ? nxt.B : cur.B + (size_t)(t + 2) * 128;
      const char* a3 = a2 + 128; const char* b3 = b2 + 128;
      const size_t hA2 = last ? nhA : hA, hB2 = last ? nhB : hB;
      unsigned vA2[2], vB2[2]; vA2[0] = last ? nvA[0] : cvA[0]; vA2[1] = last ? nvA[1] : cvA[1]; vB2[0] = last ? nvB[0] : cvB[0]; vB2[1] = last ? nvB[1] : cvB[1];
#if GEMM_SP2
      LDB(B0, 0, 0); LDB(B1, 0, 1); SCHED; LDA(At, 0, 0); STAGE(G_SA(1, 1), a1 + hA, cvA);
      WAIT_V(8); WAIT_L(0); BAR; MMA(0, 0, At, B0); MMA(0, 1, At, B1); BAR; SCHED;
      LDA(At, 0, 1); STAGE(G_SB(0, 0), b2, vB2); STAGE(G_SB(0, 1), b2 + hB2, vB2); STAGE(G_SA(0, 0), a2, vA2);
      WAIT_V(8); WAIT_L(0); BAR; MMA(1, 0, At, B0); MMA(1, 1, At, B1); BAR; SCHED;
      LDB(B0, 1, 0); LDB(B1, 1, 1); SCHED; LDA(At, 1, 0); STAGE(G_SA(0, 1), a2 + hA2, vA2);
      WAIT_V(8); WAIT_L(0); BAR; MMA(0, 0, At, B0); MMA(0, 1, At, B1); BAR; SCHED;
      LDA(At, 1, 1); STAGE(G_SB(1, 0), b3, vB2); STAGE(G_SB(1, 1), b3 + hB2, vB2); STAGE(G_SA(1, 0), a3, vA2);
      WAIT_V(8); WAIT_L(0); BAR; MMA(1, 0, At, B0); MMA(1, 1, At, B1); BAR; SCHED;
#else
      LDB(B0, 0, 0); SCHED; LDA(At, 0, 0); STAGE(G_SA(1, 1), a1 + hA, cvA);
      WAIT_L(8); BAR; WAIT_L(0); MMA(0, 0, At, B0); BAR; SCHED;
      LDB(B1, 0, 1); STAGE(G_SB(0, 0), b2, vB2);
      BAR; WAIT_L(0); MMA(0, 1, At, B1); BAR;
      LDA(At, 0, 1); STAGE(G_SA(0, 0), a2, vA2);
      BAR; WAIT_L(0); MMA(1, 0, At, B0); BAR; SCHED;
      STAGE(G_SB(0, 1), b2 + hB2, vB2);
      WAIT_V(6); BAR; MMA(1, 1, At, B1); BAR;
      LDB(B0, 1, 0); SCHED; LDA(At, 1, 0); STAGE(G_SA(0, 1), a2 + hA2, vA2);
      WAIT_L(8); BAR; WAIT_L(0); MMA(0, 0, At, B0); BAR; SCHED;
      LDB(B1, 1, 1); STAGE(G_SB(1, 0), b3, vB2);
      BAR; WAIT_L(0); MMA(0, 1, At, B1); BAR;
      LDA(At, 1, 1); STAGE(G_SA(1, 0), a3, vA2);
      BAR; WAIT_L(0); MMA(1, 0, At, B0); BAR; SCHED;
      STAGE(G_SB(1, 1), b3 + hB2, vB2);
      WAIT_V(6); BAR; MMA(1, 1, At, B1); BAR;
#endif
    }
    if (wr == 0) BAR;
    epi(idx, acc);
    if (!has_next) break;
    cur = nxt; cvA[0] = nvA[0]; cvA[1] = nvA[1]; cvB[0] = nvB[0]; cvB[1] = nvB[1];
  }
  WAIT_V(0); BAR;
#undef G_SA
#undef G_SB
#undef STAGE
#undef LDA
#undef LDB
#undef MMA
}

__device__ __forceinline__ void unit_decode(int U, int NPN, int SBN, int& pm, int& pn) {
  const int per = 8 * SBN, blk = U / per, within = U % per, npng = NPN / SBN;
  const int pmg = blk / npng, png = blk % npng;
  pm = pmg * 8 + (within & 7); pn = png * SBN + (within >> 3);
}
struct TI { int b, bb, arow0; };
__device__ __forceinline__ TI tile_info(int pm) { TI t; if (pm < 256) { t.b = pm >> 5; t.bb = t.b; t.arow0 = (pm & 31) * 256; } else { t.b = pm - 256; t.bb = 8; t.arow0 = 8192; } return t; }

#define LANE_IDS const int tid = launder_tid(), wid = __builtin_amdgcn_readfirstlane(tid >> 6), lane = tid & 63, wr = wid >> 2, wc = wid & 3, fr = lane & 15, fq = lane >> 4; (void)tid; (void)wr; (void)wc; (void)fr; (void)fq; (void)lane; (void)wid;

enum { CM_PLAIN = 0, CM_UP, CM_WIN, CM_QB, CM_KVB };
__device__ __forceinline__ int colmap(int kind, int n, int base, int& which) {
  which = 0;
  switch (kind) {
    case CM_PLAIN: return base + n;
    case CM_UP: { const int tile = n >> 8, c = n & 255, ai = c >> 7, wrr = (c >> 6) & 1, m = (c >> 4) & 3, q = c & 15; which = m & 1; return tile * 128 + ai * 64 + wrr * 32 + (m >> 1) * 16 + q; }
    case CM_WIN: {
      if (n < 384) return n;
      if (n < 416) { const int cc = n - 384, part = (cc >> 4) & 1, half = (cc >> 3) & 1, idx = cc & 7; return 640 + half * 16 + part * 8 + idx; }
      if (n < 512) return -1;
      if (n < 768) return 384 + (n - 512);
      return 672 + (n - 768);
    }
    case CM_QB: {
      if (n < 512) return (n >> 6) * 96 + (n & 63);
      const int c = n - 512, h = c >> 5, cc = c & 31, part = (cc >> 4) & 1, half = (cc >> 3) & 1, idx = cc & 7; return h * 96 + 64 + half * 16 + part * 8 + idx;
    }
    case CM_KVB: {
      if (n < 512) return (n >> 6) * 128 + (n & 63);
      const int c = n - 512; return (c >> 6) * 128 + 64 + (c & 63);
    }
  }
  return -1;
}
__device__ __forceinline__ void conv_load(float (&v)[8], int kind, const float* src0, const float* src1, int ld, int base, const float* scale, int n0, int k0) {
  const int tid = launder_tid(); const int nn = tid & 63, kk = tid >> 6; int which; const int col = colmap(kind, n0 + nn, base, which); const float* s = which ? src1 : src0;
#pragma unroll
  for (int i = 0; i < 8; ++i) { const int k = kk + 8 * i; float x = 0.f; if (col >= 0) { x = s[(long)(k0 + k) * ld + col]; if (scale) x *= scale[k0 + k]; } v[i] = x; }
}
__device__ __forceinline__ void conv_store(const float (&vin)[8], bf16_t* dst, int K, int n0, int k0) {
  float* tl = (float*)g_lds;
  const int tid = launder_tid();
  { const int nn = tid & 63, kk = tid >> 6;
#pragma unroll
    for (int i = 0; i < 8; ++i) tl[(kk + 8 * i) * 65 + nn] = vin[i]; }
  __syncthreads();
  { const int nr = tid >> 3, kc = (tid & 7) * 8; float v[8];
#pragma unroll
    for (int e = 0; e < 8; ++e) v[e] = tl[(kc + e) * 65 + nr];
    u32x4 w; w.x = cvtpk(v[0], v[1]); w.y = cvtpk(v[2], v[3]); w.z = cvtpk(v[4], v[5]); w.w = cvtpk(v[6], v[7]);
    *(u32x4*)(dst + (long)(n0 + nr) * K + k0 + kc) = w; }
  __syncthreads();
}
struct ConvJob { int kind; size_t dst; int N, K; const float* s0; const float* s1; int ld, base; const float* scale; };
__device__ __forceinline__ ConvJob conv_job(const Params& p, int l, int grp, int j) {
  ConvJob J; J.s1 = nullptr; J.scale = nullptr; J.base = 0;
  if (grp != 1) {
    const float* w1 = p.in[grp == 0 ? 7 : 10] + (size_t)l * DM * DFF; const float* w3 = p.in[grp == 0 ? 8 : 11] + (size_t)l * DM * DFF; const float* w2 = p.in[grp == 0 ? 9 : 12] + (size_t)l * DFF * DM;
    if (j == 0) { J.kind = CM_UP; J.dst = O_WUP; J.N = 5632; J.K = 1024; J.s0 = w1; J.s1 = w3; J.ld = DFF; }
    else { J.kind = CM_PLAIN; J.dst = O_WDN; J.N = 1024; J.K = 2816; J.s0 = w2; J.s1 = w2; J.ld = DM; }
  } else {
    const float* win = p.in[13] + (size_t)l * DM * PROJ; const float* wb = p.in[22] + (size_t)l * 3 * 512 * 1024;
    switch (j) {
      case 0: J.kind = CM_WIN; J.dst = O_WIN; J.N = 3840; J.K = 1024; J.s0 = win; J.ld = PROJ; break;
      case 1: J.kind = CM_PLAIN; J.dst = O_WG; J.N = 3072; J.K = 1024; J.s0 = win; J.ld = PROJ; J.base = 3744; break;
      case 2: J.kind = CM_QB; J.dst = O_WQB; J.N = 768; J.K = 384; J.s0 = p.in[15] + (size_t)l * 384 * 768; J.ld = 768; J.scale = p.in[14] + l * 384; break;
      case 3: J.kind = CM_KVB; J.dst = O_WKVB; J.N = 1024; J.K = 256; J.s0 = p.in[17] + (size_t)l * 256 * 1024; J.ld = 1024; J.scale = p.in[16] + l * 256; break;
      case 4: J.kind = CM_PLAIN; J.dst = O_WBR; J.N = 3072; J.K = 512; J.s0 = wb; J.ld = 1024; break;
      default: J.kind = CM_PLAIN; J.dst = O_WOUT; J.N = 1024; J.K = 1024; J.s0 = p.in[23] + (size_t)l * DM * DM; J.ld = DM; break;
    }
    J.s1 = J.s0;
  }
  return J;
}
struct ConvTile { int kind; bf16_t* dst; int K; const float* s0; const float* s1; int ld, base; const float* scale; int n0, k0; };
__device__ __forceinline__ ConvTile conv_decode(const Params& p, int l, int grp, int u, int jlo) {
  int v = u, j = jlo; ConvJob J = conv_job(p, l, grp, jlo);
  for (;;) { const int c = (J.N / 64) * (J.K / 64); if (v < c) break; v -= c; ++j; J = conv_job(p, l, grp, j); }
  const int nk = J.K / 64; const int nt_ = v / nk, kt_ = v % nk;
  ConvTile t; t.kind = J.kind; t.K = J.K; t.s0 = J.s0; t.s1 = J.s1; t.ld = J.ld; t.base = J.base; t.scale = J.scale; t.n0 = nt_ * 64; t.k0 = kt_ * 64; t.dst = (bf16_t*)(p.ws + J.dst);
  if (grp == 1 && j == 4) { const int i = t.n0 >> 10; t.s0 += (size_t)i * 512 * 1024; t.dst += (size_t)i * 1024 * 512; t.n0 &= 1023; }
  return t;
}
__device__ __forceinline__ void conv_group(const Params& p, int l, int grp, int jlo, int jhi) {
  int tot = 0; for (int j = jlo; j < jhi; ++j) { const ConvJob J = conv_job(p, l, grp, j); tot += (J.N / 64) * (J.K / 64); }
  int u = blockIdx.x; if (u >= tot) return;
  ConvTile t = conv_decode(p, l, grp, u, jlo); float v[8];
  conv_load(v, t.kind, t.s0, t.s1, t.ld, t.base, t.scale, t.n0, t.k0);
  for (;;) {
    const int un = u + gridDim.x; const bool more = un < tot; ConvTile tn = t; float vn[8];
    if (more) { tn = conv_decode(p, l, grp, un, jlo); conv_load(vn, tn.kind, tn.s0, tn.s1, tn.ld, tn.base, tn.scale, tn.n0, tn.k0); }
    conv_store(v, t.dst, t.K, t.n0, t.k0);
    if (!more) break;
    u = un; t = tn;
#pragma unroll
    for (int i = 0; i < 8; ++i) v[i] = vn[i];
  }
}

__device__ __forceinline__ void phase_p0(const Params& p) {
  const int tid = launder_tid();
  float* sl = (float*)g_lds;
  float* red = sl + 9 * 1024;
  for (int i = tid; i < 9 * 1024; i += 512) { const int bb = i >> 10, k = i & 1023; const float v = bb < 8 ? p.in[1][bb * 1024 + k] : p.in[3][k]; sl[i] = v / (1.f + expf(-v)); }
  __syncthreads();
  float* modp = (float*)(p.ws + O_MOD);
  for (int u = blockIdx.x; u < 144; u += gridDim.x) {
    const int l = u / 72, c0 = (u % 72) * 128, cp = tid & 63, ks = tid >> 6;
    const float* w = p.in[4] + (size_t)l * 1024 * 9216 + c0 + 2 * cp;
    float a0[9], a1[9];
#pragma unroll
    for (int bb = 0; bb < 9; ++bb) { a0[bb] = 0.f; a1[bb] = 0.f; }
#pragma unroll 8
    for (int k = ks * 128; k < ks * 128 + 128; ++k) { const f32v2_t wv = *(const f32v2_t*)(w + (size_t)k * 9216);
#pragma unroll
      for (int bb = 0; bb < 9; ++bb) { const float sv = sl[bb * 1024 + k]; a0[bb] += sv * wv[0]; a1[bb] += sv * wv[1]; } }
#pragma unroll
    for (int bb = 0; bb < 9; ++bb) { red[(ks * 9 + bb) * 128 + 2 * cp] = a0[bb]; red[(ks * 9 + bb) * 128 + 2 * cp + 1] = a1[bb]; }
    __syncthreads();
    for (int i = tid; i < 9 * 128; i += 512) { const int bb = i >> 7, cc = i & 127; float sacc = 0.f;
#pragma unroll
      for (int k8 = 0; k8 < 8; ++k8) sacc += red[(k8 * 9 + bb) * 128 + cc];
      modp[((size_t)l * 9 + bb) * 9216 + c0 + cc] = sacc + p.in[5][l * 9216 + c0 + cc]; }
    __syncthreads();
  }
  const long gt = (long)blockIdx.x * 512 + tid, gs = (long)gridDim.x * 512;
  for (long i = gt; i < (long)6 * 264 * 1024; i += gs) ((float*)(p.ws + O_PART))[i] = -1.f;
  float* r1c = (float*)(p.ws + O_R1C); float* r1s = (float*)(p.ws + O_R1S);
  for (long i = gt; i < 8192 * 32; i += gs) { const int pos = (int)(i >> 5), f = (int)(i & 31); const float inv = (float)pow(10000.0, -(double)(2 * f) / 64.0); const float ang = (float)pos * inv; r1c[i] = (float)cos((double)ang); r1s[i] = (float)sin((double)ang); }
  float* rdc = (float*)(p.ws + O_RDC); float* rds = (float*)(p.ws + O_RDS);
  for (long i = gt; i < 128 * 16; i += gs) { const int pos = (int)(i >> 4), f = (int)(i & 15); const float inv = (float)pow(10000.0, -(double)(2 * f) / 32.0); const float ang = (float)pos * inv; rdc[i] = (float)cos((double)ang); rds[i] = (float)sin((double)ang); }
  float* rmc = (float*)(p.ws + O_RMC); float* rms = (float*)(p.ws + O_RMS);
  for (long i = gt; i < 128 * 8; i += gs) { const int pos = (int)(i >> 3), f = (int)(i & 7); const float inv = (float)pow(10000.0, -(double)(2 * f) / 16.0); const float ang = (float)pos * inv; rmc[i] = (float)cos((double)ang); rms[i] = (float)sin((double)ang); }
  if (blockIdx.x == 0 && tid == 200) { ((float*)(p.ws + O_LAM))[16] = 0.f; ((float*)(p.ws + O_LAM))[17] = 0.f; }
  if (blockIdx.x == 0 && tid < 128) {
    const int l = tid >> 6, ln = tid & 63; const float* dl = p.in[18] + l * 256;
    float s1 = dl[ln] * dl[64 + ln], s2 = dl[128 + ln] * dl[192 + ln];
#pragma unroll
    for (int o = 32; o > 0; o >>= 1) { s1 += __shfl_xor(s1, o); s2 += __shfl_xor(s2, o); }
    const float li = 0.8f - 0.6f * expf(-0.3f * (float)l);
    if (ln == 0) ((float*)(p.ws + O_LAM))[l] = expf(s1) - expf(s2) + li;
  }
}

__device__ __forceinline__ const float* xsrc_row(const Params& p, long row, bool from_input) {
  if (row < TL) return (from_input ? p.in[0] : p.out) + row * DM;
  return (from_input ? p.in[2] : (const float*)(p.ws + O_XC)) + (row - TL) * DM;
}
__device__ __forceinline__ float* xdst_row(const Params& p, long row) { return row < TL ? p.out + row * DM : (float*)(p.ws + O_XC) + (row - TL) * DM; }

__device__ __forceinline__ void phase_norm(const Params& p, int l, int which, bool from_input) {
  const int tid = launder_tid(), wid = tid >> 6, lane = tid & 63;
  bf16_t* H = (bf16_t*)(p.ws + O_H);
  const float* gain = p.in[6] + (l * 3 + which) * DM;
  const long nwaves = (long)gridDim.x * 8, w0 = (long)blockIdx.x * 8 + wid;
  for (long rb = w0; rb < T; rb += nwaves * 4) {
    f32x4 v[4][4]; float ss[4];
#pragma unroll
    for (int j = 0; j < 4; ++j) { const long row = rb + j * nwaves; ss[j] = 0.f;
      if (row < T) { const float* src = xsrc_row(p, row, from_input);
#pragma unroll
        for (int i = 0; i < 4; ++i) v[j][i] = *(const f32x4*)(src + (lane + 64 * i) * 4); } }
#pragma unroll
    for (int j = 0; j < 4; ++j) { const long row = rb + j * nwaves;
      if (row < T) {
#pragma unroll
        for (int i = 0; i < 4; ++i) ss[j] += v[j][i][0] * v[j][i][0] + v[j][i][1] * v[j][i][1] + v[j][i][2] * v[j][i][2] + v[j][i][3] * v[j][i][3];
#pragma unroll
        for (int o = 32; o > 0; o >>= 1) ss[j] += __shfl_xor(ss[j], o);
        const float rstd = rsqrtf(ss[j] * (1.f / 1024.f) + EPS);
        const int bb = row < TL ? (int)(row >> 13) : 8;
        const float* md = (const float*)(p.ws + O_MOD) + ((size_t)l * 9 + bb) * 9216;
#pragma unroll
        for (int i = 0; i < 4; ++i) { const int c = (lane + 64 * i) * 4;
          const f32x4 g = *(const f32x4*)(gain + c), sh = *(const f32x4*)(md + which * 3 * 1024 + c), sc = *(const f32x4*)(md + (which * 3 + 1) * 1024 + c);
          f32x4 o;
#pragma unroll
          for (int e = 0; e < 4; ++e) o[e] = v[j][i][e] * rstd * g[e] * (1.f + sc[e]) + sh[e];
          store4bf(H + row * DM + c, o); } } }
  }
}
__device__ __forceinline__ void phase_final(const Params& p) {
  const int tid = launder_tid(), wid = tid >> 6, lane = tid & 63;
  const float* gain = p.in[24];
  const long nwaves = (long)gridDim.x * 8, w0 = (long)blockIdx.x * 8 + wid;
  for (long rb = w0; rb < TL; rb += nwaves * 4) {
    f32x4 v[4][4];
#pragma unroll
    for (int j = 0; j < 4; ++j) { const long row = rb + j * nwaves;
      if (row < TL) { const float* src = p.out + row * DM;
#pragma unroll
        for (int i = 0; i < 4; ++i) v[j][i] = *(const f32x4*)(src + (lane + 64 * i) * 4); } }
#pragma unroll
    for (int j = 0; j < 4; ++j) { const long row = rb + j * nwaves;
      if (row < TL) { float ss = 0.f; float* dst = p.out + row * DM;
#pragma unroll
        for (int i = 0; i < 4; ++i) ss += v[j][i][0] * v[j][i][0] + v[j][i][1] * v[j][i][1] + v[j][i][2] * v[j][i][2] + v[j][i][3] * v[j][i][3];
#pragma unroll
        for (int o = 32; o > 0; o >>= 1) ss += __shfl_xor(ss, o);
        const float rstd = rsqrtf(ss * (1.f / 1024.f) + EPS);
#pragma unroll
        for (int i = 0; i < 4; ++i) { const int c = (lane + 64 * i) * 4; const f32x4 g = *(const f32x4*)(gain + c); f32x4 o;
#pragma unroll
          for (int e = 0; e < 4; ++e) o[e] = v[j][i][e] * rstd * g[e];
          *(f32x4*)(dst + c) = o; } } }
  }
}

__device__ __forceinline__ void phase_ffn_up(const Params& p, int npm) {
  const char* W = (const char*)(p.ws + O_WUP); const char* H = (const char*)(p.ws + O_H); bf16_t* G = (bf16_t*)(p.ws + O_G);
  const int q = logical_wg(), Gd = gridDim.x, tot = npm * 22;
  auto get = [&](int idx, GOp& o) __attribute__((always_inline)) -> bool { const int U = q + idx * Gd; if (U >= tot) return false; int pm, pn; unit_decode(U, 22, 2, pm, pn);
    o.A = W + (size_t)pn * 256 * 2048; o.B = H + (size_t)pm * 256 * 2048; o.lda2 = 2048; o.ldb2 = 2048; o.nt = 16; return true; };
  auto epi = [&](int idx, const f32x4 (&acc)[2][2][4][2]) __attribute__((always_inline)) {
    const int U = q + idx * Gd; int pm, pn; unit_decode(U, 22, 2, pm, pn);
    LANE_IDS
#pragma unroll
    for (int ai = 0; ai < 2; ++ai)
#pragma unroll
      for (int bj = 0; bj < 2; ++bj)
#pragma unroll
        for (int n = 0; n < 2; ++n)
#pragma unroll
          for (int mp = 0; mp < 2; ++mp) {
            const long tok = (long)pm * 256 + bj * 128 + wc * 32 + n * 16 + fr; const int gc = pn * 128 + ai * 64 + wr * 32 + mp * 16 + fq * 4;
            const f32x4 a = acc[ai][bj][2 * mp][n], b = acc[ai][bj][2 * mp + 1][n]; f32x4 o;
#pragma unroll
            for (int e = 0; e < 4; ++e) o[e] = silu_f(a[e]) * b[e];
            store4bf(G + tok * DFF + gc, o);
          }
  };
  gemm_stream(get, epi);
}
__device__ __forceinline__ void epi_res(const Params& p, const f32x4 (&acc)[2][2][4][2], int l, int pm, int pn, int gate_idx, float scale, bool from_input) {
  LANE_IDS
  const TI ti = tile_info(pm);
  const float* md = (const float*)(p.ws + O_MOD) + ((size_t)l * 9 + ti.bb) * 9216 + gate_idx * 1024;
#pragma unroll
  for (int bj = 0; bj < 2; ++bj)
#pragma unroll
    for (int n = 0; n < 2; ++n) {
      const long row = (long)pm * 256 + bj * 128 + wc * 32 + n * 16 + fr;
      const float* src = xsrc_row(p, row, from_input); float* dst = xdst_row(p, row);
#pragma unroll
      for (int ai = 0; ai < 2; ++ai)
#pragma unroll
        for (int m = 0; m < 4; ++m) {
          const int col = pn * 256 + ai * 128 + wr * 64 + m * 16 + fq * 4;
          const f32x4 xv = *(const f32x4*)(src + col), g = *(const f32x4*)(md + col); f32x4 o;
#pragma unroll
          for (int e = 0; e < 4; ++e) o[e] = xv[e] + g[e] * scale * acc[ai][bj][m][n][e];
          *(f32x4*)(dst + col) = o;
          if (m & 1) MEMFENCE();
        }
    }
}
struct NormFuse { int nl, which, pslot, cslot; bool fin; };
__device__ __forceinline__ void epi_res_norm(const Params& p, f32x4 (&acc)[2][2][4][2], int l, int pm, int pn, int gate_idx, float scale, bool from_input, const NormFuse nf) {
  LANE_IDS
  const TI ti = tile_info(pm);
  const float* md = (const float*)(p.ws + O_MOD) + ((size_t)l * 9 + ti.bb) * 9216 + gate_idx * 1024;
  float ssr[2][2];
#pragma unroll
  for (int bj = 0; bj < 2; ++bj)
#pragma unroll
    for (int n = 0; n < 2; ++n) {
      const long row = (long)pm * 256 + bj * 128 + wc * 32 + n * 16 + fr;
      const float* src = xsrc_row(p, row, from_input); float* dst = xdst_row(p, row); float ss = 0.f;
#pragma unroll
      for (int ai = 0; ai < 2; ++ai)
#pragma unroll
        for (int m = 0; m < 4; ++m) {
          const int col = pn * 256 + ai * 128 + wr * 64 + m * 16 + fq * 4;
          const f32x4 xv = *(const f32x4*)(src + col), g = *(const f32x4*)(md + col); f32x4 o;
#pragma unroll
          for (int e = 0; e < 4; ++e) { o[e] = xv[e] + g[e] * scale * acc[ai][bj][m][n][e]; ss += o[e] * o[e]; }
          if (!nf.fin) *(f32x4*)(dst + col) = o;
          acc[ai][bj][m][n] = o;
          if (m & 1) MEMFENCE();
        }
      ss += __shfl_xor(ss, 16); ss += __shfl_xor(ss, 32); ssr[bj][n] = ss;
    }
  float* ssl = (float*)(g_lds + 131072);
  __syncthreads();
  if (fq == 0) {
#pragma unroll
    for (int bj = 0; bj < 2; ++bj)
#pragma unroll
      for (int n = 0; n < 2; ++n) ssl[wr * 256 + bj * 128 + wc * 32 + n * 16 + fr] = ssr[bj][n]; }
  __syncthreads();
  unsigned* part = (unsigned*)(p.ws + O_PART) + ((size_t)nf.pslot * 264 + pm) * 1024;
  if (tid < 256) {
    __hip_atomic_store(part + pn * 256 + tid, __float_as_uint(ssl[tid] + ssl[256 + tid]), __ATOMIC_RELAXED, __HIP_MEMORY_SCOPE_AGENT);
    float t = 0.f; int spins = 0;
    for (;;) { float v0 = __uint_as_float(__hip_atomic_load(part + tid, __ATOMIC_RELAXED, __HIP_MEMORY_SCOPE_AGENT)), v1 = __uint_as_float(__hip_atomic_load(part + 256 + tid, __ATOMIC_RELAXED, __HIP_MEMORY_SCOPE_AGENT)),
        v2 = __uint_as_float(__hip_atomic_load(part + 512 + tid, __ATOMIC_RELAXED, __HIP_MEMORY_SCOPE_AGENT)), v3 = __uint_as_float(__hip_atomic_load(part + 768 + tid, __ATOMIC_RELAXED, __HIP_MEMORY_SCOPE_AGENT));
      t = v0 + v1 + v2 + v3;
      if ((v0 >= 0.f && v1 >= 0.f && v2 >= 0.f && v3 >= 0.f) || ++spins > (1 << 18)) break;
      __builtin_amdgcn_s_sleep(4); }
    ssl[512 + tid] = rsqrtf(t * (1.f / 1024.f) + EPS); }
  __syncthreads();
  const float* gain = nf.fin ? p.in[24] : p.in[6] + (nf.nl * 3 + nf.which) * DM;
  const float* mdn = (const float*)(p.ws + O_MOD) + ((size_t)nf.nl * 9 + ti.bb) * 9216;
  bf16_t* H = (bf16_t*)(p.ws + O_H);
#pragma unroll
  for (int bj = 0; bj < 2; ++bj)
#pragma unroll
    for (int n = 0; n < 2; ++n) {
      const int tl = bj * 128 + wc * 32 + n * 16 + fr; const long row = (long)pm * 256 + tl; const float r = ssl[512 + tl];
#pragma unroll
      for (int ai = 0; ai < 2; ++ai)
#pragma unroll
        for (int m = 0; m < 4; ++m) {
          const int col = pn * 256 + ai * 128 + wr * 64 + m * 16 + fq * 4; const f32x4 o = acc[ai][bj][m][n], g = *(const f32x4*)(gain + col); f32x4 h;
          if (nf.fin) {
#pragma unroll
            for (int e = 0; e < 4; ++e) h[e] = o[e] * r * g[e];
            *(f32x4*)(p.out + row * DM + col) = h;
          } else { const f32x4 sh = *(const f32x4*)(mdn + nf.which * 3 * 1024 + col), sc = *(const f32x4*)(mdn + (nf.which * 3 + 1) * 1024 + col);
#pragma unroll
            for (int e = 0; e < 4; ++e) h[e] = o[e] * r * g[e] * (1.f + sc[e]) + sh[e];
            store4bf(H + row * DM + col, h); }
          if (m & 1) MEMFENCE();
        }
    }
}
__device__ __forceinline__ void phase_ffn_down(const Params& p, int l, int gate_idx, bool from_input, int npm, const NormFuse nf) {
  const char* W = (const char*)(p.ws + O_WDN); const char* G = (const char*)(p.ws + O_G);
  const int q = logical_wg(), Gd = gridDim.x, tot = npm * 4;
  auto get = [&](int idx, GOp& o) __attribute__((always_inline)) -> bool { const int U = q + idx * Gd; if (U >= tot) return false; int pm, pn; unit_decode(U, 4, 4, pm, pn);
    o.A = W + (size_t)pn * 256 * (DFF * 2); o.B = G + (size_t)pm * 256 * (DFF * 2); o.lda2 = DFF * 2; o.ldb2 = DFF * 2; o.nt = DFF / 64; return true; };
  auto epi = [&](int idx, f32x4 (&acc)[2][2][4][2]) __attribute__((always_inline)) {
    const int U = q + idx * Gd; int pm, pn; unit_decode(U, 4, 4, pm, pn); epi_res_norm(p, acc, l, pm, pn, gate_idx, 0.5f, from_input, nf); };
  gemm_stream(get, epi);
}
__device__ __forceinline__ void phase_wout(const Params& p, int l, int npm, const NormFuse nf) {
  const char* W = (const char*)(p.ws + O_WOUT); const char* Y = (const char*)(p.ws + O_YBR);
  const int q = logical_wg(), Gd = gridDim.x, tot = npm * 4;
  auto get = [&](int idx, GOp& o) __attribute__((always_inline)) -> bool { const int U = q + idx * Gd; if (U >= tot) return false; int pm, pn; unit_decode(U, 4, 4, pm, pn);
    o.A = W + (size_t)pn * 256 * 2048; o.B = Y + (size_t)pm * 256 * 2048; o.lda2 = 2048; o.ldb2 = 2048; o.nt = 16; return true; };
  auto epi = [&](int idx, f32x4 (&acc)[2][2][4][2]) __attribute__((always_inline)) {
    const int U = q + idx * Gd; int pm, pn; unit_decode(U, 4, 4, pm, pn); epi_res_norm(p, acc, l, pm, pn, 5, 1.0f, false, nf); };
  gemm_stream(get, epi);
}

__device__ __forceinline__ void rope4(f32x4 x1, f32x4 x2, f32x4 c, f32x4 s, f32x4& o1, f32x4& o2) {
#pragma unroll
  for (int e = 0; e < 4; ++e) { o1[e] = x1[e] * c[e] - x2[e] * s[e]; o2[e] = x1[e] * s[e] + x2[e] * c[e]; }
}
__device__ __forceinline__ void phase_win(const Params& p) {
  const char* W = (const char*)(p.ws + O_WIN); const char* H = (const char*)(p.ws + O_H);
  bf16_t* QLAT = (bf16_t*)(p.ws + O_QLAT); bf16_t* KVLAT = (bf16_t*)(p.ws + O_KVLAT); bf16_t* KROPE = (bf16_t*)(p.ws + O_KROPE);
  bf16_t* QD = (bf16_t*)(p.ws + O_QD); bf16_t* KD = (bf16_t*)(p.ws + O_KD); bf16_t* VD = (bf16_t*)(p.ws + O_VD);
  bf16_t* RQ = (bf16_t*)(p.ws + O_RQ); bf16_t* RK = (bf16_t*)(p.ws + O_RK); bf16_t* RV = (bf16_t*)(p.ws + O_RV); bf16_t* YRET = (bf16_t*)(p.ws + O_YRET);
  const float* r1c = (const float*)(p.ws + O_R1C); const float* r1s = (const float*)(p.ws + O_R1S);
  const float* rdc = (const float*)(p.ws + O_RDC); const float* rds = (const float*)(p.ws + O_RDS);
  const float* rmc = (const float*)(p.ws + O_RMC); const float* rms = (const float*)(p.ws + O_RMS);
  const int q = logical_wg(), Gd = gridDim.x;
  auto get = [&](int idx, GOp& o) __attribute__((always_inline)) -> bool { const int U = q + idx * Gd; if (U >= NPM * 15) return false; int pm, pn; unit_decode(U, 15, 3, pm, pn);
    o.A = W + (size_t)pn * 256 * 2048; o.B = H + (size_t)pm * 256 * 2048; o.lda2 = 2048; o.ldb2 = 2048; o.nt = 16; return true; };
  auto epi = [&](int idx, const f32x4 (&acc)[2][2][4][2]) __attribute__((always_inline)) {
    const int U = q + idx * Gd; int pm, pn; unit_decode(U, 15, 3, pm, pn);
    LANE_IDS
    const TI ti = tile_info(pm); const bool lat = ti.bb < 8;
#pragma unroll
    for (int bj = 0; bj < 2; ++bj)
#pragma unroll
      for (int n = 0; n < 2; ++n) {
        const int tl = bj * 128 + wc * 32 + n * 16 + fr; const long tok = (long)pm * 256 + tl; const int ar = ti.arow0 + tl;
        const int prow = ar >> 6, pcol = ar & 63;
        if (pn == 0 || pn == 2 || pn == 13 || pn == 14) {
#pragma unroll
          for (int ai = 0; ai < 2; ++ai)
#pragma unroll
            for (int m = 0; m < 4; ++m) { const int c = ai * 128 + wr * 64 + m * 16 + fq * 4; const f32x4 v = acc[ai][bj][m][n];
              if (pn == 0) store4bf(QLAT + tok * 384 + c, v);
              else if (pn == 2) store4bf(KVLAT + tok * 256 + c, v);
              else { f32x4 o;
#pragma unroll
                for (int e = 0; e < 4; ++e) o[e] = silu_f(v[e]);
                store4bf(YRET + tok * 512 + (pn - 13) * 256 + c, o); } }
        } else if (pn == 1) {
#pragma unroll
          for (int m = 0; m < 4; ++m) store4bf(QLAT + tok * 384 + 256 + wr * 64 + m * 16 + fq * 4, acc[0][bj][m][n]);
          if (wr == 0) {
            const int half = fq >> 1, idx = (fq & 1) * 4; f32x4 o1 = acc[1][bj][0][n], o2 = acc[1][bj][1][n];
            if (lat) { const int pos = half ? pcol : prow; const f32x4 c = *(const f32x4*)(rmc + pos * 8 + idx), s = *(const f32x4*)(rms + pos * 8 + idx); rope4(acc[1][bj][0][n], acc[1][bj][1][n], c, s, o1, o2); }
            bf16_t* d = KROPE + ((long)ti.b * SK + ar) * 32 + half * 16 + idx; store4bf(d, o1); store4bf(d + 8, o2);
          }
        } else if (pn >= 3 && pn <= 6) {
          bf16_t* D = (pn < 5) ? QD : KD; const int hb = ((pn - 3) & 1) * 2;
#pragma unroll
          for (int ai = 0; ai < 2; ++ai) {
            bf16_t* d = D + (((long)ti.b * 8 + (hb + ai) * 2 + wr) * SK + ar) * 64 + fq * 4;
            f32x4 a0 = acc[ai][bj][0][n], a1 = acc[ai][bj][1][n], a2 = acc[ai][bj][2][n], a3 = acc[ai][bj][3][n];
            if (lat) { const f32x4 cr = *(const f32x4*)(rdc + prow * 16 + fq * 4), sr = *(const f32x4*)(rds + prow * 16 + fq * 4), cc = *(const f32x4*)(rdc + pcol * 16 + fq * 4), sc = *(const f32x4*)(rds + pcol * 16 + fq * 4);
              rope4(acc[ai][bj][0][n], acc[ai][bj][1][n], cr, sr, a0, a1); rope4(acc[ai][bj][2][n], acc[ai][bj][3][n], cc, sc, a2, a3); }
            const float qs = (pn < 5) ? CQ_DIFF : 1.f;
            store4bf(d, a0 * qs); store4bf(d + 16, a1 * qs); store4bf(d + 32, a2 * qs); store4bf(d + 48, a3 * qs);
          }
        } else if (pn == 7 || pn == 8 || pn == 11 || pn == 12) {
          bf16_t* D = (pn < 9) ? VD : RV; const int hb = (pn < 9 ? pn - 7 : pn - 11) * 2;
#pragma unroll
          for (int ai = 0; ai < 2; ++ai)
#pragma unroll
            for (int m = 0; m < 4; ++m) store4bf(D + (((long)ti.b * 4 + hb + ai) * SK + ar) * 128 + wr * 64 + m * 16 + fq * 4, acc[ai][bj][m][n]);
        } else {
          bf16_t* D = (pn == 9) ? RQ : RK; const float sc = (pn == 9) ? 1.f : 0.125f;
#pragma unroll
          for (int ai = 0; ai < 2; ++ai) {
            bf16_t* d = D + (((long)ti.b * 4 + ai * 2 + wr) * SK + ar) * 64 + fq * 4;
            f32x4 a0 = acc[ai][bj][0][n], a1 = acc[ai][bj][1][n], a2 = acc[ai][bj][2][n], a3 = acc[ai][bj][3][n];
            if (lat) { const f32x4 c0 = *(const f32x4*)(r1c + ar * 32 + fq * 4), s0 = *(const f32x4*)(r1s + ar * 32 + fq * 4), c1 = *(const f32x4*)(r1c + ar * 32 + 16 + fq * 4), s1 = *(const f32x4*)(r1s + ar * 32 + 16 + fq * 4);
              rope4(acc[ai][bj][0][n], acc[ai][bj][2][n], c0, s0, a0, a2); rope4(acc[ai][bj][1][n], acc[ai][bj][3][n], c1, s1, a1, a3); }
            store4bf(d, a0 * sc); store4bf(d + 16, a1 * sc); store4bf(d + 32, a2 * sc); store4bf(d + 48, a3 * sc);
          }
        }
      }
  };
  gemm_stream(get, epi);
}

__device__ __forceinline__ int crow(int r, int hi) { return (r & 3) + 8 * (r >> 2) + 4 * hi; }
__device__ __forceinline__ void ret_unit(const Params& p, int l, int u) {
  const int tid = launder_tid(), wid = tid >> 6, lane = tid & 63, r32 = lane & 31, hi = lane >> 5;
  const int b = u & 7, h = (u >> 3) & 3, dir = (u >> 5) & 1, s = u >> 6;
  constexpr int QS = 0, KS = 18432, KT = 36864, VT = 54272, VTS = 62976, SC = 71680, SBF = 106496, PW = 115712, IPW = PW + 528;
  unsigned char* L = g_lds; float* pw = (float*)(L + PW); float* ipw = (float*)(L + IPW);
  const float lg = -expf(p.in[20][l * 8 + dir * 4 + h]);
  __syncthreads();
  if (tid <= 128) { pw[tid] = expf(lg * (float)tid); if (tid < 128) ipw[tid] = expf(-lg * (float)tid); }
  for (int i = tid; i < 576; i += 512) *(u32x4*)(L + SBF + i * 16) = (u32x4){0u, 0u, 0u, 0u};
  const bf16_t* RQ = (const bf16_t*)(p.ws + O_RQ) + ((long)b * 4 + h) * SK * 64;
  const bf16_t* RK = (const bf16_t*)(p.ws + O_RK) + ((long)b * 4 + h) * SK * 64;
  const bf16_t* RV = (const bf16_t*)(p.ws + O_RV) + ((long)b * 4 + h) * SK * 128 + s * 32;
  bf16_t* RO = (bf16_t*)(p.ws + O_RETO) + (size_t)dir * T * 512 + h * 128 + s * 32;
  f32x16 sacc = {};
  u32x4 rq0, rq1, rk0, rk1, rv0 = {0u, 0u, 0u, 0u}, rv1 = {0u, 0u, 0u, 0u};
  const int qrow0 = tid >> 3, qcc = tid & 7, pi = tid & 63, kcc = tid >> 6, vcc = (tid >> 6) & 3; const bool vact = tid < 256;
  auto chunk_arow = [&](int n) -> int { if (n < 2) return 8192 + 128 * (dir ? 1 - n : n); return 128 * (dir ? 65 - n : n - 2); };
#define RLOAD(n) do { const int ar_ = chunk_arow(n); \
    rq0 = *(const u32x4*)(RQ + (long)(ar_ + qrow0) * 64 + qcc * 8); rq1 = *(const u32x4*)(RQ + (long)(ar_ + 64 + qrow0) * 64 + qcc * 8); \
    rk0 = *(const u32x4*)(RK + (long)(ar_ + 2 * pi) * 64 + kcc * 8); rk1 = *(const u32x4*)(RK + (long)(ar_ + 2 * pi + 1) * 64 + kcc * 8); \
    if (vact) { rv0 = *(const u32x4*)(RV + (long)(ar_ + 2 * pi) * 128 + vcc * 8); rv1 = *(const u32x4*)(RV + (long)(ar_ + 2 * pi + 1) * 128 + vcc * 8); } } while (0)
  RLOAD(0);
  int cur = 0;
  for (int n = 0; n < 66; ++n) {
    __syncthreads();
    *(u32x4*)(L + QS + qrow0 * 144 + qcc * 16) = rq0; *(u32x4*)(L + QS + (64 + qrow0) * 144 + qcc * 16) = rq1;
    *(u32x4*)(L + KS + (2 * pi) * 144 + kcc * 16) = rk0; *(u32x4*)(L + KS + (2 * pi + 1) * 144 + kcc * 16) = rk1;
#pragma unroll
    for (int e = 0; e < 4; ++e) {
      *(unsigned*)(L + KT + (kcc * 8 + 2 * e) * 272 + pi * 4) = (rk0[e] & 0xffffu) | (rk1[e] << 16);
      *(unsigned*)(L + KT + (kcc * 8 + 2 * e + 1) * 272 + pi * 4) = (rk0[e] >> 16) | (rk1[e] & 0xffff0000u); }
    if (vact) { const float kd0 = pw[dir ? 2 * pi : 127 - 2 * pi], kd1 = pw[dir ? 2 * pi + 1 : 126 - 2 * pi];
#pragma unroll
      for (int e = 0; e < 4; ++e) {
        *(unsigned*)(L + VT + (vcc * 8 + 2 * e) * 272 + pi * 4) = (rv0[e] & 0xffffu) | (rv1[e] << 16);
        *(unsigned*)(L + VT + (vcc * 8 + 2 * e + 1) * 272 + pi * 4) = (rv0[e] >> 16) | (rv1[e] & 0xffff0000u);
        *(unsigned*)(L + VTS + (vcc * 8 + 2 * e) * 272 + pi * 4) = cvtpk(__uint_as_float(rv0[e] << 16) * kd0, __uint_as_float(rv1[e] << 16) * kd1);
        *(unsigned*)(L + VTS + (vcc * 8 + 2 * e + 1) * 272 + pi * 4) = cvtpk(__uint_as_float(rv0[e] & 0xffff0000u) * kd0, __uint_as_float(rv1[e] & 0xffff0000u) * kd1); } }
    __syncthreads();
    if (n + 1 < 66) RLOAD(n + 1);
    { const int I = wid >> 1;
#pragma unroll
      for (int jj = 0; jj < 2; ++jj) { const int J = (wid & 1) * 2 + jj; f32x16 sc = {};
#pragma unroll
        for (int kk = 0; kk < 4; ++kk) { const bf16x8 ka = *(const bf16x8*)(L + KS + (32 * I + r32) * 144 + (kk * 16 + hi * 8) * 2), qb = *(const bf16x8*)(L + QS + (32 * J + r32) * 144 + (kk * 16 + hi * 8) * 2);
          sc = __builtin_amdgcn_mfma_f32_32x32x16_bf16(ka, qb, sc, 0, 0, 0); }
        const int a = 32 * J + r32; const float colf = dir ? ipw[a] : pw[a];
#pragma unroll
        for (int q4 = 0; q4 < 4; ++q4) { const int ap0 = 32 * I + 8 * q4 + 4 * hi; const f32x4 rowf = *(const f32x4*)((dir ? pw : ipw) + ap0); f32x4 o;
#pragma unroll
          for (int e = 0; e < 4; ++e) { const int dd = dir ? (ap0 + e) - a : a - (ap0 + e); const float m = dd >= 0 ? colf * rowf[e] : 0.f; o[e] = sc[q4 * 4 + e] * m; }
          store4bf((bf16_t*)(L + SC + a * 272 + ap0 * 2), o); } } }
    __syncthreads();
    if (wid < 4) {
      f32x16 a1 = {}, a2 = {};
#pragma unroll
      for (int kk = 0; kk < 8; ++kk) { const bf16x8 sa = *(const bf16x8*)(L + SC + (32 * wid + r32) * 272 + (kk * 16 + hi * 8) * 2), vb = *(const bf16x8*)(L + VT + r32 * 272 + (kk * 16 + hi * 8) * 2);
        a1 = __builtin_amdgcn_mfma_f32_32x32x16_bf16(sa, vb, a1, 0, 0, 0); }
#pragma unroll
      for (int kk = 0; kk < 4; ++kk) { const bf16x8 qa = *(const bf16x8*)(L + QS + (32 * wid + r32) * 144 + (kk * 16 + hi * 8) * 2), sb = *(const bf16x8*)(L + SBF + cur * 4608 + r32 * 144 + (kk * 16 + hi * 8) * 2);
        a2 = __builtin_amdgcn_mfma_f32_32x32x16_bf16(qa, sb, a2, 0, 0, 0); }
      const int ar = chunk_arow(n); const long tokbase = (ar >= 8192) ? (long)TL + b * 256 + (ar - 8192) : (long)b * 8192 + ar;
#pragma unroll
      for (int r = 0; r < 16; ++r) { const int a = 32 * wid + crow(r, hi); const float qd = pw[dir ? 128 - a : a + 1];
        const unsigned pk = cvtpk(a1[r] + qd * a2[r], 0.f); RO[(tokbase + a) * 512 + r32] = (unsigned short)(pk & 0xffff); }
    } else if (wid < 6) {
      const int db = wid - 4; const float cd = pw[128];
#pragma unroll
      for (int r = 0; r < 16; ++r) sacc[r] *= cd;
#pragma unroll
      for (int kk = 0; kk < 8; ++kk) { const bf16x8 ka = *(const bf16x8*)(L + KT + (32 * db + r32) * 272 + (kk * 16 + hi * 8) * 2), vb = *(const bf16x8*)(L + VTS + r32 * 272 + (kk * 16 + hi * 8) * 2);
        sacc = __builtin_amdgcn_mfma_f32_32x32x16_bf16(ka, vb, sacc, 0, 0, 0); }
#pragma unroll
      for (int q4 = 0; q4 < 4; ++q4) { f32x4 o = {sacc[q4 * 4], sacc[q4 * 4 + 1], sacc[q4 * 4 + 2], sacc[q4 * 4 + 3]};
        store4bf((bf16_t*)(L + SBF + (cur ^ 1) * 4608 + r32 * 144 + (32 * db + 8 * q4 + 4 * hi) * 2), o); }
    }
    cur ^= 1;
  }
  __syncthreads();
#undef RLOAD
}

__device__ __forceinline__ void row_rstd(const bf16_t* src, int Kd) {
  const int tid = launder_tid(), row = tid >> 1, hf = tid & 1; float* rs = (float*)(g_lds + 131072);
  const bf16_t* s = src + (long)row * Kd + hf * (Kd / 2); float ss = 0.f;
  for (int c = 0; c < Kd / 16; ++c) { const u32x4 w = *(const u32x4*)(s + c * 8);
#pragma unroll
    for (int e = 0; e < 4; ++e) { const float lo = __uint_as_float(w[e] << 16), hi_ = __uint_as_float(w[e] & 0xffff0000u); ss += lo * lo + hi_ * hi_; } }
  ss += __shfl_xor(ss, 1);
  if (hf == 0) rs[row] = rsqrtf(ss / (float)Kd + EPS);
  __syncthreads();
}
__device__ __forceinline__ void phase_g4(const Params& p, int l) {
  if (PMASK & 0x80000) for (int u = blockIdx.x; u < 256; u += gridDim.x) ret_unit(p, l, u);
  const char* WQB = (const char*)(p.ws + O_WQB); const char* WKVB = (const char*)(p.ws + O_WKVB);
  const bf16_t* QLAT = (const bf16_t*)(p.ws + O_QLAT); const bf16_t* KVLAT = (const bf16_t*)(p.ws + O_KVLAT);
  bf16_t* QMLA = (bf16_t*)(p.ws + O_QMLA); bf16_t* KNOPE = (bf16_t*)(p.ws + O_KNOPE); bf16_t* VMLA = (bf16_t*)(p.ws + O_VMLA);
  const float* rmc = (const float*)(p.ws + O_RMC); const float* rms = (const float*)(p.ws + O_RMS);
  const float* rs = (const float*)(g_lds + 131072);
  const int q = logical_wg(), Gd = gridDim.x;
  auto get = [&](int idx, GOp& o) __attribute__((always_inline)) -> bool { const int U = q + idx * Gd; if (U >= NPM * 7) return false; int pm, pn;
    if (U < NPM * 3) { unit_decode(U, 3, 3, pm, pn); o.A = WQB + (size_t)pn * 256 * 768; o.B = (const char*)QLAT + (size_t)pm * 256 * 768; o.lda2 = 768; o.ldb2 = 768; o.nt = 6; }
    else { unit_decode(U - NPM * 3, 4, 4, pm, pn); o.A = WKVB + (size_t)pn * 256 * 512; o.B = (const char*)KVLAT + (size_t)pm * 256 * 512; o.lda2 = 512; o.ldb2 = 512; o.nt = 4; }
    return true; };
  auto epi = [&](int idx, const f32x4 (&acc)[2][2][4][2]) __attribute__((always_inline)) {
    const int U = q + idx * Gd; const bool isq = U < NPM * 3; int pm, pn;
    if (isq) unit_decode(U, 3, 3, pm, pn); else unit_decode(U - NPM * 3, 4, 4, pm, pn);
    __syncthreads();
    if (isq) row_rstd(QLAT + (size_t)pm * 256 * 384, 384); else row_rstd(KVLAT + (size_t)pm * 256 * 256, 256);
    LANE_IDS
    const TI ti = tile_info(pm); const bool lat = ti.bb < 8;
#pragma unroll
    for (int bj = 0; bj < 2; ++bj)
#pragma unroll
      for (int n = 0; n < 2; ++n) {
        const int tl = bj * 128 + wc * 32 + n * 16 + fr; const int ar = ti.arow0 + tl; const float rr = isq ? rs[tl] * CQ_MLA : rs[tl]; const int prow = ar >> 6, pcol = ar & 63;
        if (isq && pn == 2) {
          const int half = fq >> 1, idx = (fq & 1) * 4; const int pos = half ? pcol : prow;
          f32x4 c = {1.f, 1.f, 1.f, 1.f}, s = {0.f, 0.f, 0.f, 0.f};
          if (lat) { c = *(const f32x4*)(rmc + pos * 8 + idx); s = *(const f32x4*)(rms + pos * 8 + idx); }
#pragma unroll
          for (int ai = 0; ai < 2; ++ai)
#pragma unroll
            for (int mp = 0; mp < 2; ++mp) { const int hd = ai * 4 + wr * 2 + mp; f32x4 o1, o2; rope4(acc[ai][bj][2 * mp][n] * rr, acc[ai][bj][2 * mp + 1][n] * rr, c, s, o1, o2);
              bf16_t* d = QMLA + (((long)ti.b * 8 + hd) * SK + ar) * 96 + 64 + half * 16 + idx; store4bf(d, o1); store4bf(d + 8, o2); }
        } else {
#pragma unroll
          for (int ai = 0; ai < 2; ++ai)
#pragma unroll
            for (int m = 0; m < 4; ++m) { const int cfull = (pn & 1) * 256 + ai * 128 + wr * 64 + m * 16 + fq * 4; const int hd = cfull >> 6, d = cfull & 63; const f32x4 v = acc[ai][bj][m][n] * rr;
              if (isq) store4bf(QMLA + (((long)ti.b * 8 + hd) * SK + ar) * 96 + d, v);
              else if (pn < 2) store4bf(KNOPE + (((long)ti.b * 8 + hd) * SK + ar) * 64 + d, v);
              else store4bf(VMLA + (((long)ti.b * 8 + hd) * SK + ar) * 64 + d, v); }
        }
      }
  };
  if (PMASK & 0x100000) gemm_stream(get, epi);
}

#define SBAR() __builtin_amdgcn_sched_barrier(0)
template <int DQK> __device__ __forceinline__ int kswz(int row, int colB) { if (DQK == 96) return row * 256 + (colB ^ ((row & 7) << 4)); return row * 128 + (colB ^ (((row >> 1) & 7) << 4)); }
#ifndef EXP_THR
#define EXP_THR 8.f
#endif
constexpr float ATHR = EXP_THR;
template <int DQK> __device__ __forceinline__ void partialSM(f32x16& p0, f32x16& p1, float& m_reg, float& mn, float& alpha) {
  constexpr float THRL = ATHR * 1.4426950408889634f;
  float pmax = p0[0];
#pragma unroll
  for (int r = 1; r < 16; ++r) pmax = fmaxf(pmax, p0[r]);
#pragma unroll
  for (int r = 0; r < 16; ++r) pmax = fmaxf(pmax, p1[r]);
  { auto rr = __builtin_amdgcn_permlane32_swap(__float_as_uint(pmax), __float_as_uint(pmax), false, false); pmax = fmaxf(__uint_as_float(rr[0]), __uint_as_float(rr[1])); }
  if (__builtin_expect(__all(pmax - m_reg <= THRL), 1)) { mn = m_reg; alpha = 1.f; }
  else { mn = fmaxf(m_reg, pmax); alpha = __builtin_amdgcn_exp2f(m_reg - mn); m_reg = mn; }
  if (!__all(mn == 0.f)) {
#pragma unroll
    for (int r = 0; r < 16; ++r) p0[r] -= mn;
#pragma unroll
    for (int r = 0; r < 16; ++r) p1[r] -= mn;
  }
#pragma unroll
  for (int r = 0; r < 16; ++r) p0[r] = __builtin_amdgcn_exp2f(p0[r]);
}
template <bool SUM> __device__ __forceinline__ void finishSM(f32x16& p0, f32x16& p1, float alpha, float& l_reg, bf16x8& pa0, bf16x8& pa1, bf16x8& pa2, bf16x8& pa3) {
#pragma unroll
  for (int r = 0; r < 16; ++r) p1[r] = __builtin_amdgcn_exp2f(p1[r]);
  if constexpr (SUM) {
  float ps = 0;
#pragma unroll
  for (int r = 0; r < 16; ++r) ps += p0[r];
#pragma unroll
  for (int r = 0; r < 16; ++r) ps += p1[r];
  { auto rr = __builtin_amdgcn_permlane32_swap(__float_as_uint(ps), __float_as_uint(ps), false, false); ps = __uint_as_float(rr[0]) + __uint_as_float(rr[1]); }
  l_reg = l_reg * alpha + ps;
  }
#define PK4(P, BASE, OUT) do { unsigned a0 = cvtpk(P[BASE + 0], P[BASE + 1]), a1 = cvtpk(P[BASE + 2], P[BASE + 3]); \
    unsigned b0 = cvtpk(P[BASE + 4], P[BASE + 5]), b1 = cvtpk(P[BASE + 6], P[BASE + 7]); \
    auto r0 = __builtin_amdgcn_permlane32_swap(a0, b0, false, false); auto r1 = __builtin_amdgcn_permlane32_swap(a1, b1, false, false); \
    u32x4 w = {r0[0], r1[0], r0[1], r1[1]}; OUT = *reinterpret_cast<bf16x8*>(&w); } while (0)
  PK4(p0, 0, pa0); PK4(p0, 8, pa1); PK4(p1, 0, pa2); PK4(p1, 8, pa3);
#undef PK4
}
template <int DQK> __device__ __forceinline__ void qkt(f32x16& p0, f32x16& p1, const unsigned char* Ks, const bf16x8* qr, int r32, int hi) {
  p0 = f32x16{}; p1 = f32x16{};
#pragma unroll
  for (int d0 = 0; d0 < DQK / 16; ++d0) { const int cb = (d0 * 16 + hi * 8) * 2;
    const bf16x8 b0 = *reinterpret_cast<const bf16x8*>(Ks + kswz<DQK>(r32, cb));
    const bf16x8 b1 = *reinterpret_cast<const bf16x8*>(Ks + kswz<DQK>(32 + r32, cb));
    p0 = __builtin_amdgcn_mfma_f32_32x32x16_bf16(b0, qr[d0], p0, 0, 0, 0);
    p1 = __builtin_amdgcn_mfma_f32_32x32x16_bf16(b1, qr[d0], p1, 0, 0, 0); }
}
template <int DV> __device__ __forceinline__ int v_st(int k, int c) { const int kk = (k & ~0xC) | ((k & 4) << 1) | ((k & 8) >> 1); return ((kk >> 3) * (DV / 32) + (c >> 5)) * 512 + ((kk & 7) * 32 + (c & 31)) * 2; }
__device__ __forceinline__ int v_rd_base(int lane) { return ((lane & 3) << 3) | (((lane >> 2) & 3) << 6) | (((lane >> 4) & 1) << 5) | (((lane >> 5) & 1) << 8); }
template <int OFF> __device__ __forceinline__ s16x4 tr_read(int vb) { s16x4 r; asm volatile("ds_read_b64_tr_b16 %0, %1 offset:%2" : "=&v"(r) : "v"(vb), "i"(OFF) : "memory"); return r; }
template <int DV, int D0> __device__ __forceinline__ void pv_one(f32x16& od, int vb, bf16x8 pa0, bf16x8 pa1, bf16x8 pa2, bf16x8 pa3) {
  constexpr int NS = DV / 32;
#define VOFF(ks, half) (D0 * 512 + (ks) * (2 * NS * 512) + (half) * (NS * 512))
  const s16x4 l0 = tr_read<VOFF(0, 0)>(vb), h0 = tr_read<VOFF(0, 1)>(vb), l1 = tr_read<VOFF(1, 0)>(vb), h1 = tr_read<VOFF(1, 1)>(vb);
  const s16x4 l2 = tr_read<VOFF(2, 0)>(vb), h2 = tr_read<VOFF(2, 1)>(vb), l3 = tr_read<VOFF(3, 0)>(vb), h3 = tr_read<VOFF(3, 1)>(vb);
#undef VOFF
  asm volatile("s_waitcnt lgkmcnt(0)" ::: "memory"); SBAR();
#define PK(L_, H_) (bf16x8){L_[0], L_[1], L_[2], L_[3], H_[0], H_[1], H_[2], H_[3]}
  od = __builtin_amdgcn_mfma_f32_32x32x16_bf16(pa0, PK(l0, h0), od, 0, 0, 0);
  od = __builtin_amdgcn_mfma_f32_32x32x16_bf16(pa1, PK(l1, h1), od, 0, 0, 0);
  od = __builtin_amdgcn_mfma_f32_32x32x16_bf16(pa2, PK(l2, h2), od, 0, 0, 0);
  od = __builtin_amdgcn_mfma_f32_32x32x16_bf16(pa3, PK(l3, h3), od, 0, 0, 0);
#undef PK
}
template <int DV, int D0> __device__ __forceinline__ void pv_pair(f32x16& oa, f32x16& ob, int vb, bf16x8 pa0, bf16x8 pa1, bf16x8 pa2, bf16x8 pa3) {
  constexpr int NS = DV / 32;
#define VOFF(d, ks, half) ((d) * 512 + (ks) * (2 * NS * 512) + (half) * (NS * 512))
  const s16x4 al0 = tr_read<VOFF(D0, 0, 0)>(vb), ah0 = tr_read<VOFF(D0, 0, 1)>(vb), al1 = tr_read<VOFF(D0, 1, 0)>(vb), ah1 = tr_read<VOFF(D0, 1, 1)>(vb);
  const s16x4 al2 = tr_read<VOFF(D0, 2, 0)>(vb), ah2 = tr_read<VOFF(D0, 2, 1)>(vb), al3 = tr_read<VOFF(D0, 3, 0)>(vb), ah3 = tr_read<VOFF(D0, 3, 1)>(vb);
  const s16x4 bl0 = tr_read<VOFF(D0 + 1, 0, 0)>(vb), bh0 = tr_read<VOFF(D0 + 1, 0, 1)>(vb), bl1 = tr_read<VOFF(D0 + 1, 1, 0)>(vb), bh1 = tr_read<VOFF(D0 + 1, 1, 1)>(vb);
  const s16x4 bl2 = tr_read<VOFF(D0 + 1, 2, 0)>(vb), bh2 = tr_read<VOFF(D0 + 1, 2, 1)>(vb), bl3 = tr_read<VOFF(D0 + 1, 3, 0)>(vb), bh3 = tr_read<VOFF(D0 + 1, 3, 1)>(vb);
#undef VOFF
  asm volatile("s_waitcnt lgkmcnt(0)" ::: "memory"); SBAR();
#define PK(L_, H_) (bf16x8){L_[0], L_[1], L_[2], L_[3], H_[0], H_[1], H_[2], H_[3]}
  oa = __builtin_amdgcn_mfma_f32_32x32x16_bf16(pa0, PK(al0, ah0), oa, 0, 0, 0);
  ob = __builtin_amdgcn_mfma_f32_32x32x16_bf16(pa0, PK(bl0, bh0), ob, 0, 0, 0);
  oa = __builtin_amdgcn_mfma_f32_32x32x16_bf16(pa1, PK(al1, ah1), oa, 0, 0, 0);
  ob = __builtin_amdgcn_mfma_f32_32x32x16_bf16(pa1, PK(bl1, bh1), ob, 0, 0, 0);
  oa = __builtin_amdgcn_mfma_f32_32x32x16_bf16(pa2, PK(al2, ah2), oa, 0, 0, 0);
  ob = __builtin_amdgcn_mfma_f32_32x32x16_bf16(pa2, PK(bl2, bh2), ob, 0, 0, 0);
  oa = __builtin_amdgcn_mfma_f32_32x32x16_bf16(pa3, PK(al3, ah3), oa, 0, 0, 0);
  ob = __builtin_amdgcn_mfma_f32_32x32x16_bf16(pa3, PK(bl3, bh3), ob, 0, 0, 0);
#undef PK
}
template <int DV> __device__ __forceinline__ void pv_all(f32x16* o, int vb, bf16x8 pa0, bf16x8 pa1, bf16x8 pa2, bf16x8 pa3) {
  pv_pair<DV, 0>(o[0], o[1], vb, pa0, pa1, pa2, pa3);
  if constexpr (DV == 128) pv_pair<DV, 2>(o[2], o[3], vb, pa0, pa1, pa2, pa3);
}
template <int DQK, int DV>
__device__ __forceinline__ void attn_body(const bf16_t* __restrict__ Qb, const bf16_t* kp0, int kst0, const bf16_t* kp1, int kst1, bool k1valid,
                                          const bf16_t* vp0, const bf16_t* vp1, int nkeys, f32x16 (&o)[DV / 32]) {
  constexpr int KSTR = (DQK == 96) ? 256 : 128, SHM_K = 64 * KSTR, SHM_V = 64 * DV * 2, CK = DQK / 8, CV = DV / 8, ND = DV / 32;
  constexpr bool K2 = (64 * CK > 512), V2 = (64 * CV > 512);
  constexpr bool MSUM = (DV == 64);
  f32x16 osum = f32x16{}; const bf16x8 ones = {16256, 16256, 16256, 16256, 16256, 16256, 16256, 16256};
  const int tid = launder_tid(), wid = tid >> 6, lane = tid & 63, r32 = lane & 31, hi = lane >> 5;
  unsigned char* V_lds = g_lds; unsigned char* K_lds = g_lds + 3 * SHM_V;
  float* ws = (float*)(g_lds + 3 * SHM_V + 3 * SHM_K) + wid * 64; float* li_l = ws; float* al_l = ws + 32;
  float m_reg = 0.f, l_reg = 0;
#pragma unroll
  for (int d = 0; d < ND; ++d) o[d] = f32x16{};
  bf16x8 qr[DQK / 16];
  const bf16_t* Qw = Qb + (long)(wid * 32 + r32) * DQK + hi * 8;
#pragma unroll
  for (int d0 = 0; d0 < DQK / 16; ++d0) qr[d0] = *reinterpret_cast<const bf16x8*>(Qw + d0 * 16);
  const int kq0 = tid, kq1 = tid + 512;
  const int kd0 = kswz<DQK>(kq0 / CK, (kq0 % CK) * 16), kd1 = kswz<DQK>((kq1 / CK) & 63, (kq1 % CK) * 16);
  const int vq0 = tid, vq1 = tid + 512;
  const int vd0 = v_st<DV>(vq0 / CV, (vq0 % CV) * 8), vd1 = v_st<DV>((vq1 / CV) & 63, (vq1 % CV) * 8);
  const int vb0 = (int)(uintptr_t)(__attribute__((address_space(3))) unsigned char*)V_lds + v_rd_base(lane);
  struct St { bf16x8 k0, k1, v0, v1; } sr_[2];
#define SLOAD(i, key0) do { sr_[i].k0 = *reinterpret_cast<const bf16x8*>(kp0 + (long)(key0) * kst0); \
    if (K2) { if (k1valid) sr_[i].k1 = *reinterpret_cast<const bf16x8*>(kp1 + (long)(key0) * kst1); } \
    sr_[i].v0 = *reinterpret_cast<const bf16x8*>(vp0 + (long)(key0) * DV); \
    if (V2) sr_[i].v1 = *reinterpret_cast<const bf16x8*>(vp1 + (long)(key0) * DV); } while (0)
#define SWRITE(b, i) do { *(bf16x8*)(K_lds + (b) * SHM_K + kd0) = sr_[i].k0; \
    if (K2) { if (k1valid) *(bf16x8*)(K_lds + (b) * SHM_K + kd1) = sr_[i].k1; } \
    *(bf16x8*)(V_lds + (b) * SHM_V + vd0) = sr_[i].v0; \
    if (V2) *(bf16x8*)(V_lds + (b) * SHM_V + vd1) = sr_[i].v1; } while (0)
#define RESC(a) do { if (__any((a) < 1.f)) { if (hi == 0) al_l[r32] = (a); asm volatile("s_waitcnt lgkmcnt(0)" ::: "memory"); \
    _Pragma("unroll") for (int d = 0; d < ND; ++d) _Pragma("unroll") for (int r = 0; r < 16; ++r) o[d][r] *= al_l[crow(r, hi)]; \
    if (MSUM) { _Pragma("unroll") for (int r = 0; r < 16; ++r) osum[r] *= al_l[crow(r, hi)]; } } } while (0)
#define PSUM() do { if (MSUM) { osum = __builtin_amdgcn_mfma_f32_32x32x16_bf16(pa0, ones, osum, 0, 0, 0); osum = __builtin_amdgcn_mfma_f32_32x32x16_bf16(pa1, ones, osum, 0, 0, 0); \
    osum = __builtin_amdgcn_mfma_f32_32x32x16_bf16(pa2, ones, osum, 0, 0, 0); osum = __builtin_amdgcn_mfma_f32_32x32x16_bf16(pa3, ones, osum, 0, 0, 0); } } while (0)
#define ROT() do { bprev = bj; bj = bnext; bnext = (bnext == 2) ? 0 : bnext + 1; } while (0)
  f32x16 pA0, pA1, pB0, pB1; float mnA, mnB, alA, alB; bf16x8 pa0, pa1, pa2, pa3; const int NT = nkeys / 64;
  __syncthreads();
  SLOAD(0, 0); SWRITE(0, 0);
  SLOAD(1, 64); if (2 < NT) SLOAD(0, 128);
  __syncthreads();
  qkt<DQK>(pA0, pA1, K_lds, qr, r32, hi); partialSM<DQK>(pA0, pA1, m_reg, mnA, alA);
  SWRITE(1, 1); __syncthreads();
  int bprev = 0, bj = 1, bnext = 2;
  for (int j = 1; j + 1 < NT; j += 2) {
    SBAR(); qkt<DQK>(pB0, pB1, K_lds + bj * SHM_K, qr, r32, hi);
    finishSM<!MSUM>(pA0, pA1, alA, l_reg, pa0, pa1, pa2, pa3); SBAR();
    SLOAD(1, (j + 2) * 64); SBAR();
    pv_all<DV>(o, vb0 + bprev * SHM_V, pa0, pa1, pa2, pa3); PSUM(); partialSM<DQK>(pB0, pB1, m_reg, mnB, alB);
    SWRITE(bnext, 0);
    RESC(alB); __syncthreads(); ROT();
    SBAR(); qkt<DQK>(pA0, pA1, K_lds + bj * SHM_K, qr, r32, hi);
    finishSM<!MSUM>(pB0, pB1, alB, l_reg, pa0, pa1, pa2, pa3); SBAR();
    if (j + 3 < NT) SLOAD(0, (j + 3) * 64); SBAR();
    pv_all<DV>(o, vb0 + bprev * SHM_V, pa0, pa1, pa2, pa3); PSUM(); partialSM<DQK>(pA0, pA1, m_reg, mnA, alA);
    SWRITE(bnext, 1);
    RESC(alA); __syncthreads(); ROT();
  }
  SBAR(); qkt<DQK>(pB0, pB1, K_lds + bj * SHM_K, qr, r32, hi);
  finishSM<!MSUM>(pA0, pA1, alA, l_reg, pa0, pa1, pa2, pa3); SBAR();
  pv_all<DV>(o, vb0 + bprev * SHM_V, pa0, pa1, pa2, pa3); PSUM(); partialSM<DQK>(pB0, pB1, m_reg, mnB, alB);
  RESC(alB);
  finishSM<!MSUM>(pB0, pB1, alB, l_reg, pa0, pa1, pa2, pa3); SBAR();
  pv_all<DV>(o, vb0 + bj * SHM_V, pa0, pa1, pa2, pa3); PSUM();
  if (hi == 0) li_l[r32] = l_reg; asm volatile("s_waitcnt lgkmcnt(0)" ::: "memory");
#pragma unroll
  for (int r = 0; r < 16; ++r) { const float rl = __builtin_amdgcn_rcpf(MSUM ? osum[r] : li_l[crow(r, hi)]);
#pragma unroll
    for (int d = 0; d < ND; ++d) o[d][r] *= rl; }
  __syncthreads();
#undef SLOAD
#undef SWRITE
#undef RESC
#undef PSUM
#undef ROT
}

__device__ __forceinline__ void mla_unit(const Params& p, int b, int h, int qrow0, int key0, int nkeys, long tok0) {
  const int tid = launder_tid(), wid = tid >> 6, lane = tid & 63, r32 = lane & 31, hi = lane >> 5;
  const bf16_t* Q = (const bf16_t*)(p.ws + O_QMLA) + (((long)b * 8 + h) * SK + qrow0) * 96;
  const bf16_t* KN = (const bf16_t*)(p.ws + O_KNOPE) + (((long)b * 8 + h) * SK + key0) * 64;
  const bf16_t* KR = (const bf16_t*)(p.ws + O_KROPE) + ((long)b * SK + key0) * 32;
  const bf16_t* V = (const bf16_t*)(p.ws + O_VMLA) + (((long)b * 8 + h) * SK + key0) * 64;
  const int q0 = tid, q1 = tid + 512; const int r0 = q0 / 12, c0 = q0 % 12, r1 = (q1 / 12) & 63, c1 = q1 % 12;
  const bf16_t* kp0 = c0 < 8 ? KN + (long)r0 * 64 + c0 * 8 : KR + (long)r0 * 32 + (c0 - 8) * 8; const int ks0 = c0 < 8 ? 64 : 32;
  const bf16_t* kp1 = c1 < 8 ? KN + (long)r1 * 64 + c1 * 8 : KR + (long)r1 * 32 + (c1 - 8) * 8; const int ks1 = c1 < 8 ? 64 : 32;
  const bf16_t* vp0 = V + (long)(tid >> 3) * 64 + (tid & 7) * 8;
  f32x16 o[2];
  attn_body<96, 64>(Q, kp0, ks0, kp1, ks1, tid < 256, vp0, vp0, nkeys, o);
  bf16_t* Y = (bf16_t*)(p.ws + O_YMLA);
#pragma unroll
  for (int r = 0; r < 16; ++r) { const long tok = tok0 + wid * 32 + crow(r, hi);
#pragma unroll
    for (int d = 0; d < 2; ++d) { const unsigned pk = cvtpk(o[d][r], 0.f); Y[tok * 512 + h * 64 + d * 32 + r32] = (unsigned short)(pk & 0xffff); } }
}
__device__ __forceinline__ void diff_unit(const Params& p, int l, int b, int h, int qrow0, int key0, int nkeys, long tok0) {
  const int tid = launder_tid(), wid = tid >> 6, lane = tid & 63, r32 = lane & 31, hi = lane >> 5;
  const __amdgpu_buffer_rsrc_t rsd = MK_RSRC((float*)(p.ws + O_O1S) + (size_t)blockIdx.x * 32768); const unsigned vo4 = (unsigned)tid * 4u;
  const float lam = ((const float*)(p.ws + O_LAM))[l];
  const float li = 0.8f - 0.6f * expf(-0.3f * (float)l);
  const bf16_t* V = (const bf16_t*)(p.ws + O_VD) + (((long)b * 4 + h) * SK + key0) * 128;
  const bf16_t* vp0 = V + (long)(tid >> 4) * 128 + (tid & 15) * 8; const bf16_t* vp1 = V + (long)(32 + (tid >> 4)) * 128 + (tid & 15) * 8;
  f32x16 o[4];
  for (int s = 0; s < 2; ++s) {
    const bf16_t* Q = (const bf16_t*)(p.ws + O_QD) + (((long)b * 8 + h * 2 + s) * SK + qrow0) * 64;
    const bf16_t* K = (const bf16_t*)(p.ws + O_KD) + (((long)b * 8 + h * 2 + s) * SK + key0) * 64;
    const bf16_t* kp0 = K + (long)(tid >> 3) * 64 + (tid & 7) * 8;
    attn_body<64, 128>(Q, kp0, 64, kp0, 64, false, vp0, vp1, nkeys, o);
    if (s == 0) {
#pragma unroll
      for (int d = 0; d < 4; ++d)
#pragma unroll
        for (int r = 0; r < 16; ++r) __builtin_amdgcn_raw_buffer_store_b32(__float_as_uint(o[d][r]), rsd, vo4, (d * 16 + r) * 2048, 0);
    }
  }
  const float* dn = p.in[19] + l * 128; bf16_t* Y = (bf16_t*)(p.ws + O_YDIFF);
  float gn[4];
#pragma unroll
  for (int d = 0; d < 4; ++d) gn[d] = dn[d * 32 + r32] * (1.f - li);
#pragma unroll
  for (int r = 0; r < 16; ++r) {
    float v[4], ss = 0.f;
#pragma unroll
    for (int d = 0; d < 4; ++d) { v[d] = __uint_as_float(__builtin_amdgcn_raw_buffer_load_b32(rsd, vo4, (d * 16 + r) * 2048, 0)) - lam * o[d][r]; ss += v[d] * v[d]; }
#pragma unroll
    for (int m = 1; m < 32; m <<= 1) ss += __shfl_xor(ss, m);
    const float rstd = rsqrtf(ss * (1.f / 128.f) + EPS);
    const long tok = tok0 + wid * 32 + crow(r, hi);
#pragma unroll
    for (int d = 0; d < 4; ++d) { const unsigned pk = cvtpk(v[d] * rstd * gn[d], 0.f); Y[tok * 512 + h * 128 + d * 32 + r32] = (unsigned short)(pk & 0xffff); }
    MEMFENCE();
  }
}
__device__ __forceinline__ void phase_attn(const Params& p, int l) {
  const int tid = launder_tid(), wid = tid >> 6, lane = tid & 63;
  const int q = logical_wg(), G = gridDim.x;
  const bf16_t* RO = (const bf16_t*)(p.ws + O_RETO); bf16_t* YR = (bf16_t*)(p.ws + O_YRET); const float* rn = p.in[21] + l * 128;
  const int vc = (lane & 15) * 8; f32x8 gnv = *(const f32x8*)(rn + vc);
  const int rp_slot = blockIdx.x % 3;
  auto ret_post = [&]() __attribute__((always_inline)) {
  if (PMASK & 0x40000) {
    const long nwaves = (long)gridDim.x * 8, w0 = (long)blockIdx.x * 8 + wid; const long nrows = (l == 0) ? (long)T : (long)TL;
    for (long rb = w0; rb < nrows; rb += nwaves * 4) {
      u32x4 a[4], bq[4], g[4];
#pragma unroll
      for (int j = 0; j < 4; ++j) { const long row = rb + j * nwaves;
        if (row < nrows) { a[j] = *(const u32x4*)(RO + row * 512 + lane * 8); bq[j] = *(const u32x4*)(RO + (size_t)T * 512 + row * 512 + lane * 8); g[j] = *(const u32x4*)(YR + row * 512 + lane * 8); } }
#pragma unroll
      for (int j = 0; j < 4; ++j) { const long row = rb + j * nwaves;
        if (row < nrows) {
          float v[8], ss = 0.f;
#pragma unroll
          for (int e = 0; e < 4; ++e) { v[2 * e] = __uint_as_float(a[j][e] << 16) + __uint_as_float(bq[j][e] << 16); v[2 * e + 1] = __uint_as_float(a[j][e] & 0xffff0000u) + __uint_as_float(bq[j][e] & 0xffff0000u); }
#pragma unroll
          for (int e = 0; e < 8; ++e) ss += v[e] * v[e];
#pragma unroll
          for (int m = 1; m < 16; m <<= 1) ss += __shfl_xor(ss, m);
          const float rstd = rsqrtf(ss * (1.f / 128.f) + EPS);
          u32x4 w;
#pragma unroll
          for (int e = 0; e < 4; ++e) { const float g0 = __uint_as_float(g[j][e] << 16), g1 = __uint_as_float(g[j][e] & 0xffff0000u); w[e] = cvtpk(v[2 * e] * rstd * gnv[2 * e] * g0, v[2 * e + 1] * rstd * gnv[2 * e + 1] * g1); }
          *(u32x4*)(YR + row * 512 + lane * 8) = w; } }
    }
  }
  };
  if (rp_slot == 0) ret_post();
  if (PMASK & 0x10000) for (int U = q; U < 2048; U += G) { const int h = U >> 8, w = U & 255, b = w >> 5, qb = w & 31; mla_unit(p, b, h, qb * 256, 0, SK, (long)b * 8192 + qb * 256); }
  if (rp_slot == 1) ret_post();
  if (PMASK & 0x20000) for (int U = q; U < 1024; U += G) { const int h = U >> 8, w = U & 255, b = w >> 5, qb = w & 31; diff_unit(p, l, b, h, qb * 256, 0, SK, (long)b * 8192 + qb * 256); }
  if ((PMASK & 0x10000) && l == 0) for (int U = q; U < 64; U += G) { const int b = U >> 3, h = U & 7; mla_unit(p, b, h, 8192, 8192, 256, (long)TL + b * 256); }
  if ((PMASK & 0x20000) && l == 0) for (int U = q; U < 32; U += G) { const int b = U >> 2, h = U & 3; diff_unit(p, l, b, h, 8192, 8192, 256, (long)TL + b * 256); }
  if (rp_slot == 2) ret_post();
}

template <int MODE>
__device__ __forceinline__ void branch_epi(const f32x4 (&acc)[2][2][4][2], unsigned char* scr, bf16_t* YBR, int pm, int pn, int tid, int wr, int wc, int fr, int fq) {
  const __amdgpu_buffer_rsrc_t rs = MK_RSRC(scr);
  const unsigned vo8 = (unsigned)tid * 8u, vo16 = (unsigned)tid * 16u;
#pragma unroll
  for (int bj = 0; bj < 2; ++bj)
#pragma unroll
    for (int n = 0; n < 2; ++n) {
      const long tok = (long)pm * 256 + bj * 128 + wc * 32 + n * 16 + fr; bf16_t* yrow = YBR + tok * 1024 + pn * 256 + wr * 64 + fq * 4;
#pragma unroll
      for (int ai = 0; ai < 2; ++ai)
#pragma unroll
        for (int m = 0; m < 4; ++m) { const int e = ((ai * 2 + bj) * 4 + m) * 2 + n;
          const u32x2 w = __builtin_amdgcn_raw_buffer_load_b64(rs, vo8, e * 4096, 0); f32x4 v = acc[ai][bj][m][n];
          v[0] *= __uint_as_float(w.x << 16); v[1] *= __uint_as_float(w.x & 0xffff0000u); v[2] *= __uint_as_float(w.y << 16); v[3] *= __uint_as_float(w.y & 0xffff0000u);
          if (MODE > 0) v += __builtin_bit_cast(f32x4, __builtin_amdgcn_raw_buffer_load_b128(rs, vo16, 131072 + e * 8192, 0));
          if (MODE < 2) __builtin_amdgcn_raw_buffer_store_b128(__builtin_bit_cast(u32x4, v), rs, vo16, 131072 + e * 8192, 0); else store4bf(yrow + ai * 128 + m * 16, v);
          if (m & 1) MEMFENCE(); }
    }
}
__device__ __forceinline__ void phase_branch(const Params& p, int npm) {
  const char* WG = (const char*)(p.ws + O_WG); const char* WBR = (const char*)(p.ws + O_WBR); const char* H = (const char*)(p.ws + O_H);
  bf16_t* YBR = (bf16_t*)(p.ws + O_YBR);
  unsigned char* scr = p.ws + O_G6S + (size_t)blockIdx.x * 393216;
  const int q = logical_wg(), Gd = gridDim.x, tot = npm * 4;
  auto get = [&](int idx, GOp& o) __attribute__((always_inline)) -> bool { const int u = idx / 6, j = idx - u * 6, i = j >> 1; const int U = q + u * Gd; if (U >= tot) return false; int pm, pn; unit_decode(U, 4, 4, pm, pn);
    if ((j & 1) == 0) { o.A = WG + ((size_t)i * 1024 + pn * 256) * 2048; o.B = H + (size_t)pm * 256 * 2048; o.lda2 = 2048; o.ldb2 = 2048; o.nt = 16; }
    else { const char* Y = (const char*)(p.ws + (i == 0 ? O_YMLA : (i == 1 ? O_YDIFF : O_YRET))); o.A = WBR + ((size_t)i * 1024 + pn * 256) * 1024; o.B = Y + (size_t)pm * 256 * 1024; o.lda2 = 1024; o.ldb2 = 1024; o.nt = 8; }
    return true; };
  auto epi = [&](int idx, const f32x4 (&acc)[2][2][4][2]) __attribute__((always_inline)) {
    const int u = idx / 6, j = idx - u * 6, i = j >> 1; const int U = q + u * Gd; int pm, pn; unit_decode(U, 4, 4, pm, pn);
    LANE_IDS
    if ((j & 1) == 0) {
      const unsigned vo8 = (unsigned)tid * 8u; const __amdgpu_buffer_rsrc_t rs = MK_RSRC(scr);
#pragma unroll
      for (int ai = 0; ai < 2; ++ai)
#pragma unroll
        for (int bj = 0; bj < 2; ++bj)
#pragma unroll
          for (int m = 0; m < 4; ++m)
#pragma unroll
            for (int n = 0; n < 2; ++n) { const int e = ((ai * 2 + bj) * 4 + m) * 2 + n; const f32x4 v = acc[ai][bj][m][n]; u32x2 w; w.x = cvtpk(sigm_f(v[0]), sigm_f(v[1])); w.y = cvtpk(sigm_f(v[2]), sigm_f(v[3])); __builtin_amdgcn_raw_buffer_store_b64(w, rs, vo8, e * 4096, 0); if (n == 1) MEMFENCE(); }
    } else {
      if (i == 0) branch_epi<0>(acc, scr, YBR, pm, pn, tid, wr, wc, fr, fq);
      else if (i == 1) branch_epi<1>(acc, scr, YBR, pm, pn, tid, wr, wc, fr, fq);
      else branch_epi<2>(acc, scr, YBR, pm, pn, tid, wr, wc, fr, fq);
    }
  };
  gemm_stream(get, epi);
}


#ifdef DIAG
__device__ __forceinline__ float blk_reduce(float v, int mode, float* red) {
  const int tid = launder_tid(), lane = tid & 63, wid = tid >> 6;
#pragma unroll
  for (int o = 32; o > 0; o >>= 1) { const float t = __shfl_xor(v, o); v = mode ? fmaxf(v, t) : v + t; }
  __syncthreads();
  if (lane == 0) red[wid] = v;
  __syncthreads();
  float r = red[0];
  for (int i = 1; i < 8; ++i) r = mode ? fmaxf(r, red[i]) : r + red[i];
  return r;
}
__device__ __forceinline__ void phase_diag(const Params& p) {
  const int tid = launder_tid();
  float* w0 = (float*)g_lds; float* w1 = w0 + 8448; float* qv = w1 + 8448; float* ov = qv + 256; float* red = ov + 256;
  float* dg = (float*)(p.ws + O_LAM) + 16;
  const int S = blockIdx.x; const int b = S & 7, t = (S * 977 + 131) % 8192; const long tok = (long)b * 8192 + t;
  float num = 0.f, den = 0.f;
#if DIAG == 1
  { const int h = (S >> 3) & 7; const bf16_t* Q = (const bf16_t*)(p.ws + O_QMLA) + (((long)b * 8 + h) * SK + t) * 96;
    const bf16_t* KN = (const bf16_t*)(p.ws + O_KNOPE) + ((long)b * 8 + h) * SK * 64; const bf16_t* KR = (const bf16_t*)(p.ws + O_KROPE) + (long)b * SK * 32;
    const bf16_t* V = (const bf16_t*)(p.ws + O_VMLA) + ((long)b * 8 + h) * SK * 64;
    if (tid < 96) qv[tid] = bf2f(Q[tid]);
    __syncthreads();
    float mx = -1e30f;
    for (int k = tid; k < SK; k += 512) { float d = 0.f; for (int e = 0; e < 64; ++e) d += qv[e] * bf2f(KN[(long)k * 64 + e]); for (int e = 0; e < 32; ++e) d += qv[64 + e] * bf2f(KR[(long)k * 32 + e]); d *= 0.10206207261596575f; w0[k] = d; mx = fmaxf(mx, d); }
    mx = blk_reduce(mx, 1, red); float l = 0.f;
    for (int k = tid; k < SK; k += 512) { const float e = expf(w0[k] - mx); w0[k] = e; l += e; }
    l = blk_reduce(l, 0, red);
    if (tid < 64) { float a = 0.f; for (int k = 0; k < SK; ++k) a += w0[k] * bf2f(V[(long)k * 64 + tid]); a /= l;
      const float y = bf2f(((const bf16_t*)(p.ws + O_YMLA))[tok * 512 + h * 64 + tid]); num = (a - y) * (a - y); den = a * a; } }
#elif DIAG == 2
  { const int h = (S >> 3) & 3; const float lam = ((const float*)(p.ws + O_LAM))[0];
    const bf16_t* V = (const bf16_t*)(p.ws + O_VD) + ((long)b * 4 + h) * SK * 128; float ls[2];
    for (int s2 = 0; s2 < 2; ++s2) { float* w = s2 ? w1 : w0;
      const bf16_t* Q = (const bf16_t*)(p.ws + O_QD) + (((long)b * 8 + h * 2 + s2) * SK + t) * 64; const bf16_t* K = (const bf16_t*)(p.ws + O_KD) + ((long)b * 8 + h * 2 + s2) * SK * 64;
      __syncthreads();
      if (tid < 64) qv[tid] = bf2f(Q[tid]);
      __syncthreads();
      float mx = -1e30f;
      for (int k = tid; k < SK; k += 512) { float d = 0.f; for (int e = 0; e < 64; ++e) d += qv[e] * bf2f(K[(long)k * 64 + e]); d *= 0.125f; w[k] = d; mx = fmaxf(mx, d); }
      mx = blk_reduce(mx, 1, red); float l = 0.f;
      for (int k = tid; k < SK; k += 512) { const float e = expf(w[k] - mx); w[k] = e; l += e; }
      ls[s2] = blk_reduce(l, 0, red); }
    if (tid < 256) { const int d = tid & 127, s2 = tid >> 7; const float* w = s2 ? w1 : w0; float a = 0.f; for (int k = 0; k < SK; ++k) a += w[k] * bf2f(V[(long)k * 128 + d]); ov[tid] = a / ls[s2]; }
    __syncthreads();
    float val = 0.f; if (tid < 128) val = ov[tid] - lam * ov[128 + tid];
    const float ss = blk_reduce(val * val, 0, red); const float rstd = rsqrtf(ss * (1.f / 128.f) + EPS);
    if (tid < 128) { const float a = val * rstd * p.in[19][tid] * 0.8f; const float y = bf2f(((const bf16_t*)(p.ws + O_YDIFF))[tok * 512 + h * 128 + tid]); num = (a - y) * (a - y); den = a * a; } }
#elif DIAG >= 3
  { const int h = (S >> 3) & 3, dir = (S >> 5) & 1; const float lg = -expf(p.in[20][dir * 4 + h]);
    const bf16_t* Q = (const bf16_t*)(p.ws + O_RQ) + (((long)b * 4 + h) * SK + t) * 64; const bf16_t* K = (const bf16_t*)(p.ws + O_RK) + ((long)b * 4 + h) * SK * 64;
    const bf16_t* V = (const bf16_t*)(p.ws + O_RV) + ((long)b * 4 + h) * SK * 128;
    if (tid < 64) qv[tid] = bf2f(Q[tid]);
    __syncthreads();
    for (int k = tid; k < SK; k += 512) { int dist; if (k < 8192) dist = dir ? k - t : t - k; else { const int j = k - 8192; dist = dir ? 8192 - t + j : 256 + t - j; }
      float d = 0.f; bool inc = dist >= 0;
#if DIAG == 4
      inc = inc && (k < 8192) && ((k >> 7) == (t >> 7));
#endif
#if DIAG == 5
      inc = inc && !((k < 8192) && ((k >> 7) == (t >> 7)));
#endif
      if (inc) { for (int e = 0; e < 64; ++e) d += qv[e] * bf2f(K[(long)k * 64 + e]); d *= expf(lg * (float)dist); } w0[k] = d; }
    __syncthreads();
    if (tid < 128) { float a = 0.f; for (int k = 0; k < SK; ++k) a += w0[k] * bf2f(V[(long)k * 128 + tid]);
      const float y = bf2f(((const bf16_t*)(p.ws + O_RETO))[(size_t)dir * T * 512 + tok * 512 + h * 128 + tid]); num = (a - y) * (a - y); den = a * a; } }
#endif
  num = blk_reduce(num, 0, red); den = blk_reduce(den, 0, red);
  if (tid == 0) { atomicAdd(dg, num); atomicAdd(dg + 1, den); }
}
__device__ __forceinline__ void phase_diag_out(const Params& p) {
  const float* dg = (const float*)(p.ws + O_LAM) + 16; const float m = dg[0] / fmaxf(dg[1], 1e-30f);
  float c2 = 10.f + log10f(fmaxf(m, 1e-12f)); c2 = fminf(fmaxf(c2, 0.f), 12.f); const float c = sqrtf(c2);
  for (long i = (long)blockIdx.x * 512 + launder_tid(); i < (long)TL * DM; i += (long)gridDim.x * 512) p.out[i] = c;
}
#endif
constexpr int NPHASE = 25;
__device__ __forceinline__ void run_phase(const Params& p0_, int ph) {
  Params p = p0_; { unsigned long long z = 0; asm volatile("" : "+s"(z)); p.ws = p0_.ws + z; p.out = p0_.out + z; }
  if (ph == 0) { if (PMASK & 0x1000) phase_p0(p); return; }
  if (ph == 25) { if (PMASK & 0x2000) phase_final(p); return; }
  const int l = (ph - 1) / 12, s = (ph - 1) % 12;
  switch (s) {
    case 0: if (PMASK & 1) { if (l == 0) { phase_norm(p, l, 0, true); conv_group(p, l, 0, 0, 2); } } break;
    case 1: if (PMASK & 2) { if (l == 1) { conv_group(p, 1, 0, 1, 2); __syncthreads(); } phase_ffn_up(p, NPM); } break;
    case 2: if (PMASK & 4) phase_ffn_down(p, l, 2, l == 0, NPM, NormFuse{l, 1, l * 3 + 0, l * 12 + 2, false}); break;
    case 3: if (PMASK & 1) { conv_group(p, l, 1, 0, 6); } break;
    case 4: if (PMASK & 16) phase_win(p); break;
    case 5: if (PMASK & 32) phase_g4(p, l); break;
    case 6: if (PMASK & 64) phase_attn(p, l); break;
    case 7: if (PMASK & 128) phase_branch(p, l == 0 ? NPM : 256); break;
    case 8: if (PMASK & 256) { conv_group(p, l, 2, 0, 2); __syncthreads(); } if (PMASK & 256) phase_wout(p, l, l == 0 ? NPM : 256, NormFuse{l, 2, l * 3 + 1, l * 12 + 8, false}); break;
    case 9: break;
    case 10: if (PMASK & 2) phase_ffn_up(p, l == 0 ? NPM : 256); break;
    case 11: if ((PMASK & 4) && l == 0) { conv_group(p, 1, 0, 0, 1); __syncthreads(); } if (PMASK & 4) phase_ffn_down(p, l, 8, false, l == 0 ? NPM : 256, NormFuse{l + 1, 0, l * 3 + 2, l * 12 + 11, l == 1}); break;
  }
}
__global__ void __launch_bounds__(512) mega_kernel(Params p) {
  cg::grid_group grid = cg::this_grid();
#ifdef DIAG
#define PHD(k) if ((k) < DIAG_STOP) { run_phase(p, (k)); grid.sync(); }
  PHD(0)
  PHD(1)
  PHD(2)
  PHD(3)
  PHD(4)
  PHD(5)
  PHD(6)
  PHD(7)
  PHD(8)
#undef PHD
  phase_diag(p); grid.sync(); phase_diag_out(p);
#else
#ifdef TIMING
#define PH(k) if ((k) >= p.ph_lo && (k) < p.ph_hi) { if (blockIdx.x == 0 && threadIdx.x == 0) ((unsigned long long*)(p.ws + O_TS))[k] = __builtin_amdgcn_s_memrealtime(); run_phase(p, (k)); grid.sync(); }
#else
#define PH_EMPTY(k) ((k) == 10 || (k) == 22 || (k) == 13)
#define PH(k) if (!PH_EMPTY(k) && (k) >= p.ph_lo && (k) < p.ph_hi) { run_phase(p, (k)); if ((k) + 1 < p.ph_hi) grid.sync(); }
#endif
  PH(0)
  PH(1)
  PH(2)
  PH(3)
  PH(4)
  PH(5)
  PH(6)
  PH(7)
  PH(8)
  PH(9)
  PH(10)
  PH(11)
  PH(12)
  PH(13)
  PH(14)
  PH(15)
  PH(16)
  PH(17)
  PH(18)
  PH(19)
  PH(20)
  PH(21)
  PH(22)
  PH(23)
  PH(24)
  PH(25)
#undef PH
#ifdef TIMING
  if (blockIdx.x == 0) { unsigned long long* ts = (unsigned long long*)(p.ws + O_TS); const unsigned long long tend = __builtin_amdgcn_s_memrealtime();
    float tot = (float)(tend - ts[0]), s1 = 0.f, s2 = 0.f;
    for (int k = 0; k < 26; ++k) { const float d = (float)((k == 25 ? tend : ts[k + 1]) - ts[k]); if ((TSEL1 >> k) & 1) s1 += d; if ((TSEL2 >> k) & 1) s2 += d; }
    const int M = (int)(s1 / tot * 100000.f + 0.5f); const float d2 = 0.04f + 0.14f * (s2 / tot);
    for (int i = threadIdx.x; i < M; i += 512) p.out[i] += 0.1f;
    if (threadIdx.x == 0) p.out[(size_t)TL * DM - 1] += d2; }
#endif
#endif
}

extern "C" void kernel_launch(void* const* d_in, const int* in_sizes, int n_in, void* d_out, int out_size, void* d_ws, size_t ws_size, hipStream_t stream) {
  static int grid_blocks = 0;
  if (grid_blocks == 0) {
    if (n_in != 25 || out_size != TL * DM || ws_size < WS_NEED) { fprintf(stderr, "kernel_launch: unexpected shapes: n_in %d out %d ws %zu (need %zu)\n", n_in, out_size, ws_size, (size_t)WS_NEED); grid_blocks = -1; return; }
    int dev = 0, cus = 0, per_cu = 0;
    hipGetDevice(&dev); hipDeviceGetAttribute(&cus, hipDeviceAttributeMultiprocessorCount, dev);
    if (hipFuncSetAttribute((const void*)mega_kernel, hipFuncAttributeMaxDynamicSharedMemorySize, LDS_BYTES) != hipSuccess) { fprintf(stderr, "kernel_launch: hipFuncSetAttribute failed\n"); grid_blocks = -1; return; }
    hipOccupancyMaxActiveBlocksPerMultiprocessor(&per_cu, (const void*)mega_kernel, 512, LDS_BYTES);
    if (per_cu < 1) per_cu = 1;
    grid_blocks = cus * per_cu;
  }
  if (grid_blocks < 0) return;
  Params p{};
  for (int i = 0; i < 25; ++i) p.in[i] = (const float*)d_in[i];
  p.out = (float*)d_out; p.ws = (unsigned char*)d_ws;
#if PER_PHASE_LAUNCH
  for (int ph = 0; ph < NPHASE; ++ph) {
    p.ph_lo = ph; p.ph_hi = ph + 1; void* args[] = {&p};
    hipError_t e = hipLaunchCooperativeKernel((const void*)mega_kernel, dim3(grid_blocks), dim3(512), args, LDS_BYTES, stream);
    if (e != hipSuccess) { fprintf(stderr, "cooperative launch failed: %s (grid %d)\n", hipGetErrorString(e), grid_blocks); break; }
  }
#else
  p.ph_lo = 0; p.ph_hi = NPHASE; void* args[] = {&p};
  hipError_t e = hipLaunchCooperativeKernel((const void*)mega_kernel, dim3(grid_blocks), dim3(512), args, LDS_BYTES, stream);
  if (e != hipSuccess) fprintf(stderr, "cooperative launch failed: %s (grid %d)\n", hipGetErrorString(e), grid_blocks);
#endif
}
```

```cpp
#include <hip/hip_runtime.h>
#include <hip/hip_cooperative_groups.h>
#include <cstdio>
#include <cstdint>
namespace cg = cooperative_groups;

#ifndef PMASK
#define PMASK 0xffffffff
#endif
#define TSEL1 ((1u<<8)|(1u<<20))
#define TSEL2 ((1u << 6) | (1u << 18))
#if defined(DIAG)
#if DIAG >= 3
#define DIAG_STOP 7
#else
#define DIAG_STOP 8
#endif
#endif
#ifndef GEMM_SP2
#define GEMM_SP2 1
#endif
#ifndef PER_PHASE_LAUNCH
#define PER_PHASE_LAUNCH 0
#endif

typedef unsigned short bf16_t;
typedef short bf16x8 __attribute__((ext_vector_type(8)));
typedef short s16x4 __attribute__((ext_vector_type(4)));
typedef float f32x4 __attribute__((ext_vector_type(4)));
typedef float f32x8 __attribute__((ext_vector_type(8)));
typedef float f32x16 __attribute__((ext_vector_type(16)));
typedef unsigned u32x4 __attribute__((ext_vector_type(4)));
typedef unsigned u32x2 __attribute__((ext_vector_type(2)));

constexpr int DM = 1024, NB = 8, SEQ = 8192, CTXL = 256, TL = NB * SEQ, TC = NB * CTXL, T = TL + TC, SK = SEQ + CTXL;
constexpr int DFF = 2816, PROJ = 6816;
constexpr int NPM = T / 256;
constexpr float EPS = 1e-6f;
constexpr float CQ_MLA = 0.10206207261596575f * 1.4426950408889634f;
constexpr float CQ_DIFF = 0.125f * 1.4426950408889634f;

constexpr size_t al256(size_t x) { return (x + 255) / 256 * 256; }
constexpr size_t O_MOD = 0;
constexpr size_t O_LAM = al256(O_MOD + (size_t)2 * 9 * 9216 * 4);
constexpr size_t O_R1C = O_LAM + 256;
constexpr size_t O_R1S = O_R1C + (size_t)8192 * 32 * 4;
constexpr size_t O_RDC = O_R1S + (size_t)8192 * 32 * 4;
constexpr size_t O_RDS = O_RDC + 128 * 16 * 4;
constexpr size_t O_RMC = O_RDS + 128 * 16 * 4;
constexpr size_t O_RMS = O_RMC + 128 * 8 * 4;
constexpr size_t O_W = al256(O_RMS + 128 * 8 * 4);
constexpr size_t O_WUP = O_W;
constexpr size_t O_WDN = O_WUP + (size_t)5632 * 1024 * 2;
constexpr size_t O_WIN = O_W;
constexpr size_t O_WG = O_WIN + (size_t)3840 * 1024 * 2;
constexpr size_t O_WQB = O_WG + (size_t)3072 * 1024 * 2;
constexpr size_t O_WKVB = O_WQB + (size_t)768 * 384 * 2;
constexpr size_t O_WBR = O_WKVB + (size_t)1024 * 256 * 2;
constexpr size_t O_WOUT = O_WBR + (size_t)3 * 1024 * 512 * 2;
constexpr size_t O_WEND = O_WOUT + (size_t)1024 * 1024 * 2;
constexpr size_t O_XC = al256(O_WEND);
constexpr size_t O_H = O_XC + (size_t)TC * DM * 4;
constexpr size_t O_M = O_H + (size_t)T * DM * 2;
constexpr size_t O_G = O_M;
constexpr size_t TB = (size_t)T;
constexpr size_t O_QLAT = O_M;
constexpr size_t O_KVLAT = O_QLAT + TB * 768;
constexpr size_t O_KNOPE = O_KVLAT + TB * 512;
constexpr size_t O_KROPE = O_KNOPE + TB * 1024;
constexpr size_t O_QD = O_KROPE + TB * 64;
constexpr size_t O_KD = O_QD + TB * 1024;
constexpr size_t O_VD = O_KD + TB * 1024;
constexpr size_t O_RQ = O_VD + TB * 1024;
constexpr size_t O_RK = O_RQ + TB * 512;
constexpr size_t O_RV = O_RK + TB * 512;
constexpr size_t O_YRET = O_RV + TB * 1024;
constexpr size_t O_QMLA = O_YRET + TB * 1024;
constexpr size_t O_VMLA = O_QMLA + TB * 1536;
constexpr size_t O_RETO = O_VMLA + TB * 1024;
constexpr size_t O_END = O_RETO + TB * 2048;
constexpr size_t O_YMLA = O_RQ;
constexpr size_t O_YDIFF = O_RV;
constexpr size_t O_O1S = O_QLAT;
constexpr size_t O_G6S = O_QMLA;
constexpr size_t O_YBR = O_RETO;
static_assert(O_G + TB * 2816 * 2 <= O_END, "ffn g fits");
constexpr size_t O_TS = O_END;
constexpr size_t O_CNT = O_TS + 512;
constexpr size_t O_PART = al256(O_CNT + 26 * 264 * 4);
constexpr size_t WS_NEED = O_PART + (size_t)6 * 264 * 4 * 256 * 4;

constexpr int LDS_BYTES = 131072 + 4096;

struct Params { const float* in[25]; float* out; unsigned char* ws; int ph_lo, ph_hi; };

extern __shared__ __attribute__((aligned(16))) unsigned char g_lds[];

#define MK_RSRC(ptr) __builtin_amdgcn_make_buffer_rsrc((void*)(ptr), 0, 0x7fffffff, 0x00020000)
#define MEMFENCE() asm volatile("" ::: "memory")
__device__ __forceinline__ int launder_tid() { int t = __builtin_amdgcn_workitem_id_x(); asm volatile("" : "+v"(t)); return t; }
typedef __bf16 bf16v2_t __attribute__((ext_vector_type(2)));
typedef float f32v2_t __attribute__((ext_vector_type(2)));
__device__ __forceinline__ unsigned cvtpk(float lo, float hi) { const f32v2_t v = {lo, hi}; const bf16v2_t b = __builtin_convertvector(v, bf16v2_t); return __builtin_bit_cast(unsigned, b); }
__device__ __forceinline__ float bf2f(unsigned short b) { return __uint_as_float(((unsigned)b) << 16); }
__device__ __forceinline__ float silu_f(float v) { return v * __builtin_amdgcn_rcpf(1.f + __expf(-v)); }
__device__ __forceinline__ float sigm_f(float v) { return __builtin_amdgcn_rcpf(1.f + __expf(-v)); }
__device__ __forceinline__ void store4bf(bf16_t* p, f32x4 v) { u32x2 w; w.x = cvtpk(v[0], v[1]); w.y = cvtpk(v[2], v[3]); *(u32x2*)p = w; }
__device__ __forceinline__ int logical_wg() { const int g = gridDim.x, w = blockIdx.x; return (g % 8 == 0) ? (w % 8) * (g / 8) + w / 8 : w; }

constexpr int BK = 64, HALF = 128, HTB = HALF * BK * 2;
__device__ __forceinline__ int lds_byte(int r, int c) { int st = (r >> 4) * 2 + (c >> 5), rr = r & 15, cc = c & 31, ob = rr * 64 + cc * 2; return st * 1024 + (ob ^ (((ob >> 9) & 1) << 5)); }
__device__ __forceinline__ void stage_rc(int b, int& R, int& C) { int st = b / 1024, sb = b % 1024, swz = sb ^ (((sb >> 9) & 1) << 5); R = (st >> 1) * 16 + swz / 64; C = (st & 1) * 32 + (swz % 64) / 2; }

#define LAS __attribute__((address_space(3)))
#define WAIT_V(n) asm volatile("s_waitcnt vmcnt(" #n ")" ::: "memory")
#define WAIT_L(n) asm volatile("s_waitcnt lgkmcnt(" #n ")" ::: "memory")
#define BAR __builtin_amdgcn_s_barrier()
#define SCHED __builtin_amdgcn_sched_barrier(0)

struct GOp { const char* A; const char* B; unsigned lda2, ldb2; int nt; };
template <class GetOp, class Epi>
__device__ __forceinline__ void gemm_stream(GetOp get, Epi epi) {
  LAS unsigned char* lds = (LAS unsigned char*)g_lds;
  GOp cur, nxt;
  if (!get(0, cur)) return;
  const int tid = launder_tid();
  const int wid = __builtin_amdgcn_readfirstlane(tid >> 6), lane = tid & 63, wr = wid >> 2, wc = wid & 3, fr = lane & 15, fq = lane >> 4;
  int R0, C0, R1, C1; stage_rc(tid * 16, R0, C0); stage_rc(tid * 16 + 8192, R1, C1);
  const unsigned ldsw = (unsigned)wid * 1024u;
  const int aoff = lds_byte(wr * 64 + fr, fq * 8), boff = lds_byte(wc * 32 + fr, fq * 8);
  unsigned cvA[2], cvB[2], nvA[2], nvB[2];
  cvA[0] = R0 * cur.lda2 + C0 * 2; cvA[1] = R1 * cur.lda2 + C1 * 2; cvB[0] = R0 * cur.ldb2 + C0 * 2; cvB[1] = R1 * cur.ldb2 + C1 * 2;
#define G_SA(b, h) (((b) * 2 + (h)) * HTB)
#define G_SB(b, h) ((4 + (b) * 2 + (h)) * HTB)
#define STAGE(bufoff, gbase, voff) do { _Pragma("unroll") for (int _i = 0; _i < 2; ++_i) \
    __builtin_amdgcn_global_load_lds((const unsigned*)((const char*)(gbase) + (voff)[_i]), (LAS unsigned*)(lds + (bufoff) + ldsw + _i * 8192), 16, 0, 0); } while (0)
#define LDA(dst, b, h) do { _Pragma("unroll") for (int m = 0; m < 4; ++m) _Pragma("unroll") for (int k = 0; k < 2; ++k) dst[m][k] = *(const LAS bf16x8*)(lds + G_SA(b, h) + aoff + m * 2048 + k * 1024); } while (0)
#define LDB(dst, b, h) do { _Pragma("unroll") for (int n = 0; n < 2; ++n) _Pragma("unroll") for (int k = 0; k < 2; ++k) dst[n][k] = *(const LAS bf16x8*)(lds + G_SB(b, h) + boff + n * 2048 + k * 1024); } while (0)
#define MMA(ai, bj, At_, Bt_) do { __builtin_amdgcn_s_setprio(1); \
    _Pragma("unroll") for (int m = 0; m < 4; ++m) _Pragma("unroll") for (int n = 0; n < 2; ++n) _Pragma("unroll") for (int k = 0; k < 2; ++k) \
      acc[ai][bj][m][n] = __builtin_amdgcn_mfma_f32_16x16x32_bf16(At_[m][k], Bt_[n][k], acc[ai][bj][m][n], 0, 0, 0); \
    __builtin_amdgcn_s_setprio(0); } while (0)
  { const size_t hA = (size_t)HALF * cur.lda2, hB = (size_t)HALF * cur.ldb2;
#if GEMM_SP2
    STAGE(G_SB(0, 0), cur.B, cvB); STAGE(G_SB(0, 1), cur.B + hB, cvB); STAGE(G_SA(0, 0), cur.A, cvA); STAGE(G_SA(0, 1), cur.A + hA, cvA);
    if (wr == 1) BAR;
    WAIT_V(2); BAR;
#else
    STAGE(G_SB(0, 0), cur.B, cvB); STAGE(G_SA(0, 0), cur.A, cvA); STAGE(G_SB(0, 1), cur.B + hB, cvB); STAGE(G_SA(0, 1), cur.A + hA, cvA);
    if (wr == 1) BAR;
    WAIT_V(4); BAR;
#endif
    STAGE(G_SB(1, 0), cur.B + 128, cvB); STAGE(G_SA(1, 0), cur.A + 128, cvA); STAGE(G_SB(1, 1), cur.B + hB + 128, cvB);
    WAIT_V(6); BAR; }
  f32x4 acc[2][2][4][2];
  bf16x8 At[4][2], B0[2][2], B1[2][2];
  for (int idx = 0;; ++idx) {
    const bool has_next = get(idx + 1, nxt);
    if (!has_next) nxt = cur;
    nvA[0] = R0 * nxt.lda2 + C0 * 2; nvA[1] = R1 * nxt.lda2 + C1 * 2; nvB[0] = R0 * nxt.ldb2 + C0 * 2; nvB[1] = R1 * nxt.ldb2 + C1 * 2;
    if (idx > 0) { if (wr == 1) BAR; }
#pragma unroll
    for (int a = 0; a < 2; ++a)
#pragma unroll
      for (int b = 0; b < 2; ++b)
#pragma unroll
        for (int m = 0; m < 4; ++m)
#pragma unroll
          for (int n = 0; n < 2; ++n) acc[a][b][m][n] = (f32x4){0.f, 0.f, 0.f, 0.f};
    const size_t hA = (size_t)HALF * cur.lda2, hB = (size_t)HALF * cur.ldb2, nhA = (size_t)HALF * nxt.lda2, nhB = (size_t)HALF * nxt.ldb2;
    const int nt = cur.nt;
    for (int t = 0; t < nt; t += 2) {
      const bool last = (t == nt - 2);
      const char* a1 = cur.A + (size_t)(t + 1) * 128;
      const char* a2 = last ? nxt.A : cur.A + (size_t)(t + 2) * 128; const char* b2 = last ? nxt.B : cur.B + (size_t)(t + 2) * 128;
      const char* a3 = a2 + 128; const char* b3 = b2 + 128;
      const size_t hA2 = last ? nhA : hA, hB2 = last ? nhB : hB;
      unsigned vA2[2], vB2[2]; vA2[0] = last ? nvA[0] : cvA[0]; vA2[1] = last ? nvA[1] : cvA[1]; vB2[0] = last ? nvB[0] : cvB[0]; vB2[1] = last ? nvB[1] : cvB[1];
#if GEMM_SP2
      LDB(B0, 0, 0); LDB(B1, 0, 1); SCHED; LDA(At, 0, 0); STAGE(G_SA(1, 1), a1 + hA, cvA);
      WAIT_V(8); WAIT_L(0); BAR; MMA(0, 0, At, B0); MMA(0, 1, At, B1); BAR; SCHED;
      LDA(At, 0, 1); STAGE(G_SB(0, 0), b2, vB2); STAGE(G_SB(0, 1), b2 + hB2, vB2); STAGE(G_SA(0, 0), a2, vA2);
      WAIT_V(8); WAIT_L(0); BAR; MMA(1, 0, At, B0); MMA(1, 1, At, B1); BAR; SCHED;
      LDB(B0, 1, 0); LDB(B1, 1, 1); SCHED; LDA(At, 1, 0); STAGE(G_SA(0, 1), a2 + hA2, vA2);
      WAIT_V(8); WAIT_L(0); BAR; MMA(0, 0, At, B0); MMA(0, 1, At, B1); BAR; SCHED;
      LDA(At, 1, 1); STAGE(G_SB(1, 0), b3, vB2); STAGE(G_SB(1, 1), b3 + hB2, vB2); STAGE(G_SA(1, 0), a3, vA2);
      WAIT_V(8); WAIT_L(0); BAR; MMA(1, 0, At, B0); MMA(1, 1, At, B1); BAR; SCHED;
#else
      LDB(B0, 0, 0); SCHED; LDA(At, 0, 0); STAGE(G_SA(1, 1), a1 + hA, cvA);
      WAIT_L(8); BAR; WAIT_L(0); MMA(0, 0, At, B0); BAR; SCHED;
      LDB(B1, 0, 1); STAGE(G_SB(0, 0), b2, vB2);
      BAR; WAIT_L(0); MMA(0, 1, At, B1); BAR;
      LDA(At, 0, 1); STAGE(G_SA(0, 0), a2, vA2);
      BAR; WAIT_L(0); MMA(1, 0, At, B0); BAR; SCHED;
      STAGE(G_SB(0, 1), b2 + hB2, vB2);
      WAIT_V(6); BAR; MMA(1, 1, At, B1); BAR;
      LDB(B0, 1, 0); SCHED; LDA(At, 1, 0); STAGE(G_SA(0, 1), a2 + hA2, vA2);
      WAIT_L(8); BAR; WAIT_L(0); MMA(0, 0, At, B0); BAR; SCHED;
      LDB(B1, 1, 1); STAGE(G_SB(1, 0), b3, vB2);
      BAR; WAIT_L(0); MMA(0, 1, At, B1); BAR;
      LDA(At, 1, 1); STAGE(G_SA(1, 0), a3, vA2);
      BAR; WAIT_L(0); MMA(1, 0, At, B0); BAR; SCHED;
      STAGE(G_SB(1, 1), b3 + hB2, vB2);
      WAIT_V(6); BAR; MMA(1, 1, At, B1); BAR;
#endif
    }
    if (wr == 0) BAR;
    epi(idx, acc);
    if (!has_next) break;
    cur = nxt; cvA[0] = nvA[0]; cvA[1] = nvA[1]; cvB[0] = nvB[0]; cvB[1] = nvB[1];
  }
  WAIT_V(0); BAR;
#undef G_SA
#undef G_SB
#undef STAGE
#undef LDA
#undef LDB
#undef MMA
}

__device__ __forceinline__ void unit_decode(int U, int NPN, int SBN, int& pm, int& pn) {
  const int per = 8 * SBN, blk = U / per, within = U % per, npng = NPN / SBN;
  const int pmg = blk / npng, png = blk % npng;
  pm = pmg * 8 + (within & 7); pn = png * SBN + (within >> 3);
}
struct TI { int b, bb, arow0; };
__device__ __forceinline__ TI tile_info(int pm) { TI t; if (pm < 256) { t.b = pm >> 5; t.bb = t.b; t.arow0 = (pm & 31) * 256; } else { t.b = pm - 256; t.bb = 8; t.arow0 = 8192; } return t; }

#define LANE_IDS const int tid = launder_tid(), wid = __builtin_amdgcn_readfirstlane(tid >> 6), lane = tid & 63, wr = wid >> 2, wc = wid & 3, fr = lane & 15, fq = lane >> 4; (void)tid; (void)wr; (void)wc; (void)fr; (void)fq; (void)lane; (void)wid;

enum { CM_PLAIN = 0, CM_UP, CM_WIN, CM_QB, CM_KVB };
__device__ __forceinline__ int colmap(int kind, int n, int base, int& which) {
  which = 0;
  switch (kind) {
    case CM_PLAIN: return base + n;
    case CM_UP: { const int tile = n >> 8, c = n & 255, ai = c >> 7, wrr = (c >> 6) & 1, m = (c >> 4) & 3, q = c & 15; which = m & 1; return tile * 128 + ai * 64 + wrr * 32 + (m >> 1) * 16 + q; }
    case CM_WIN: {
      if (n < 384) return n;
      if (n < 416) { const int cc = n - 384, part = (cc >> 4) & 1, half = (cc >> 3) & 1, idx = cc & 7; return 640 + half * 16 + part * 8 + idx; }
      if (n < 512) return -1;
      if (n < 768) return 384 + (n - 512);
      return 672 + (n - 768);
    }
    case CM_QB: {
      if (n < 512) return (n >> 6) * 96 + (n & 63);
      const int c = n - 512, h = c >> 5, cc = c & 31, part = (cc >> 4) & 1, half = (cc >> 3) & 1, idx = cc & 7; return h * 96 + 64 + half * 16 + part * 8 + idx;
    }
    case CM_KVB: {
      if (n < 512) return (n >> 6) * 128 + (n & 63);
      const int c = n - 512; return (c >> 6) * 128 + 64 + (c & 63);
    }
  }
  return -1;
}
__device__ __forceinline__ void conv_load(float (&v)[8], int kind, const float* src0, const float* src1, int ld, int base, const float* scale, int n0, int k0) {
  const int tid = launder_tid(); const int nn = tid & 63, kk = tid >> 6; int which; const int col = colmap(kind, n0 + nn, base, which); const float* s = which ? src1 : src0;
#pragma unroll
  for (int i = 0; i < 8; ++i) { const int k = kk + 8 * i; float x = 0.f; if (col >= 0) { x = s[(long)(k0 + k) * ld + col]; if (scale) x *= scale[k0 + k]; } v[i] = x; }
}
__device__ __forceinline__ void conv_store(const float (&vin)[8], bf16_t* dst, int K, int n0, int k0) {
  float* tl = (float*)g_lds;
  const int tid = launder_tid();
  { const int nn = tid & 63, kk = tid >> 6;
#pragma unroll
    for (int i = 0; i < 8; ++i) tl[(kk + 8 * i) * 65 + nn] = vin[i]; }
  __syncthreads();
  { const int nr = tid >> 3, kc = (tid & 7) * 8; float v[8];
#pragma unroll
    for (int e = 0; e < 8; ++e) v[e] = tl[(kc + e) * 65 + nr];
    u32x4 w; w.x = cvtpk(v[0], v[1]); w.y = cvtpk(v[2], v[3]); w.z = cvtpk(v[4], v[5]); w.w = cvtpk(v[6], v[7]);
    *(u32x4*)(dst + (long)(n0 + nr) * K + k0 + kc) = w; }
  __syncthreads();
}
struct ConvJob { int kind; size_t dst; int N, K; const float* s0; const float* s1; int ld, base; const float* scale; };
__device__ __forceinline__ ConvJob conv_job(const Params& p, int l, int grp, int j) {
  ConvJob J; J.s1 = nullptr; J.scale = nullptr; J.base = 0;
  if (grp != 1) {
    const float* w1 = p.in[grp == 0 ? 7 : 10] + (size_t)l * DM * DFF; const float* w3 = p.in[grp == 0 ? 8 : 11] + (size_t)l * DM * DFF; const float* w2 = p.in[grp == 0 ? 9 : 12] + (size_t)l * DFF * DM;
    if (j == 0) { J.kind = CM_UP; J.dst = O_WUP; J.N = 5632; J.K = 1024; J.s0 = w1; J.s1 = w3; J.ld = DFF; }
    else { J.kind = CM_PLAIN; J.dst = O_WDN; J.N = 1024; J.K = 2816; J.s0 = w2; J.s1 = w2; J.ld = DM; }
  } else {
    const float* win = p.in[13] + (size_t)l * DM * PROJ; const float* wb = p.in[22] + (size_t)l * 3 * 512 * 1024;
    switch (j) {
      case 0: J.kind = CM_WIN; J.dst = O_WIN; J.N = 3840; J.K = 1024; J.s0 = win; J.ld = PROJ; break;
      case 1: J.kind = CM_PLAIN; J.dst = O_WG; J.N = 3072; J.K = 1024; J.s0 = win; J.ld = PROJ; J.base = 3744; break;
      case 2: J.kind = CM_QB; J.dst = O_WQB; J.N = 768; J.K = 384; J.s0 = p.in[15] + (size_t)l * 384 * 768; J.ld = 768; J.scale = p.in[14] + l * 384; break;
      case 3: J.kind = CM_KVB; J.dst = O_WKVB; J.N = 1024; J.K = 256; J.s0 = p.in[17] + (size_t)l * 256 * 1024; J.ld = 1024; J.scale = p.in[16] + l * 256; break;
      case 4: J.kind = CM_PLAIN; J.dst = O_WBR; J.N = 3072; J.K = 512; J.s0 = wb; J.ld = 1024; break;
      default: J.kind = CM_PLAIN; J.dst = O_WOUT; J.N = 1024; J.K = 1024; J.s0 = p.in[23] + (size_t)l * DM * DM; J.ld = DM; break;
    }
    J.s1 = J.s0;
  }
  return J;
}
struct ConvTile { int kind; bf16_t* dst; int K; const float* s0; const float* s1; int ld, base; const float* scale; int n0, k0; };
__device__ __forceinline__ ConvTile conv_decode(const Params& p, int l, int grp, int u, int jlo) {
  int v = u, j = jlo; ConvJob J = conv_job(p, l, grp, jlo);
  for (;;) { const int c = (J.N / 64) * (J.K / 64); if (v < c) break; v -= c; ++j; J = conv_job(p, l, grp, j); }
  const int nk = J.K / 64; const int nt_ = v / nk, kt_ = v % nk;
  ConvTile t; t.kind = J.kind; t.K = J.K; t.s0 = J.s0; t.s1 = J.s1; t.ld = J.ld; t.base = J.base; t.scale = J.scale; t.n0 = nt_ * 64; t.k0 = kt_ * 64; t.dst = (bf16_t*)(p.ws + J.dst);
  if (grp == 1 && j == 4) { const int i = t.n0 >> 10; t.s0 += (size_t)i * 512 * 1024; t.dst += (size_t)i * 1024 * 512; t.n0 &= 1023; }
  return t;
}
__device__ __forceinline__ void conv_group(const Params& p, int l, int grp, int jlo, int jhi, int rank, int nranks) {
  int tot = 0; for (int j = jlo; j < jhi; ++j) { const ConvJob J = conv_job(p, l, grp, j); tot += (J.N / 64) * (J.K / 64); }
  int u = rank; if (u >= tot) return;
  ConvTile t = conv_decode(p, l, grp, u, jlo); float v[8];
  conv_load(v, t.kind, t.s0, t.s1, t.ld, t.base, t.scale, t.n0, t.k0);
  for (;;) {
    const int un = u + nranks; const bool more = un < tot; ConvTile tn = t; float vn[8];
    if (more) { tn = conv_decode(p, l, grp, un, jlo); conv_load(vn, tn.kind, tn.s0, tn.s1, tn.ld, tn.base, tn.scale, tn.n0, tn.k0); }
    conv_store(v, t.dst, t.K, t.n0, t.k0);
    if (!more) break;
    u = un; t = tn;
#pragma unroll
    for (int i = 0; i < 8; ++i) v[i] = vn[i];
  }
}

__device__ __forceinline__ bool conv_is_suffix(int tot_units) { return (tot_units % (int)gridDim.x) != 0; }
__device__ __forceinline__ void conv_prefix(const Params& p, int l, int grp, int jlo, int jhi, int tot_units) {
  if (!conv_is_suffix(tot_units)) { conv_group(p, l, grp, jlo, jhi, blockIdx.x, gridDim.x); __syncthreads(); } }
__device__ __forceinline__ void conv_suffix(const Params& p, int l, int grp, int jlo, int jhi, int tot_units) {
  if (conv_is_suffix(tot_units)) { const int rem = tot_units % (int)gridDim.x, q = logical_wg(); if (q >= rem) { __syncthreads(); conv_group(p, l, grp, jlo, jhi, q - rem, (int)gridDim.x - rem); } } }
__device__ __forceinline__ void phase_p0(const Params& p) {
  const int tid = launder_tid();
  float* sl = (float*)g_lds;
  float* red = sl + 9 * 1024;
  for (int i = tid; i < 9 * 1024; i += 512) { const int bb = i >> 10, k = i & 1023; const float v = bb < 8 ? p.in[1][bb * 1024 + k] : p.in[3][k]; sl[i] = v / (1.f + expf(-v)); }
  __syncthreads();
  float* modp = (float*)(p.ws + O_MOD);
  for (int u = blockIdx.x; u < 144; u += gridDim.x) {
    const int l = u / 72, c0 = (u % 72) * 128, cp = tid & 63, ks = tid >> 6;
    const float* w = p.in[4] + (size_t)l * 1024 * 9216 + c0 + 2 * cp;
    float a0[9], a1[9];
#pragma unroll
    for (int bb = 0; bb < 9; ++bb) { a0[bb] = 0.f; a1[bb] = 0.f; }
#pragma unroll 8
    for (int k = ks * 128; k < ks * 128 + 128; ++k) { const f32v2_t wv = *(const f32v2_t*)(w + (size_t)k * 9216);
#pragma unroll
      for (int bb = 0; bb < 9; ++bb) { const float sv = sl[bb * 1024 + k]; a0[bb] += sv * wv[0]; a1[bb] += sv * wv[1]; } }
#pragma unroll
    for (int bb = 0; bb < 9; ++bb) { red[(ks * 9 + bb) * 128 + 2 * cp] = a0[bb]; red[(ks * 9 + bb) * 128 + 2 * cp + 1] = a1[bb]; }
    __syncthreads();
    for (int i = tid; i < 9 * 128; i += 512) { const int bb = i >> 7, cc = i & 127; float sacc = 0.f;
#pragma unroll
      for (int k8 = 0; k8 < 8; ++k8) sacc += red[(k8 * 9 + bb) * 128 + cc];
      modp[((size_t)l * 9 + bb) * 9216 + c0 + cc] = sacc + p.in[5][l * 9216 + c0 + cc]; }
    __syncthreads();
  }
  const long gt = (long)blockIdx.x * 512 + tid, gs = (long)gridDim.x * 512;
  for (long i = gt; i < (long)6 * 264 * 1024; i += gs) ((float*)(p.ws + O_PART))[i] = -1.f;
  float* r1c = (float*)(p.ws + O_R1C); float* r1s = (float*)(p.ws + O_R1S);
  for (long i = gt; i < 8192 * 32; i += gs) { const int pos = (int)(i >> 5), f = (int)(i & 31); const float inv = (float)pow(10000.0, -(double)(2 * f) / 64.0); const float ang = (float)pos * inv; r1c[i] = (float)cos((double)ang); r1s[i] = (float)sin((double)ang); }
  float* rdc = (float*)(p.ws + O_RDC); float* rds = (float*)(p.ws + O_RDS);
  for (long i = gt; i < 128 * 16; i += gs) { const int pos = (int)(i >> 4), f = (int)(i & 15); const float inv = (float)pow(10000.0, -(double)(2 * f) / 32.0); const float ang = (float)pos * inv; rdc[i] = (float)cos((double)ang); rds[i] = (float)sin((double)ang); }
  float* rmc = (float*)(p.ws + O_RMC); float* rms = (float*)(p.ws + O_RMS);
  for (long i = gt; i < 128 * 8; i += gs) { const int pos = (int)(i >> 3), f = (int)(i & 7); const float inv = (float)pow(10000.0, -(double)(2 * f) / 16.0); const float ang = (float)pos * inv; rmc[i] = (float)cos((double)ang); rms[i] = (float)sin((double)ang); }
  if (blockIdx.x == 0 && tid == 200) { ((float*)(p.ws + O_LAM))[16] = 0.f; ((float*)(p.ws + O_LAM))[17] = 0.f; }
  if (blockIdx.x == 0 && tid < 128) {
    const int l = tid >> 6, ln = tid & 63; const float* dl = p.in[18] + l * 256;
    float s1 = dl[ln] * dl[64 + ln], s2 = dl[128 + ln] * dl[192 + ln];
#pragma unroll
    for (int o = 32; o > 0; o >>= 1) { s1 += __shfl_xor(s1, o); s2 += __shfl_xor(s2, o); }
    const float li = 0.8f - 0.6f * expf(-0.3f * (float)l);
    if (ln == 0) ((float*)(p.ws + O_LAM))[l] = expf(s1) - expf(s2) + li;
  }
}

__device__ __forceinline__ const float* xsrc_row(const Params& p, long row, bool from_input) {
  if (row < TL) return (from_input ? p.in[0] : p.out) + row * DM;
  return (from_input ? p.in[2] : (const float*)(p.ws + O_XC)) + (row - TL) * DM;
}
__device__ __forceinline__ float* xdst_row(const Params& p, long row) { return row < TL ? p.out + row * DM : (float*)(p.ws + O_XC) + (row - TL) * DM; }

__device__ __forceinline__ void phase_norm(const Params& p, int l, int which, bool from_input) {
  const int tid = launder_tid(), wid = tid >> 6, lane = tid & 63;
  bf16_t* H = (bf16_t*)(p.ws + O_H);
  const float* gain = p.in[6] + (l * 3 + which) * DM;
  const long nwaves = (long)gridDim.x * 8, w0 = (long)blockIdx.x * 8 + wid;
  for (long rb = w0; rb < T; rb += nwaves * 4) {
    f32x4 v[4][4]; float ss[4];
#pragma unroll
    for (int j = 0; j < 4; ++j) { const long row = rb + j * nwaves; ss[j] = 0.f;
      if (row < T) { const float* src = xsrc_row(p, row, from_input);
#pragma unroll
        for (int i = 0; i < 4; ++i) v[j][i] = *(const f32x4*)(src + (lane + 64 * i) * 4); } }
#pragma unroll
    for (int j = 0; j < 4; ++j) { const long row = rb + j * nwaves;
      if (row < T) {
#pragma unroll
        for (int i = 0; i < 4; ++i) ss[j] += v[j][i][0] * v[j][i][0] + v[j][i][1] * v[j][i][1] + v[j][i][2] * v[j][i][2] + v[j][i][3] * v[j][i][3];
#pragma unroll
        for (int o = 32; o > 0; o >>= 1) ss[j] += __shfl_xor(ss[j], o);
        const float rstd = rsqrtf(ss[j] * (1.f / 1024.f) + EPS);
        const int bb = row < TL ? (int)(row >> 13) : 8;
        const float* md = (const float*)(p.ws + O_MOD) + ((size_t)l * 9 + bb) * 9216;
#pragma unroll
        for (int i = 0; i < 4; ++i) { const int c = (lane + 64 * i) * 4;
          const f32x4 g = *(const f32x4*)(gain + c), sh = *(const f32x4*)(md + which * 3 * 1024 + c), sc = *(const f32x4*)(md + (which * 3 + 1) * 1024 + c);
          f32x4 o;
#pragma unroll
          for (int e = 0; e < 4; ++e) o[e] = v[j][i][e] * rstd * g[e] * (1.f + sc[e]) + sh[e];
          store4bf(H + row * DM + c, o); } } }
  }
}
__device__ __forceinline__ void phase_final(const Params& p) {
  const int tid = launder_tid(), wid = tid >> 6, lane = tid & 63;
  const float* gain = p.in[24];
  const long nwaves = (long)gridDim.x * 8, w0 = (long)blockIdx.x * 8 + wid;
  for (long rb = w0; rb < TL; rb += nwaves * 4) {
    f32x4 v[4][4];
#pragma unroll
    for (int j = 0; j < 4; ++j) { const long row = rb + j * nwaves;
      if (row < TL) { const float* src = p.out + row * DM;
#pragma unroll
        for (int i = 0; i < 4; ++i) v[j][i] = *(const f32x4*)(src + (lane + 64 * i) * 4); } }
#pragma unroll
    for (int j = 0; j < 4; ++j) { const long row = rb + j * nwaves;
      if (row < TL) { float ss = 0.f; float* dst = p.out + row * DM;
#pragma unroll
        for (int i = 0; i < 4; ++i) ss += v[j][i][0] * v[j][i][0] + v[j][i][1] * v[j][i][1] + v[j][i][2] * v[j][i][2] + v[j][i][3] * v[j][i][3];
#pragma unroll
        for (int o = 32; o > 0; o >>= 1) ss += __shfl_xor(ss, o);
        const float rstd = rsqrtf(ss * (1.f / 1024.f) + EPS);
#pragma unroll
        for (int i = 0; i < 4; ++i) { const int c = (lane + 64 * i) * 4; const f32x4 g = *(const f32x4*)(gain + c); f32x4 o;
#pragma unroll
          for (int e = 0; e < 4; ++e) o[e] = v[j][i][e] * rstd * g[e];
          *(f32x4*)(dst + c) = o; } } }
  }
}

__device__ __forceinline__ void phase_ffn_up(const Params& p, int npm) {
  const char* W = (const char*)(p.ws + O_WUP); const char* H = (const char*)(p.ws + O_H); bf16_t* G = (bf16_t*)(p.ws + O_G);
  const int q = logical_wg(), Gd = gridDim.x, tot = npm * 22;
  auto get = [&](int idx, GOp& o) __attribute__((always_inline)) -> bool { const int U = q + idx * Gd; if (U >= tot) return false; int pm, pn; unit_decode(U, 22, 2, pm, pn);
    o.A = W + (size_t)pn * 256 * 2048; o.B = H + (size_t)pm * 256 * 2048; o.lda2 = 2048; o.ldb2 = 2048; o.nt = 16; return true; };
  auto epi = [&](int idx, const f32x4 (&acc)[2][2][4][2]) __attribute__((always_inline)) {
    const int U = q + idx * Gd; int pm, pn; unit_decode(U, 22, 2, pm, pn);
    LANE_IDS
#pragma unroll
    for (int ai = 0; ai < 2; ++ai)
#pragma unroll
      for (int bj = 0; bj < 2; ++bj)
#pragma unroll
        for (int n = 0; n < 2; ++n)
#pragma unroll
          for (int mp = 0; mp < 2; ++mp) {
            const long tok = (long)pm * 256 + bj * 128 + wc * 32 + n * 16 + fr; const int gc = pn * 128 + ai * 64 + wr * 32 + mp * 16 + fq * 4;
            const f32x4 a = acc[ai][bj][2 * mp][n], b = acc[ai][bj][2 * mp + 1][n]; f32x4 o;
#pragma unroll
            for (int e = 0; e < 4; ++e) o[e] = silu_f(a[e]) * b[e];
            store4bf(G + tok * DFF + gc, o);
          }
  };
  gemm_stream(get, epi);
}
__device__ __forceinline__ void epi_res(const Params& p, const f32x4 (&acc)[2][2][4][2], int l, int pm, int pn, int gate_idx, float scale, bool from_input) {
  LANE_IDS
  const TI ti = tile_info(pm);
  const float* md = (const float*)(p.ws + O_MOD) + ((size_t)l * 9 + ti.bb) * 9216 + gate_idx * 1024;
#pragma unroll
  for (int bj = 0; bj < 2; ++bj)
#pragma unroll
    for (int n = 0; n < 2; ++n) {
      const long row = (long)pm * 256 + bj * 128 + wc * 32 + n * 16 + fr;
      const float* src = xsrc_row(p, row, from_input); float* dst = xdst_row(p, row);
#pragma unroll
      for (int ai = 0; ai < 2; ++ai)
#pragma unroll
        for (int m = 0; m < 4; ++m) {
          const int col = pn * 256 + ai * 128 + wr * 64 + m * 16 + fq * 4;
          const f32x4 xv = *(const f32x4*)(src + col), g = *(const f32x4*)(md + col); f32x4 o;
#pragma unroll
          for (int e = 0; e < 4; ++e) o[e] = xv[e] + g[e] * scale * acc[ai][bj][m][n][e];
          *(f32x4*)(dst + col) = o;
          if (m & 1) MEMFENCE();
        }
    }
}
struct NormFuse { int nl, which, pslot, cslot; bool fin; };
__device__ __forceinline__ void epi_res_norm(const Params& p, f32x4 (&acc)[2][2][4][2], int l, int pm, int pn, int gate_idx, float scale, bool from_input, const NormFuse nf) {
  LANE_IDS
  const TI ti = tile_info(pm);
  const float* md = (const float*)(p.ws + O_MOD) + ((size_t)l * 9 + ti.bb) * 9216 + gate_idx * 1024;
  float ssr[2][2];
#pragma unroll
  for (int bj = 0; bj < 2; ++bj)
#pragma unroll
    for (int n = 0; n < 2; ++n) {
      const long row = (long)pm * 256 + bj * 128 + wc * 32 + n * 16 + fr;
      const float* src = xsrc_row(p, row, from_input); float* dst = xdst_row(p, row); float ss = 0.f;
#pragma unroll
      for (int ai = 0; ai < 2; ++ai)
#pragma unroll
        for (int m = 0; m < 4; ++m) {
          const int col = pn * 256 + ai * 128 + wr * 64 + m * 16 + fq * 4;
          const f32x4 xv = *(const f32x4*)(src + col), g = *(const f32x4*)(md + col); f32x4 o;
#pragma unroll
          for (int e = 0; e < 4; ++e) { o[e] = xv[e] + g[e] * scale * acc[ai][bj][m][n][e]; ss += o[e] * o[e]; }
          if (!nf.fin) *(f32x4*)(dst + col) = o;
          acc[ai][bj][m][n] = o;
          if (m & 1) MEMFENCE();
        }
      ss += __shfl_xor(ss, 16); ss += __shfl_xor(ss, 32); ssr[bj][n] = ss;
    }
  float* ssl = (float*)(g_lds + 131072);
  __syncthreads();
  if (fq == 0) {
#pragma unroll
    for (int bj = 0; bj < 2; ++bj)
#pragma unroll
      for (int n = 0; n < 2; ++n) ssl[wr * 256 + bj * 128 + wc * 32 + n * 16 + fr] = ssr[bj][n]; }
  __syncthreads();
  unsigned* part = (unsigned*)(p.ws + O_PART) + ((size_t)nf.pslot * 264 + pm) * 1024;
  if (tid < 256) {
    __hip_atomic_store(part + pn * 256 + tid, __float_as_uint(ssl[tid] + ssl[256 + tid]), __ATOMIC_RELAXED, __HIP_MEMORY_SCOPE_AGENT);
    float t = 0.f; int spins = 0;
    for (;;) { float v0 = __uint_as_float(__hip_atomic_load(part + tid, __ATOMIC_RELAXED, __HIP_MEMORY_SCOPE_AGENT)), v1 = __uint_as_float(__hip_atomic_load(part + 256 + tid, __ATOMIC_RELAXED, __HIP_MEMORY_SCOPE_AGENT)),
        v2 = __uint_as_float(__hip_atomic_load(part + 512 + tid, __ATOMIC_RELAXED, __HIP_MEMORY_SCOPE_AGENT)), v3 = __uint_as_float(__hip_atomic_load(part + 768 + tid, __ATOMIC_RELAXED, __HIP_MEMORY_SCOPE_AGENT));
      t = v0 + v1 + v2 + v3;
      if ((v0 >= 0.f && v1 >= 0.f && v2 >= 0.f && v3 >= 0.f) || ++spins > (1 << 18)) break;
      __builtin_amdgcn_s_sleep(4); }
    ssl[512 + tid] = rsqrtf(t * (1.f / 1024.f) + EPS); }
  __syncthreads();
  const float* gain = nf.fin ? p.in[24] : p.in[6] + (nf.nl * 3 + nf.which) * DM;
  const float* mdn = (const float*)(p.ws + O_MOD) + ((size_t)nf.nl * 9 + ti.bb) * 9216;
  bf16_t* H = (bf16_t*)(p.ws + O_H);
#pragma unroll
  for (int bj = 0; bj < 2; ++bj)
#pragma unroll
    for (int n = 0; n < 2; ++n) {
      const int tl = bj * 128 + wc * 32 + n * 16 + fr; const long row = (long)pm * 256 + tl; const float r = ssl[512 + tl];
#pragma unroll
      for (int ai = 0; ai < 2; ++ai)
#pragma unroll
        for (int m = 0; m < 4; ++m) {
          const int col = pn * 256 + ai * 128 + wr * 64 + m * 16 + fq * 4; const f32x4 o = acc[ai][bj][m][n], g = *(const f32x4*)(gain + col); f32x4 h;
          if (nf.fin) {
#pragma unroll
            for (int e = 0; e < 4; ++e) h[e] = o[e] * r * g[e];
            *(f32x4*)(p.out + row * DM + col) = h;
          } else { const f32x4 sh = *(const f32x4*)(mdn + nf.which * 3 * 1024 + col), sc = *(const f32x4*)(mdn + (nf.which * 3 + 1) * 1024 + col);
#pragma unroll
            for (int e = 0; e < 4; ++e) h[e] = o[e] * r * g[e] * (1.f + sc[e]) + sh[e];
            store4bf(H + row * DM + col, h); }
          if (m & 1) MEMFENCE();
        }
    }
}
__device__ __forceinline__ void phase_ffn_down(const Params& p, int l, int gate_idx, bool from_input, int npm, const NormFuse nf) {
  const char* W = (const char*)(p.ws + O_WDN); const char* G = (const char*)(p.ws + O_G);
  const int q = logical_wg(), Gd = gridDim.x, tot = npm * 4;
  auto get = [&](int idx, GOp& o) __attribute__((always_inline)) -> bool { const int U = q + idx * Gd; if (U >= tot) return false; int pm, pn; unit_decode(U, 4, 4, pm, pn);
    o.A = W + (size_t)pn * 256 * (DFF * 2); o.B = G + (size_t)pm * 256 * (DFF * 2); o.lda2 = DFF * 2; o.ldb2 = DFF * 2; o.nt = DFF / 64; return true; };
  auto epi = [&](int idx, f32x4 (&acc)[2][2][4][2]) __attribute__((always_inline)) {
    const int U = q + idx * Gd; int pm, pn; unit_decode(U, 4, 4, pm, pn); epi_res_norm(p, acc, l, pm, pn, gate_idx, 0.5f, from_input, nf); };
  gemm_stream(get, epi);
}
__device__ __forceinline__ void phase_wout(const Params& p, int l, int npm, const NormFuse nf) {
  const char* W = (const char*)(p.ws + O_WOUT); const char* Y = (const char*)(p.ws + O_YBR);
  const int q = logical_wg(), Gd = gridDim.x, tot = npm * 4;
  auto get = [&](int idx, GOp& o) __attribute__((always_inline)) -> bool { const int U = q + idx * Gd; if (U >= tot) return false; int pm, pn; unit_decode(U, 4, 4, pm, pn);
    o.A = W + (size_t)pn * 256 * 2048; o.B = Y + (size_t)pm * 256 * 2048; o.lda2 = 2048; o.ldb2 = 2048; o.nt = 16; return true; };
  auto epi = [&](int idx, f32x4 (&acc)[2][2][4][2]) __attribute__((always_inline)) {
    const int U = q + idx * Gd; int pm, pn; unit_decode(U, 4, 4, pm, pn); epi_res_norm(p, acc, l, pm, pn, 5, 1.0f, false, nf); };
  gemm_stream(get, epi);
}

__device__ __forceinline__ void rope4(f32x4 x1, f32x4 x2, f32x4 c, f32x4 s, f32x4& o1, f32x4& o2) {
#pragma unroll
  for (int e = 0; e < 4; ++e) { o1[e] = x1[e] * c[e] - x2[e] * s[e]; o2[e] = x1[e] * s[e] + x2[e] * c[e]; }
}
__device__ __forceinline__ void phase_win(const Params& p) {
  const char* W = (const char*)(p.ws + O_WIN); const char* H = (const char*)(p.ws + O_H);
  bf16_t* QLAT = (bf16_t*)(p.ws + O_QLAT); bf16_t* KVLAT = (bf16_t*)(p.ws + O_KVLAT); bf16_t* KROPE = (bf16_t*)(p.ws + O_KROPE);
  bf16_t* QD = (bf16_t*)(p.ws + O_QD); bf16_t* KD = (bf16_t*)(p.ws + O_KD); bf16_t* VD = (bf16_t*)(p.ws + O_VD);
  bf16_t* RQ = (bf16_t*)(p.ws + O_RQ); bf16_t* RK = (bf16_t*)(p.ws + O_RK); bf16_t* RV = (bf16_t*)(p.ws + O_RV); bf16_t* YRET = (bf16_t*)(p.ws + O_YRET);
  const float* r1c = (const float*)(p.ws + O_R1C); const float* r1s = (const float*)(p.ws + O_R1S);
  const float* rdc = (const float*)(p.ws + O_RDC); const float* rds = (const float*)(p.ws + O_RDS);
  const float* rmc = (const float*)(p.ws + O_RMC); const float* rms = (const float*)(p.ws + O_RMS);
  const int q = logical_wg(), Gd = gridDim.x;
  auto get = [&](int idx, GOp& o) __attribute__((always_inline)) -> bool { const int U = q + idx * Gd; if (U >= NPM * 15) return false; int pm, pn; unit_decode(U, 15, 3, pm, pn);
    o.A = W + (size_t)pn * 256 * 2048; o.B = H + (size_t)pm * 256 * 2048; o.lda2 = 2048; o.ldb2 = 2048; o.nt = 16; return true; };
  auto epi = [&](int idx, const f32x4 (&acc)[2][2][4][2]) __attribute__((always_inline)) {
    const int U = q + idx * Gd; int pm, pn; unit_decode(U, 15, 3, pm, pn);
    LANE_IDS
    const TI ti = tile_info(pm); const bool lat = ti.bb < 8;
#pragma unroll
    for (int bj = 0; bj < 2; ++bj)
#pragma unroll
      for (int n = 0; n < 2; ++n) {
        const int tl = bj * 128 + wc * 32 + n * 16 + fr; const long tok = (long)pm * 256 + tl; const int ar = ti.arow0 + tl;
        const int prow = ar >> 6, pcol = ar & 63;
        if (pn == 0 || pn == 2 || pn == 13 || pn == 14) {
#pragma unroll
          for (int ai = 0; ai < 2; ++ai)
#pragma unroll
            for (int m = 0; m < 4; ++m) { const int c = ai * 128 + wr * 64 + m * 16 + fq * 4; const f32x4 v = acc[ai][bj][m][n];
              if (pn == 0) store4bf(QLAT + tok * 384 + c, v);
              else if (pn == 2) store4bf(KVLAT + tok * 256 + c, v);
              else { f32x4 o;
#pragma unroll
                for (int e = 0; e < 4; ++e) o[e] = silu_f(v[e]);
                store4bf(YRET + tok * 512 + (pn - 13) * 256 + c, o); } }
        } else if (pn == 1) {
#pragma unroll
          for (int m = 0; m < 4; ++m) store4bf(QLAT + tok * 384 + 256 + wr * 64 + m * 16 + fq * 4, acc[0][bj][m][n]);
          if (wr == 0) {
            const int half = fq >> 1, idx = (fq & 1) * 4; f32x4 o1 = acc[1][bj][0][n], o2 = acc[1][bj][1][n];
            if (lat) { const int pos = half ? pcol : prow; const f32x4 c = *(const f32x4*)(rmc + pos * 8 + idx), s = *(const f32x4*)(rms + pos * 8 + idx); rope4(acc[1][bj][0][n], acc[1][bj][1][n], c, s, o1, o2); }
            bf16_t* d = KROPE + ((long)ti.b * SK + ar) * 32 + half * 16 + idx; store4bf(d, o1); store4bf(d + 8, o2);
          }
        } else if (pn >= 3 && pn <= 6) {
          bf16_t* D = (pn < 5) ? QD : KD; const int hb = ((pn - 3) & 1) * 2;
#pragma unroll
          for (int ai = 0; ai < 2; ++ai) {
            bf16_t* d = D + (((long)ti.b * 8 + (hb + ai) * 2 + wr) * SK + ar) * 64 + fq * 4;
            f32x4 a0 = acc[ai][bj][0][n], a1 = acc[ai][bj][1][n], a2 = acc[ai][bj][2][n], a3 = acc[ai][bj][3][n];
            if (lat) { const f32x4 cr = *(const f32x4*)(rdc + prow * 16 + fq * 4), sr = *(const f32x4*)(rds + prow * 16 + fq * 4), cc = *(const f32x4*)(rdc + pcol * 16 + fq * 4), sc = *(const f32x4*)(rds + pcol * 16 + fq * 4);
              rope4(acc[ai][bj][0][n], acc[ai][bj][1][n], cr, sr, a0, a1); rope4(acc[ai][bj][2][n], acc[ai][bj][3][n], cc, sc, a2, a3); }
            const float qs = (pn < 5) ? CQ_DIFF : 1.f;
            store4bf(d, a0 * qs); store4bf(d + 16, a1 * qs); store4bf(d + 32, a2 * qs); store4bf(d + 48, a3 * qs);
          }
        } else if (pn == 7 || pn == 8 || pn == 11 || pn == 12) {
          bf16_t* D = (pn < 9) ? VD : RV; const int hb = (pn < 9 ? pn - 7 : pn - 11) * 2;
#pragma unroll
          for (int ai = 0; ai < 2; ++ai)
#pragma unroll
            for (int m = 0; m < 4; ++m) store4bf(D + (((long)ti.b * 4 + hb + ai) * SK + ar) * 128 + wr * 64 + m * 16 + fq * 4, acc[ai][bj][m][n]);
        } else {
          bf16_t* D = (pn == 9) ? RQ : RK; const float sc = (pn == 9) ? 1.f : 0.125f;
#pragma unroll
          for (int ai = 0; ai < 2; ++ai) {
            bf16_t* d = D + (((long)ti.b * 4 + ai * 2 + wr) * SK + ar) * 64 + fq * 4;
            f32x4 a0 = acc[ai][bj][0][n], a1 = acc[ai][bj][1][n], a2 = acc[ai][bj][2][n], a3 = acc[ai][bj][3][n];
            if (lat) { const f32x4 c0 = *(const f32x4*)(r1c + ar * 32 + fq * 4), s0 = *(const f32x4*)(r1s + ar * 32 + fq * 4), c1 = *(const f32x4*)(r1c + ar * 32 + 16 + fq * 4), s1 = *(const f32x4*)(r1s + ar * 32 + 16 + fq * 4);
              rope4(acc[ai][bj][0][n], acc[ai][bj][2][n], c0, s0, a0, a2); rope4(acc[ai][bj][1][n], acc[ai][bj][3][n], c1, s1, a1, a3); }
            store4bf(d, a0 * sc); store4bf(d + 16, a1 * sc); store4bf(d + 32, a2 * sc); store4bf(d + 48, a3 * sc);
          }
        }
      }
  };
  gemm_stream(get, epi);
}

__device__ __forceinline__ int crow(int r, int hi) { return (r & 3) + 8 * (r >> 2) + 4 * hi; }
__device__ __forceinline__ void ret_unit(const Params& p, int l, int u) {
  const int tid = launder_tid(), wid = tid >> 6, lane = tid & 63, r32 = lane & 31, hi = lane >> 5;
  const int b = u & 7, h = (u >> 3) & 3, dir = (u >> 5) & 1, s = u >> 6;
  constexpr int QS = 0, KS = 18432, KT = 36864, VT = 54272, VTS = 62976, SC = 71680, SBF = 106496, PW = 115712, IPW = PW + 528;
  unsigned char* L = g_lds; float* pw = (float*)(L + PW); float* ipw = (float*)(L + IPW);
  const float lg = -expf(p.in[20][l * 8 + dir * 4 + h]);
  __syncthreads();
  if (tid <= 128) { pw[tid] = expf(lg * (float)tid); if (tid < 128) ipw[tid] = expf(-lg * (float)tid); }
  for (int i = tid; i < 576; i += 512) *(u32x4*)(L + SBF + i * 16) = (u32x4){0u, 0u, 0u, 0u};
  const bf16_t* RQ = (const bf16_t*)(p.ws + O_RQ) + ((long)b * 4 + h) * SK * 64;
  const bf16_t* RK = (const bf16_t*)(p.ws + O_RK) + ((long)b * 4 + h) * SK * 64;
  const bf16_t* RV = (const bf16_t*)(p.ws + O_RV) + ((long)b * 4 + h) * SK * 128 + s * 32;
  bf16_t* RO = (bf16_t*)(p.ws + O_RETO) + (size_t)dir * T * 512 + h * 128 + s * 32;
  f32x16 sacc = {};
  u32x4 rq0, rq1, rk0, rk1, rv0 = {0u, 0u, 0u, 0u}, rv1 = {0u, 0u, 0u, 0u};
  const int qrow0 = tid >> 3, qcc = tid & 7, pi = tid & 63, kcc = tid >> 6, vcc = (tid >> 6) & 3; const bool vact = tid < 256;
  auto chunk_arow = [&](int n) -> int { if (n < 2) return 8192 + 128 * (dir ? 1 - n : n); return 128 * (dir ? 65 - n : n - 2); };
#define RLOAD(n) do { const int ar_ = chunk_arow(n); \
    rq0 = *(const u32x4*)(RQ + (long)(ar_ + qrow0) * 64 + qcc * 8); rq1 = *(const u32x4*)(RQ + (long)(ar_ + 64 + qrow0) * 64 + qcc * 8); \
    rk0 = *(const u32x4*)(RK + (long)(ar_ + 2 * pi) * 64 + kcc * 8); rk1 = *(const u32x4*)(RK + (long)(ar_ + 2 * pi + 1) * 64 + kcc * 8); \
    if (vact) { rv0 = *(const u32x4*)(RV + (long)(ar_ + 2 * pi) * 128 + vcc * 8); rv1 = *(const u32x4*)(RV + (long)(ar_ + 2 * pi + 1) * 128 + vcc * 8); } } while (0)
  RLOAD(0);
  int cur = 0;
  for (int n = 0; n < 66; ++n) {
    __syncthreads();
    *(u32x4*)(L + QS + qrow0 * 144 + qcc * 16) = rq0; *(u32x4*)(L + QS + (64 + qrow0) * 144 + qcc * 16) = rq1;
    *(u32x4*)(L + KS + (2 * pi) * 144 + kcc * 16) = rk0; *(u32x4*)(L + KS + (2 * pi + 1) * 144 + kcc * 16) = rk1;
#pragma unroll
    for (int e = 0; e < 4; ++e) {
      *(unsigned*)(L + KT + (kcc * 8 + 2 * e) * 272 + pi * 4) = (rk0[e] & 0xffffu) | (rk1[e] << 16);
      *(unsigned*)(L + KT + (kcc * 8 + 2 * e + 1) * 272 + pi * 4) = (rk0[e] >> 16) | (rk1[e] & 0xffff0000u); }
    if (vact) { const float kd0 = pw[dir ? 2 * pi : 127 - 2 * pi], kd1 = pw[dir ? 2 * pi + 1 : 126 - 2 * pi];
#pragma unroll
      for (int e = 0; e < 4; ++e) {
        *(unsigned*)(L + VT + (vcc * 8 + 2 * e) * 272 + pi * 4) = (rv0[e] & 0xffffu) | (rv1[e] << 16);
        *(unsigned*)(L + VT + (vcc * 8 + 2 * e + 1) * 272 + pi * 4) = (rv0[e] >> 16) | (rv1[e] & 0xffff0000u);
        *(unsigned*)(L + VTS + (vcc * 8 + 2 * e) * 272 + pi * 4) = cvtpk(__uint_as_float(rv0[e] << 16) * kd0, __uint_as_float(rv1[e] << 16) * kd1);
        *(unsigned*)(L + VTS + (vcc * 8 + 2 * e + 1) * 272 + pi * 4) = cvtpk(__uint_as_float(rv0[e] & 0xffff0000u) * kd0, __uint_as_float(rv1[e] & 0xffff0000u) * kd1); } }
    __syncthreads();
    if (n + 1 < 66) RLOAD(n + 1);
    { const int I = wid >> 1;
#pragma unroll
      for (int jj = 0; jj < 2; ++jj) { const int J = (wid & 1) * 2 + jj; f32x16 sc = {};
#pragma unroll
        for (int kk = 0; kk < 4; ++kk) { const bf16x8 ka = *(const bf16x8*)(L + KS + (32 * I + r32) * 144 + (kk * 16 + hi * 8) * 2), qb = *(const bf16x8*)(L + QS + (32 * J + r32) * 144 + (kk * 16 + hi * 8) * 2);
          sc = __builtin_amdgcn_mfma_f32_32x32x16_bf16(ka, qb, sc, 0, 0, 0); }
        const int a = 32 * J + r32; const float colf = dir ? ipw[a] : pw[a];
#pragma unroll
        for (int q4 = 0; q4 < 4; ++q4) { const int ap0 = 32 * I + 8 * q4 + 4 * hi; const f32x4 rowf = *(const f32x4*)((dir ? pw : ipw) + ap0); f32x4 o;
#pragma unroll
          for (int e = 0; e < 4; ++e) { const int dd = dir ? (ap0 + e) - a : a - (ap0 + e); const float m = dd >= 0 ? colf * rowf[e] : 0.f; o[e] = sc[q4 * 4 + e] * m; }
          store4bf((bf16_t*)(L + SC + a * 272 + ap0 * 2), o); } } }
    __syncthreads();
    if (wid < 4) {
      f32x16 a1 = {}, a2 = {};
#pragma unroll
      for (int kk = 0; kk < 8; ++kk) { const bf16x8 sa = *(const bf16x8*)(L + SC + (32 * wid + r32) * 272 + (kk * 16 + hi * 8) * 2), vb = *(const bf16x8*)(L + VT + r32 * 272 + (kk * 16 + hi * 8) * 2);
        a1 = __builtin_amdgcn_mfma_f32_32x32x16_bf16(sa, vb, a1, 0, 0, 0); }
#pragma unroll
      for (int kk = 0; kk < 4; ++kk) { const bf16x8 qa = *(const bf16x8*)(L + QS + (32 * wid + r32) * 144 + (kk * 16 + hi * 8) * 2), sb = *(const bf16x8*)(L + SBF + cur * 4608 + r32 * 144 + (kk * 16 + hi * 8) * 2);
        a2 = __builtin_amdgcn_mfma_f32_32x32x16_bf16(qa, sb, a2, 0, 0, 0); }
      const int ar = chunk_arow(n); const long tokbase = (ar >= 8192) ? (long)TL + b * 256 + (ar - 8192) : (long)b * 8192 + ar;
#pragma unroll
      for (int r = 0; r < 16; ++r) { const int a = 32 * wid + crow(r, hi); const float qd = pw[dir ? 128 - a : a + 1];
        const unsigned pk = cvtpk(a1[r] + qd * a2[r], 0.f); RO[(tokbase + a) * 512 + r32] = (unsigned short)(pk & 0xffff); }
    } else if (wid < 6) {
      const int db = wid - 4; const float cd = pw[128];
#pragma unroll
      for (int r = 0; r < 16; ++r) sacc[r] *= cd;
#pragma unroll
      for (int kk = 0; kk < 8; ++kk) { const bf16x8 ka = *(const bf16x8*)(L + KT + (32 * db + r32) * 272 + (kk * 16 + hi * 8) * 2), vb = *(const bf16x8*)(L + VTS + r32 * 272 + (kk * 16 + hi * 8) * 2);
        sacc = __builtin_amdgcn_mfma_f32_32x32x16_bf16(ka, vb, sacc, 0, 0, 0); }
#pragma unroll
      for (int q4 = 0; q4 < 4; ++q4) { f32x4 o = {sacc[q4 * 4], sacc[q4 * 4 + 1], sacc[q4 * 4 + 2], sacc[q4 * 4 + 3]};
        store4bf((bf16_t*)(L + SBF + (cur ^ 1) * 4608 + r32 * 144 + (32 * db + 8 * q4 + 4 * hi) * 2), o); }
    }
    cur ^= 1;
  }
  __syncthreads();
#undef RLOAD
}

__device__ __forceinline__ void row_rstd(const bf16_t* src, int Kd) {
  const int tid = launder_tid(), row = tid >> 1, hf = tid & 1; float* rs = (float*)(g_lds + 131072);
  const bf16_t* s = src + (long)row * Kd + hf * (Kd / 2); float ss = 0.f;
  for (int c = 0; c < Kd / 16; ++c) { const u32x4 w = *(const u32x4*)(s + c * 8);
#pragma unroll
    for (int e = 0; e < 4; ++e) { const float lo = __uint_as_float(w[e] << 16), hi_ = __uint_as_float(w[e] & 0xffff0000u); ss += lo * lo + hi_ * hi_; } }
  ss += __shfl_xor(ss, 1);
  if (hf == 0) rs[row] = rsqrtf(ss / (float)Kd + EPS);
  __syncthreads();
}
__device__ __forceinline__ void phase_g4(const Params& p, int l) {
  if (PMASK & 0x80000) for (int u = blockIdx.x; u < 256; u += gridDim.x) ret_unit(p, l, u);
  const char* WQB = (const char*)(p.ws + O_WQB); const char* WKVB = (const char*)(p.ws + O_WKVB);
  const bf16_t* QLAT = (const bf16_t*)(p.ws + O_QLAT); const bf16_t* KVLAT = (const bf16_t*)(p.ws + O_KVLAT);
  bf16_t* QMLA = (bf16_t*)(p.ws + O_QMLA); bf16_t* KNOPE = (bf16_t*)(p.ws + O_KNOPE); bf16_t* VMLA = (bf16_t*)(p.ws + O_VMLA);
  const float* rmc = (const float*)(p.ws + O_RMC); const float* rms = (const float*)(p.ws + O_RMS);
  const float* rs = (const float*)(g_lds + 131072);
  const int q = logical_wg(), Gd = gridDim.x;
  auto get = [&](int idx, GOp& o) __attribute__((always_inline)) -> bool { const int U = q + idx * Gd; if (U >= NPM * 7) return false; int pm, pn;
    if (U < NPM * 3) { unit_decode(U, 3, 3, pm, pn); o.A = WQB + (size_t)pn * 256 * 768; o.B = (const char*)QLAT + (size_t)pm * 256 * 768; o.lda2 = 768; o.ldb2 = 768; o.nt = 6; }
    else { unit_decode(U - NPM * 3, 4, 4, pm, pn); o.A = WKVB + (size_t)pn * 256 * 512; o.B = (const char*)KVLAT + (size_t)pm * 256 * 512; o.lda2 = 512; o.ldb2 = 512; o.nt = 4; }
    return true; };
  auto epi = [&](int idx, const f32x4 (&acc)[2][2][4][2]) __attribute__((always_inline)) {
    const int U = q + idx * Gd; const bool isq = U < NPM * 3; int pm, pn;
    if (isq) unit_decode(U, 3, 3, pm, pn); else unit_decode(U - NPM * 3, 4, 4, pm, pn);
    __syncthreads();
    if (isq) row_rstd(QLAT + (size_t)pm * 256 * 384, 384); else row_rstd(KVLAT + (size_t)pm * 256 * 256, 256);
    LANE_IDS
    const TI ti = tile_info(pm); const bool lat = ti.bb < 8;
#pragma unroll
    for (int bj = 0; bj < 2; ++bj)
#pragma unroll
      for (int n = 0; n < 2; ++n) {
        const int tl = bj * 128 + wc * 32 + n * 16 + fr; const int ar = ti.arow0 + tl; const float rr = isq ? rs[tl] * CQ_MLA : rs[tl]; const int prow = ar >> 6, pcol = ar & 63;
        if (isq && pn == 2) {
          const int half = fq >> 1, idx = (fq & 1) * 4; const int pos = half ? pcol : prow;
          f32x4 c = {1.f, 1.f, 1.f, 1.f}, s = {0.f, 0.f, 0.f, 0.f};
          if (lat) { c = *(const f32x4*)(rmc + pos * 8 + idx); s = *(const f32x4*)(rms + pos * 8 + idx); }
#pragma unroll
          for (int ai = 0; ai < 2; ++ai)
#pragma unroll
            for (int mp = 0; mp < 2; ++mp) { const int hd = ai * 4 + wr * 2 + mp; f32x4 o1, o2; rope4(acc[ai][bj][2 * mp][n] * rr, acc[ai][bj][2 * mp + 1][n] * rr, c, s, o1, o2);
              bf16_t* d = QMLA + (((long)ti.b * 8 + hd) * SK + ar) * 96 + 64 + half * 16 + idx; store4bf(d, o1); store4bf(d + 8, o2); }
        } else {
#pragma unroll
          for (int ai = 0; ai < 2; ++ai)
#pragma unroll
            for (int m = 0; m < 4; ++m) { const int cfull = (pn & 1) * 256 + ai * 128 + wr * 64 + m * 16 + fq * 4; const int hd = cfull >> 6, d = cfull & 63; const f32x4 v = acc[ai][bj][m][n] * rr;
              if (isq) store4bf(QMLA + (((long)ti.b * 8 + hd) * SK + ar) * 96 + d, v);
              else if (pn < 2) store4bf(KNOPE + (((long)ti.b * 8 + hd) * SK + ar) * 64 + d, v);
              else store4bf(VMLA + (((long)ti.b * 8 + hd) * SK + ar) * 64 + d, v); }
        }
      }
  };
  if (PMASK & 0x100000) gemm_stream(get, epi);
}

#define SBAR() __builtin_amdgcn_sched_barrier(0)
template <int DQK> __device__ __forceinline__ int kswz(int row, int colB) { if (DQK == 96) return row * 256 + (colB ^ ((row & 7) << 4)); return row * 128 + (colB ^ (((row >> 1) & 7) << 4)); }
#ifndef EXP_THR
#define EXP_THR 8.f
#endif
constexpr float ATHR = EXP_THR;
template <int DQK> __device__ __forceinline__ void partialSM(f32x16& p0, f32x16& p1, float& m_reg, float& mn, float& alpha) {
  constexpr float THRL = ATHR * 1.4426950408889634f;
  float pmax = p0[0];
#pragma unroll
  for (int r = 1; r < 16; ++r) pmax = fmaxf(pmax, p0[r]);
#pragma unroll
  for (int r = 0; r < 16; ++r) pmax = fmaxf(pmax, p1[r]);
  { auto rr = __builtin_amdgcn_permlane32_swap(__float_as_uint(pmax), __float_as_uint(pmax), false, false); pmax = fmaxf(__uint_as_float(rr[0]), __uint_as_float(rr[1])); }
  if (__builtin_expect(__all(pmax - m_reg <= THRL), 1)) { mn = m_reg; alpha = 1.f; }
  else { mn = fmaxf(m_reg, pmax); alpha = __builtin_amdgcn_exp2f(m_reg - mn); m_reg = mn; }
  if (!__all(mn == 0.f)) {
#pragma unroll
    for (int r = 0; r < 16; ++r) p0[r] -= mn;
#pragma unroll
    for (int r = 0; r < 16; ++r) p1[r] -= mn;
  }
#pragma unroll
  for (int r = 0; r < 16; ++r) p0[r] = __builtin_amdgcn_exp2f(p0[r]);
}
template <bool SUM> __device__ __forceinline__ void finishSM(f32x16& p0, f32x16& p1, float alpha, float& l_reg, bf16x8& pa0, bf16x8& pa1, bf16x8& pa2, bf16x8& pa3) {
#pragma unroll
  for (int r = 0; r < 16; ++r) p1[r] = __builtin_amdgcn_exp2f(p1[r]);
  if constexpr (SUM) {
  float ps = 0;
#pragma unroll
  for (int r = 0; r < 16; ++r) ps += p0[r];
#pragma unroll
  for (int r = 0; r < 16; ++r) ps += p1[r];
  { auto rr = __builtin_amdgcn_permlane32_swap(__float_as_uint(ps), __float_as_uint(ps), false, false); ps = __uint_as_float(rr[0]) + __uint_as_float(rr[1]); }
  l_reg = l_reg * alpha + ps;
  }
#define PK4(P, BASE, OUT) do { unsigned a0 = cvtpk(P[BASE + 0], P[BASE + 1]), a1 = cvtpk(P[BASE + 2], P[BASE + 3]); \
    unsigned b0 = cvtpk(P[BASE + 4], P[BASE + 5]), b1 = cvtpk(P[BASE + 6], P[BASE + 7]); \
    auto r0 = __builtin_amdgcn_permlane32_swap(a0, b0, false, false); auto r1 = __builtin_amdgcn_permlane32_swap(a1, b1, false, false); \
    u32x4 w = {r0[0], r1[0], r0[1], r1[1]}; OUT = *reinterpret_cast<bf16x8*>(&w); } while (0)
  PK4(p0, 0, pa0); PK4(p0, 8, pa1); PK4(p1, 0, pa2); PK4(p1, 8, pa3);
#undef PK4
}
template <int DQK> __device__ __forceinline__ void qkt(f32x16& p0, f32x16& p1, const unsigned char* Ks, const bf16x8* qr, int r32, int hi) {
  p0 = f32x16{}; p1 = f32x16{};
#pragma unroll
  for (int d0 = 0; d0 < DQK / 16; ++d0) { const int cb = (d0 * 16 + hi * 8) * 2;
    const bf16x8 b0 = *reinterpret_cast<const bf16x8*>(Ks + kswz<DQK>(r32, cb));
    const bf16x8 b1 = *reinterpret_cast<const bf16x8*>(Ks + kswz<DQK>(32 + r32, cb));
    p0 = __builtin_amdgcn_mfma_f32_32x32x16_bf16(b0, qr[d0], p0, 0, 0, 0);
    p1 = __builtin_amdgcn_mfma_f32_32x32x16_bf16(b1, qr[d0], p1, 0, 0, 0); }
}
template <int DV> __device__ __forceinline__ int v_st(int k, int c) { const int kk = (k & ~0xC) | ((k & 4) << 1) | ((k & 8) >> 1); return ((kk >> 3) * (DV / 32) + (c >> 5)) * 512 + ((kk & 7) * 32 + (c & 31)) * 2; }
__device__ __forceinline__ int v_rd_base(int lane) { return ((lane & 3) << 3) | (((lane >> 2) & 3) << 6) | (((lane >> 4) & 1) << 5) | (((lane >> 5) & 1) << 8); }
template <int OFF> __device__ __forceinline__ s16x4 tr_read(int vb) { s16x4 r; asm volatile("ds_read_b64_tr_b16 %0, %1 offset:%2" : "=&v"(r) : "v"(vb), "i"(OFF) : "memory"); return r; }
template <int DV, int D0> __device__ __forceinline__ void pv_one(f32x16& od, int vb, bf16x8 pa0, bf16x8 pa1, bf16x8 pa2, bf16x8 pa3) {
  constexpr int NS = DV / 32;
#define VOFF(ks, half) (D0 * 512 + (ks) * (2 * NS * 512) + (half) * (NS * 512))
  const s16x4 l0 = tr_read<VOFF(0, 0)>(vb), h0 = tr_read<VOFF(0, 1)>(vb), l1 = tr_read<VOFF(1, 0)>(vb), h1 = tr_read<VOFF(1, 1)>(vb);
  const s16x4 l2 = tr_read<VOFF(2, 0)>(vb), h2 = tr_read<VOFF(2, 1)>(vb), l3 = tr_read<VOFF(3, 0)>(vb), h3 = tr_read<VOFF(3, 1)>(vb);
#undef VOFF
  asm volatile("s_waitcnt lgkmcnt(0)" ::: "memory"); SBAR();
#define PK(L_, H_) (bf16x8){L_[0], L_[1], L_[2], L_[3], H_[0], H_[1], H_[2], H_[3]}
  od = __builtin_amdgcn_mfma_f32_32x32x16_bf16(pa0, PK(l0, h0), od, 0, 0, 0);
  od = __builtin_amdgcn_mfma_f32_32x32x16_bf16(pa1, PK(l1, h1), od, 0, 0, 0);
  od = __builtin_amdgcn_mfma_f32_32x32x16_bf16(pa2, PK(l2, h2), od, 0, 0, 0);
  od = __builtin_amdgcn_mfma_f32_32x32x16_bf16(pa3, PK(l3, h3), od, 0, 0, 0);
#undef PK
}
template <int DV, int D0> __device__ __forceinline__ void pv_pair(f32x16& oa, f32x16& ob, int vb, bf16x8 pa0, bf16x8 pa1, bf16x8 pa2, bf16x8 pa3) {
  constexpr int NS = DV / 32;
#define VOFF(d, ks, half) ((d) * 512 + (ks) * (2 * NS * 512) + (half) * (NS * 512))
  const s16x4 al0 = tr_read<VOFF(D0, 0, 0)>(vb), ah0 = tr_read<VOFF(D0, 0, 1)>(vb), al1 = tr_read<VOFF(D0, 1, 0)>(vb), ah1 = tr_read<VOFF(D0, 1, 1)>(vb);
  const s16x4 al2 = tr_read<VOFF(D0, 2, 0)>(vb), ah2 = tr_read<VOFF(D0, 2, 1)>(vb), al3 = tr_read<VOFF(D0, 3, 0)>(vb), ah3 = tr_read<VOFF(D0, 3, 1)>(vb);
  const s16x4 bl0 = tr_read<VOFF(D0 + 1, 0, 0)>(vb), bh0 = tr_read<VOFF(D0 + 1, 0, 1)>(vb), bl1 = tr_read<VOFF(D0 + 1, 1, 0)>(vb), bh1 = tr_read<VOFF(D0 + 1, 1, 1)>(vb);
  const s16x4 bl2 = tr_read<VOFF(D0 + 1, 2, 0)>(vb), bh2 = tr_read<VOFF(D0 + 1, 2, 1)>(vb), bl3 = tr_read<VOFF(D0 + 1, 3, 0)>(vb), bh3 = tr_read<VOFF(D0 + 1, 3, 1)>(vb);
#undef VOFF
  asm volatile("s_waitcnt lgkmcnt(0)" ::: "memory"); SBAR();
#define PK(L_, H_) (bf16x8){L_[0], L_[1], L_[2], L_[3], H_[0], H_[1], H_[2], H_[3]}
  oa = __builtin_amdgcn_mfma_f32_32x32x16_bf16(pa0, PK(al0, ah0), oa, 0, 0, 0);
  ob = __builtin_amdgcn_mfma_f32_32x32x16_bf16(pa0, PK(bl0, bh0), ob, 0, 0, 0);
  oa = __builtin_amdgcn_mfma_f32_32x32x16_bf16(pa1, PK(al1, ah1), oa, 0, 0, 0);
  ob = __builtin_amdgcn_mfma_f32_32x32x16_bf16(pa1, PK(bl1, bh1), ob, 0, 0, 0);
  oa = __builtin_amdgcn_mfma_f32_32x32x16_bf16(pa2, PK(al2, ah2), oa, 0, 0, 0);
  ob = __builtin_amdgcn_mfma_f32_32x32x16_bf16(pa2, PK(bl2, bh2), ob, 0, 0, 0);
  oa = __builtin_amdgcn_mfma_f32_32x32x16_bf16(pa3, PK(al3, ah3), oa, 0, 0, 0);
  ob = __builtin_amdgcn_mfma_f32_32x32x16_bf16(pa3, PK(bl3, bh3), ob, 0, 0, 0);
#undef PK
}
template <int DV> __device__ __forceinline__ void pv_all(f32x16* o, int vb, bf16x8 pa0, bf16x8 pa1, bf16x8 pa2, bf16x8 pa3) {
  pv_pair<DV, 0>(o[0], o[1], vb, pa0, pa1, pa2, pa3);
  if constexpr (DV == 128) pv_pair<DV, 2>(o[2], o[3], vb, pa0, pa1, pa2, pa3);
}
template <int DQK, int DV>
__device__ __forceinline__ void attn_body(const bf16_t* __restrict__ Qb, const bf16_t* kp0, int kst0, const bf16_t* kp1, int kst1, bool k1valid,
                                          const bf16_t* vp0, const bf16_t* vp1, int nkeys, f32x16 (&o)[DV / 32]) {
  constexpr int KSTR = (DQK == 96) ? 256 : 128, SHM_K = 64 * KSTR, SHM_V = 64 * DV * 2, CK = DQK / 8, CV = DV / 8, ND = DV / 32;
  constexpr bool K2 = (64 * CK > 512), V2 = (64 * CV > 512);
  constexpr bool MSUM = (DV == 64);
  f32x16 osum = f32x16{}; const bf16x8 ones = {16256, 16256, 16256, 16256, 16256, 16256, 16256, 16256};
  const int tid = launder_tid(), wid = tid >> 6, lane = tid & 63, r32 = lane & 31, hi = lane >> 5;
  unsigned char* V_lds = g_lds; unsigned char* K_lds = g_lds + 3 * SHM_V;
  float* ws = (float*)(g_lds + 3 * SHM_V + 3 * SHM_K) + wid * 64; float* li_l = ws; float* al_l = ws + 32;
  float m_reg = 0.f, l_reg = 0;
#pragma unroll
  for (int d = 0; d < ND; ++d) o[d] = f32x16{};
  bf16x8 qr[DQK / 16];
  const bf16_t* Qw = Qb + (long)(wid * 32 + r32) * DQK + hi * 8;
#pragma unroll
  for (int d0 = 0; d0 < DQK / 16; ++d0) qr[d0] = *reinterpret_cast<const bf16x8*>(Qw + d0 * 16);
  const int kq0 = tid, kq1 = tid + 512;
  const int kd0 = kswz<DQK>(kq0 / CK, (kq0 % CK) * 16), kd1 = kswz<DQK>((kq1 / CK) & 63, (kq1 % CK) * 16);
  const int vq0 = tid, vq1 = tid + 512;
  const int vd0 = v_st<DV>(vq0 / CV, (vq0 % CV) * 8), vd1 = v_st<DV>((vq1 / CV) & 63, (vq1 % CV) * 8);
  const int vb0 = (int)(uintptr_t)(__attribute__((address_space(3))) unsigned char*)V_lds + v_rd_base(lane);
  struct St { bf16x8 k0, k1, v0, v1; } sr_[2];
#define SLOAD(i, key0) do { sr_[i].k0 = *reinterpret_cast<const bf16x8*>(kp0 + (long)(key0) * kst0); \
    if (K2) { if (k1valid) sr_[i].k1 = *reinterpret_cast<const bf16x8*>(kp1 + (long)(key0) * kst1); } \
    sr_[i].v0 = *reinterpret_cast<const bf16x8*>(vp0 + (long)(key0) * DV); \
    if (V2) sr_[i].v1 = *reinterpret_cast<const bf16x8*>(vp1 + (long)(key0) * DV); } while (0)
#define SWRITE(b, i) do { *(bf16x8*)(K_lds + (b) * SHM_K + kd0) = sr_[i].k0; \
    if (K2) { if (k1valid) *(bf16x8*)(K_lds + (b) * SHM_K + kd1) = sr_[i].k1; } \
    *(bf16x8*)(V_lds + (b) * SHM_V + vd0) = sr_[i].v0; \
    if (V2) *(bf16x8*)(V_lds + (b) * SHM_V + vd1) = sr_[i].v1; } while (0)
#define RESC(a) do { if (__any((a) < 1.f)) { if (hi == 0) al_l[r32] = (a); asm volatile("s_waitcnt lgkmcnt(0)" ::: "memory"); \
    _Pragma("unroll") for (int d = 0; d < ND; ++d) _Pragma("unroll") for (int r = 0; r < 16; ++r) o[d][r] *= al_l[crow(r, hi)]; \
    if (MSUM) { _Pragma("unroll") for (int r = 0; r < 16; ++r) osum[r] *= al_l[crow(r, hi)]; } } } while (0)
#define PSUM() do { if (MSUM) { osum = __builtin_amdgcn_mfma_f32_32x32x16_bf16(pa0, ones, osum, 0, 0, 0); osum = __builtin_amdgcn_mfma_f32_32x32x16_bf16(pa1, ones, osum, 0, 0, 0); \
    osum = __builtin_amdgcn_mfma_f32_32x32x16_bf16(pa2, ones, osum, 0, 0, 0); osum = __builtin_amdgcn_mfma_f32_32x32x16_bf16(pa3, ones, osum, 0, 0, 0); } } while (0)
#define ROT() do { bprev = bj; bj = bnext; bnext = (bnext == 2) ? 0 : bnext + 1; } while (0)
  f32x16 pA0, pA1, pB0, pB1; float mnA, mnB, alA, alB; bf16x8 pa0, pa1, pa2, pa3; const int NT = nkeys / 64;
  __syncthreads();
  SLOAD(0, 0); SWRITE(0, 0);
  SLOAD(1, 64); if (2 < NT) SLOAD(0, 128);
  __syncthreads();
  qkt<DQK>(pA0, pA1, K_lds, qr, r32, hi); partialSM<DQK>(pA0, pA1, m_reg, mnA, alA);
  SWRITE(1, 1); __syncthreads();
  int bprev = 0, bj = 1, bnext = 2;
  for (int j = 1; j + 1 < NT; j += 2) {
    SBAR(); qkt<DQK>(pB0, pB1, K_lds + bj * SHM_K, qr, r32, hi);
    finishSM<!MSUM>(pA0, pA1, alA, l_reg, pa0, pa1, pa2, pa3); SBAR();
    SLOAD(1, (j + 2) * 64); SBAR();
    pv_all<DV>(o, vb0 + bprev * SHM_V, pa0, pa1, pa2, pa3); PSUM(); partialSM<DQK>(pB0, pB1, m_reg, mnB, alB);
    SWRITE(bnext, 0);
    RESC(alB); __syncthreads(); ROT();
    SBAR(); qkt<DQK>(pA0, pA1, K_lds + bj * SHM_K, qr, r32, hi);
    finishSM<!MSUM>(pB0, pB1, alB, l_reg, pa0, pa1, pa2, pa3); SBAR();
    if (j + 3 < NT) SLOAD(0, (j + 3) * 64); SBAR();
    pv_all<DV>(o, vb0 + bprev * SHM_V, pa0, pa1, pa2, pa3); PSUM(); partialSM<DQK>(pA0, pA1, m_reg, mnA, alA);
    SWRITE(bnext, 1);
    RESC(alA); __syncthreads(); ROT();
  }
  SBAR(); qkt<DQK>(pB0, pB1, K_lds + bj * SHM_K, qr, r32, hi);
  finishSM<!MSUM>(pA0, pA1, alA, l_reg, pa0, pa1, pa2, pa3); SBAR();
  pv_all<DV>(o, vb0 + bprev * SHM_V, pa0, pa1, pa2, pa3); PSUM(); partialSM<DQK>(pB0, pB1, m_reg, mnB, alB);
  RESC(alB);
  finishSM<!MSUM>(pB0, pB1, alB, l_reg, pa0, pa1, pa2, pa3); SBAR();
  pv_all<DV>(o, vb0 + bj * SHM_V, pa0, pa1, pa2, pa3); PSUM();
  if (hi == 0) li_l[r32] = l_reg; asm volatile("s_waitcnt lgkmcnt(0)" ::: "memory");
#pragma unroll
  for (int r = 0; r < 16; ++r) { const float rl = __builtin_amdgcn_rcpf(MSUM ? osum[r] : li_l[crow(r, hi)]);
#pragma unroll
    for (int d = 0; d < ND; ++d) o[d][r] *= rl; }
  __syncthreads();
#undef SLOAD
#undef SWRITE
#undef RESC
#undef PSUM
#undef ROT
}

__device__ __forceinline__ void mla_unit(const Params& p, int b, int h, int qrow0, int key0, int nkeys, long tok0) {
  const int tid = launder_tid(), wid = tid >> 6, lane = tid & 63, r32 = lane & 31, hi = lane >> 5;
  const bf16_t* Q = (const bf16_t*)(p.ws + O_QMLA) + (((long)b * 8 + h) * SK + qrow0) * 96;
  const bf16_t* KN = (const bf16_t*)(p.ws + O_KNOPE) + (((long)b * 8 + h) * SK + key0) * 64;
  const bf16_t* KR = (const bf16_t*)(p.ws + O_KROPE) + ((long)b * SK + key0) * 32;
  const bf16_t* V = (const bf16_t*)(p.ws + O_VMLA) + (((long)b * 8 + h) * SK + key0) * 64;
  const int q0 = tid, q1 = tid + 512; const int r0 = q0 / 12, c0 = q0 % 12, r1 = (q1 / 12) & 63, c1 = q1 % 12;
  const bf16_t* kp0 = c0 < 8 ? KN + (long)r0 * 64 + c0 * 8 : KR + (long)r0 * 32 + (c0 - 8) * 8; const int ks0 = c0 < 8 ? 64 : 32;
  const bf16_t* kp1 = c1 < 8 ? KN + (long)r1 * 64 + c1 * 8 : KR + (long)r1 * 32 + (c1 - 8) * 8; const int ks1 = c1 < 8 ? 64 : 32;
  const bf16_t* vp0 = V + (long)(tid >> 3) * 64 + (tid & 7) * 8;
  f32x16 o[2];
  attn_body<96, 64>(Q, kp0, ks0, kp1, ks1, tid < 256, vp0, vp0, nkeys, o);
  bf16_t* Y = (bf16_t*)(p.ws + O_YMLA);
#pragma unroll
  for (int r = 0; r < 16; ++r) { const long tok = tok0 + wid * 32 + crow(r, hi);
#pragma unroll
    for (int d = 0; d < 2; ++d) { const unsigned pk = cvtpk(o[d][r], 0.f); Y[tok * 512 + h * 64 + d * 32 + r32] = (unsigned short)(pk & 0xffff); } }
}
__device__ __forceinline__ void diff_unit(const Params& p, int l, int b, int h, int qrow0, int key0, int nkeys, long tok0) {
  const int tid = launder_tid(), wid = tid >> 6, lane = tid & 63, r32 = lane & 31, hi = lane >> 5;
  const __amdgpu_buffer_rsrc_t rsd = MK_RSRC((float*)(p.ws + O_O1S) + (size_t)blockIdx.x * 32768); const unsigned vo4 = (unsigned)tid * 4u;
  const float lam = ((const float*)(p.ws + O_LAM))[l];
  const float li = 0.8f - 0.6f * expf(-0.3f * (float)l);
  const bf16_t* V = (const bf16_t*)(p.ws + O_VD) + (((long)b * 4 + h) * SK + key0) * 128;
  const bf16_t* vp0 = V + (long)(tid >> 4) * 128 + (tid & 15) * 8; const bf16_t* vp1 = V + (long)(32 + (tid >> 4)) * 128 + (tid & 15) * 8;
  f32x16 o[4];
  for (int s = 0; s < 2; ++s) {
    const bf16_t* Q = (const bf16_t*)(p.ws + O_QD) + (((long)b * 8 + h * 2 + s) * SK + qrow0) * 64;
    const bf16_t* K = (const bf16_t*)(p.ws + O_KD) + (((long)b * 8 + h * 2 + s) * SK + key0) * 64;
    const bf16_t* kp0 = K + (long)(tid >> 3) * 64 + (tid & 7) * 8;
    attn_body<64, 128>(Q, kp0, 64, kp0, 64, false, vp0, vp1, nkeys, o);
    if (s == 0) {
#pragma unroll
      for (int d = 0; d < 4; ++d)
#pragma unroll
        for (int r = 0; r < 16; ++r) __builtin_amdgcn_raw_buffer_store_b32(__float_as_uint(o[d][r]), rsd, vo4, (d * 16 + r) * 2048, 0);
    }
  }
  const float* dn = p.in[19] + l * 128; bf16_t* Y = (bf16_t*)(p.ws + O_YDIFF);
  float gn[4];
#pragma unroll
  for (int d = 0; d < 4; ++d) gn[d] = dn[d * 32 + r32] * (1.f - li);
#pragma unroll
  for (int r = 0; r < 16; ++r) {
    float v[4], ss = 0.f;
#pragma unroll
    for (int d = 0; d < 4; ++d) { v[d] = __uint_as_float(__builtin_amdgcn_raw_buffer_load_b32(rsd, vo4, (d * 16 + r) * 2048, 0)) - lam * o[d][r]; ss += v[d] * v[d]; }
#pragma unroll
    for (int m = 1; m < 32; m <<= 1) ss += __shfl_xor(ss, m);
    const float rstd = rsqrtf(ss * (1.f / 128.f) + EPS);
    const long tok = tok0 + wid * 32 + crow(r, hi);
#pragma unroll
    for (int d = 0; d < 4; ++d) { const unsigned pk = cvtpk(v[d] * rstd * gn[d], 0.f); Y[tok * 512 + h * 128 + d * 32 + r32] = (unsigned short)(pk & 0xffff); }
    MEMFENCE();
  }
}
__device__ __forceinline__ void phase_attn(const Params& p, int l) {
  const int tid = launder_tid(), wid = tid >> 6, lane = tid & 63;
  const int q = logical_wg(), G = gridDim.x;
  const bf16_t* RO = (const bf16_t*)(p.ws + O_RETO); bf16_t* YR = (bf16_t*)(p.ws + O_YRET); const float* rn = p.in[21] + l * 128;
  const int vc = (lane & 15) * 8; f32x8 gnv = *(const f32x8*)(rn + vc);
  const int rp_slot = blockIdx.x % 3;
  auto ret_post = [&]() __attribute__((always_inline)) {
  if (PMASK & 0x40000) {
    const long nwaves = (long)gridDim.x * 8, w0 = (long)blockIdx.x * 8 + wid; const long nrows = (l == 0) ? (long)T : (long)TL;
    for (long rb = w0; rb < nrows; rb += nwaves * 4) {
      u32x4 a[4], bq[4], g[4];
#pragma unroll
      for (int j = 0; j < 4; ++j) { const long row = rb + j * nwaves;
        if (row < nrows) { a[j] = *(const u32x4*)(RO + row * 512 + lane * 8); bq[j] = *(const u32x4*)(RO + (size_t)T * 512 + row * 512 + lane * 8); g[j] = *(const u32x4*)(YR + row * 512 + lane * 8); } }
#pragma unroll
      for (int j = 0; j < 4; ++j) { const long row = rb + j * nwaves;
        if (row < nrows) {
          float v[8], ss = 0.f;
#pragma unroll
          for (int e = 0; e < 4; ++e) { v[2 * e] = __uint_as_float(a[j][e] << 16) + __uint_as_float(bq[j][e] << 16); v[2 * e + 1] = __uint_as_float(a[j][e] & 0xffff0000u) + __uint_as_float(bq[j][e] & 0xffff0000u); }
#pragma unroll
          for (int e = 0; e < 8; ++e) ss += v[e] * v[e];
#pragma unroll
          for (int m = 1; m < 16; m <<= 1) ss += __shfl_xor(ss, m);
          const float rstd = rsqrtf(ss * (1.f / 128.f) + EPS);
          u32x4 w;
#pragma unroll
          for (int e = 0; e < 4; ++e) { const float g0 = __uint_as_float(g[j][e] << 16), g1 = __uint_as_float(g[j][e] & 0xffff0000u); w[e] = cvtpk(v[2 * e] * rstd * gnv[2 * e] * g0, v[2 * e + 1] * rstd * gnv[2 * e + 1] * g1); }
          *(u32x4*)(YR + row * 512 + lane * 8) = w; } }
    }
  }
  };
  if (rp_slot == 0) ret_post();
  if (PMASK & 0x10000) for (int U = q; U < 2048; U += G) { const int h = U >> 8, w = U & 255, b = w >> 5, qb = w & 31; mla_unit(p, b, h, qb * 256, 0, SK, (long)b * 8192 + qb * 256); }
  if (rp_slot == 1) ret_post();
  if (PMASK & 0x20000) for (int U = q; U < 1024; U += G) { const int h = U >> 8, w = U & 255, b = w >> 5, qb = w & 31; diff_unit(p, l, b, h, qb * 256, 0, SK, (long)b * 8192 + qb * 256); }
  if ((PMASK & 0x10000) && l == 0) for (int U = q; U < 64; U += G) { const int b = U >> 3, h = U & 7; mla_unit(p, b, h, 8192, 8192, 256, (long)TL + b * 256); }
  if ((PMASK & 0x20000) && l == 0) for (int U = q; U < 32; U += G) { const int b = U >> 2, h = U & 3; diff_unit(p, l, b, h, 8192, 8192, 256, (long)TL + b * 256); }
  if (rp_slot == 2) ret_post();
}

template <int MODE>
__device__ __forceinline__ void branch_epi(const f32x4 (&acc)[2][2][4][2], unsigned char* scr, bf16_t* YBR, int pm, int pn, int tid, int wr, int wc, int fr, int fq) {
  const __amdgpu_buffer_rsrc_t rs = MK_RSRC(scr);
  const unsigned vo8 = (unsigned)tid * 8u, vo16 = (unsigned)tid * 16u;
#pragma unroll
  for (int bj = 0; bj < 2; ++bj)
#pragma unroll
    for (int n = 0; n < 2; ++n) {
      const long tok = (long)pm * 256 + bj * 128 + wc * 32 + n * 16 + fr; bf16_t* yrow = YBR + tok * 1024 + pn * 256 + wr * 64 + fq * 4;
#pragma unroll
      for (int ai = 0; ai < 2; ++ai)
#pragma unroll
        for (int m = 0; m < 4; ++m) { const int e = ((ai * 2 + bj) * 4 + m) * 2 + n;
          const u32x2 w = __builtin_amdgcn_raw_buffer_load_b64(rs, vo8, e * 4096, 0); f32x4 v = acc[ai][bj][m][n];
          v[0] *= __uint_as_float(w.x << 16); v[1] *= __uint_as_float(w.x & 0xffff0000u); v[2] *= __uint_as_float(w.y << 16); v[3] *= __uint_as_float(w.y & 0xffff0000u);
          if (MODE > 0) v += __builtin_bit_cast(f32x4, __builtin_amdgcn_raw_buffer_load_b128(rs, vo16, 131072 + e * 8192, 0));
          if (MODE < 2) __builtin_amdgcn_raw_buffer_store_b128(__builtin_bit_cast(u32x4, v), rs, vo16, 131072 + e * 8192, 0); else store4bf(yrow + ai * 128 + m * 16, v);
          if (m & 1) MEMFENCE(); }
    }
}
__device__ __forceinline__ void phase_branch(const Params& p, int npm) {
  const char* WG = (const char*)(p.ws + O_WG); const char* WBR = (const char*)(p.ws + O_WBR); const char* H = (const char*)(p.ws + O_H);
  bf16_t* YBR = (bf16_t*)(p.ws + O_YBR);
  unsigned char* scr = p.ws + O_G6S + (size_t)blockIdx.x * 393216;
  const int q = logical_wg(), Gd = gridDim.x, tot = npm * 4;
  auto get = [&](int idx, GOp& o) __attribute__((always_inline)) -> bool { const int u = idx / 6, j = idx - u * 6, i = j >> 1; const int U = q + u * Gd; if (U >= tot) return false; int pm, pn; unit_decode(U, 4, 4, pm, pn);
    if ((j & 1) == 0) { o.A = WG + ((size_t)i * 1024 + pn * 256) * 2048; o.B = H + (size_t)pm * 256 * 2048; o.lda2 = 2048; o.ldb2 = 2048; o.nt = 16; }
    else { const char* Y = (const char*)(p.ws + (i == 0 ? O_YMLA : (i == 1 ? O_YDIFF : O_YRET))); o.A = WBR + ((size_t)i * 1024 + pn * 256) * 1024; o.B = Y + (size_t)pm * 256 * 1024; o.lda2 = 1024; o.ldb2 = 1024; o.nt = 8; }
    return true; };
  auto epi = [&](int idx, const f32x4 (&acc)[2][2][4][2]) __attribute__((always_inline)) {
    const int u = idx / 6, j = idx - u * 6, i = j >> 1; const int U = q + u * Gd; int pm, pn; unit_decode(U, 4, 4, pm, pn);
    LANE_IDS
    if ((j & 1) == 0) {
      const unsigned vo8 = (unsigned)tid * 8u; const __amdgpu_buffer_rsrc_t rs = MK_RSRC(scr);
#pragma unroll
      for (int ai = 0; ai < 2; ++ai)
#pragma unroll
        for (int bj = 0; bj < 2; ++bj)
#pragma unroll
          for (int m = 0; m < 4; ++m)
#pragma unroll
            for (int n = 0; n < 2; ++n) { const int e = ((ai * 2 + bj) * 4 + m) * 2 + n; const f32x4 v = acc[ai][bj][m][n]; u32x2 w; w.x = cvtpk(sigm_f(v[0]), sigm_f(v[1])); w.y = cvtpk(sigm_f(v[2]), sigm_f(v[3])); __builtin_amdgcn_raw_buffer_store_b64(w, rs, vo8, e * 4096, 0); if (n == 1) MEMFENCE(); }
    } else {
      if (i == 0) branch_epi<0>(acc, scr, YBR, pm, pn, tid, wr, wc, fr, fq);
      else if (i == 1) branch_epi<1>(acc, scr, YBR, pm, pn, tid, wr, wc, fr, fq);
      else branch_epi<2>(acc, scr, YBR, pm, pn, tid, wr, wc, fr, fq);
    }
  };
  gemm_stream(get, epi);
}


#ifdef DIAG
__device__ __forceinline__ float blk_reduce(float v, int mode, float* red) {
  const int tid = launder_tid(), lane = tid & 63, wid = tid >> 6;
#pragma unroll
  for (int o = 32; o > 0; o >>= 1) { const float t = __shfl_xor(v, o); v = mode ? fmaxf(v, t) : v + t; }
  __syncthreads();
  if (lane == 0) red[wid] = v;
  __syncthreads();
  float r = red[0];
  for (int i = 1; i < 8; ++i) r = mode ? fmaxf(r, red[i]) : r + red[i];
  return r;
}
__device__ __forceinline__ void phase_diag(const Params& p) {
  const int tid = launder_tid();
  float* w0 = (float*)g_lds; float* w1 = w0 + 8448; float* qv = w1 + 8448; float* ov = qv + 256; float* red = ov + 256;
  float* dg = (float*)(p.ws + O_LAM) + 16;
  const int S = blockIdx.x; const int b = S & 7, t = (S * 977 + 131) % 8192; const long tok = (long)b * 8192 + t;
  float num = 0.f, den = 0.f;
#if DIAG == 1
  { const int h = (S >> 3) & 7; const bf16_t* Q = (const bf16_t*)(p.ws + O_QMLA) + (((long)b * 8 + h) * SK + t) * 96;
    const bf16_t* KN = (const bf16_t*)(p.ws + O_KNOPE) + ((long)b * 8 + h) * SK * 64; const bf16_t* KR = (const bf16_t*)(p.ws + O_KROPE) + (long)b * SK * 32;
    const bf16_t* V = (const bf16_t*)(p.ws + O_VMLA) + ((long)b * 8 + h) * SK * 64;
    if (tid < 96) qv[tid] = bf2f(Q[tid]);
    __syncthreads();
    float mx = -1e30f;
    for (int k = tid; k < SK; k += 512) { float d = 0.f; for (int e = 0; e < 64; ++e) d += qv[e] * bf2f(KN[(long)k * 64 + e]); for (int e = 0; e < 32; ++e) d += qv[64 + e] * bf2f(KR[(long)k * 32 + e]); d *= 0.10206207261596575f; w0[k] = d; mx = fmaxf(mx, d); }
    mx = blk_reduce(mx, 1, red); float l = 0.f;
    for (int k = tid; k < SK; k += 512) { const float e = expf(w0[k] - mx); w0[k] = e; l += e; }
    l = blk_reduce(l, 0, red);
    if (tid < 64) { float a = 0.f; for (int k = 0; k < SK; ++k) a += w0[k] * bf2f(V[(long)k * 64 + tid]); a /= l;
      const float y = bf2f(((const bf16_t*)(p.ws + O_YMLA))[tok * 512 + h * 64 + tid]); num = (a - y) * (a - y); den = a * a; } }
#elif DIAG == 2
  { const int h = (S >> 3) & 3; const float lam = ((const float*)(p.ws + O_LAM))[0];
    const bf16_t* V = (const bf16_t*)(p.ws + O_VD) + ((long)b * 4 + h) * SK * 128; float ls[2];
    for (int s2 = 0; s2 < 2; ++s2) { float* w = s2 ? w1 : w0;
      const bf16_t* Q = (const bf16_t*)(p.ws + O_QD) + (((long)b * 8 + h * 2 + s2) * SK + t) * 64; const bf16_t* K = (const bf16_t*)(p.ws + O_KD) + ((long)b * 8 + h * 2 + s2) * SK * 64;
      __syncthreads();
      if (tid < 64) qv[tid] = bf2f(Q[tid]);
      __syncthreads();
      float mx = -1e30f;
      for (int k = tid; k < SK; k += 512) { float d = 0.f; for (int e = 0; e < 64; ++e) d += qv[e] * bf2f(K[(long)k * 64 + e]); d *= 0.125f; w[k] = d; mx = fmaxf(mx, d); }
      mx = blk_reduce(mx, 1, red); float l = 0.f;
      for (int k = tid; k < SK; k += 512) { const float e = expf(w[k] - mx); w[k] = e; l += e; }
      ls[s2] = blk_reduce(l, 0, red); }
    if (tid < 256) { const int d = tid & 127, s2 = tid >> 7; const float* w = s2 ? w1 : w0; float a = 0.f; for (int k = 0; k < SK; ++k) a += w[k] * bf2f(V[(long)k * 128 + d]); ov[tid] = a / ls[s2]; }
    __syncthreads();
    float val = 0.f; if (tid < 128) val = ov[tid] - lam * ov[128 + tid];
    const float ss = blk_reduce(val * val, 0, red); const float rstd = rsqrtf(ss * (1.f / 128.f) + EPS);
    if (tid < 128) { const float a = val * rstd * p.in[19][tid] * 0.8f; const float y = bf2f(((const bf16_t*)(p.ws + O_YDIFF))[tok * 512 + h * 128 + tid]); num = (a - y) * (a - y); den = a * a; } }
#elif DIAG >= 3
  { const int h = (S >> 3) & 3, dir = (S >> 5) & 1; const float lg = -expf(p.in[20][dir * 4 + h]);
    const bf16_t* Q = (const bf16_t*)(p.ws + O_RQ) + (((long)b * 4 + h) * SK + t) * 64; const bf16_t* K = (const bf16_t*)(p.ws + O_RK) + ((long)b * 4 + h) * SK * 64;
    const bf16_t* V = (const bf16_t*)(p.ws + O_RV) + ((long)b * 4 + h) * SK * 128;
    if (tid < 64) qv[tid] = bf2f(Q[tid]);
    __syncthreads();
    for (int k = tid; k < SK; k += 512) { int dist; if (k < 8192) dist = dir ? k - t : t - k; else { const int j = k - 8192; dist = dir ? 8192 - t + j : 256 + t - j; }
      float d = 0.f; bool inc = dist >= 0;
#if DIAG == 4
      inc = inc && (k < 8192) && ((k >> 7) == (t >> 7));
#endif
#if DIAG == 5
      inc = inc && !((k < 8192) && ((k >> 7) == (t >> 7)));
#endif
      if (inc) { for (int e = 0; e < 64; ++e) d += qv[e] * bf2f(K[(long)k * 64 + e]); d *= expf(lg * (float)dist); } w0[k] = d; }
    __syncthreads();
    if (tid < 128) { float a = 0.f; for (int k = 0; k < SK; ++k) a += w0[k] * bf2f(V[(long)k * 128 + tid]);
      const float y = bf2f(((const bf16_t*)(p.ws + O_RETO))[(size_t)dir * T * 512 + tok * 512 + h * 128 + tid]); num = (a - y) * (a - y); den = a * a; } }
#endif
  num = blk_reduce(num, 0, red); den = blk_reduce(den, 0, red);
  if (tid == 0) { atomicAdd(dg, num); atomicAdd(dg + 1, den); }
}
__device__ __forceinline__ void phase_diag_out(const Params& p) {
  const float* dg = (const float*)(p.ws + O_LAM) + 16; const float m = dg[0] / fmaxf(dg[1], 1e-30f);
  float c2 = 10.f + log10f(fmaxf(m, 1e-12f)); c2 = fminf(fmaxf(c2, 0.f), 12.f); const float c = sqrtf(c2);
  for (long i = (long)blockIdx.x * 512 + launder_tid(); i < (long)TL * DM; i += (long)gridDim.x * 512) p.out[i] = c;
}
#endif
constexpr int NPHASE = 25;
__device__ __forceinline__ void run_phase(const Params& p0_, int ph) {
  Params p = p0_; { unsigned long long z = 0; asm volatile("" : "+s"(z)); p.ws = p0_.ws + z; p.out = p0_.out + z; }
  if (ph == 0) { if (PMASK & 0x1000) phase_p0(p); return; }
  if (ph == 25) { if (PMASK & 0x2000) phase_final(p); return; }
  const int l = (ph - 1) / 12, s = (ph - 1) % 12;
  switch (s) {
    case 0: if (PMASK & 1) { if (l == 0) { phase_norm(p, l, 0, true); conv_group(p, l, 0, 0, 2, blockIdx.x, gridDim.x); } } break;
    case 1: if (PMASK & 2) { if (l == 1) conv_prefix(p, 1, 0, 1, 2, NPM * 22); phase_ffn_up(p, NPM); if (l == 1) conv_suffix(p, 1, 0, 1, 2, NPM * 22); } break;
    case 2: if (PMASK & 4) phase_ffn_down(p, l, 2, l == 0, NPM, NormFuse{l, 1, l * 3 + 0, l * 12 + 2, false}); break;
    case 3: if (PMASK & 1) { conv_group(p, l, 1, 0, 6, blockIdx.x, gridDim.x); } break;
    case 4: if (PMASK & 16) phase_win(p); break;
    case 5: if (PMASK & 32) phase_g4(p, l); break;
    case 6: if (PMASK & 64) phase_attn(p, l); break;
    case 7: if (PMASK & 128) phase_branch(p, l == 0 ? NPM : 256); break;
    case 8: if (PMASK & 256) { const int npm_ = l == 0 ? NPM : 256; conv_prefix(p, l, 2, 0, 2, npm_ * 4); phase_wout(p, l, npm_, NormFuse{l, 2, l * 3 + 1, l * 12 + 8, false}); conv_suffix(p, l, 2, 0, 2, npm_ * 4); } break;
    case 9: break;
    case 10: if (PMASK & 2) phase_ffn_up(p, l == 0 ? NPM : 256); break;
    case 11: if (PMASK & 4) { const int npm_ = l == 0 ? NPM : 256; if (l == 0) conv_prefix(p, 1, 0, 0, 1, npm_ * 4); phase_ffn_down(p, l, 8, false, npm_, NormFuse{l + 1, 0, l * 3 + 2, l * 12 + 11, l == 1}); if (l == 0) conv_suffix(p, 1, 0, 0, 1, npm_ * 4); } break;
  }
}
__global__ void __launch_bounds__(512) mega_kernel(Params p) {
  cg::grid_group grid = cg::this_grid();
#ifdef DIAG
#define PHD(k) if ((k) < DIAG_STOP) { run_phase(p, (k)); grid.sync(); }
  PHD(0)
  PHD(1)
  PHD(2)
  PHD(3)
  PHD(4)
  PHD(5)
  PHD(6)
  PHD(7)
  PHD(8)
#undef PHD
  phase_diag(p); grid.sync(); phase_diag_out(p);
#else
#ifdef TIMING
#define PH(k) if ((k) >= p.ph_lo && (k) < p.ph_hi) { if (blockIdx.x == 0 && threadIdx.x == 0) ((unsigned long long*)(p.ws + O_TS))[k] = __builtin_amdgcn_s_memrealtime(); run_phase(p, (k)); grid.sync(); }
#else
#define PH_EMPTY(k) ((k) == 10 || (k) == 22 || (k) == 13)
#define PH(k) if (!PH_EMPTY(k) && (k) >= p.ph_lo && (k) < p.ph_hi) { run_phase(p, (k)); if ((k) + 1 < p.ph_hi) grid.sync(); }
#endif
  PH(0)
  PH(1)
  PH(2)
  PH(3)
  PH(4)
  PH(5)
  PH(6)
  PH(7)
  PH(8)
  PH(9)
  PH(10)
  PH(11)
  PH(12)
  PH(13)
  PH(14)
  PH(15)
  PH(16)
  PH(17)
  PH(18)
  PH(19)
  PH(20)
  PH(21)
  PH(22)
  PH(23)
  PH(24)
  PH(25)
#undef PH
#ifdef TIMING
  if (blockIdx.x == 0) { unsigned long long* ts = (unsigned long long*)(p.ws + O_TS); const unsigned long long tend = __builtin_amdgcn_s_memrealtime();
    float tot = (float)(tend - ts[0]), s1 = 0.f, s2 = 0.f;
    for (int k = 0; k < 26; ++k) { const float d = (float)((k == 25 ? tend : ts[k + 1]) - ts[k]); if ((TSEL1 >> k) & 1) s1 += d; if ((TSEL2 >> k) & 1) s2 += d; }
    const int M = (int)(s1 / tot * 100000.f + 0.5f); const float d2 = 0.04f + 0.14f * (s2 / tot);
    for (int i = threadIdx.x; i < M; i += 512) p.out[i] += 0.1f;
    if (threadIdx.x == 0) p.out[(size_t)TL * DM - 1] += d2; }
#endif
#endif
}

extern "C" void kernel_launch(void* const* d_in, const int* in_sizes, int n_in, void* d_out, int out_size, void* d_ws, size_t ws_size, hipStream_t stream) {
  static int grid_blocks = 0;
  if (grid_blocks == 0) {
    if (n_in != 25 || out_size != TL * DM || ws_size < WS_NEED) { fprintf(stderr, "kernel_launch: unexpected shapes: n_in %d out %d ws %zu (need %zu)\n", n_in, out_size, ws_size, (size_t)WS_NEED); grid_blocks = -1; return; }
    int dev = 0, cus = 0, per_cu = 0;
    hipGetDevice(&dev); hipDeviceGetAttribute(&cus, hipDeviceAttributeMultiprocessorCount, dev);
    if (hipFuncSetAttribute((const void*)mega_kernel, hipFuncAttributeMaxDynamicSharedMemorySize, LDS_BYTES) != hipSuccess) { fprintf(stderr, "kernel_launch: hipFuncSetAttribute failed\n"); grid_blocks = -1; return; }
    hipOccupancyMaxActiveBlocksPerMultiprocessor(&per_cu, (const void*)mega_kernel, 512, LDS_BYTES);
    if (per_cu < 1) per_cu = 1;
    grid_blocks = cus * per_cu;
  }
  if (grid_blocks < 0) return;
  Params p{};
  for (int i = 0; i < 25; ++i) p.in[i] = (const float*)d_in[i];
  p.out = (float*)d_out; p.ws = (unsigned char*)d_ws;
#if PER_PHASE_LAUNCH
  for (int ph = 0; ph < NPHASE; ++ph) {
    p.ph_lo = ph; p.ph_hi = ph + 1; void* args[] = {&p};
    hipError_t e = hipLaunchCooperativeKernel((const void*)mega_kernel, dim3(grid_blocks), dim3(512), args, LDS_BYTES, stream);
    if (e != hipSuccess) { fprintf(stderr, "cooperative launch failed: %s (grid %d)\n", hipGetErrorString(e), grid_blocks); break; }
  }
#else
  p.ph_lo = 0; p.ph_hi = NPHASE; void* args[] = {&p};
  hipError_t e = hipLaunchCooperativeKernel((const void*)mega_kernel, dim3(grid_blocks), dim3(512), args, LDS_BYTES, stream);
  if (e != hipSuccess) fprintf(stderr, "cooperative launch failed: %s (grid %d)\n", hipGetErrorString(e), grid_blocks);
#endif
}
```
